# Optimizing an MI355X kernel written in HIP

```python
import jax, jax.numpy as jnp
from jax import lax
import numpy as np

D_MODEL = 1024
BATCH = 8
SEQ = 2048
DEPTH = 2
DEC_BATCH = 128
DEC_SEQ = 8
PAST_LEN = 16384
PAGE_SIZE = 128

N_META = 16
N_EVEN = (DEPTH + 1) // 2
N_ODD = DEPTH // 2
H_A = 4
DK_A = D_MODEL // (2 * H_A)
DV_A = D_MODEL // (2 * H_A)
H_B = 4
DK_B = D_MODEL // (2 * H_B)
DV_B = D_MODEL // (2 * H_B)
DK_C = 128
H_C = D_MODEL // DK_C
DV_C = D_MODEL // H_C
D_FF = 2816
CONV_W = 3
CHUNK_A = 128
CHUNK_B = 128
CHUNK_C = 32
ROPE_BASE = 10000.0
EPS = 1e-6
F_BIAS_LO = 3.0
F_BIAS_HI = 6.0
AB_SIZES = (H_A * DK_A, H_A * DK_A, H_A * DV_A, H_A * DV_A, H_A, H_A, H_B * DK_B, H_B * DK_B, H_B * DV_B, H_B * DV_B)
C_SIZES = (H_C * DK_C, H_C * DK_C, H_C * DV_C, H_C * DV_C)
MIX_AB = H_A * DV_A + H_B * DV_B

kernel_name = 'hybrid_mlstm_retention_hgrn2_convffn_step'


def split_cols(z, sizes):
    out, start = [], 0
    for s in sizes:
        out.append(z[..., start:start + s])
        start += s
    return out


def rms_norm(x, gain):
    xf = x.astype(jnp.float32)
    y = xf * lax.rsqrt(jnp.mean(xf * xf, axis=-1, keepdims=True) + EPS)
    return (y * gain.astype(jnp.float32)).astype(x.dtype)


def head_layer_norm(h, gain):
    mu = jnp.mean(h, axis=-1, keepdims=True)
    c = h - mu
    y = c * lax.rsqrt(jnp.mean(c * c, axis=-1, keepdims=True) + EPS)
    return y.reshape(h.shape[:2] + (-1,)) * gain.astype(jnp.float32)


def head_rms_norm(h, gain):
    y = h * lax.rsqrt(jnp.mean(h * h, axis=-1, keepdims=True) + EPS)
    return y.reshape(h.shape[:2] + (-1,)) * gain.astype(jnp.float32)


def rotary(x, pos):
    half = x.shape[-1] // 2
    inv = 1.0 / (ROPE_BASE ** jnp.linspace(0.0, 1.0, half, dtype=jnp.float32))
    ang = pos[:, None] * inv[None, :]
    cos = jnp.cos(ang)[None, :, None, :]
    sin = jnp.sin(ang)[None, :, None, :]
    x1, x2 = x[..., :half], x[..., half:]
    return jnp.concatenate([x1 * cos - x2 * sin, x2 * cos + x1 * sin], axis=-1)


def run_blocks(step, state, xs, chunk, prompt):
    if not prompt:
        return step(state, *xs)
    state, y_meta = step(state, *(a[:, :N_META] for a in xs))

    def to_chunks(a):
        a = a[:, N_META:]
        bsz, t = a.shape[:2]
        return jnp.moveaxis(a.reshape((bsz, t // chunk, chunk) + a.shape[2:]), 1, 0)

    state, ys = lax.scan(lambda s, c: step(s, *c), state, tuple(to_chunks(a) for a in xs))
    ys = jnp.moveaxis(ys, 0, 1)
    ys = ys.reshape((ys.shape[0], ys.shape[1] * ys.shape[2]) + ys.shape[3:])
    return state, jnp.concatenate([y_meta, ys], axis=1)


def mlstm_block(state, q, k, v, li, lf):
    c0, n0, m0 = state
    L = q.shape[1]
    causal = jnp.tril(jnp.ones((L, L), dtype=bool))
    b = jnp.cumsum(lf, axis=1)
    log_d = b[:, :, None, :] - b[:, None, :, :] + li[:, None, :, :]
    log_d = jnp.where(causal[None, :, :, None], log_d, -jnp.inf)
    log_inter = b + m0[:, None, :]
    m = jnp.maximum(log_inter, jnp.max(log_d, axis=2))
    d = jnp.exp(log_d - m[:, :, None, :])
    inter = jnp.exp(log_inter - m)
    s = jnp.einsum('bthd,bshd->btsh', q, k) * d
    num = jnp.einsum('btsh,bshv->bthv', s, v) + inter[..., None] * jnp.einsum('bthd,bhdv->bthv', q, c0)
    den = jnp.sum(s, axis=2) + inter * jnp.einsum('bthd,bhd->bth', q, n0)
    h = num / jnp.maximum(jnp.abs(den), jnp.exp(-m))[..., None]
    m_new = m[:, -1]
    w = jnp.exp(li + b[:, -1:, :] - b - m_new[:, None, :])
    carry = jnp.exp(log_inter[:, -1] - m_new)
    c_new = carry[..., None, None] * c0 + jnp.einsum('bsh,bshd,bshv->bhdv', w, k, v)
    n_new = carry[..., None] * n0 + jnp.einsum('bsh,bshd->bhd', w, k)
    return (c_new, n_new, m_new), h


def retention_block(s0, q, k, v, log_gamma):
    L = q.shape[1]
    idx = jnp.arange(L, dtype=jnp.float32)
    causal = idx[:, None] >= idx[None, :]
    rel = jnp.where(causal, idx[:, None] - idx[None, :], 0.0)
    decay = jnp.where(causal[..., None], jnp.exp(rel[..., None] * log_gamma), 0.0)
    s = jnp.einsum('bthd,bshd->btsh', q, k) * decay[None]
    inner = jnp.exp((idx + 1.0)[:, None] * log_gamma)
    o = jnp.einsum('btsh,bshv->bthv', s, v) + jnp.einsum('bthd,bhdv->bthv', q, s0) * inner[None, :, :, None]
    tail = jnp.exp((L - 1.0 - idx)[:, None] * log_gamma)
    s_new = jnp.exp(L * log_gamma)[None, :, None, None] * s0 + jnp.einsum('bshd,bshv,sh->bhdv', k, v, tail)
    return s_new, o


def hgrn_block(s0, q, k, v, log_f):
    L = q.shape[1]
    causal = jnp.tril(jnp.ones((L, L), dtype=bool))
    b = jnp.cumsum(log_f, axis=1)
    diff = b[:, :, None] - b[:, None, :]
    decay = jnp.exp(jnp.where(causal[None, :, :, None, None], diff, -jnp.inf))
    a = jnp.einsum('bthc,bshc,btshc->btsh', q, k, decay)
    o = jnp.einsum('btsh,bshv->bthv', a, v) + jnp.einsum('bthc,bhcv->bthv', q * jnp.exp(b), s0)
    b_last = b[:, -1]
    s_new = jnp.exp(b_last)[..., None] * s0 + jnp.einsum('bshc,bshv->bhcv', k * jnp.exp(b_last[:, None] - b), v)
    return s_new, o


def ab_mixer(xn, pos, prompt, w_in, b_i, b_f, g_a, g_b, w_out, state_a, state_b):
    bsz, t = xn.shape[:2]
    q_a, k_a, v_a, o_a, i_a, f_a, q_b, k_b, v_b, g_gate = split_cols(xn @ w_in, AB_SIZES)
    heads = lambda a, h: a.astype(jnp.float32).reshape(bsz, t, h, -1)
    li = i_a.astype(jnp.float32) + b_i.astype(jnp.float32)
    lf = jax.nn.log_sigmoid(f_a.astype(jnp.float32) + b_f.astype(jnp.float32))
    xs_a = (heads(q_a, H_A), heads(k_a, H_A) * DK_A ** -0.5, heads(v_a, H_A), li, lf)
    state_a, h_a = run_blocks(mlstm_block, state_a, xs_a, CHUNK_A, prompt)
    h_a = jax.nn.sigmoid(o_a.astype(jnp.float32)) * head_layer_norm(h_a, g_a)
    log_gamma = jnp.log1p(-jnp.exp2(-5.0 - jnp.arange(H_B, dtype=jnp.float32)))
    ret_step = lambda s, q, k, v: retention_block(s, q, k, v, log_gamma)
    xs_b = (rotary(heads(q_b, H_B), pos), rotary(heads(k_b, H_B), pos) * DK_B ** -0.5, heads(v_b, H_B))
    state_b, h_b = run_blocks(ret_step, state_b, xs_b, CHUNK_B, prompt)
    h_b = jax.nn.silu(g_gate.astype(jnp.float32)) * head_layer_norm(h_b, g_b)
    mixed = jnp.concatenate([h_a, h_b], axis=-1).astype(xn.dtype)
    return mixed @ w_out, state_a, state_b


def hgrn_lower_bound(lb_logits, layer):
    p = jax.nn.softmax(lb_logits.astype(jnp.float32), axis=0)
    return jnp.cumsum(p, axis=0)[layer] - p[0]


def hgrn_mixer(xn, prompt, w_in, lb, gain, w_out, s0):
    bsz, t = xn.shape[:2]
    q, f, i, g = split_cols(xn @ w_in, C_SIZES)
    f = f.astype(jnp.float32)
    log_f = jnp.log(lb + (1.0 - lb) * jax.nn.sigmoid(f))
    k = (1.0 - lb) * jax.nn.sigmoid(-f)
    heads = lambda a, h: a.astype(jnp.float32).reshape(bsz, t, h, -1)
    xs = (heads(q, H_C), heads(k, H_C), heads(i, H_C), heads(log_f, H_C))
    s_new, o = run_blocks(hgrn_block, s0, xs, CHUNK_C, prompt)
    o = head_rms_norm(o, gain) * jax.nn.silu(g.astype(jnp.float32))
    return o.astype(xn.dtype) @ w_out, s_new


def conv_ffn(xn, w_in, conv_w, conv_b, w_out, buf):
    t = xn.shape[1]
    u, gate = jnp.split(xn @ w_in, 2, axis=-1)
    padded = jnp.concatenate([buf.astype(u.dtype), u], axis=1)
    cw = conv_w.astype(jnp.float32)
    conv = conv_b.astype(jnp.float32) + sum(padded[:, j:j + t].astype(jnp.float32) * cw[j] for j in range(CONV_W))
    h = (jax.nn.silu(conv) * gate.astype(jnp.float32)).astype(xn.dtype)
    return h @ w_out, padded[:, t:]


def trunk(x, pos, prompt, st_c, st_n, st_m, st_r, st_s, st_conv,
          norm_mix, w_in_ab, b_igate, b_fgate, gn_mlstm, gn_ret, w_out_ab,
          lb_logits, w_in_c, gn_hgrn, w_out_c,
          norm_ffn, w_ffn_in, conv_w, conv_b, w_ffn_out, norm_final):
    f32 = jnp.float32
    new_c, new_n, new_m, new_r, new_s, new_conv = [], [], [], [], [], []
    for layer in range(DEPTH):
        j = layer // 2
        xn = rms_norm(x, norm_mix[layer])
        if layer % 2 == 0:
            out, (c, n, m), r = ab_mixer(xn, pos, prompt, w_in_ab[j], b_igate[j], b_fgate[j], gn_mlstm[j], gn_ret[j], w_out_ab[j],
                                         (st_c[j].astype(f32), st_n[j].astype(f32), st_m[j].astype(f32)), st_r[j].astype(f32))
            new_c.append(c)
            new_n.append(n)
            new_m.append(m)
            new_r.append(r)
        else:
            lb = hgrn_lower_bound(lb_logits, layer)
            out, s = hgrn_mixer(xn, prompt, w_in_c[j], lb, gn_hgrn[j], w_out_c[j], st_s[j].astype(f32))
            new_s.append(s)
        x = x + out.astype(x.dtype)
        h, buf = conv_ffn(rms_norm(x, norm_ffn[layer]), w_ffn_in[layer], conv_w[layer], conv_b[layer], w_ffn_out[layer], st_conv[layer])
        x = x + h.astype(x.dtype)
        new_conv.append(buf)
    y = rms_norm(x, norm_final)
    return y, jnp.stack(new_c), jnp.stack(new_n), jnp.stack(new_m), jnp.stack(new_r), jnp.stack(new_s), jnp.stack(new_conv)


def setup_inputs(seed: int = 0) -> dict:
    key = jax.random.key(seed)
    ks = jax.random.split(key, 32)
    nrm = lambda k, shape, scale: scale * jax.random.normal(k, shape, jnp.float32)
    ab_width = sum(AB_SIZES)
    c_width = sum(C_SIZES)
    return {
        'x_prompt': nrm(ks[0], (BATCH, SEQ, D_MODEL), 1.0),
        'x_sample': nrm(ks[1], (DEC_BATCH, DEC_SEQ, D_MODEL), 1.0),
        'state_mlstm_C': nrm(ks[2], (N_EVEN, DEC_BATCH, H_A, DK_A, DV_A), 0.1),
        'state_mlstm_n': nrm(ks[3], (N_EVEN, DEC_BATCH, H_A, DK_A), 0.1),
        'state_mlstm_m': nrm(ks[4], (N_EVEN, DEC_BATCH, H_A), 1.0),
        'state_ret_S': nrm(ks[5], (N_EVEN, DEC_BATCH, H_B, DK_B, DV_B), 0.5),
        'state_hgrn_S': nrm(ks[6], (N_ODD, DEC_BATCH, H_C, DK_C, DV_C), 0.5),
        'state_ffn_conv': nrm(ks[7], (DEPTH, DEC_BATCH, CONV_W - 1, D_FF), 1.0),
        'meta_tokens': nrm(ks[8], (N_META, D_MODEL), 1.0),
        'norm_mix': 1.0 + nrm(ks[9], (DEPTH, D_MODEL), 0.02),
        'w_in_ab': nrm(ks[10], (N_EVEN, D_MODEL, ab_width), D_MODEL ** -0.5),
        'b_igate': nrm(ks[11], (N_EVEN, H_A), 0.1),
        'b_fgate': jnp.linspace(F_BIAS_LO, F_BIAS_HI, H_A, dtype=jnp.float32)[None, :] + nrm(ks[12], (N_EVEN, H_A), 0.1),
        'gn_mlstm': 1.0 + nrm(ks[13], (N_EVEN, H_A * DV_A), 0.02),
        'gn_ret': 1.0 + nrm(ks[14], (N_EVEN, H_B * DV_B), 0.02),
        'w_out_ab': nrm(ks[15], (N_EVEN, MIX_AB, D_MODEL), MIX_AB ** -0.5),
        'lb_logits': nrm(ks[16], (DEPTH, H_C * DK_C), 1.0),
        'w_in_c': nrm(ks[17], (N_ODD, D_MODEL, c_width), D_MODEL ** -0.5),
        'gn_hgrn': 1.0 + nrm(ks[18], (N_ODD, H_C * DV_C), 0.02),
        'w_out_c': nrm(ks[19], (N_ODD, H_C * DV_C, D_MODEL), (H_C * DV_C) ** -0.5),
        'norm_ffn': 1.0 + nrm(ks[20], (DEPTH, D_MODEL), 0.02),
        'w_ffn_in': nrm(ks[21], (DEPTH, D_MODEL, 2 * D_FF), D_MODEL ** -0.5),
        'conv_w': nrm(ks[22], (DEPTH, CONV_W, D_FF), CONV_W ** -0.5),
        'conv_b': nrm(ks[23], (DEPTH, D_FF), 0.02),
        'w_ffn_out': nrm(ks[24], (DEPTH, D_FF, D_MODEL), D_FF ** -0.5),
        'norm_final': 1.0 + nrm(ks[25], (D_MODEL,), 0.02),
    }


def reference(x_prompt, x_sample, state_mlstm_C, state_mlstm_n, state_mlstm_m, state_ret_S, state_hgrn_S, state_ffn_conv,
              meta_tokens, norm_mix, w_in_ab, b_igate, b_fgate, gn_mlstm, gn_ret, w_out_ab,
              lb_logits, w_in_c, gn_hgrn, w_out_c, norm_ffn, w_ffn_in, conv_w, conv_b, w_ffn_out, norm_final):
    f32 = jnp.float32
    bp = x_prompt.shape[0]
    meta = jnp.broadcast_to(meta_tokens.astype(x_prompt.dtype)[None], (bp, N_META, D_MODEL))
    xp = jnp.concatenate([meta, x_prompt], axis=1)
    pos_p = jnp.arange(xp.shape[1], dtype=f32)
    pos_s = PAST_LEN + jnp.arange(x_sample.shape[1], dtype=f32)

    yp, cp, n_p, mp, rp, sp, convp = trunk(
        xp, pos_p, True,
        jnp.zeros((N_EVEN, bp, H_A, DK_A, DV_A), f32), jnp.zeros((N_EVEN, bp, H_A, DK_A), f32),
        jnp.zeros((N_EVEN, bp, H_A), f32), jnp.zeros((N_EVEN, bp, H_B, DK_B, DV_B), f32),
        jnp.zeros((N_ODD, bp, H_C, DK_C, DV_C), f32), jnp.zeros((DEPTH, bp, CONV_W - 1, D_FF), x_prompt.dtype),
        norm_mix, w_in_ab, b_igate, b_fgate, gn_mlstm, gn_ret, w_out_ab,
        lb_logits, w_in_c, gn_hgrn, w_out_c, norm_ffn, w_ffn_in, conv_w, conv_b, w_ffn_out, norm_final)

    ys, cs, n_s, ms, rs, ss, convs = trunk(
        x_sample, pos_s, False,
        state_mlstm_C, state_mlstm_n, state_mlstm_m, state_ret_S, state_hgrn_S, state_ffn_conv,
        norm_mix, w_in_ab, b_igate, b_fgate, gn_mlstm, gn_ret, w_out_ab,
        lb_logits, w_in_c, gn_hgrn, w_out_c, norm_ffn, w_ffn_in, conv_w, conv_b, w_ffn_out, norm_final)

    y_prompt = yp[:, N_META:]
    return (y_prompt, ys,
            cp.astype(state_mlstm_C.dtype), cs.astype(state_mlstm_C.dtype),
            n_p.astype(state_mlstm_n.dtype), n_s.astype(state_mlstm_n.dtype),
            mp.astype(state_mlstm_m.dtype), ms.astype(state_mlstm_m.dtype),
            rp.astype(state_ret_S.dtype), rs.astype(state_ret_S.dtype),
            sp.astype(state_hgrn_S.dtype), ss.astype(state_hgrn_S.dtype),
            convp.astype(state_ffn_conv.dtype), convs.astype(state_ffn_conv.dtype))
```

```cpp
#include <hip/hip_runtime.h>
#include <hip/hip_cooperative_groups.h>
#include <cstdio>
#include <cstdint>
namespace cg = cooperative_groups;
#define MK_N_LAUNCHES 17
namespace pg8 {
#define PG8_LAS __attribute__((address_space(3)))
typedef unsigned short bf16_t;
typedef short bf16x8 __attribute__((ext_vector_type(8)));
typedef float f32x4 __attribute__((ext_vector_type(4)));
typedef unsigned u32x4 __attribute__((ext_vector_type(4)));
typedef unsigned u32x2 __attribute__((ext_vector_type(2)));
constexpr int BM = 256, BK = 64, HALF = 128, HTB = HALF * BK * 2  , STAGE_BYTES = 8 * HTB, NXCD = 8, WGM = 8;

__host__ __device__ __forceinline__ int lds_byte(int r, int c) { const int st = (r >> 4) * 2 + (c >> 5), rr = r & 15, cc = c & 31, ob = rr * 64 + cc * 2; return st * 1024 + (ob ^ (((ob >> 9) & 1) << 5)); }
__host__ __device__ __forceinline__ void stage_rc(int b, int& R, int& C) { const int st = b / 1024, sb = b % 1024, swz = sb ^ (((sb >> 9) & 1) << 5); R = (st >> 1) * 16 + swz / 64; C = (st & 1) * 32 + (swz % 64) / 2; }
__host__ __device__ __forceinline__ int perm32(int rho) { const int n = rho >> 4, i = rho & 15; return 8 * (i >> 2) + 4 * n + (i & 3); }

struct Unit { int pm, pn; };
struct Gemm { const bf16_t* A; const bf16_t* Bt; int M, N, K; };

struct StaticOrder {
    int nM, nN, nwg, G, c;
    __host__ __device__ void init(int M, int N, int G_, int c_) { nM = M / BM; nN = N / BM; nwg = nM * nN; G = G_; c = c_; }
    __host__ __device__ bool next(int i, Unit& u) const {
        const long L = (long)i * G + c; if (L >= nwg) return false;
        int wgid = (int)L; { const int q = nwg / NXCD, r = nwg % NXCD, xcd = wgid % NXCD, off = wgid / NXCD; wgid = (xcd < r ? xcd * (q + 1) : r * (q + 1) + (xcd - r) * q) + off; }
        const int nig = WGM * nN, gid = wgid / nig, fm = gid * WGM, gsz = (nM - fm) < WGM ? (nM - fm) : WGM;
        u.pm = fm + ((wgid % nig) % gsz); u.pn = (wgid % nig) / gsz; return true;
    }
    __device__ __forceinline__ void a_ready(const Unit&) const {}
    __device__ __forceinline__ void done(const Unit&) const {}
};

__device__ __forceinline__ unsigned cvt_pk_bf16(float lo, float hi) { unsigned r; asm volatile("v_cvt_pk_bf16_f32 %0, %1, %2" : "=v"(r) : "v"(lo), "v"(hi)); return r; }

struct EpiBf16 {
    static constexpr bool PERM = true, AFTER_DRAIN = false;
    bf16_t* O; int ldc;
    __device__ __forceinline__ void operator()(const f32x4 (&acc)[2][2][4][2], const Unit& u, int wr, int wc, int fr, int fq) const {
        const int row0 = u.pm * BM + wr * 64 + fr; const int col0 = u.pn * BM + wc * 32 + 8 * fq;
#pragma unroll
        for (int ai = 0; ai < 2; ++ai)
#pragma unroll
            for (int m = 0; m < 4; ++m) { bf16_t* rowp = O + (size_t)(row0 + ai * HALF + m * 16) * ldc + col0;
#pragma unroll
                for (int bj = 0; bj < 2; ++bj) { const f32x4 v0 = acc[ai][bj][m][0], v1 = acc[ai][bj][m][1];
                    u32x4 w; w.x = cvt_pk_bf16(v0[0], v0[1]); w.y = cvt_pk_bf16(v0[2], v0[3]); w.z = cvt_pk_bf16(v1[0], v1[1]); w.w = cvt_pk_bf16(v1[2], v1[3]);
                    *(u32x4*)(rowp + bj * HALF) = w; } }
    }
};

struct EpiResid {
    static constexpr bool PERM = false, AFTER_DRAIN = false;
    float* X0; float* X1; int pm_split; int ldc;
    __device__ __forceinline__ void operator()(const f32x4 (&acc)[2][2][4][2], const Unit& u, int wr, int wc, int fr, int fq) const {
        float* C = (u.pm < pm_split) ? X0 : X1;
        const int row0 = u.pm * BM + wr * 64 + fr, col0 = u.pn * BM + wc * 32 + 4 * fq;
#pragma unroll
        for (int ai = 0; ai < 2; ++ai)
#pragma unroll
            for (int m = 0; m < 4; ++m) { float* rowp = C + (size_t)(row0 + ai * HALF + m * 16) * ldc + col0;
                f32x4 t[2][2];
#pragma unroll
                for (int bj = 0; bj < 2; ++bj)
#pragma unroll
                    for (int n = 0; n < 2; ++n) t[bj][n] = *(const f32x4*)(rowp + bj * HALF + n * 16);
#pragma unroll
                for (int bj = 0; bj < 2; ++bj)
#pragma unroll
                    for (int n = 0; n < 2; ++n) *(f32x4*)(rowp + bj * HALF + n * 16) = t[bj][n] + acc[ai][bj][m][n];
                asm volatile("" ::: "memory"); }
    }
};

template <class Epi, class Sched, bool APERM>
__device__ __forceinline__ void gemm_phase(PG8_LAS unsigned char* lds, const Gemm g, const Sched& S, const Epi& E) {
    int tid_ = threadIdx.x; asm volatile("" : "+v"(tid_));
    const int tid = tid_, wid = __builtin_amdgcn_readfirstlane(tid >> 6), lane = tid & 63, wr = wid >> 2, wc = wid & 3, fr = lane & 15, fq = lane >> 4;
    const int K = g.K, nt = K / BK;
    unsigned voffA[2], voffB[2];
#pragma unroll
    for (int i = 0; i < 2; ++i) { int R, C; stage_rc(tid * 16 + i * 8192, R, C); const int Rb = Epi::PERM ? ((R & ~31) + perm32(R & 31)) : R;
        const int Ra = APERM ? (128 * (R >> 6) + 8 * (R & 15) + ((R >> 4) & 3)) : R;
        voffA[i] = (unsigned)(Ra * K + C) * 2u; voffB[i] = (unsigned)(Rb * K + C) * 2u; }
    const size_t kstep = (size_t)(BK * 2);
    const size_t hstep = (size_t)HALF * K * 2;
    const size_t hstepA = APERM ? (size_t)4 * K * 2 : hstep;
    const size_t tstep = 2 * hstep;
    const unsigned ldsw = (unsigned)wid * 1024u;
    const int aoff = lds_byte(wr * 64 + fr, fq * 8), boff = lds_byte(wc * 32 + fr, fq * 8);
#define PG8_SA(b, h) (((b) * 2 + (h)) * HTB)
#define PG8_SB(b, h) ((4 + (b) * 2 + (h)) * HTB)
#define PG8_STAGE(bufoff, gbase, voff) do { _Pragma("unroll") for (int _i = 0; _i < 2; ++_i) \
        __builtin_amdgcn_global_load_lds((const unsigned*)((const char*)(gbase) + (voff)[_i]), (PG8_LAS unsigned*)(lds + (bufoff) + ldsw + _i * 8192), 16, 0, 0); } while (0)
#define PG8_LDA(dst, b, h) do { _Pragma("unroll") for (int m = 0; m < 4; ++m) _Pragma("unroll") for (int k = 0; k < 2; ++k) dst[m][k] = *(const PG8_LAS bf16x8*)(lds + PG8_SA(b, h) + aoff + m * 2048 + k * 1024); } while (0)
#define PG8_LDB(dst, b, h) do { _Pragma("unroll") for (int n = 0; n < 2; ++n) _Pragma("unroll") for (int k = 0; k < 2; ++k) dst[n][k] = *(const PG8_LAS bf16x8*)(lds + PG8_SB(b, h) + boff + n * 2048 + k * 1024); } while (0)
#define PG8_MMA(ai, bj, At, Bt) do { __builtin_amdgcn_s_setprio(1); _Pragma("unroll") for (int m = 0; m < 4; ++m) _Pragma("unroll") for (int n = 0; n < 2; ++n) _Pragma("unroll") for (int k = 0; k < 2; ++k) \
        acc[ai][bj][m][n] = __builtin_amdgcn_mfma_f32_16x16x32_bf16(Bt[n][k], At[m][k], acc[ai][bj][m][n], 0, 0, 0); __builtin_amdgcn_s_setprio(0); } while (0)
#define PG8_WAIT_V(n) asm volatile("s_waitcnt vmcnt(" #n ")" ::: "memory")
#define PG8_WAIT_L(n) asm volatile("s_waitcnt lgkmcnt(" #n ")" ::: "memory")
#define PG8_BAR __builtin_amdgcn_s_barrier()
#define PG8_SCHED __builtin_amdgcn_sched_barrier(0)
    Unit cur, nxt; int ui = 0;
    if (!S.next(0, cur)) return;
    f32x4 acc[2][2][4][2];
#pragma unroll
    for (int a = 0; a < 2; ++a)
#pragma unroll
        for (int b = 0; b < 2; ++b)
#pragma unroll
            for (int m = 0; m < 4; ++m)
#pragma unroll
                for (int n = 0; n < 2; ++n) acc[a][b][m][n] = (f32x4){0.f, 0.f, 0.f, 0.f};
    bf16x8 At[4][2], B0[2][2], B1[2][2];
    const char* cA = (const char*)g.A + (size_t)cur.pm * tstep; const char* cB = (const char*)g.Bt + (size_t)cur.pn * tstep;
    S.a_ready(cur);
    PG8_STAGE(PG8_SB(0, 0), cB, voffB); PG8_STAGE(PG8_SB(0, 1), cB + hstep, voffB); PG8_STAGE(PG8_SA(0, 0), cA, voffA); PG8_STAGE(PG8_SA(0, 1), cA + hstepA, voffA);
    if (wr == 1) PG8_BAR;
    PG8_WAIT_V(2); PG8_BAR;
    PG8_STAGE(PG8_SB(1, 0), cB + kstep, voffB); PG8_STAGE(PG8_SA(1, 0), cA + kstep, voffA); PG8_STAGE(PG8_SB(1, 1), cB + hstep + kstep, voffB);
    PG8_WAIT_V(6); PG8_BAR;
    for (;;) {
        const bool has_next = S.next(ui + 1, nxt);
        const char* nA = has_next ? (const char*)g.A + (size_t)nxt.pm * tstep : cA; const char* nB = has_next ? (const char*)g.Bt + (size_t)nxt.pn * tstep : cB;
        for (int t = 0; t < nt; t += 2) {
            const bool last = (t == nt - 2);
            const char* a1 = cA + (size_t)(t + 1) * kstep;
            const char* a2 = last ? nA : cA + (size_t)(t + 2) * kstep; const char* b2 = last ? nB : cB + (size_t)(t + 2) * kstep;
            const char* a3 = a2 + kstep; const char* b3 = b2 + kstep;
            if (last && has_next) S.a_ready(nxt);
            PG8_LDB(B0, 0, 0); PG8_LDB(B1, 0, 1); PG8_SCHED; PG8_LDA(At, 0, 0); PG8_STAGE(PG8_SA(1, 1), a1 + hstepA, voffA);
            PG8_WAIT_V(8); PG8_WAIT_L(0); PG8_BAR; PG8_MMA(0, 0, At, B0); PG8_MMA(0, 1, At, B1); PG8_BAR; PG8_SCHED;
            PG8_LDA(At, 0, 1); PG8_STAGE(PG8_SB(0, 0), b2, voffB); PG8_STAGE(PG8_SB(0, 1), b2 + hstep, voffB); PG8_STAGE(PG8_SA(0, 0), a2, voffA);
            PG8_WAIT_V(8); PG8_WAIT_L(0); PG8_BAR; PG8_MMA(1, 0, At, B0); PG8_MMA(1, 1, At, B1); PG8_BAR; PG8_SCHED;
            PG8_LDB(B0, 1, 0); PG8_LDB(B1, 1, 1); PG8_SCHED; PG8_LDA(At, 1, 0); PG8_STAGE(PG8_SA(0, 1), a2 + hstepA, voffA);
            PG8_WAIT_V(8); PG8_WAIT_L(0); PG8_BAR; PG8_MMA(0, 0, At, B0); PG8_MMA(0, 1, At, B1); PG8_BAR; PG8_SCHED;
            PG8_LDA(At, 1, 1); PG8_STAGE(PG8_SB(1, 0), b3, voffB); PG8_STAGE(PG8_SB(1, 1), b3 + hstep, voffB); PG8_STAGE(PG8_SA(1, 0), a3, voffA);
            PG8_WAIT_V(8); PG8_WAIT_L(0); PG8_BAR; PG8_MMA(1, 0, At, B0); PG8_MMA(1, 1, At, B1); PG8_BAR; PG8_SCHED;
        }
        if (wr == 0) PG8_BAR;
        E(acc, cur, wr, wc, fr, fq); S.done(cur);
        if (!has_next) break;
#pragma unroll
        for (int a = 0; a < 2; ++a)
#pragma unroll
            for (int b = 0; b < 2; ++b)
#pragma unroll
                for (int m = 0; m < 4; ++m)
#pragma unroll
                    for (int n = 0; n < 2; ++n) acc[a][b][m][n] = (f32x4){0.f, 0.f, 0.f, 0.f};
        cur = nxt; cA = nA; cB = nB; ++ui;
        if (wr == 1) PG8_BAR;
    }
    PG8_WAIT_V(0);
    PG8_BAR;
#undef PG8_SA
#undef PG8_SB
#undef PG8_STAGE
#undef PG8_LDA
#undef PG8_LDB
#undef PG8_MMA
#undef PG8_WAIT_V
#undef PG8_WAIT_L
#undef PG8_BAR
#undef PG8_SCHED
}
}
constexpr int DM = 1024;
constexpr int ROW_S = 16384;
constexpr int ROW_M = 17408;
constexpr int NREAL = 17424;
constexpr int MPAD = 17664;
constexpr int PM_META = 68;
constexpr int NAB = 4096, NCC = 4096, DFF = 2816, NFF = 5632, ABW = 4104;
constexpr int NGRP = 138, GRP_META = 136;
constexpr float EPS = 1e-6f;
constexpr float KSCALE = 0.08838834764831845f;

constexpr size_t O_YP = 0, O_YS = 16777216, O_CP = 17825792, O_CS = 18350080, O_NP = 26738688, O_NS = 26742784, O_MP = 26808320, O_MS = 26808352,
                 O_RP = 26808864, O_RS = 27333152, O_HP = 35721760, O_HS = 36770336, O_FP = 53547552, O_FS = 53637664, O_END = 55079456;

constexpr size_t MiB = 1u << 20;
constexpr size_t WS_CTL = 0, CTL_ZERO_BYTES = 1 * MiB;
constexpr size_t WS_WAB = 1 * MiB, WS_WOAB = 9 * MiB, WS_WC = 11 * MiB, WS_WOC = 19 * MiB, WS_WF1 = 21 * MiB  , WS_WF2 = 43 * MiB  ;
constexpr size_t WS_XN = 54 * MiB;
constexpr size_t WS_Z = 89 * MiB;
constexpr size_t WS_XM = 227 * MiB;
constexpr size_t WS_G = 228 * MiB;
constexpr size_t WS_SBL = 229 * MiB;
constexpr size_t WS_SBF = 233 * MiB;
constexpr size_t WS_END = 240 * MiB;
static_assert(WS_XN + (size_t)MPAD * DM * 2 <= WS_Z && WS_Z + (size_t)MPAD * 4096 * 2 <= WS_XM && WS_SBL + (size_t)NGRP * 2 * DFF * 4 <= WS_SBF && WS_SBF + (size_t)NGRP * 4 * DFF * 4 <= WS_END, "ws map");

constexpr int LDS_BYTES = 147456;
constexpr int NWAVES = 8;

#define GAS __attribute__((address_space(1)))
#define LAS __attribute__((address_space(3)))
typedef unsigned short bf16;
typedef float f32x4 __attribute__((ext_vector_type(4)));
typedef unsigned u32x2 __attribute__((ext_vector_type(2)));
typedef unsigned u32x4 __attribute__((ext_vector_type(4)));
#define LDS_WAIT() asm volatile("s_waitcnt lgkmcnt(0)" ::: "memory")

__device__ __forceinline__ unsigned f2bf(float f) { unsigned u = __builtin_bit_cast(unsigned, f); return (u + 0x7fffu + ((u >> 16) & 1u)) >> 16; }
__device__ __forceinline__ unsigned pk2(float lo, float hi) { return f2bf(lo) | (f2bf(hi) << 16); }
__device__ __forceinline__ float bf2f(unsigned short b) { return __builtin_bit_cast(float, ((unsigned)b) << 16); }
__device__ __forceinline__ float bflo(unsigned w) { return __builtin_bit_cast(float, w << 16); }
__device__ __forceinline__ float bfhi(unsigned w) { return __builtin_bit_cast(float, w & 0xffff0000u); }
__device__ __forceinline__ f32x4 ld_bf4(const bf16* p) { const u32x2 w = *(const u32x2*)p; return (f32x4){bflo(w.x), bfhi(w.x), bflo(w.y), bfhi(w.y)}; }
__device__ __forceinline__ float wave_sum(float v) {
#pragma unroll
    for (int o = 1; o < 64; o <<= 1) v += __shfl_xor(v, o);
    return v;
}
__device__ __forceinline__ float half_sum(float v) {
#pragma unroll
    for (int o = 1; o < 32; o <<= 1) v += __shfl_xor(v, o);
    return v;
}
__device__ __forceinline__ float sigmoidf_(float x) { return 1.f / (1.f + __expf(-x)); }
__device__ __forceinline__ float siluf_(float x) { return x / (1.f + __expf(-x)); }
__device__ __forceinline__ float logsigmoidf_(float x) { return fminf(x, 0.f) - log1pf(__expf(-fabsf(x))); }

struct Args { const float* in[26]; float* out; unsigned char* ws; int ph_lo, ph_hi; };

struct Frame {
    LAS unsigned char* lds;
    int tid, lane, wave, G, gw, NGW;
    const float* const* in; float* out; unsigned char* ws;
    float* X0; float* X1;
    bf16* XN; bf16* Z; float* Gt; float* SBL; float* SBF;
};
__device__ __forceinline__ float* xrow(const Frame& F, int r) { return (r < ROW_M ? F.X0 : F.X1) + (size_t)r * DM; }

__device__ __forceinline__ void p0_transpose_item(const float* W, int K, int Nsrc, int n0src, bf16* WT, int dstrow0, LAS float* scr, int kb, int lane) {
    const int k0 = 64 * kb;
#pragma unroll 8
    for (int i = 0; i < 32; ++i) { const int kk = 2 * i + (lane >> 5); scr[kk * 33 + (lane & 31)] = W[(size_t)(k0 + kk) * Nsrc + n0src + (lane & 31)]; }
    LDS_WAIT(); asm volatile("" ::: "memory");
    const int c = lane & 7;
#pragma unroll
    for (int j = 0; j < 4; ++j) { const int n = (lane >> 3) + 8 * j; const LAS float* s = scr + (8 * c) * 33 + n;
        u32x4 o; o.x = pk2(s[0 * 33], s[1 * 33]); o.y = pk2(s[2 * 33], s[3 * 33]); o.z = pk2(s[4 * 33], s[5 * 33]); o.w = pk2(s[6 * 33], s[7 * 33]);
        *(u32x4*)(WT + (size_t)(dstrow0 + n) * K + k0 + 8 * c) = o; }
    LDS_WAIT(); asm volatile("" ::: "memory");
}

__device__ __forceinline__ void p0_weights(Frame& F) {
    LAS float* scr = (LAS float*)(F.lds + F.wave * 16384);
    constexpr int I_AB = 16 * 128, I_O = 16 * 32, I_C = 16 * 128, I_F1 = 16 * 176, I_F2 = 44 * 32;
    constexpr int NIT = I_AB + I_O + I_C + I_O + 2 * I_F1 + 2 * I_F2;
    for (int it = F.gw; it < NIT; it += F.NGW) {
        int r = it;
        if (r < I_AB) { const int kb = r / 128, nb = r % 128; p0_transpose_item(F.in[10], 1024, ABW, nb < 64 ? 32 * nb : 32 * nb + 8, (bf16*)(F.ws + WS_WAB), 32 * nb, scr, kb, F.lane); continue; } r -= I_AB;
        if (r < I_O) { const int kb = r / 32, nb = r % 32; p0_transpose_item(F.in[15], 1024, 1024, 32 * nb, (bf16*)(F.ws + WS_WOAB), 32 * nb, scr, kb, F.lane); continue; } r -= I_O;
        if (r < I_C) { const int kb = r / 128, nb = r % 128; p0_transpose_item(F.in[17], 1024, 4096, 32 * nb, (bf16*)(F.ws + WS_WC), 32 * nb, scr, kb, F.lane); continue; } r -= I_C;
        if (r < I_O) { const int kb = r / 32, nb = r % 32; p0_transpose_item(F.in[19], 1024, 1024, 32 * nb, (bf16*)(F.ws + WS_WOC), 32 * nb, scr, kb, F.lane); continue; } r -= I_O;
        if (r < 2 * I_F1) { const int l = r / I_F1; r -= l * I_F1; const int kb = r / 176, nb = r % 176; const int c = 32 * nb;
            const int ch = c < DFF ? c : c - DFF; const int dst = 256 * (ch / 128) + (c < DFF ? 0 : 128) + (ch % 128);
            p0_transpose_item(F.in[21] + (size_t)l * 1024 * NFF, 1024, NFF, c, (bf16*)(F.ws + WS_WF1) + (size_t)l * NFF * 1024, dst, scr, kb, F.lane); continue; } r -= 2 * I_F1;
        { const int l = r / I_F2; r -= l * I_F2; const int kb = r / 32, nb = r % 32;
            p0_transpose_item(F.in[24] + (size_t)l * DFF * 1024, DFF, 1024, 32 * nb, (bf16*)(F.ws + WS_WF2) + (size_t)l * 1024 * DFF, 32 * nb, scr, kb, F.lane); }
    }
}

__device__ __forceinline__ void p0_rows(Frame& F) {
    LAS float* wg = (LAS float*)F.lds;
    for (int i = F.tid; i < 8192; i += NWAVES * 64) { const int k = i >> 3, c = i & 7; wg[c * 1024 + k] = F.in[10][(size_t)k * ABW + 2048 + c]; }
    __syncthreads();
    const float* gain = F.in[9];
    for (int r = F.gw; r < MPAD; r += F.NGW) {
        const float* src = nullptr;
        if (r < ROW_S) src = F.in[0] + (size_t)r * DM; else if (r < ROW_M) src = F.in[1] + (size_t)(r - ROW_S) * DM; else if (r < NREAL) src = F.in[8] + (size_t)(r - ROW_M) * DM;
        f32x4 v[4]; float ss = 0.f;
#pragma unroll
        for (int j = 0; j < 4; ++j) { v[j] = src ? *(const f32x4*)(src + 4 * F.lane + 256 * j) : (f32x4){0.f, 0.f, 0.f, 0.f}; ss += (v[j].x * v[j].x + v[j].y * v[j].y) + (v[j].z * v[j].z + v[j].w * v[j].w); }
        const float rs = rsqrtf(wave_sum(ss) * (1.f / DM) + EPS);
        float* xr = xrow(F, r); bf16* xn = F.XN + (size_t)r * DM;
        float ga[8];
#pragma unroll
        for (int c = 0; c < 8; ++c) ga[c] = 0.f;
#pragma unroll
        for (int j = 0; j < 4; ++j) {
            *(f32x4*)(xr + 4 * F.lane + 256 * j) = v[j];
            const f32x4 gn = *(const f32x4*)(gain + 4 * F.lane + 256 * j);
            const f32x4 y = v[j] * rs * gn;
            u32x2 w; w.x = pk2(y.x, y.y); w.y = pk2(y.z, y.w);
            *(u32x2*)(xn + 4 * F.lane + 256 * j) = w;
#pragma unroll
            for (int c = 0; c < 8; ++c) { const f32x4 wv = *(const LAS f32x4*)(wg + c * 1024 + 4 * F.lane + 256 * j); ga[c] += (y.x * wv.x + y.y * wv.y) + (y.z * wv.z + y.w * wv.w); }
        }
#pragma unroll
        for (int c = 0; c < 8; ++c) ga[c] = wave_sum(ga[c]);
        if (F.lane == 0) { *(f32x4*)(F.Gt + (size_t)r * 8) = (f32x4){ga[0], ga[1], ga[2], ga[3]}; *(f32x4*)(F.Gt + (size_t)r * 8 + 4) = (f32x4){ga[4], ga[5], ga[6], ga[7]}; }
    }
}

__device__ __forceinline__ void rms_rows(Frame& F, const float* gain) {
    for (int r = F.gw; r < NREAL; r += F.NGW) {
        const float* xr = xrow(F, r); f32x4 v[4]; float ss = 0.f;
#pragma unroll
        for (int j = 0; j < 4; ++j) { v[j] = *(const f32x4*)(xr + 4 * F.lane + 256 * j); ss += (v[j].x * v[j].x + v[j].y * v[j].y) + (v[j].z * v[j].z + v[j].w * v[j].w); }
        const float rs = rsqrtf(wave_sum(ss) * (1.f / DM) + EPS);
        bf16* xn = F.XN + (size_t)r * DM;
#pragma unroll
        for (int j = 0; j < 4; ++j) { const f32x4 gn = *(const f32x4*)(gain + 4 * F.lane + 256 * j); const f32x4 y = v[j] * rs * gn;
            u32x2 w; w.x = pk2(y.x, y.y); w.y = pk2(y.z, y.w); *(u32x2*)(xn + 4 * F.lane + 256 * j) = w; }
    }
}
__device__ __forceinline__ void rms_final(Frame& F, const float* gain) {
    for (int r = F.gw; r < ROW_M; r += F.NGW) {
        float* xr = F.X0 + (size_t)r * DM; f32x4 v[4]; float ss = 0.f;
#pragma unroll
        for (int j = 0; j < 4; ++j) { v[j] = *(const f32x4*)(xr + 4 * F.lane + 256 * j); ss += (v[j].x * v[j].x + v[j].y * v[j].y) + (v[j].z * v[j].z + v[j].w * v[j].w); }
        const float rs = rsqrtf(wave_sum(ss) * (1.f / DM) + EPS);
#pragma unroll
        for (int j = 0; j < 4; ++j) { const f32x4 gn = *(const f32x4*)(gain + 4 * F.lane + 256 * j); *(f32x4*)(xr + 4 * F.lane + 256 * j) = v[j] * rs * gn; }
    }
}

struct EpiFfn {
    static constexpr bool PERM = true, AFTER_DRAIN = false;
    bf16* H; const float* cw; const float* cb; const float* cst; float* cso; float* sbl; float* sbf;
    __device__ __forceinline__ void operator()(const f32x4 (&acc)[2][2][4][2], const pg8::Unit& u, int wr, int wc, int fr, int fq) const {
        const int ch0 = 128 * u.pn + 32 * wc + 8 * fq;
        const int tok0 = 256 * u.pm + 128 * wr + 8 * fr;
        const int grp = 2 * u.pm + wr;
        const bool samp = (u.pm >= 64 && u.pm < PM_META), meta = (u.pm == PM_META);
        const int sb = 32 * (u.pm - 64) + 16 * wr + fr;
        const bool defer = (!samp && !meta && fr == 0);
        const bool lastlane = meta ? (wr == 0 && fr == 1) : (!samp && fr == 15);
#pragma unroll
        for (int n = 0; n < 2; ++n) {
            const int c4 = ch0 + 4 * n;
            const f32x4 w0 = *(const f32x4*)(cw + c4), w1 = *(const f32x4*)(cw + DFF + c4), w2 = *(const f32x4*)(cw + 2 * DFF + c4), bb = *(const f32x4*)(cb + c4);
            f32x4 p6, p7;
#pragma unroll
            for (int e = 0; e < 4; ++e) { p6[e] = __shfl_up(acc[1][0][2][n][e], 1, 16); p7[e] = __shfl_up(acc[1][0][3][n][e], 1, 16); }
            if (samp) { p6 = *(const f32x4*)(cst + (size_t)(sb * 2 + 0) * DFF + c4); p7 = *(const f32x4*)(cst + (size_t)(sb * 2 + 1) * DFF + c4); }
            if (meta && wr == 0 && fr == 0) { p6 = (f32x4){0.f, 0.f, 0.f, 0.f}; p7 = p6; }
#pragma unroll
            for (int k = 0; k < 8; ++k) {
                const f32x4 uk = acc[k >> 2][0][k & 3][n], gk = acc[k >> 2][1][k & 3][n];
                const f32x4 um1 = (k >= 1) ? acc[(k - 1 < 0 ? 0 : k - 1) >> 2][0][(k - 1 < 0 ? 0 : k - 1) & 3][n] : p7;
                const f32x4 um2 = (k >= 2) ? acc[(k - 2 < 0 ? 0 : k - 2) >> 2][0][(k - 2 < 0 ? 0 : k - 2) & 3][n] : (k == 1 ? p7 : p6);
                const f32x4 cv = bb + w0 * um2 + w1 * um1 + w2 * uk;
                f32x4 hv;
#pragma unroll
                for (int e = 0; e < 4; ++e) hv[e] = siluf_(cv[e]) * gk[e];
                if (defer && k < 2) {
                    *(f32x4*)(sbf + (size_t)((grp * 2 + k) * 2 + 0) * DFF + c4) = uk;
                    *(f32x4*)(sbf + (size_t)((grp * 2 + k) * 2 + 1) * DFF + c4) = gk;
                } else {
                    u32x2 w; w.x = pg8::cvt_pk_bf16(hv[0], hv[1]); w.y = pg8::cvt_pk_bf16(hv[2], hv[3]);
                    *(u32x2*)(H + (size_t)(tok0 + k) * DFF + c4) = w;
                }
            }
            if (lastlane) { *(f32x4*)(sbl + (size_t)(grp * 2 + 0) * DFF + c4) = acc[1][0][2][n]; *(f32x4*)(sbl + (size_t)(grp * 2 + 1) * DFF + c4) = acc[1][0][3][n]; }
            if (samp) { *(f32x4*)(cso + (size_t)(sb * 2 + 0) * DFF + c4) = acc[1][0][2][n]; *(f32x4*)(cso + (size_t)(sb * 2 + 1) * DFF + c4) = acc[1][0][3][n]; }
        }
    }
};

__device__ __forceinline__ void ffn_fixup(Frame& F, int layer) {
    const float* cw = F.in[22] + (size_t)layer * 3 * DFF; const float* cb = F.in[23] + (size_t)layer * DFF;
    bf16* H = F.Z;
    const int gt = blockIdx.x * (NWAVES * 64) + F.tid, NT = F.G * NWAVES * 64;
    for (int i = gt; i < 128 * DFF; i += NT) {
        const int grp = i / DFF, ch = i - grp * DFF;
        const int r0 = 128 * grp;
        const int pg = (r0 % 2048 == 0) ? GRP_META : grp - 1;
        const float um2 = F.SBL[(size_t)(pg * 2 + 0) * DFF + ch], um1 = F.SBL[(size_t)(pg * 2 + 1) * DFF + ch];
        const float u0 = F.SBF[(size_t)((grp * 2 + 0) * 2 + 0) * DFF + ch], g0 = F.SBF[(size_t)((grp * 2 + 0) * 2 + 1) * DFF + ch];
        const float u1 = F.SBF[(size_t)((grp * 2 + 1) * 2 + 0) * DFF + ch], g1 = F.SBF[(size_t)((grp * 2 + 1) * 2 + 1) * DFF + ch];
        const float w0 = cw[ch], w1 = cw[DFF + ch], w2 = cw[2 * DFF + ch], bb = cb[ch];
        const float c0 = bb + w0 * um2 + w1 * um1 + w2 * u0, c1 = bb + w0 * um1 + w1 * u0 + w2 * u1;
        H[(size_t)r0 * DFF + ch] = (bf16)f2bf(siluf_(c0) * g0);
        H[(size_t)(r0 + 1) * DFF + ch] = (bf16)f2bf(siluf_(c1) * g1);
    }
    float* fo = F.out + O_FP + (size_t)layer * 8 * 2 * DFF;
    for (int i = gt; i < 8 * 2 * DFF; i += NT) {
        const int b = i / (2 * DFF), rem = i - b * 2 * DFF, j = rem / DFF, ch = rem - j * DFF;
        const int grp = 2 * (8 * b + 7) + 1;
        fo[i] = F.SBL[(size_t)(grp * 2 + j) * DFF + ch];
    }
}
template <int TYPE>
__device__ __forceinline__ void mixer_unit(Frame& F, int b, int h, bool prompt) {
    const int tid = F.tid, dv = tid & 127, g = __builtin_amdgcn_readfirstlane(tid >> 7), tk = tid >> 5, j = tid & 31;
    LAS float* L = (LAS float*)F.lds;
    LAS float* sq = L; LAS float* sk = L + 2048; LAS float* sa = L + 4096; LAS float* sv = L + 6144; LAS float* red = L + 8192; LAS float* rdn = L + 16384;
    LAS float* sc_li = L + 16448; LAS float* sc_lf = sc_li + 16; LAS float* sc_al = sc_li + 32; LAS float* sc_be = sc_li + 48; LAS float* sc_em = sc_li + 64; LAS float* sc_m = sc_li + 80;
    const bf16* Z = F.Z; bf16* MIX = F.XN;
    constexpr int NH = (TYPE == 2) ? 8 : 4;
    float s[32], nn[32]; float mprev = 0.f;
#pragma unroll
    for (int i = 0; i < 32; ++i) { s[i] = 0.f; nn[i] = 0.f; }
    if (!prompt) {
        const float* Sin = (TYPE == 0 ? F.in[2] : TYPE == 1 ? F.in[5] : F.in[6]) + (size_t)(b * NH + h) * 16384;
#pragma unroll
        for (int i = 0; i < 32; ++i) s[i] = Sin[(32 * g + i) * 128 + dv];
        if (TYPE == 0) {
#pragma unroll
            for (int i = 0; i < 32; ++i) nn[i] = F.in[3][(size_t)(b * 4 + h) * 128 + 32 * g + i];
            mprev = F.in[4][b * 4 + h];
        }
    }
    float lbv[4] = {0.f, 0.f, 0.f, 0.f};
    if (TYPE == 2) {
#pragma unroll
        for (int e = 0; e < 4; ++e) { const int c = 128 * h + 4 * j + e; lbv[e] = sigmoidf_(F.in[16][1024 + c] - F.in[16][c]); }
    }
    const float gamma = (TYPE == 1) ? (1.f - exp2f(-5.f - (float)h)) : 1.f;
    const int nbatch = prompt ? 129 : 1;
    for (int bi = 0; bi < nbatch; ++bi) {
        int row0, ntok; float pos0;
        if (prompt) { ntok = 16; if (bi == 0) { row0 = ROW_M; pos0 = 0.f; } else { row0 = b * 2048 + (bi - 1) * 16; pos0 = 16.f + (float)((bi - 1) * 16); } }
        else { ntok = 8; row0 = ROW_S + 8 * b; pos0 = 16384.f; }
        {
            const bool valid = tk < ntok; const int row = row0 + (valid ? tk : 0);
            const bf16* zr = Z + (size_t)row * 4096;
            f32x4 q4 = {0.f, 0.f, 0.f, 0.f}, k4 = q4, v4 = q4, a4 = {1.f, 1.f, 1.f, 1.f};
            if (TYPE == 0) {
                if (valid) { q4 = ld_bf4(zr + 128 * h + 4 * j); k4 = ld_bf4(zr + 512 + 128 * h + 4 * j) * KSCALE; v4 = ld_bf4(zr + 1024 + 128 * h + 4 * j); }
                if (j == 0) { float li = -1e30f, lf = 0.f;
                    if (valid) { li = F.Gt[(size_t)row * 8 + h] + F.in[11][h]; lf = logsigmoidf_(F.Gt[(size_t)row * 8 + 4 + h] + F.in[12][h]); }
                    sc_li[tk] = li; sc_lf[tk] = lf; }
                *(LAS f32x4*)(sq + tk * 128 + 4 * j) = q4; *(LAS f32x4*)(sk + tk * 128 + 4 * j) = k4; *(LAS f32x4*)(sv + tk * 128 + 4 * j) = v4;
            } else if (TYPE == 1) {
                if (valid) v4 = ld_bf4(zr + 3072 + 128 * h + 4 * j);
                *(LAS f32x4*)(sv + tk * 128 + 4 * j) = v4;
                if (j < 16) {
                    f32x4 q1 = q4, q2 = q4, k1 = q4, k2 = q4;
                    if (valid) { q1 = ld_bf4(zr + 2048 + 128 * h + 4 * j); q2 = ld_bf4(zr + 2048 + 128 * h + 64 + 4 * j); k1 = ld_bf4(zr + 2560 + 128 * h + 4 * j); k2 = ld_bf4(zr + 2560 + 128 * h + 64 + 4 * j); }
                    const float pos = pos0 + (float)tk;
                    f32x4 qo1, qo2, ko1, ko2;
#pragma unroll
                    for (int e = 0; e < 4; ++e) {
                        const float inv = 1.0f / powf(10000.0f, (float)(4 * j + e) * (1.0f / 63.0f));
                        const float ang = pos * inv; float sn, cs; sincosf(ang, &sn, &cs);
                        qo1[e] = q1[e] * cs - q2[e] * sn; qo2[e] = q2[e] * cs + q1[e] * sn;
                        ko1[e] = (k1[e] * cs - k2[e] * sn) * KSCALE; ko2[e] = (k2[e] * cs + k1[e] * sn) * KSCALE;
                    }
                    *(LAS f32x4*)(sq + tk * 128 + 4 * j) = qo1; *(LAS f32x4*)(sq + tk * 128 + 64 + 4 * j) = qo2;
                    *(LAS f32x4*)(sk + tk * 128 + 4 * j) = ko1; *(LAS f32x4*)(sk + tk * 128 + 64 + 4 * j) = ko2;
                }
            } else {
                if (valid) {
                    q4 = ld_bf4(zr + 128 * h + 4 * j); const f32x4 f4 = ld_bf4(zr + 1024 + 128 * h + 4 * j); v4 = ld_bf4(zr + 2048 + 128 * h + 4 * j);
#pragma unroll
                    for (int e = 0; e < 4; ++e) { const float sg = sigmoidf_(f4[e]); a4[e] = lbv[e] + (1.f - lbv[e]) * sg; k4[e] = (1.f - lbv[e]) * (1.f - sg); }
                }
                *(LAS f32x4*)(sq + tk * 128 + 4 * j) = q4; *(LAS f32x4*)(sk + tk * 128 + 4 * j) = k4; *(LAS f32x4*)(sv + tk * 128 + 4 * j) = v4; *(LAS f32x4*)(sa + tk * 128 + 4 * j) = a4;
            }
        }
        __syncthreads();
        if (TYPE == 0) {
            if (tid == 0) { float m = mprev;
                for (int t = 0; t < 16; ++t) { float al = 1.f, be = 0.f;
                    if (t < ntok) { const float li = sc_li[t], lf = sc_lf[t]; const float mn = fmaxf(lf + m, li); al = __expf(lf + m - mn); be = __expf(li - mn); m = mn; }
                    sc_al[t] = al; sc_be[t] = be; sc_em[t] = __expf(-m); }
                sc_m[0] = m; }
            __syncthreads();
            mprev = sc_m[0];
        }
        for (int t = 0; t < ntok; ++t) {
            float al = (TYPE == 1) ? gamma : 1.f, be = 1.f;
            if (TYPE == 0) { al = sc_al[t]; be = sc_be[t]; }
            const float kv = sv[t * 128 + dv] * be;
            float po = 0.f, pd = 0.f;
#pragma unroll
            for (int i4 = 0; i4 < 8; ++i4) {
                const f32x4 qq = *(const LAS f32x4*)(sq + t * 128 + 32 * g + 4 * i4), kk = *(const LAS f32x4*)(sk + t * 128 + 32 * g + 4 * i4);
                f32x4 aa = {al, al, al, al};
                if (TYPE == 2) aa = *(const LAS f32x4*)(sa + t * 128 + 32 * g + 4 * i4);
#pragma unroll
                for (int e = 0; e < 4; ++e) { const int i = 4 * i4 + e;
                    s[i] = aa[e] * s[i] + kk[e] * kv; po += qq[e] * s[i];
                    if (TYPE == 0) { nn[i] = al * nn[i] + be * kk[e]; pd += qq[e] * nn[i]; } }
            }
            red[(t * 4 + g) * 128 + dv] = po;
            if (TYPE == 0 && dv == 0) rdn[t * 4 + g] = pd;
        }
        __syncthreads();
        {
            const bool valid = tk < ntok; const int row = row0 + (valid ? tk : 0);
            f32x4 o = *(const LAS f32x4*)(red + (tk * 4 + 0) * 128 + 4 * j) + *(const LAS f32x4*)(red + (tk * 4 + 1) * 128 + 4 * j) + *(const LAS f32x4*)(red + (tk * 4 + 2) * 128 + 4 * j) + *(const LAS f32x4*)(red + (tk * 4 + 3) * 128 + 4 * j);
            if (!valid) o = (f32x4){0.f, 0.f, 0.f, 0.f};
            const bf16* zr = Z + (size_t)row * 4096;
            f32x4 y;
            if (TYPE == 0) {
                const float den = (rdn[tk * 4 + 0] + rdn[tk * 4 + 1]) + (rdn[tk * 4 + 2] + rdn[tk * 4 + 3]);
                const float dn = fmaxf(fabsf(den), sc_em[tk]);
                o = o / dn;
            }
            if (TYPE == 2) {
                const float ms = half_sum((o.x * o.x + o.y * o.y) + (o.z * o.z + o.w * o.w)) * (1.f / 128.f);
                y = o * rsqrtf(ms + EPS);
            } else {
                const float mu = half_sum((o.x + o.y) + (o.z + o.w)) * (1.f / 128.f);
                const f32x4 c = o - mu;
                const float var = half_sum((c.x * c.x + c.y * c.y) + (c.z * c.z + c.w * c.w)) * (1.f / 128.f);
                y = c * rsqrtf(var + EPS);
            }
            if (valid) {
                f32x4 gn, gt; int mcol;
                if (TYPE == 0) { gn = *(const f32x4*)(F.in[13] + 128 * h + 4 * j); gt = ld_bf4(zr + 1536 + 128 * h + 4 * j); mcol = 128 * h + 4 * j;
#pragma unroll
                    for (int e = 0; e < 4; ++e) gt[e] = sigmoidf_(gt[e]); }
                else if (TYPE == 1) { gn = *(const f32x4*)(F.in[14] + 128 * h + 4 * j); gt = ld_bf4(zr + 3584 + 128 * h + 4 * j); mcol = 512 + 128 * h + 4 * j;
#pragma unroll
                    for (int e = 0; e < 4; ++e) gt[e] = siluf_(gt[e]); }
                else { gn = *(const f32x4*)(F.in[18] + 128 * h + 4 * j); gt = ld_bf4(zr + 3072 + 128 * h + 4 * j); mcol = 128 * h + 4 * j;
#pragma unroll
                    for (int e = 0; e < 4; ++e) gt[e] = siluf_(gt[e]); }
                const f32x4 r = y * gn * gt;
                u32x2 w; w.x = pk2(r.x, r.y); w.y = pk2(r.z, r.w);
                *(u32x2*)(MIX + (size_t)row * DM + mcol) = w;
            }
        }
        __syncthreads();
    }
    {
        float* So; float* No = nullptr; float* Mo = nullptr;
        if (TYPE == 0) { So = F.out + (prompt ? O_CP : O_CS) + (size_t)(b * 4 + h) * 16384; No = F.out + (prompt ? O_NP : O_NS) + (size_t)(b * 4 + h) * 128; Mo = F.out + (prompt ? O_MP : O_MS) + (b * 4 + h); }
        else if (TYPE == 1) So = F.out + (prompt ? O_RP : O_RS) + (size_t)(b * 4 + h) * 16384;
        else So = F.out + (prompt ? O_HP : O_HS) + (size_t)(b * 8 + h) * 16384;
#pragma unroll
        for (int i = 0; i < 32; ++i) So[(32 * g + i) * 128 + dv] = s[i];
        if (TYPE == 0) { if (dv == 0) {
#pragma unroll
                for (int i = 0; i < 32; ++i) No[32 * g + i] = nn[i]; }
            if (tid == 0) *Mo = mprev; }
    }
}

__device__ __forceinline__ void mixer_layer0(Frame& F) {
    constexpr int NU = 64 + 1024;
    for (int u = blockIdx.x; u < NU; u += F.G) {
        if (u < 64) { const int ty = u >> 5, bh = u & 31; if (ty == 0) mixer_unit<0>(F, bh >> 2, bh & 3, true); else mixer_unit<1>(F, bh >> 2, bh & 3, true); }
        else { const int su = u - 64, ty = su >> 9, bh = su & 511; if (ty == 0) mixer_unit<0>(F, bh >> 2, bh & 3, false); else mixer_unit<1>(F, bh >> 2, bh & 3, false); }
    }
}
__device__ __forceinline__ void mixer_layer1(Frame& F) {
    constexpr int NU = 64 + 1024;
    for (int u = blockIdx.x; u < NU; u += F.G) {
        if (u < 64) mixer_unit<2>(F, u >> 3, u & 7, true);
        else { const int su = u - 64; mixer_unit<2>(F, su >> 3, su & 7, false); }
    }
}
constexpr int NPHASE = 17;
#ifndef MK_N_LAUNCHES
#define MK_N_LAUNCHES 1
#endif

__global__ void __launch_bounds__(NWAVES * 64, 2) fwd_kernel(Args args) {
    extern __shared__ __attribute__((aligned(16))) unsigned char lds_raw[];
    cg::grid_group grid = cg::this_grid();
    Frame F;
    F.lds = (LAS unsigned char*)lds_raw;
#define REFRESH() do { int t_ = threadIdx.x; asm volatile("" : "+v"(t_)); F.tid = t_; F.lane = t_ & 63; F.wave = __builtin_amdgcn_readfirstlane(t_ >> 6); F.gw = blockIdx.x * NWAVES + F.wave; } while (0)
    F.G = gridDim.x; F.NGW = F.G * NWAVES; REFRESH();
    F.in = args.in; F.out = args.out; F.ws = args.ws;
    F.X0 = args.out; F.X1 = (float*)(args.ws + WS_XM) - (size_t)ROW_M * DM;
    F.XN = (bf16*)(args.ws + WS_XN); F.Z = (bf16*)(args.ws + WS_Z); F.Gt = (float*)(args.ws + WS_G); F.SBL = (float*)(args.ws + WS_SBL); F.SBF = (float*)(args.ws + WS_SBF);
    const int lo = args.ph_lo, hi = args.ph_hi;
#ifndef KMASK
#define KMASK 0x1ff
#endif
#define IN(k) (lo <= (k) && (k) < hi)
#define INK(kind, k) ((((KMASK) >> (kind)) & 1) && IN(k))
#define SEAM(k) do { if (IN(k) && IN((k) + 1)) { grid.sync(); } } while (0)

    if (INK(0, 0)) { p0_weights(F); __syncthreads(); REFRESH(); p0_rows(F); }
    SEAM(0);
#pragma unroll 1
    for (int layer = 0; layer < 2; ++layer) {
        const int pb = 1 + 8 * layer;
        if (INK(1, pb)) {
            pg8::Gemm g{F.XN, (const bf16*)(args.ws + (layer == 0 ? WS_WAB : WS_WC)), MPAD, 4096, 1024}; pg8::StaticOrder S; S.init(MPAD, 4096, F.G, (int)blockIdx.x);
            pg8::EpiBf16 E{F.Z, 4096};
            pg8::gemm_phase<pg8::EpiBf16, pg8::StaticOrder, false>(F.lds, g, S, E);
        }
        SEAM(pb);
        if (INK(2, pb + 1)) { REFRESH(); if (layer == 0) mixer_layer0(F); else mixer_layer1(F); }
        SEAM(pb + 1);
        if (INK(3, pb + 2)) {
            pg8::Gemm g{F.XN, (const bf16*)(args.ws + (layer == 0 ? WS_WOAB : WS_WOC)), MPAD, 1024, 1024}; pg8::StaticOrder S; S.init(MPAD, 1024, F.G, (int)blockIdx.x);
            pg8::EpiResid E{F.X0, F.X1, PM_META, DM};
            pg8::gemm_phase<pg8::EpiResid, pg8::StaticOrder, false>(F.lds, g, S, E);
        }
        SEAM(pb + 2);
        if (INK(4, pb + 3)) { REFRESH(); rms_rows(F, F.in[20] + (size_t)layer * DM); }
        SEAM(pb + 3);
        if (INK(5, pb + 4)) {
            pg8::Gemm g{F.XN, (const bf16*)(args.ws + WS_WF1) + (size_t)layer * NFF * 1024, MPAD, NFF, 1024}; pg8::StaticOrder S; S.init(MPAD, NFF, F.G, (int)blockIdx.x);
            EpiFfn E{F.Z, F.in[22] + (size_t)layer * 3 * DFF, F.in[23] + (size_t)layer * DFF, F.in[7] + (size_t)layer * 128 * 2 * DFF, F.out + O_FS + (size_t)layer * 128 * 2 * DFF, F.SBL, F.SBF};
            pg8::gemm_phase<EpiFfn, pg8::StaticOrder, true>(F.lds, g, S, E);
        }
        SEAM(pb + 4);
        if (INK(6, pb + 5)) { REFRESH(); ffn_fixup(F, layer); }
        SEAM(pb + 5);
        if (INK(7, pb + 6)) {
            pg8::Gemm g{F.Z, (const bf16*)(args.ws + WS_WF2) + (size_t)layer * 1024 * DFF, MPAD, 1024, DFF}; pg8::StaticOrder S; S.init(MPAD, 1024, F.G, (int)blockIdx.x);
            pg8::EpiResid E{F.X0, F.X1, PM_META, DM};
            pg8::gemm_phase<pg8::EpiResid, pg8::StaticOrder, false>(F.lds, g, S, E);
        }
        SEAM(pb + 6);
        if (INK(8, pb + 7)) { REFRESH(); if (layer == 0) rms_rows(F, F.in[9] + DM); else rms_final(F, F.in[25]); }
        SEAM(pb + 7);
    }
#undef IN
#undef REFRESH
#undef INK
#undef SEAM
}

extern "C" void kernel_launch(void* const* d_in, const int* in_sizes, int n_in, void* d_out, int out_size, void* d_ws, size_t ws_size, hipStream_t stream) {
    static int grid = 0;
    if (grid == 0) {
        if (n_in != 26 || (size_t)out_size != O_END || ws_size < WS_END) { fprintf(stderr, "kernel_launch: unexpected shapes: n_in %d out %d ws %zu\n", n_in, out_size, ws_size); grid = -1; return; }
        int dev = 0, cus = 0, per_cu = 0;
        if (hipGetDevice(&dev) != hipSuccess || hipDeviceGetAttribute(&cus, hipDeviceAttributeMultiprocessorCount, dev) != hipSuccess) { grid = -1; return; }
        if (hipFuncSetAttribute((const void*)fwd_kernel, hipFuncAttributeMaxDynamicSharedMemorySize, LDS_BYTES) != hipSuccess) { fprintf(stderr, "kernel_launch: hipFuncSetAttribute failed\n"); grid = -1; return; }
        if (hipOccupancyMaxActiveBlocksPerMultiprocessor(&per_cu, (const void*)fwd_kernel, NWAVES * 64, LDS_BYTES) != hipSuccess || per_cu < 1) { fprintf(stderr, "kernel_launch: occupancy query says %d\n", per_cu); per_cu = 1; }
        (void)hipGetLastError();
        grid = cus;
    }
    if (grid < 0) return;
    Args a{};
    for (int i = 0; i < 26; ++i) a.in[i] = (const float*)d_in[i];
    a.out = (float*)d_out; a.ws = (unsigned char*)d_ws;
#if MK_N_LAUNCHES == 1
    a.ph_lo = 0; a.ph_hi = NPHASE;
    void* kargs[] = {&a};
    hipError_t e = hipLaunchCooperativeKernel((const void*)fwd_kernel, dim3(grid), dim3(NWAVES * 64), kargs, LDS_BYTES, stream);
    if (e != hipSuccess) fprintf(stderr, "kernel_launch: cooperative launch failed: %s (grid %d)\n", hipGetErrorString(e), grid);
#else
    for (int p = 0; p < NPHASE; ++p) {
        a.ph_lo = p; a.ph_hi = p + 1;
        hipLaunchKernelGGL(fwd_kernel, dim3(grid), dim3(NWAVES * 64), LDS_BYTES, stream, a);
    }
#endif
}
```

```cpp
#include <hip/hip_runtime.h>
#include <hip/hip_cooperative_groups.h>
#include <cstdio>
#include <cstdint>
namespace cg = cooperative_groups;
#define MK_N_LAUNCHES 1
namespace pg8 {
#define PG8_LAS __attribute__((address_space(3)))
typedef unsigned short bf16_t;
typedef short bf16x8 __attribute__((ext_vector_type(8)));
typedef float f32x4 __attribute__((ext_vector_type(4)));
typedef unsigned u32x4 __attribute__((ext_vector_type(4)));
typedef unsigned u32x2 __attribute__((ext_vector_type(2)));
constexpr int BM = 256, BK = 64, HALF = 128, HTB = HALF * BK * 2  , STAGE_BYTES = 8 * HTB, NXCD = 8, WGM = 8;

__host__ __device__ __forceinline__ int lds_byte(int r, int c) { const int st = (r >> 4) * 2 + (c >> 5), rr = r & 15, cc = c & 31, ob = rr * 64 + cc * 2; return st * 1024 + (ob ^ (((ob >> 9) & 1) << 5)); }
__host__ __device__ __forceinline__ void stage_rc(int b, int& R, int& C) { const int st = b / 1024, sb = b % 1024, swz = sb ^ (((sb >> 9) & 1) << 5); R = (st >> 1) * 16 + swz / 64; C = (st & 1) * 32 + (swz % 64) / 2; }
__host__ __device__ __forceinline__ int perm32(int rho) { const int n = rho >> 4, i = rho & 15; return 8 * (i >> 2) + 4 * n + (i & 3); }

struct Unit { int pm, pn; };
struct Gemm { const bf16_t* A; const bf16_t* Bt; int M, N, K; };

struct StaticOrder {
    int nM, nN, nwg, G, c;
    __host__ __device__ void init(int M, int N, int G_, int c_) { nM = M / BM; nN = N / BM; nwg = nM * nN; G = G_; c = c_; }
    __host__ __device__ bool next(int i, Unit& u) const {
        const long L = (long)i * G + c; if (L >= nwg) return false;
        int wgid = (int)L; { const int q = nwg / NXCD, r = nwg % NXCD, xcd = wgid % NXCD, off = wgid / NXCD; wgid = (xcd < r ? xcd * (q + 1) : r * (q + 1) + (xcd - r) * q) + off; }
        const int nig = WGM * nN, gid = wgid / nig, fm = gid * WGM, gsz = (nM - fm) < WGM ? (nM - fm) : WGM;
        u.pm = fm + ((wgid % nig) % gsz); u.pn = (wgid % nig) / gsz; return true;
    }
    __device__ __forceinline__ void a_ready(const Unit&) const {}
    __device__ __forceinline__ void done(const Unit&) const {}
};

__device__ __forceinline__ unsigned cvt_pk_bf16(float lo, float hi) { unsigned r; asm volatile("v_cvt_pk_bf16_f32 %0, %1, %2" : "=v"(r) : "v"(lo), "v"(hi)); return r; }

__device__ __forceinline__ float row_rs(const float* ssq, int row, int fq) {
    const f32x4 a = *(const f32x4*)(ssq + (size_t)row * 16 + 4 * fq);
    float s = (a[0] + a[1]) + (a[2] + a[3]); s += __shfl_xor(s, 16); s += __shfl_xor(s, 32);
    return __builtin_amdgcn_rsqf(s * (1.0f / 1024.0f) + 1e-6f);
}
struct EpiBf16 {
    static constexpr bool PERM = true, AFTER_DRAIN = false;
    bf16_t* O; int ldc; const float* ssq;
    __device__ __forceinline__ void operator()(f32x4 (&acc)[2][2][4][2], const Unit& u, int wr, int wc, int fr, int fq) const {
        const int row0 = u.pm * BM + wr * 64 + fr; const int col0 = u.pn * BM + wc * 32 + 8 * fq;
#pragma unroll
        for (int ai = 0; ai < 2; ++ai)
#pragma unroll
            for (int m = 0; m < 4; ++m) { const int row = row0 + ai * HALF + m * 16; bf16_t* rowp = O + (size_t)row * ldc + col0;
                const float rs = ssq ? row_rs(ssq, row, fq) : 1.0f;
#pragma unroll
                for (int bj = 0; bj < 2; ++bj) { const f32x4 v0 = acc[ai][bj][m][0] * rs, v1 = acc[ai][bj][m][1] * rs;
                    u32x4 w; w.x = cvt_pk_bf16(v0[0], v0[1]); w.y = cvt_pk_bf16(v0[2], v0[3]); w.z = cvt_pk_bf16(v1[0], v1[1]); w.w = cvt_pk_bf16(v1[2], v1[3]);
                    *(u32x4*)(rowp + bj * HALF) = w; } }
    }
};

struct EpiResid {
    static constexpr bool PERM = false, AFTER_DRAIN = false;
    float* X0; float* X1; int pm_split; int ldc; bf16_t* XG; const float* gain; float* ssq;
    __device__ __forceinline__ void operator()(f32x4 (&acc)[2][2][4][2], const Unit& u, int wr, int wc, int fr, int fq) const {
        float* C = (u.pm < pm_split) ? X0 : X1;
        const int row0 = u.pm * BM + wr * 64 + fr, col0 = u.pn * BM + wc * 32 + 4 * fq;
        f32x4 gv[2][2];
#pragma unroll
        for (int bj = 0; bj < 2; ++bj)
#pragma unroll
            for (int n = 0; n < 2; ++n) gv[bj][n] = XG ? *(const f32x4*)(gain + col0 + bj * HALF + n * 16) : (f32x4){0.f, 0.f, 0.f, 0.f};
#pragma unroll
        for (int ai = 0; ai < 2; ++ai)
#pragma unroll
            for (int m = 0; m < 4; ++m) { const int row = row0 + ai * HALF + m * 16; float* rowp = C + (size_t)row * ldc + col0;
                f32x4 t[2][2]; float sq = 0.f;
#pragma unroll
                for (int bj = 0; bj < 2; ++bj)
#pragma unroll
                    for (int n = 0; n < 2; ++n) t[bj][n] = *(const f32x4*)(rowp + bj * HALF + n * 16);
#pragma unroll
                for (int bj = 0; bj < 2; ++bj)
#pragma unroll
                    for (int n = 0; n < 2; ++n) { const f32x4 v = t[bj][n] + acc[ai][bj][m][n]; *(f32x4*)(rowp + bj * HALF + n * 16) = v;
                        sq += (v[0] * v[0] + v[1] * v[1]) + (v[2] * v[2] + v[3] * v[3]);
                        if (XG) { const f32x4 y = v * gv[bj][n]; u32x2 w; w.x = cvt_pk_bf16(y[0], y[1]); w.y = cvt_pk_bf16(y[2], y[3]); *(u32x2*)(XG + (size_t)row * ldc + col0 + bj * HALF + n * 16) = w; } }
                if (XG) { sq += __shfl_xor(sq, 16); sq += __shfl_xor(sq, 32); if (fq == 0) ssq[(size_t)row * 16 + u.pn * 4 + wc] = sq; }
                asm volatile("" ::: "memory"); }
    }
};

template <class Epi, class Sched, bool APERM>
__device__ __forceinline__ void gemm_phase(PG8_LAS unsigned char* lds, const Gemm g, const Sched& S, const Epi& E) {
    int tid_ = threadIdx.x; asm volatile("" : "+v"(tid_));
    const int tid = tid_, wid = __builtin_amdgcn_readfirstlane(tid >> 6), lane = tid & 63, wr = wid >> 2, wc = wid & 3, fr = lane & 15, fq = lane >> 4;
    const int K = g.K, nt = K / BK;
    unsigned voffA[2], voffB[2];
#pragma unroll
    for (int i = 0; i < 2; ++i) { int R, C; stage_rc(tid * 16 + i * 8192, R, C); const int Rb = Epi::PERM ? ((R & ~31) + perm32(R & 31)) : R;
        const int Ra = APERM ? (128 * (R >> 6) + 8 * (R & 15) + ((R >> 4) & 3)) : R;
        voffA[i] = (unsigned)(Ra * K + C) * 2u; voffB[i] = (unsigned)(Rb * K + C) * 2u; }
    const size_t kstep = (size_t)(BK * 2);
    const size_t hstep = (size_t)HALF * K * 2;
    const size_t hstepA = APERM ? (size_t)4 * K * 2 : hstep;
    const size_t tstep = 2 * hstep;
    const unsigned ldsw = (unsigned)wid * 1024u;
    const int aoff = lds_byte(wr * 64 + fr, fq * 8), boff = lds_byte(wc * 32 + fr, fq * 8);
#define PG8_SA(b, h) (((b) * 2 + (h)) * HTB)
#define PG8_SB(b, h) ((4 + (b) * 2 + (h)) * HTB)
#define PG8_STAGE(bufoff, gbase, voff) do { _Pragma("unroll") for (int _i = 0; _i < 2; ++_i) \
        __builtin_amdgcn_global_load_lds((const unsigned*)((const char*)(gbase) + (voff)[_i]), (PG8_LAS unsigned*)(lds + (bufoff) + ldsw + _i * 8192), 16, 0, 0); } while (0)
#define PG8_LDA(dst, b, h) do { _Pragma("unroll") for (int m = 0; m < 4; ++m) _Pragma("unroll") for (int k = 0; k < 2; ++k) dst[m][k] = *(const PG8_LAS bf16x8*)(lds + PG8_SA(b, h) + aoff + m * 2048 + k * 1024); } while (0)
#define PG8_LDB(dst, b, h) do { _Pragma("unroll") for (int n = 0; n < 2; ++n) _Pragma("unroll") for (int k = 0; k < 2; ++k) dst[n][k] = *(const PG8_LAS bf16x8*)(lds + PG8_SB(b, h) + boff + n * 2048 + k * 1024); } while (0)
#define PG8_MMA(ai, bj, At, Bt) do { __builtin_amdgcn_s_setprio(1); _Pragma("unroll") for (int m = 0; m < 4; ++m) _Pragma("unroll") for (int n = 0; n < 2; ++n) _Pragma("unroll") for (int k = 0; k < 2; ++k) \
        acc[ai][bj][m][n] = __builtin_amdgcn_mfma_f32_16x16x32_bf16(Bt[n][k], At[m][k], acc[ai][bj][m][n], 0, 0, 0); __builtin_amdgcn_s_setprio(0); } while (0)
#define PG8_WAIT_V(n) asm volatile("s_waitcnt vmcnt(" #n ")" ::: "memory")
#define PG8_WAIT_L(n) asm volatile("s_waitcnt lgkmcnt(" #n ")" ::: "memory")
#define PG8_BAR __builtin_amdgcn_s_barrier()
#define PG8_SCHED __builtin_amdgcn_sched_barrier(0)
    Unit cur, nxt; int ui = 0;
    if (!S.next(0, cur)) return;
    f32x4 acc[2][2][4][2];
#pragma unroll
    for (int a = 0; a < 2; ++a)
#pragma unroll
        for (int b = 0; b < 2; ++b)
#pragma unroll
            for (int m = 0; m < 4; ++m)
#pragma unroll
                for (int n = 0; n < 2; ++n) acc[a][b][m][n] = (f32x4){0.f, 0.f, 0.f, 0.f};
    bf16x8 At[4][2], B0[2][2], B1[2][2];
    const char* cA = (const char*)g.A + (size_t)cur.pm * tstep; const char* cB = (const char*)g.Bt + (size_t)cur.pn * tstep;
    S.a_ready(cur);
    PG8_STAGE(PG8_SB(0, 0), cB, voffB); PG8_STAGE(PG8_SB(0, 1), cB + hstep, voffB); PG8_STAGE(PG8_SA(0, 0), cA, voffA); PG8_STAGE(PG8_SA(0, 1), cA + hstepA, voffA);
    if (wr == 1) PG8_BAR;
    PG8_WAIT_V(2); PG8_BAR;
    PG8_STAGE(PG8_SB(1, 0), cB + kstep, voffB); PG8_STAGE(PG8_SA(1, 0), cA + kstep, voffA); PG8_STAGE(PG8_SB(1, 1), cB + hstep + kstep, voffB);
    PG8_WAIT_V(6); PG8_BAR;
    for (;;) {
        const bool has_next = S.next(ui + 1, nxt);
        const char* nA = has_next ? (const char*)g.A + (size_t)nxt.pm * tstep : cA; const char* nB = has_next ? (const char*)g.Bt + (size_t)nxt.pn * tstep : cB;
        for (int t = 0; t < nt; t += 2) {
            const bool last = (t == nt - 2);
            const char* a1 = cA + (size_t)(t + 1) * kstep;
            const char* a2 = last ? nA : cA + (size_t)(t + 2) * kstep; const char* b2 = last ? nB : cB + (size_t)(t + 2) * kstep;
            const char* a3 = a2 + kstep; const char* b3 = b2 + kstep;
            if (last && has_next) S.a_ready(nxt);
            PG8_LDB(B0, 0, 0); PG8_LDB(B1, 0, 1); PG8_SCHED; PG8_LDA(At, 0, 0); PG8_STAGE(PG8_SA(1, 1), a1 + hstepA, voffA);
            PG8_WAIT_V(8); PG8_WAIT_L(0); PG8_BAR; PG8_MMA(0, 0, At, B0); PG8_MMA(0, 1, At, B1); PG8_BAR; PG8_SCHED;
            PG8_LDA(At, 0, 1); PG8_STAGE(PG8_SB(0, 0), b2, voffB); PG8_STAGE(PG8_SB(0, 1), b2 + hstep, voffB); PG8_STAGE(PG8_SA(0, 0), a2, voffA);
            PG8_WAIT_V(8); PG8_WAIT_L(0); PG8_BAR; PG8_MMA(1, 0, At, B0); PG8_MMA(1, 1, At, B1); PG8_BAR; PG8_SCHED;
            PG8_LDB(B0, 1, 0); PG8_LDB(B1, 1, 1); PG8_SCHED; PG8_LDA(At, 1, 0); PG8_STAGE(PG8_SA(0, 1), a2 + hstepA, voffA);
            PG8_WAIT_V(8); PG8_WAIT_L(0); PG8_BAR; PG8_MMA(0, 0, At, B0); PG8_MMA(0, 1, At, B1); PG8_BAR; PG8_SCHED;
            PG8_LDA(At, 1, 1); PG8_STAGE(PG8_SB(1, 0), b3, voffB); PG8_STAGE(PG8_SB(1, 1), b3 + hstep, voffB); PG8_STAGE(PG8_SA(1, 0), a3, voffA);
            PG8_WAIT_V(8); PG8_WAIT_L(0); PG8_BAR; PG8_MMA(1, 0, At, B0); PG8_MMA(1, 1, At, B1); PG8_BAR; PG8_SCHED;
        }
        if (wr == 0) PG8_BAR;
        E(acc, cur, wr, wc, fr, fq); S.done(cur);
        if (!has_next) break;
#pragma unroll
        for (int a = 0; a < 2; ++a)
#pragma unroll
            for (int b = 0; b < 2; ++b)
#pragma unroll
                for (int m = 0; m < 4; ++m)
#pragma unroll
                    for (int n = 0; n < 2; ++n) acc[a][b][m][n] = (f32x4){0.f, 0.f, 0.f, 0.f};
        cur = nxt; cA = nA; cB = nB; ++ui;
        if (wr == 1) PG8_BAR;
    }
    PG8_WAIT_V(0);
    PG8_BAR;
#undef PG8_SA
#undef PG8_SB
#undef PG8_STAGE
#undef PG8_LDA
#undef PG8_LDB
#undef PG8_MMA
#undef PG8_WAIT_V
#undef PG8_WAIT_L
#undef PG8_BAR
#undef PG8_SCHED
}
}
constexpr int DM = 1024;
constexpr int ROW_S = 16384;
constexpr int ROW_M = 17408;
constexpr int NREAL = 17424;
constexpr int MPAD = 17664;
constexpr int PM_META = 68;
constexpr int NAB = 4096, NCC = 4096, DFF = 2816, NFF = 5632, ABW = 4104;
constexpr int NGRP = 138, GRP_META = 136;
constexpr float EPS = 1e-6f;
constexpr float KSCALE = 0.08838834764831845f;

constexpr size_t O_YP = 0, O_YS = 16777216, O_CP = 17825792, O_CS = 18350080, O_NP = 26738688, O_NS = 26742784, O_MP = 26808320, O_MS = 26808352,
                 O_RP = 26808864, O_RS = 27333152, O_HP = 35721760, O_HS = 36770336, O_FP = 53547552, O_FS = 53637664, O_END = 55079456;

constexpr size_t MiB = 1u << 20;
constexpr size_t WS_CTL = 0, CTL_ZERO_BYTES = 1 * MiB;
constexpr size_t WS_WAB = 1 * MiB, WS_WOAB = 9 * MiB, WS_WC = 11 * MiB, WS_WOC = 19 * MiB, WS_WF1 = 21 * MiB  , WS_WF2 = 43 * MiB  ;
constexpr size_t WS_XN = 54 * MiB;
constexpr size_t WS_Z = 89 * MiB;
constexpr size_t WS_XM = 227 * MiB;
constexpr size_t WS_G = 228 * MiB;
constexpr size_t WS_SBL = 229 * MiB;
constexpr size_t WS_SBF = 233 * MiB;
constexpr size_t WS_ROT = 240 * MiB;
constexpr size_t WS_XG = 242 * MiB;
constexpr size_t WS_SSQ = 277 * MiB;
constexpr size_t WS_END = 279 * MiB;
static_assert(WS_XN + (size_t)MPAD * DM * 2 <= WS_Z && WS_Z + (size_t)MPAD * 4096 * 2 <= WS_XM && WS_SBL + (size_t)NGRP * 2 * DFF * 4 <= WS_SBF && WS_SBF + (size_t)NGRP * 4 * DFF * 4 <= WS_END, "ws map");

constexpr int LDS_BYTES = 147456;
constexpr int NWAVES = 8;

#define GAS __attribute__((address_space(1)))
#define LAS __attribute__((address_space(3)))
typedef unsigned short bf16;
typedef float f32x4 __attribute__((ext_vector_type(4)));
typedef unsigned u32x2 __attribute__((ext_vector_type(2)));
typedef unsigned u32x4 __attribute__((ext_vector_type(4)));
#define LDS_WAIT() asm volatile("s_waitcnt lgkmcnt(0)" ::: "memory")

__device__ __forceinline__ unsigned f2bf(float f) { unsigned u = __builtin_bit_cast(unsigned, f); return (u + 0x7fffu + ((u >> 16) & 1u)) >> 16; }
__device__ __forceinline__ unsigned pk2(float lo, float hi) { return f2bf(lo) | (f2bf(hi) << 16); }
__device__ __forceinline__ float bf2f(unsigned short b) { return __builtin_bit_cast(float, ((unsigned)b) << 16); }
__device__ __forceinline__ float bflo(unsigned w) { return __builtin_bit_cast(float, w << 16); }
__device__ __forceinline__ float bfhi(unsigned w) { return __builtin_bit_cast(float, w & 0xffff0000u); }
__device__ __forceinline__ f32x4 ld_bf4(const bf16* p) { const u32x2 w = *(const u32x2*)p; return (f32x4){bflo(w.x), bfhi(w.x), bflo(w.y), bfhi(w.y)}; }
__device__ __forceinline__ float wave_sum(float v) {
#pragma unroll
    for (int o = 1; o < 64; o <<= 1) v += __shfl_xor(v, o);
    return v;
}
__device__ __forceinline__ float half_sum(float v) {
#pragma unroll
    for (int o = 1; o < 32; o <<= 1) v += __shfl_xor(v, o);
    return v;
}
__device__ __forceinline__ float sigmoidf_(float x) { return 1.f / (1.f + __expf(-x)); }
__device__ __forceinline__ float siluf_(float x) { return x / (1.f + __expf(-x)); }
__device__ __forceinline__ float logsigmoidf_(float x) { return fminf(x, 0.f) - log1pf(__expf(-fabsf(x))); }

struct Args { const float* in[26]; float* out; unsigned char* ws; int ph_lo, ph_hi; };

struct Frame {
    LAS unsigned char* lds;
    int tid, lane, wave, G, gw, NGW;
    const float* const* in; float* out; unsigned char* ws;
};
#define F_X0(F) ((F).out)
#define F_X1(F) ((float*)((F).ws + WS_XM) - (size_t)ROW_M * DM)
#define F_XN(F) ((bf16*)((F).ws + WS_XN))
#define F_XG(F) ((bf16*)((F).ws + WS_XG))
#define F_SSQ(F) ((float*)((F).ws + WS_SSQ))
#define F_Z(F) ((bf16*)((F).ws + WS_Z))
#define F_GT(F) ((float*)((F).ws + WS_G))
#define F_SBL(F) ((float*)((F).ws + WS_SBL))
#define F_SBF(F) ((float*)((F).ws + WS_SBF))
__device__ __forceinline__ float* xrow(const Frame& F, int r) { return (r < ROW_M ? F_X0(F) : F_X1(F)) + (size_t)r * DM; }

__device__ __forceinline__ void p0_transpose_item(const float* W, int K, int Nsrc, int n0src, bf16* WT, int dstrow0, LAS float* scr, int kb, int lane) {
    const int k0 = 64 * kb;
#pragma unroll 8
    for (int i = 0; i < 32; ++i) { const int kk = 2 * i + (lane >> 5); scr[kk * 33 + (lane & 31)] = W[(size_t)(k0 + kk) * Nsrc + n0src + (lane & 31)]; }
    LDS_WAIT(); asm volatile("" ::: "memory");
    const int c = lane & 7;
#pragma unroll
    for (int j = 0; j < 4; ++j) { const int n = (lane >> 3) + 8 * j; const LAS float* s = scr + (8 * c) * 33 + n;
        u32x4 o; o.x = pk2(s[0 * 33], s[1 * 33]); o.y = pk2(s[2 * 33], s[3 * 33]); o.z = pk2(s[4 * 33], s[5 * 33]); o.w = pk2(s[6 * 33], s[7 * 33]);
        *(u32x4*)(WT + (size_t)(dstrow0 + n) * K + k0 + 8 * c) = o; }
    LDS_WAIT(); asm volatile("" ::: "memory");
}

__device__ __forceinline__ void p0_weights(Frame& F) {
    LAS float* scr = (LAS float*)(F.lds + F.wave * 16384);
    constexpr int I_AB = 16 * 128, I_O = 16 * 32, I_C = 16 * 128, I_F1 = 16 * 176, I_F2 = 44 * 32;
    constexpr int NIT = I_AB + I_O + I_C + I_O + 2 * I_F1 + 2 * I_F2;
    for (int it = F.gw; it < NIT; it += F.NGW) {
        int r = it;
        if (r < I_AB) { const int kb = r / 128, nb = r % 128; p0_transpose_item(F.in[10], 1024, ABW, nb < 64 ? 32 * nb : 32 * nb + 8, (bf16*)(F.ws + WS_WAB), 32 * nb, scr, kb, F.lane); continue; } r -= I_AB;
        if (r < I_O) { const int kb = r / 32, nb = r % 32; p0_transpose_item(F.in[15], 1024, 1024, 32 * nb, (bf16*)(F.ws + WS_WOAB), 32 * nb, scr, kb, F.lane); continue; } r -= I_O;
        if (r < I_C) { const int kb = r / 128, nb = r % 128; p0_transpose_item(F.in[17], 1024, 4096, 32 * nb, (bf16*)(F.ws + WS_WC), 32 * nb, scr, kb, F.lane); continue; } r -= I_C;
        if (r < I_O) { const int kb = r / 32, nb = r % 32; p0_transpose_item(F.in[19], 1024, 1024, 32 * nb, (bf16*)(F.ws + WS_WOC), 32 * nb, scr, kb, F.lane); continue; } r -= I_O;
        if (r < 2 * I_F1) { const int l = r / I_F1; r -= l * I_F1; const int kb = r / 176, nb = r % 176; const int c = 32 * nb;
            const int ch = c < DFF ? c : c - DFF; const int dst = 256 * (ch / 128) + (c < DFF ? 0 : 128) + (ch % 128);
            p0_transpose_item(F.in[21] + (size_t)l * 1024 * NFF, 1024, NFF, c, (bf16*)(F.ws + WS_WF1) + (size_t)l * NFF * 1024, dst, scr, kb, F.lane); continue; } r -= 2 * I_F1;
        { const int l = r / I_F2; r -= l * I_F2; const int kb = r / 32, nb = r % 32;
            p0_transpose_item(F.in[24] + (size_t)l * DFF * 1024, DFF, 1024, 32 * nb, (bf16*)(F.ws + WS_WF2) + (size_t)l * 1024 * DFF, 32 * nb, scr, kb, F.lane); }
    }
}

__device__ __forceinline__ void p0_rows(Frame& F) {
    LAS float* wg = (LAS float*)F.lds;
    for (int i = F.tid; i < 8192; i += NWAVES * 64) { const int k = i >> 3, c = i & 7; wg[c * 1024 + k] = F.in[10][(size_t)k * ABW + 2048 + c]; }
    __syncthreads();
    const float* gain = F.in[9];
    for (int r = F.gw; r < MPAD; r += F.NGW) {
        const float* src = nullptr;
        if (r < ROW_S) src = F.in[0] + (size_t)r * DM; else if (r < ROW_M) src = F.in[1] + (size_t)(r - ROW_S) * DM; else if (r < NREAL) src = F.in[8] + (size_t)(r - ROW_M) * DM;
        f32x4 v[4]; float ss = 0.f;
#pragma unroll
        for (int j = 0; j < 4; ++j) { v[j] = src ? *(const f32x4*)(src + 4 * F.lane + 256 * j) : (f32x4){0.f, 0.f, 0.f, 0.f}; ss += (v[j].x * v[j].x + v[j].y * v[j].y) + (v[j].z * v[j].z + v[j].w * v[j].w); }
        const float rs = rsqrtf(wave_sum(ss) * (1.f / DM) + EPS);
        float* xr = xrow(F, r); bf16* xn = F_XG(F) + (size_t)r * DM;
        float ga[8];
#pragma unroll
        for (int c = 0; c < 8; ++c) ga[c] = 0.f;
#pragma unroll
        for (int j = 0; j < 4; ++j) {
            *(f32x4*)(xr + 4 * F.lane + 256 * j) = v[j];
            const f32x4 gn = *(const f32x4*)(gain + 4 * F.lane + 256 * j);
            const f32x4 y = v[j] * rs * gn;
            u32x2 w; w.x = pk2(y.x, y.y); w.y = pk2(y.z, y.w);
            *(u32x2*)(xn + 4 * F.lane + 256 * j) = w;
#pragma unroll
            for (int c = 0; c < 8; ++c) { const f32x4 wv = *(const LAS f32x4*)(wg + c * 1024 + 4 * F.lane + 256 * j); ga[c] += (y.x * wv.x + y.y * wv.y) + (y.z * wv.z + y.w * wv.w); }
        }
#pragma unroll
        for (int c = 0; c < 8; ++c) ga[c] = wave_sum(ga[c]);
        if (F.lane == 0) { *(f32x4*)(F_GT(F) + (size_t)r * 8) = (f32x4){ga[0], ga[1], ga[2], ga[3]}; *(f32x4*)(F_GT(F) + (size_t)r * 8 + 4) = (f32x4){ga[4], ga[5], ga[6], ga[7]}; }
    }
}

__device__ __forceinline__ void rms_final(Frame& F, const float* gain) {
    for (int r = F.gw; r < ROW_M; r += F.NGW) {
        float* xr = F_X0(F) + (size_t)r * DM; f32x4 v[4]; float ss = 0.f;
#pragma unroll
        for (int j = 0; j < 4; ++j) { v[j] = *(const f32x4*)(xr + 4 * F.lane + 256 * j); ss += (v[j].x * v[j].x + v[j].y * v[j].y) + (v[j].z * v[j].z + v[j].w * v[j].w); }
        const float rs = rsqrtf(wave_sum(ss) * (1.f / DM) + EPS);
#pragma unroll
        for (int j = 0; j < 4; ++j) { const f32x4 gn = *(const f32x4*)(gain + 4 * F.lane + 256 * j); *(f32x4*)(xr + 4 * F.lane + 256 * j) = v[j] * rs * gn; }
    }
}

struct EpiFfn {
    static constexpr bool PERM = true, AFTER_DRAIN = false;
    bf16* H; const float* cw; const float* cb; const float* cst; float* cso; float* sbl; float* sbf; const float* ssq;
    __device__ __forceinline__ void operator()(f32x4 (&acc)[2][2][4][2], const pg8::Unit& u, int wr, int wc, int fr, int fq) const {
        const int ch0 = 128 * u.pn + 32 * wc + 8 * fq;
        const int tok0 = 256 * u.pm + 128 * wr + 8 * fr;
        const int grp = 2 * u.pm + wr;
        const bool samp = (u.pm >= 64 && u.pm < PM_META), meta = (u.pm == PM_META);
        const int sb = 32 * (u.pm - 64) + 16 * wr + fr;
        const bool defer = (!samp && !meta && fr == 0);
        const bool lastlane = meta ? (wr == 0 && fr == 1) : (!samp && fr == 15);
#pragma unroll
        for (int k = 0; k < 8; ++k) { const float rs = pg8::row_rs(ssq, tok0 + k, fq);
#pragma unroll
            for (int bj = 0; bj < 2; ++bj)
#pragma unroll
                for (int n = 0; n < 2; ++n) acc[k >> 2][bj][k & 3][n] = acc[k >> 2][bj][k & 3][n] * rs; }
#pragma unroll
        for (int n = 0; n < 2; ++n) {
            const int c4 = ch0 + 4 * n;
            const f32x4 w0 = *(const f32x4*)(cw + c4), w1 = *(const f32x4*)(cw + DFF + c4), w2 = *(const f32x4*)(cw + 2 * DFF + c4), bb = *(const f32x4*)(cb + c4);
            f32x4 p6, p7;
#pragma unroll
            for (int e = 0; e < 4; ++e) { p6[e] = __shfl_up(acc[1][0][2][n][e], 1, 16); p7[e] = __shfl_up(acc[1][0][3][n][e], 1, 16); }
            if (samp) { p6 = *(const f32x4*)(cst + (size_t)(sb * 2 + 0) * DFF + c4); p7 = *(const f32x4*)(cst + (size_t)(sb * 2 + 1) * DFF + c4); }
            if (meta && wr == 0 && fr == 0) { p6 = (f32x4){0.f, 0.f, 0.f, 0.f}; p7 = p6; }
#pragma unroll
            for (int k = 0; k < 8; ++k) {
                const f32x4 uk = acc[k >> 2][0][k & 3][n], gk = acc[k >> 2][1][k & 3][n];
                const f32x4 um1 = (k >= 1) ? acc[(k - 1 < 0 ? 0 : k - 1) >> 2][0][(k - 1 < 0 ? 0 : k - 1) & 3][n] : p7;
                const f32x4 um2 = (k >= 2) ? acc[(k - 2 < 0 ? 0 : k - 2) >> 2][0][(k - 2 < 0 ? 0 : k - 2) & 3][n] : (k == 1 ? p7 : p6);
                const f32x4 cv = bb + w0 * um2 + w1 * um1 + w2 * uk;
                f32x4 hv;
#pragma unroll
                for (int e = 0; e < 4; ++e) hv[e] = siluf_(cv[e]) * gk[e];
                if (defer && k < 2) {
                    *(f32x4*)(sbf + (size_t)((grp * 2 + k) * 2 + 0) * DFF + c4) = uk;
                    *(f32x4*)(sbf + (size_t)((grp * 2 + k) * 2 + 1) * DFF + c4) = gk;
                } else {
                    u32x2 w; w.x = pg8::cvt_pk_bf16(hv[0], hv[1]); w.y = pg8::cvt_pk_bf16(hv[2], hv[3]);
                    *(u32x2*)(H + (size_t)(tok0 + k) * DFF + c4) = w;
                }
            }
            if (lastlane) { *(f32x4*)(sbl + (size_t)(grp * 2 + 0) * DFF + c4) = acc[1][0][2][n]; *(f32x4*)(sbl + (size_t)(grp * 2 + 1) * DFF + c4) = acc[1][0][3][n]; }
            if (samp) { *(f32x4*)(cso + (size_t)(sb * 2 + 0) * DFF + c4) = acc[1][0][2][n]; *(f32x4*)(cso + (size_t)(sb * 2 + 1) * DFF + c4) = acc[1][0][3][n]; }
        }
    }
};

__device__ __forceinline__ void ffn_fixup(Frame& F, int layer) {
    const float* cw = F.in[22] + (size_t)layer * 3 * DFF; const float* cb = F.in[23] + (size_t)layer * DFF;
    bf16* H = F_Z(F);
    const int gt = blockIdx.x * (NWAVES * 64) + F.tid, NT = F.G * NWAVES * 64;
    for (int i = gt; i < 128 * DFF; i += NT) {
        const int grp = i / DFF, ch = i - grp * DFF;
        const int r0 = 128 * grp;
        const int pg = (r0 % 2048 == 0) ? GRP_META : grp - 1;
        const float um2 = F_SBL(F)[(size_t)(pg * 2 + 0) * DFF + ch], um1 = F_SBL(F)[(size_t)(pg * 2 + 1) * DFF + ch];
        const float u0 = F_SBF(F)[(size_t)((grp * 2 + 0) * 2 + 0) * DFF + ch], g0 = F_SBF(F)[(size_t)((grp * 2 + 0) * 2 + 1) * DFF + ch];
        const float u1 = F_SBF(F)[(size_t)((grp * 2 + 1) * 2 + 0) * DFF + ch], g1 = F_SBF(F)[(size_t)((grp * 2 + 1) * 2 + 1) * DFF + ch];
        const float w0 = cw[ch], w1 = cw[DFF + ch], w2 = cw[2 * DFF + ch], bb = cb[ch];
        const float c0 = bb + w0 * um2 + w1 * um1 + w2 * u0, c1 = bb + w0 * um1 + w1 * u0 + w2 * u1;
        H[(size_t)r0 * DFF + ch] = (bf16)f2bf(siluf_(c0) * g0);
        H[(size_t)(r0 + 1) * DFF + ch] = (bf16)f2bf(siluf_(c1) * g1);
    }
    float* fo = F.out + O_FP + (size_t)layer * 8 * 2 * DFF;
    for (int i = gt; i < 8 * 2 * DFF; i += NT) {
        const int b = i / (2 * DFF), rem = i - b * 2 * DFF, j = rem / DFF, ch = rem - j * DFF;
        const int grp = 2 * (8 * b + 7) + 1;
        fo[i] = F_SBL(F)[(size_t)(grp * 2 + j) * DFF + ch];
    }
}
typedef short bf16x8 __attribute__((ext_vector_type(8)));
typedef short v4i16_t __attribute__((ext_vector_type(4)));
constexpr int MX_PITCH = 272;
constexpr int MX_Q = 0, MX_K = 17408, MX_KH = 34816, MX_V = 52224, MX_GD = 69632  , MX_SC = 71680  , MX_OB = 74752  , MX_RP = 108544  , MX_DI = 110592  , MX_GN = 110848  , MX_LB = 111360  , MX_END = 111872;
constexpr int MX_OP = 132;
constexpr float LNKS = -2.4260151319598084f;
static_assert(MX_END <= 139264, "mixer LDS map");

__device__ __forceinline__ bf16x8 mk8(unsigned a, unsigned b, unsigned c, unsigned d) { const u32x4 v = {a, b, c, d}; return __builtin_bit_cast(bf16x8, v); }
__device__ __forceinline__ u32x2 tr16(const LAS unsigned char* p) { return __builtin_bit_cast(u32x2, __builtin_amdgcn_ds_read_tr16_b64_v4i16((LAS v4i16_t*)p)); }
__device__ __forceinline__ unsigned pkbf(float lo, float hi) { return pg8::cvt_pk_bf16(lo, hi); }
#define MFMA16(a, b, c) __builtin_amdgcn_mfma_f32_16x16x32_bf16((a), (b), (c), 0, 0, 0)
template <int CTRL> __device__ __forceinline__ float dppf(float ident, float x) { return __builtin_bit_cast(float, __builtin_amdgcn_update_dpp(__builtin_bit_cast(int, ident), __builtin_bit_cast(int, x), CTRL, 0xf, 0xf, false)); }
__device__ __forceinline__ float row_prefix_sum(float x) { x += dppf<0x111>(0.f, x); x += dppf<0x112>(0.f, x); x += dppf<0x114>(0.f, x); x += dppf<0x118>(0.f, x); return x; }
__device__ __forceinline__ float row_prefix_max(float x) { x = fmaxf(x, dppf<0x111>(-3e38f, x)); x = fmaxf(x, dppf<0x112>(-3e38f, x)); x = fmaxf(x, dppf<0x114>(-3e38f, x)); x = fmaxf(x, dppf<0x118>(-3e38f, x)); return x; }
__device__ __forceinline__ float row_prefix_prod(float x) { x *= dppf<0x111>(1.f, x); x *= dppf<0x112>(1.f, x); x *= dppf<0x114>(1.f, x); x *= dppf<0x118>(1.f, x); return x; }
__device__ __forceinline__ float row_suffix_prod(float x) { x *= dppf<0x101>(1.f, x); x *= dppf<0x102>(1.f, x); x *= dppf<0x104>(1.f, x); x *= dppf<0x108>(1.f, x); return x; }
__device__ __forceinline__ float rdlane(float x, int l) { return __builtin_bit_cast(float, __builtin_amdgcn_readlane(__builtin_bit_cast(int, x), l)); }

constexpr int ROT_N = 2072;
__device__ __forceinline__ void p0_rotary(Frame& F, float* tab) {
    const int gt = blockIdx.x * (NWAVES * 64) + F.tid, NT = F.G * NWAVES * 64;
    for (int i = gt; i < ROT_N * 64; i += NT) {
        const int pi = i >> 6, fi = i & 63;
        const float pos = pi < 2064 ? (float)pi : (float)(16384 + pi - 2064);
        const float inv = 1.0f / powf(10000.0f, (float)fi * (1.0f / 63.0f));
        float sn, cs; sincosf(pos * inv, &sn, &cs);
        tab[2 * i] = cs; tab[2 * i + 1] = sn;
    }
}

#define MX_SC_PARAMS(scv, row0, ntok, nmc, pos0) do { if (prompt) { if ((scv) == 0) { row0 = ROW_M; ntok = 16; nmc = 1; pos0 = 0; } else { row0 = b * 2048 + ((scv) - 1) * 64; ntok = 64; nmc = 4; pos0 = 16 + ((scv) - 1) * 64; } } \
        else { row0 = ROW_S + 8 * b; ntok = 8; nmc = 1; pos0 = 2064; } } while (0)

template <int TYPE>
__device__ __forceinline__ void mix_sg_unit(Frame& F, int b, int h, bool prompt, const float* rot) {
    const int tid = F.tid, lane = F.lane, w = F.wave, r16 = lane & 15, q = lane >> 4;
    const int tk = tid >> 3, p = tid & 7;
    LAS unsigned char* L = F.lds;
    LAS float* OB = (LAS float*)(L + MX_OB); LAS float* RP = (LAS float*)(L + MX_RP); LAS float* DI = (LAS float*)(L + MX_DI);
    const bf16* Z = F_Z(F); bf16* MIX = F_XN(F);
    const int qcol = (TYPE == 0 ? 0 : 2048) + 128 * h, kcol = (TYPE == 0 ? 512 : 2560) + 128 * h, vcol = (TYPE == 0 ? 1024 : 3072) + 128 * h, gcol = (TYPE == 0 ? 1536 : 3584) + 128 * h, mcol = (TYPE == 0 ? 0 : 512) + 128 * h;
    f32x4 S[8]; f32x4 nacc = {0.f, 0.f, 0.f, 0.f}; float m0 = 0.f;
#pragma unroll
    for (int mt = 0; mt < 8; ++mt) S[mt] = (f32x4){0.f, 0.f, 0.f, 0.f};
    if (!prompt) {
        const float* Sin = (TYPE == 0 ? F.in[2] : F.in[5]) + (size_t)(b * 4 + h) * 16384;
#pragma unroll
        for (int mt = 0; mt < 8; ++mt)
#pragma unroll
            for (int r = 0; r < 4; ++r) S[mt][r] = Sin[(16 * mt + 4 * q + r) * 128 + 16 * w + r16];
        if (TYPE == 0) {
#pragma unroll
            for (int r = 0; r < 4; ++r) nacc[r] = F.in[3][(size_t)(b * 4 + h) * 128 + 16 * w + 4 * q + r];
            m0 = F.in[4][b * 4 + h];
        }
    }
    const float lgam = (TYPE == 1) ? log1pf(-exp2f(-5.f - (float)h)) : 0.f;
    const float bias_i = (TYPE == 0) ? F.in[11][h] : 0.f, bias_f = (TYPE == 0) ? F.in[12][h] : 0.f;
    LAS float* GN = (LAS float*)(L + MX_GN);
    if (tid < 128) GN[tid] = (TYPE == 0 ? F.in[13] : F.in[14])[128 * h + tid];
    const int nsc = prompt ? 33 : 1;
    u32x4 pa[6]; f32x4 pr[4]; float pli = 0.f, plf = 0.f; u32x4 pg[2];
    const u32x4 z4 = {0u, 0u, 0u, 0u};
#define SG_LOAD(scv) do { int row0_, ntok_, nmc_, pos0_; MX_SC_PARAMS(scv, row0_, ntok_, nmc_, pos0_); (void)nmc_; \
        const bool valid_ = tk < ntok_; const bf16* zr_ = Z + (size_t)(row0_ + (valid_ ? tk : 0)) * 4096; \
        _Pragma("unroll") for (int i_ = 0; i_ < 6; ++i_) pa[i_] = z4; \
        if (valid_) { pa[4] = *(const u32x4*)(zr_ + vcol + 16 * p); pa[5] = *(const u32x4*)(zr_ + vcol + 16 * p + 8); \
            if (TYPE == 0) { pa[0] = *(const u32x4*)(zr_ + qcol + 16 * p); pa[1] = *(const u32x4*)(zr_ + qcol + 16 * p + 8); pa[2] = *(const u32x4*)(zr_ + kcol + 16 * p); pa[3] = *(const u32x4*)(zr_ + kcol + 16 * p + 8); } \
            else { pa[0] = *(const u32x4*)(zr_ + qcol + 8 * p); pa[1] = *(const u32x4*)(zr_ + qcol + 64 + 8 * p); pa[2] = *(const u32x4*)(zr_ + kcol + 8 * p); pa[3] = *(const u32x4*)(zr_ + kcol + 64 + 8 * p); } } \
        if (TYPE == 1) { const float* tb_ = rot + ((size_t)(pos0_ + (valid_ ? tk : 0)) * 64 + 8 * p) * 2; _Pragma("unroll") for (int e_ = 0; e_ < 4; ++e_) pr[e_] = *(const f32x4*)(tb_ + 4 * e_); } \
        if (TYPE == 0 && w == 0) { const bool vt_ = lane < ntok_; const float* gp_ = F_GT(F) + (size_t)(row0_ + (vt_ ? lane : 0)) * 8; pli = gp_[h]; plf = gp_[4 + h]; } } while (0)
    SG_LOAD(0);
#pragma unroll 1
    for (int sc = 0; sc < nsc; ++sc) {
        int row0, ntok, nmc, pos0; MX_SC_PARAMS(sc, row0, ntok, nmc, pos0); (void)pos0;
        LAS float* SC = (LAS float*)(L + MX_SC) + (sc & 1) * 384;
        if (tk < 16 * nmc) {
            *(LAS u32x4*)(L + MX_V + tk * MX_PITCH + 32 * p) = pa[4]; *(LAS u32x4*)(L + MX_V + tk * MX_PITCH + 32 * p + 16) = pa[5];
            if (TYPE == 0) {
                *(LAS u32x4*)(L + MX_Q + tk * MX_PITCH + 32 * p) = pa[0]; *(LAS u32x4*)(L + MX_Q + tk * MX_PITCH + 32 * p + 16) = pa[1];
                *(LAS u32x4*)(L + MX_K + tk * MX_PITCH + 32 * p) = pa[2]; *(LAS u32x4*)(L + MX_K + tk * MX_PITCH + 32 * p + 16) = pa[3];
            } else {
                u32x4 q1, q2, k1, k2;
#pragma unroll
                for (int e2 = 0; e2 < 4; ++e2) {
                    const f32x4 cs = pr[e2];
                    { const float x1l = bflo(pa[0][e2]), x1h = bfhi(pa[0][e2]), x2l = bflo(pa[1][e2]), x2h = bfhi(pa[1][e2]);
                      q1[e2] = pkbf(x1l * cs[0] - x2l * cs[1], x1h * cs[2] - x2h * cs[3]); q2[e2] = pkbf(x2l * cs[0] + x1l * cs[1], x2h * cs[2] + x1h * cs[3]); }
                    { const float x1l = bflo(pa[2][e2]), x1h = bfhi(pa[2][e2]), x2l = bflo(pa[3][e2]), x2h = bfhi(pa[3][e2]);
                      k1[e2] = pkbf(x1l * cs[0] - x2l * cs[1], x1h * cs[2] - x2h * cs[3]); k2[e2] = pkbf(x2l * cs[0] + x1l * cs[1], x2h * cs[2] + x1h * cs[3]); }
                }
                *(LAS u32x4*)(L + MX_Q + tk * MX_PITCH + 16 * p) = q1; *(LAS u32x4*)(L + MX_Q + tk * MX_PITCH + 128 + 16 * p) = q2;
                *(LAS u32x4*)(L + MX_K + tk * MX_PITCH + 16 * p) = k1; *(LAS u32x4*)(L + MX_K + tk * MX_PITCH + 128 + 16 * p) = k2;
            }
        }
        if (w == 0) {
            const bool valid = lane < ntok;
            float li = -1e30f, lf = 0.f;
            if (TYPE == 0) { if (valid) { li = pli + bias_i; lf = logsigmoidf_(plf + bias_f); } } else { if (valid) { li = 0.f; lf = lgam; } }
            const float bb = row_prefix_sum(lf);
            const float y = li - bb;
            const float am = row_prefix_max(y);
            const float a = bb + am;
            const float B0 = rdlane(bb, 15), B1 = rdlane(bb, 31), B2 = rdlane(bb, 47), B3 = rdlane(bb, 63);
            float M1 = 0.f, M2 = 0.f, M3 = 0.f, M4 = 0.f;
            if (TYPE == 0) { const float A0 = rdlane(a, 15), A1 = rdlane(a, 31), A2 = rdlane(a, 47), A3 = rdlane(a, 63);
                M1 = fmaxf(B0 + m0, A0); M2 = fmaxf(B1 + M1, A1); M3 = fmaxf(B2 + M2, A2); M4 = fmaxf(B3 + M3, A3); }
            const float m0q = q == 0 ? m0 : q == 1 ? M1 : q == 2 ? M2 : M3;
            const float mnq = q == 0 ? M1 : q == 1 ? M2 : q == 2 ? M3 : M4;
            const float b15 = q == 0 ? B0 : q == 1 ? B1 : q == 2 ? B2 : B3;
            const float m = (TYPE == 0) ? fmaxf(bb + m0q, a) : 0.f;
            SC[lane] = bb - m; SC[64 + lane] = y + LNKS; SC[128 + lane] = __expf(bb + m0q - m);
            SC[192 + lane] = __expf(y + LNKS + b15 - mnq); SC[256 + lane] = __expf(-m);
            if (r16 == 0) SC[320 + q] = __expf(b15 + m0q - mnq);
            m0 = (nmc == 4) ? M4 : M1;
        }
        __syncthreads();
        if (sc + 1 < nsc) SG_LOAD(sc + 1);
        { const bool valid = tk < ntok; const bf16* zr = Z + (size_t)(row0 + (valid ? tk : 0)) * 4096 + gcol + 16 * p; pg[0] = *(const u32x4*)zr; pg[1] = *(const u32x4*)(zr + 8); }
#pragma unroll 1
        for (int mc = 0; mc < nmc; ++mc) {
            {
                const LAS unsigned char* Qb = L + MX_Q + 16 * mc * MX_PITCH; const LAS unsigned char* Kb = L + MX_K + 16 * mc * MX_PITCH; const LAS unsigned char* Vb = L + MX_V + 16 * mc * MX_PITCH;
                f32x4 g = {0.f, 0.f, 0.f, 0.f};
#pragma unroll
                for (int ks = 0; ks < 4; ++ks) {
                    const u32x2 ka = *(const LAS u32x2*)(Kb + r16 * MX_PITCH + (32 * ks + 4 * q) * 2), kb = *(const LAS u32x2*)(Kb + r16 * MX_PITCH + (32 * ks + 16 + 4 * q) * 2);
                    const u32x2 qa = *(const LAS u32x2*)(Qb + r16 * MX_PITCH + (32 * ks + 4 * q) * 2), qb = *(const LAS u32x2*)(Qb + r16 * MX_PITCH + (32 * ks + 16 + 4 * q) * 2);
                    g = MFMA16(mk8(ka.x, ka.y, kb.x, kb.y), mk8(qa.x, qa.y, qb.x, qb.y), g);
                }
                const float xi = SC[mc * 16 + r16]; const f32x4 y4 = *(const LAS f32x4*)(SC + 64 + mc * 16 + 4 * q);
                f32x4 P;
#pragma unroll
                for (int r = 0; r < 4; ++r) P[r] = (4 * q + r <= r16) ? g[r] * __expf(xi + y4[r]) : 0.f;
                if (TYPE == 0) { float ps = (P[0] + P[1]) + (P[2] + P[3]); ps += __shfl_xor(ps, 16); ps += __shfl_xor(ps, 32); if (w == 0 && q == 0) DI[16 * mc + r16] = ps; }
                const u32x2 vt = tr16(Vb + (4 * q + (r16 >> 2)) * MX_PITCH + (16 * w + 4 * (r16 & 3)) * 2);
                f32x4 o1 = {0.f, 0.f, 0.f, 0.f}; o1 = MFMA16(mk8(pkbf(P[0], P[1]), pkbf(P[2], P[3]), 0u, 0u), mk8(vt.x, vt.y, 0u, 0u), o1);
#pragma unroll
                for (int r = 0; r < 4; ++r) OB[(16 * mc + 4 * q + r) * MX_OP + 16 * w + r16] = o1[r];
            }
        }
#pragma unroll 1
        for (int mc = 0; mc < nmc; ++mc) {
            {
                const LAS unsigned char* Qb = L + MX_Q + 16 * mc * MX_PITCH; const LAS unsigned char* Kb = L + MX_K + 16 * mc * MX_PITCH;
                const u32x2 vt = tr16(L + MX_V + 16 * mc * MX_PITCH + (4 * q + (r16 >> 2)) * MX_PITCH + (16 * w + 4 * (r16 & 3)) * 2);
                f32x4 o2 = {0.f, 0.f, 0.f, 0.f};
#pragma unroll
                for (int ks = 0; ks < 4; ++ks) {
                    const u32x2 qa = *(const LAS u32x2*)(Qb + r16 * MX_PITCH + (32 * ks + 4 * q) * 2), qb = *(const LAS u32x2*)(Qb + r16 * MX_PITCH + (32 * ks + 16 + 4 * q) * 2);
                    const bf16x8 SB = mk8(pkbf(S[2 * ks][0], S[2 * ks][1]), pkbf(S[2 * ks][2], S[2 * ks][3]), pkbf(S[2 * ks + 1][0], S[2 * ks + 1][1]), pkbf(S[2 * ks + 1][2], S[2 * ks + 1][3]));
                    o2 = MFMA16(mk8(qa.x, qa.y, qb.x, qb.y), SB, o2);
                }
                const f32x4 in4 = *(const LAS f32x4*)(SC + 128 + mc * 16 + 4 * q);
#pragma unroll
                for (int r = 0; r < 4; ++r) { LAS float* op = OB + (16 * mc + 4 * q + r) * MX_OP + 16 * w + r16; *op = *op + in4[r] * o2[r]; }
                const f32x4 w4 = *(const LAS f32x4*)(SC + 192 + mc * 16 + 4 * q); const float carry = SC[320 + mc];
                if (TYPE == 0) {
                    const u32x2 qn = *(const LAS u32x2*)(Qb + r16 * MX_PITCH + (16 * w + 4 * q) * 2);
                    f32x4 rr = {0.f, 0.f, 0.f, 0.f}; rr = MFMA16(mk8(qn.x, qn.y, 0u, 0u), mk8(pkbf(nacc[0], nacc[1]), pkbf(nacc[2], nacc[3]), 0u, 0u), rr);
                    if (r16 == 0) {
#pragma unroll
                        for (int r = 0; r < 4; ++r) RP[w * 64 + 16 * mc + 4 * q + r] = rr[r]; }
                }
                const bf16x8 VH = mk8(pkbf(bflo(vt.x) * w4[0], bfhi(vt.x) * w4[1]), pkbf(bflo(vt.y) * w4[2], bfhi(vt.y) * w4[3]), 0u, 0u);
#pragma unroll
                for (int mt = 0; mt < 8; ++mt) {
                    const u32x2 kt = tr16(Kb + (4 * q + (r16 >> 2)) * MX_PITCH + (16 * mt + 4 * (r16 & 3)) * 2);
                    S[mt] = S[mt] * carry; S[mt] = MFMA16(mk8(kt.x, kt.y, 0u, 0u), VH, S[mt]);
                }
                if (TYPE == 0) {
                    const u32x2 kt = tr16(Kb + (4 * q + (r16 >> 2)) * MX_PITCH + (16 * w + 4 * (r16 & 3)) * 2);
                    nacc = nacc * carry; nacc = MFMA16(mk8(kt.x, kt.y, 0u, 0u), mk8(pkbf(w4[0], w4[1]), pkbf(w4[2], w4[3]), 0u, 0u), nacc);
                }
            }
        }
        __syncthreads();
        {
            const bool valid = tk < ntok; const int row = row0 + (valid ? tk : 0);
            f32x4 o[4];
#pragma unroll
            for (int c = 0; c < 4; ++c) o[c] = *(const LAS f32x4*)(OB + tk * MX_OP + 16 * p + 4 * c);
            if (tk >= 16 * nmc) {
#pragma unroll
                for (int c = 0; c < 4; ++c) o[c] = (f32x4){0.f, 0.f, 0.f, 0.f}; }
            if (TYPE == 0) {
                float rs = 0.f;
#pragma unroll
                for (int ww = 0; ww < 8; ++ww) rs += RP[ww * 64 + tk];
                const float den = DI[tk] + SC[128 + tk] * rs;
                float dn = fmaxf(fabsf(den), SC[256 + tk]); if (tk >= 16 * nmc) dn = 1.f;
                const float rd = 1.f / dn;
#pragma unroll
                for (int c = 0; c < 4; ++c) o[c] = o[c] * rd;
            }
            float sm = 0.f;
#pragma unroll
            for (int c = 0; c < 4; ++c) sm += (o[c].x + o[c].y) + (o[c].z + o[c].w);
            sm += __shfl_xor(sm, 1); sm += __shfl_xor(sm, 2); sm += __shfl_xor(sm, 4);
            const float mu = sm * (1.f / 128.f); float vs = 0.f;
#pragma unroll
            for (int c = 0; c < 4; ++c) { o[c] = o[c] - mu; vs += (o[c].x * o[c].x + o[c].y * o[c].y) + (o[c].z * o[c].z + o[c].w * o[c].w); }
            vs += __shfl_xor(vs, 1); vs += __shfl_xor(vs, 2); vs += __shfl_xor(vs, 4);
            const float rstd = rsqrtf(vs * (1.f / 128.f) + EPS);
            if (valid) {
                unsigned ow[8];
#pragma unroll
                for (int c = 0; c < 4; ++c) {
                    const unsigned ga = c < 2 ? pg[0][2 * c] : pg[1][2 * c - 4], gb = c < 2 ? pg[0][2 * c + 1] : pg[1][2 * c - 3];
                    f32x4 gt = {bflo(ga), bfhi(ga), bflo(gb), bfhi(gb)};
#pragma unroll
                    for (int e = 0; e < 4; ++e) gt[e] = (TYPE == 0) ? sigmoidf_(gt[e]) : siluf_(gt[e]);
                    const f32x4 r = o[c] * rstd * *(const LAS f32x4*)(GN + 16 * p + 4 * c) * gt;
                    ow[2 * c] = pkbf(r.x, r.y); ow[2 * c + 1] = pkbf(r.z, r.w);
                }
                bf16* mp = MIX + (size_t)row * DM + mcol + 16 * p;
                *(u32x4*)mp = (u32x4){ow[0], ow[1], ow[2], ow[3]}; *(u32x4*)(mp + 8) = (u32x4){ow[4], ow[5], ow[6], ow[7]};
            }
        }
    }
#undef SG_LOAD
    __syncthreads();
    {
        float* So = F.out + (TYPE == 0 ? (prompt ? O_CP : O_CS) : (prompt ? O_RP : O_RS)) + (size_t)(b * 4 + h) * 16384;
#pragma unroll
        for (int mt = 0; mt < 8; ++mt)
#pragma unroll
            for (int r = 0; r < 4; ++r) So[(16 * mt + 4 * q + r) * 128 + 16 * w + r16] = S[mt][r];
        if (TYPE == 0) {
            if (r16 == 0) { float* No = F.out + (prompt ? O_NP : O_NS) + (size_t)(b * 4 + h) * 128;
#pragma unroll
                for (int r = 0; r < 4; ++r) No[16 * w + 4 * q + r] = nacc[r]; }
            if (w == 0 && lane == 0) F.out[(prompt ? O_MP : O_MS) + b * 4 + h] = m0;
        }
    }
}

__device__ __forceinline__ void mix_hg_unit(Frame& F, int b, int h, bool prompt) {
    const int tid = F.tid, lane = F.lane, w = F.wave, r16 = lane & 15, q = lane >> 4;
    const int tk = tid >> 3, p = tid & 7;
    const int amc = w >> 1, app = q + 4 * (w & 1);
    LAS unsigned char* L = F.lds;
    LAS float* GD = (LAS float*)(L + MX_GD); LAS float* OB = (LAS float*)(L + MX_OB);
    const bf16* Z = F_Z(F); bf16* MIX = F_XN(F);
    f32x4 S[8];
#pragma unroll
    for (int mt = 0; mt < 8; ++mt) S[mt] = (f32x4){0.f, 0.f, 0.f, 0.f};
    if (!prompt) {
        const float* Sin = F.in[6] + (size_t)(b * 8 + h) * 16384;
#pragma unroll
        for (int mt = 0; mt < 8; ++mt)
#pragma unroll
            for (int r = 0; r < 4; ++r) S[mt][r] = Sin[(16 * mt + 4 * q + r) * 128 + 16 * w + r16];
    }
    LAS float* GN = (LAS float*)(L + MX_GN); LAS float* LB = (LAS float*)(L + MX_LB);
    if (tid < 128) { GN[tid] = F.in[18][128 * h + tid]; LB[tid] = sigmoidf_(F.in[16][1024 + 128 * h + tid] - F.in[16][128 * h + tid]); }
    __syncthreads();
    const int nsc = prompt ? 33 : 1;
    u32x4 pa[6]; u32x4 pg[2];
    const u32x4 z4 = {0u, 0u, 0u, 0u};
#define HG_LOAD(scv) do { int row0_, ntok_, nmc_, pos0_; MX_SC_PARAMS(scv, row0_, ntok_, nmc_, pos0_); (void)pos0_; \
        const int t_ = 16 * amc + r16; const bool valid_ = (amc < nmc_) && (t_ < ntok_); const bf16* zr_ = Z + (size_t)(row0_ + (valid_ ? t_ : 0)) * 4096 + 128 * h + 16 * app; \
        _Pragma("unroll") for (int i_ = 0; i_ < 6; ++i_) pa[i_] = z4; \
        if (valid_) { pa[0] = *(const u32x4*)zr_; pa[1] = *(const u32x4*)(zr_ + 8); pa[2] = *(const u32x4*)(zr_ + 1024); pa[3] = *(const u32x4*)(zr_ + 1032); pa[4] = *(const u32x4*)(zr_ + 2048); pa[5] = *(const u32x4*)(zr_ + 2056); } } while (0)
    HG_LOAD(0);
#pragma unroll 1
    for (int sc = 0; sc < nsc; ++sc) {
        int row0, ntok, nmc, pos0; MX_SC_PARAMS(sc, row0, ntok, nmc, pos0); (void)pos0;
        if (amc < nmc) {
            const bool valid = (16 * amc + r16) < ntok;
            unsigned wq[8], wk[8], wh[8]; float Aend[16]; float lbv[16];
#pragma unroll
            for (int c = 0; c < 4; ++c) { const f32x4 t4 = *(const LAS f32x4*)(LB + 16 * app + 4 * c); lbv[4 * c] = t4[0]; lbv[4 * c + 1] = t4[1]; lbv[4 * c + 2] = t4[2]; lbv[4 * c + 3] = t4[3]; }
#pragma unroll
            for (int e2 = 0; e2 < 8; ++e2) {
                const unsigned qw = e2 < 4 ? pa[0][e2] : pa[1][e2 - 4], fw = e2 < 4 ? pa[2][e2] : pa[3][e2 - 4];
                float qo[2], ko[2], ho[2];
#pragma unroll
                for (int hh = 0; hh < 2; ++hh) {
                    const int e = 2 * e2 + hh;
                    const float qv = hh ? bfhi(qw) : bflo(qw), fv = hh ? bfhi(fw) : bflo(fw);
                    const float sg = sigmoidf_(fv);
                    const float a = valid ? lbv[e] + (1.f - lbv[e]) * sg : 1.f;
                    const float kk = valid ? (1.f - lbv[e]) * (1.f - sg) : 0.f;
                    const float A = row_prefix_prod(a);
                    const float Sx = row_suffix_prod(a);
                    const float R = dppf<0x101>(1.f, Sx);
                    qo[hh] = qv * A; ko[hh] = kk * __builtin_amdgcn_rcpf(fmaxf(A, 1e-30f)); ho[hh] = kk * R; Aend[e] = A;
                }
                wq[e2] = pkbf(qo[0], qo[1]); wk[e2] = pkbf(ko[0], ko[1]); wh[e2] = pkbf(ho[0], ho[1]);
            }
            const int ro = (16 * amc + r16) * MX_PITCH + 32 * app;
            *(LAS u32x4*)(L + MX_Q + ro) = (u32x4){wq[0], wq[1], wq[2], wq[3]}; *(LAS u32x4*)(L + MX_Q + ro + 16) = (u32x4){wq[4], wq[5], wq[6], wq[7]};
            *(LAS u32x4*)(L + MX_K + ro) = (u32x4){wk[0], wk[1], wk[2], wk[3]}; *(LAS u32x4*)(L + MX_K + ro + 16) = (u32x4){wk[4], wk[5], wk[6], wk[7]};
            *(LAS u32x4*)(L + MX_KH + ro) = (u32x4){wh[0], wh[1], wh[2], wh[3]}; *(LAS u32x4*)(L + MX_KH + ro + 16) = (u32x4){wh[4], wh[5], wh[6], wh[7]};
            *(LAS u32x4*)(L + MX_V + ro) = pa[4]; *(LAS u32x4*)(L + MX_V + ro + 16) = pa[5];
            if (r16 == 15) {
#pragma unroll
                for (int c = 0; c < 4; ++c) *(LAS f32x4*)(GD + amc * 128 + 16 * app + 4 * c) = (f32x4){Aend[4 * c], Aend[4 * c + 1], Aend[4 * c + 2], Aend[4 * c + 3]}; }
        }
        __syncthreads();
        if (sc + 1 < nsc) HG_LOAD(sc + 1);
        { const bool valid = tk < ntok; const bf16* zr = Z + (size_t)(row0 + (valid ? tk : 0)) * 4096 + 3072 + 128 * h + 16 * p; pg[0] = *(const u32x4*)zr; pg[1] = *(const u32x4*)(zr + 8); }
#pragma unroll 1
        for (int mc = 0; mc < nmc; ++mc) {
            {
                const LAS unsigned char* Qb = L + MX_Q + 16 * mc * MX_PITCH; const LAS unsigned char* Kb = L + MX_K + 16 * mc * MX_PITCH; const LAS unsigned char* Vb = L + MX_V + 16 * mc * MX_PITCH;
                f32x4 g = {0.f, 0.f, 0.f, 0.f};
#pragma unroll
                for (int ks = 0; ks < 4; ++ks) {
                    const u32x2 ka = *(const LAS u32x2*)(Kb + r16 * MX_PITCH + (32 * ks + 4 * q) * 2), kb = *(const LAS u32x2*)(Kb + r16 * MX_PITCH + (32 * ks + 16 + 4 * q) * 2);
                    const u32x2 qa = *(const LAS u32x2*)(Qb + r16 * MX_PITCH + (32 * ks + 4 * q) * 2), qb = *(const LAS u32x2*)(Qb + r16 * MX_PITCH + (32 * ks + 16 + 4 * q) * 2);
                    g = MFMA16(mk8(ka.x, ka.y, kb.x, kb.y), mk8(qa.x, qa.y, qb.x, qb.y), g);
                }
                f32x4 P;
#pragma unroll
                for (int r = 0; r < 4; ++r) P[r] = (4 * q + r <= r16) ? g[r] : 0.f;
                const u32x2 vt = tr16(Vb + (4 * q + (r16 >> 2)) * MX_PITCH + (16 * w + 4 * (r16 & 3)) * 2);
                f32x4 o1 = {0.f, 0.f, 0.f, 0.f}; o1 = MFMA16(mk8(pkbf(P[0], P[1]), pkbf(P[2], P[3]), 0u, 0u), mk8(vt.x, vt.y, 0u, 0u), o1);
#pragma unroll
                for (int r = 0; r < 4; ++r) OB[(16 * mc + 4 * q + r) * MX_OP + 16 * w + r16] = o1[r];
            }
        }
#pragma unroll 1
        for (int mc = 0; mc < nmc; ++mc) {
            {
                const LAS unsigned char* Qb = L + MX_Q + 16 * mc * MX_PITCH; const LAS unsigned char* Hb = L + MX_KH + 16 * mc * MX_PITCH;
                const u32x2 vt = tr16(L + MX_V + 16 * mc * MX_PITCH + (4 * q + (r16 >> 2)) * MX_PITCH + (16 * w + 4 * (r16 & 3)) * 2);
                f32x4 oo;
#pragma unroll
                for (int r = 0; r < 4; ++r) oo[r] = OB[(16 * mc + 4 * q + r) * MX_OP + 16 * w + r16];
#pragma unroll
                for (int ks = 0; ks < 4; ++ks) {
                    const u32x2 qa = *(const LAS u32x2*)(Qb + r16 * MX_PITCH + (32 * ks + 4 * q) * 2), qb = *(const LAS u32x2*)(Qb + r16 * MX_PITCH + (32 * ks + 16 + 4 * q) * 2);
                    const bf16x8 SB = mk8(pkbf(S[2 * ks][0], S[2 * ks][1]), pkbf(S[2 * ks][2], S[2 * ks][3]), pkbf(S[2 * ks + 1][0], S[2 * ks + 1][1]), pkbf(S[2 * ks + 1][2], S[2 * ks + 1][3]));
                    oo = MFMA16(mk8(qa.x, qa.y, qb.x, qb.y), SB, oo);
                }
#pragma unroll
                for (int r = 0; r < 4; ++r) OB[(16 * mc + 4 * q + r) * MX_OP + 16 * w + r16] = oo[r];
                const bf16x8 VB = mk8(vt.x, vt.y, 0u, 0u);
#pragma unroll
                for (int mt = 0; mt < 8; ++mt) {
                    const f32x4 gd = *(const LAS f32x4*)(GD + mc * 128 + 16 * mt + 4 * q);
                    const u32x2 kt = tr16(Hb + (4 * q + (r16 >> 2)) * MX_PITCH + (16 * mt + 4 * (r16 & 3)) * 2);
                    S[mt] = S[mt] * gd; S[mt] = MFMA16(mk8(kt.x, kt.y, 0u, 0u), VB, S[mt]);
                }
            }
        }
        __syncthreads();
        {
            const bool valid = tk < ntok; const int row = row0 + (valid ? tk : 0);
            f32x4 o[4];
#pragma unroll
            for (int c = 0; c < 4; ++c) o[c] = *(const LAS f32x4*)(OB + tk * MX_OP + 16 * p + 4 * c);
            if (tk >= 16 * nmc) {
#pragma unroll
                for (int c = 0; c < 4; ++c) o[c] = (f32x4){0.f, 0.f, 0.f, 0.f}; }
            float vs = 0.f;
#pragma unroll
            for (int c = 0; c < 4; ++c) vs += (o[c].x * o[c].x + o[c].y * o[c].y) + (o[c].z * o[c].z + o[c].w * o[c].w);
            vs += __shfl_xor(vs, 1); vs += __shfl_xor(vs, 2); vs += __shfl_xor(vs, 4);
            const float rstd = rsqrtf(vs * (1.f / 128.f) + EPS);
            if (valid) {
                unsigned ow[8];
#pragma unroll
                for (int c = 0; c < 4; ++c) {
                    const unsigned ga = c < 2 ? pg[0][2 * c] : pg[1][2 * c - 4], gb = c < 2 ? pg[0][2 * c + 1] : pg[1][2 * c - 3];
                    f32x4 gt = {bflo(ga), bfhi(ga), bflo(gb), bfhi(gb)};
#pragma unroll
                    for (int e = 0; e < 4; ++e) gt[e] = siluf_(gt[e]);
                    const f32x4 r = o[c] * rstd * *(const LAS f32x4*)(GN + 16 * p + 4 * c) * gt;
                    ow[2 * c] = pkbf(r.x, r.y); ow[2 * c + 1] = pkbf(r.z, r.w);
                }
                bf16* mp = MIX + (size_t)row * DM + 128 * h + 16 * p;
                *(u32x4*)mp = (u32x4){ow[0], ow[1], ow[2], ow[3]}; *(u32x4*)(mp + 8) = (u32x4){ow[4], ow[5], ow[6], ow[7]};
            }
        }
    }
#undef HG_LOAD
    __syncthreads();
    {
        float* So = F.out + (prompt ? O_HP : O_HS) + (size_t)(b * 8 + h) * 16384;
#pragma unroll
        for (int mt = 0; mt < 8; ++mt)
#pragma unroll
            for (int r = 0; r < 4; ++r) So[(16 * mt + 4 * q + r) * 128 + 16 * w + r16] = S[mt][r];
    }
}

__device__ __forceinline__ void mixer_layer0(Frame& F) {
    constexpr int NU = 64 + 1024;
    const float* rot = (const float*)(F.ws + WS_ROT);
    int u0, ustep, uend;
    if (F.G > 128) { if (blockIdx.x < 64) { u0 = blockIdx.x; ustep = NU; uend = 64; } else { u0 = 64 + (blockIdx.x - 64); ustep = F.G - 64; uend = NU; } } else { u0 = blockIdx.x; ustep = F.G; uend = NU; }
#pragma unroll 1
    for (int u = u0; u < uend; u += ustep) {
        int ty, bh; const bool prompt = u < 64;
        if (prompt) { ty = u >> 5; bh = u & 31; } else { const int su = u - 64; ty = su >> 9; bh = su & 511; }
        if (ty == 0) mix_sg_unit<0>(F, bh >> 2, bh & 3, prompt, rot); else mix_sg_unit<1>(F, bh >> 2, bh & 3, prompt, rot);
    }
}
__device__ __forceinline__ void mixer_layer1(Frame& F) {
    constexpr int NU = 64 + 1024;
    int u0, ustep, uend;
    if (F.G > 128) { if (blockIdx.x < 64) { u0 = blockIdx.x; ustep = NU; uend = 64; } else { u0 = 64 + (blockIdx.x - 64); ustep = F.G - 64; uend = NU; } } else { u0 = blockIdx.x; ustep = F.G; uend = NU; }
#pragma unroll 1
    for (int u = u0; u < uend; u += ustep) {
        const bool prompt = u < 64; const int bh = prompt ? u : u - 64;
        mix_hg_unit(F, bh >> 3, bh & 7, prompt);
    }
}
constexpr int NPHASE = 14;
constexpr int LDSCTL_OFF = 139264;
#define RLX_AGENT __ATOMIC_RELAXED, __HIP_MEMORY_SCOPE_AGENT
#define XB_TMO      128
#define XB_XCNT(j)  (256  + 64 * (j))
#define XB_XSUB(j)  (1280 + 64 * (j))
#define XB_XGEN(j)  (2304 + 64 * (j))
#define XB_TOP      3328
#define XB_TOPGEN   3392
#define XCD_BAR_WORDS 3456
#define XB_SPIN_CAP (1u << 18)

__device__ __forceinline__ unsigned xb_ld(unsigned* p)              { return __hip_atomic_load(p, __ATOMIC_RELAXED, __HIP_MEMORY_SCOPE_AGENT); }
__device__ __forceinline__ unsigned xb_add(unsigned* p, unsigned v) { return __hip_atomic_fetch_add(p, v, __ATOMIC_RELAXED, __HIP_MEMORY_SCOPE_AGENT); }
__device__ __forceinline__ unsigned xb_xcc_id() { return (unsigned)__builtin_amdgcn_s_getreg((3 << 11) | 20) & 0xFu; }
#define XB_SPIN(cond, bar) do { unsigned _sp = 0; while (cond) { __builtin_amdgcn_s_sleep(1); \
    if ((++_sp & 255u) == 0u) { if (xb_ld(&(bar)[XB_TMO])) break; if (_sp > XB_SPIN_CAP) { atomicAdd(&(bar)[XB_TMO], 1u); break; } } } } while (0)

struct XcdBarrier {
    unsigned* bar; unsigned x;
    volatile LAS unsigned* st;
};

__device__ __forceinline__ XcdBarrier xcd_barrier_post(unsigned* bar, volatile LAS unsigned* st) {
    XcdBarrier b; b.bar = bar; b.x = xb_xcc_id(); b.st = st;
    if (threadIdx.x == 0) (void)xb_add(&bar[XB_XCNT(b.x)], 1u);
    return b;
}
__device__ __forceinline__ void xcd_barrier_complete(unsigned* bar, unsigned x, unsigned& nloc, unsigned& nx) {
    const unsigned G = gridDim.x * gridDim.y * gridDim.z;
    unsigned sum, cnt, mine, sp = 0u;
    for (;;) {
        sum = 0u; cnt = 0u; mine = 0u;
#pragma unroll
        for (unsigned j = 0; j < 16; ++j) { const unsigned c = xb_ld(&bar[XB_XCNT(j)]); sum += c; cnt += (c > 0u) ? 1u : 0u; mine = (j == x) ? c : mine; }
        if (sum == G) break;
        __builtin_amdgcn_s_sleep(1);
        if ((++sp & 255u) == 0u) { if (xb_ld(&bar[XB_TMO])) break; if (sp > XB_SPIN_CAP) { atomicAdd(&bar[XB_TMO], 1u); break; } }
    }
    nloc = mine > 0u ? mine : 1u; nx = cnt > 0u ? cnt : 1u;
}

__device__ __forceinline__ void xcd_barrier(const XcdBarrier& b) {
    asm volatile("s_waitcnt vmcnt(0)" ::: "memory");
    __syncthreads();
    if (threadIdx.x == 0) {
        unsigned* bar = b.bar;
        __builtin_amdgcn_s_waitcnt(0);
        unsigned nloc = b.st[0], nx = b.st[1];
        if (nloc == 0u) { xcd_barrier_complete(bar, b.x, nloc, nx); b.st[0] = nloc; b.st[1] = nx; }
        const unsigned old = xb_add(&bar[XB_XSUB(b.x)], 1u);
        const unsigned gen = old / nloc;
        if (old + 1u == (gen + 1u) * nloc) {
            __builtin_amdgcn_fence(__ATOMIC_RELEASE, "agent");
            asm volatile("s_waitcnt vmcnt(0)" ::: "memory");
            const unsigned og = xb_add(&bar[XB_TOP], 1u);
            const unsigned tg = og / nx;
            if (og + 1u == (tg + 1u) * nx) xb_add(&bar[XB_TOPGEN], 1u);
            else XB_SPIN(xb_ld(&bar[XB_TOPGEN]) == tg, bar);
            __builtin_amdgcn_fence(__ATOMIC_ACQUIRE, "agent");
            xb_add(&bar[XB_XGEN(b.x)], 1u);
            asm volatile("s_waitcnt vmcnt(0)" ::: "memory");
        } else {
            XB_SPIN(xb_ld(&bar[XB_XGEN(b.x)]) == gen, bar);
            __builtin_amdgcn_fence(__ATOMIC_ACQUIRE, "agent");
            asm volatile("s_waitcnt vmcnt(0)" ::: "memory");
        }
    }
    __syncthreads();
}

#ifndef MK_N_LAUNCHES
#define MK_N_LAUNCHES 1
#endif

__global__ void __launch_bounds__(NWAVES * 64, 2) fwd_kernel(Args args) {
    extern __shared__ __attribute__((aligned(16))) unsigned char lds_raw[];
    cg::grid_group grid = cg::this_grid();
    Frame F;
    F.lds = (LAS unsigned char*)lds_raw;
#define REFRESH() do { int t_ = threadIdx.x; asm volatile("" : "+v"(t_)); F.tid = t_; F.lane = t_ & 63; F.wave = __builtin_amdgcn_readfirstlane(t_ >> 6); F.gw = blockIdx.x * NWAVES + F.wave; } while (0)
    F.G = gridDim.x; F.NGW = F.G * NWAVES; REFRESH();
    F.in = args.in; F.out = args.out; F.ws = args.ws;
    const int lo = args.ph_lo, hi = args.ph_hi;
    volatile LAS unsigned* MISC = (volatile LAS unsigned*)(F.lds + LDSCTL_OFF);
    if (threadIdx.x < 16) MISC[threadIdx.x] = 0u;
    __syncthreads();
    (void)xcd_barrier_post((unsigned*)(args.ws + WS_CTL), MISC + 8);
#ifndef KMASK
#define KMASK 0x1ff
#endif
#define IN(k) (lo <= (k) && (k) < hi)
#define INK(kind, k) ((((KMASK) >> (kind)) & 1) && IN(k))
#define SEAM(k) do { if (IN(k) && IN((k) + 1)) { if ((k) == 0) grid.sync(); else { XcdBarrier bar_; bar_.bar = (unsigned*)(args.ws + WS_CTL); bar_.x = xb_xcc_id(); bar_.st = (volatile LAS unsigned*)(F.lds + LDSCTL_OFF) + 8; xcd_barrier(bar_); } } } while (0)

    if (INK(0, 0)) { p0_weights(F); __syncthreads(); REFRESH(); p0_rows(F); REFRESH(); p0_rotary(F, (float*)(args.ws + WS_ROT)); }
    SEAM(0);
#pragma unroll 1
    for (int layer = 0; layer < 2; ++layer) {
        const int pb = 1 + 6 * layer;
        if (INK(1, pb)) {
            pg8::Gemm g{F_XG(F), (const bf16*)(args.ws + (layer == 0 ? WS_WAB : WS_WC)), MPAD, 4096, 1024}; pg8::StaticOrder S; S.init(MPAD, 4096, F.G, (int)blockIdx.x);
            pg8::EpiBf16 E{F_Z(F), 4096, layer == 0 ? (const float*)nullptr : (const float*)F_SSQ(F)};
            pg8::gemm_phase<pg8::EpiBf16, pg8::StaticOrder, false>(F.lds, g, S, E);
        }
        SEAM(pb);
        if (INK(2, pb + 1)) { REFRESH(); if (layer == 0) mixer_layer0(F); else mixer_layer1(F); }
        SEAM(pb + 1);
        if (INK(3, pb + 2)) {
            pg8::Gemm g{F_XN(F), (const bf16*)(args.ws + (layer == 0 ? WS_WOAB : WS_WOC)), MPAD, 1024, 1024}; pg8::StaticOrder S; S.init(MPAD, 1024, F.G, (int)blockIdx.x);
            pg8::EpiResid E{F_X0(F), F_X1(F), PM_META, DM, F_XG(F), F.in[20] + (size_t)layer * DM, F_SSQ(F)};
            pg8::gemm_phase<pg8::EpiResid, pg8::StaticOrder, false>(F.lds, g, S, E);
        }
        SEAM(pb + 2);
        if (INK(5, pb + 3)) {
            pg8::Gemm g{F_XG(F), (const bf16*)(args.ws + WS_WF1) + (size_t)layer * NFF * 1024, MPAD, NFF, 1024}; pg8::StaticOrder S; S.init(MPAD, NFF, F.G, (int)blockIdx.x);
            EpiFfn E{F_Z(F), F.in[22] + (size_t)layer * 3 * DFF, F.in[23] + (size_t)layer * DFF, F.in[7] + (size_t)layer * 128 * 2 * DFF, F.out + O_FS + (size_t)layer * 128 * 2 * DFF, F_SBL(F), F_SBF(F), F_SSQ(F)};
            pg8::gemm_phase<EpiFfn, pg8::StaticOrder, true>(F.lds, g, S, E);
        }
        SEAM(pb + 3);
        if (INK(6, pb + 4)) { REFRESH(); ffn_fixup(F, layer); }
        SEAM(pb + 4);
        if (INK(7, pb + 5)) {
            pg8::Gemm g{F_Z(F), (const bf16*)(args.ws + WS_WF2) + (size_t)layer * 1024 * DFF, MPAD, 1024, DFF}; pg8::StaticOrder S; S.init(MPAD, 1024, F.G, (int)blockIdx.x);
            pg8::EpiResid E{F_X0(F), F_X1(F), PM_META, DM, layer == 0 ? F_XG(F) : (bf16*)nullptr, F.in[9] + DM, F_SSQ(F)};
            pg8::gemm_phase<pg8::EpiResid, pg8::StaticOrder, false>(F.lds, g, S, E);
        }
        SEAM(pb + 5);
    }
    if (INK(8, 13)) { REFRESH(); rms_final(F, F.in[25]); }
#undef IN
#undef REFRESH
#undef INK
#undef SEAM
}

extern "C" void kernel_launch(void* const* d_in, const int* in_sizes, int n_in, void* d_out, int out_size, void* d_ws, size_t ws_size, hipStream_t stream) {
    static int grid = 0;
    if (grid == 0) {
        if (n_in != 26 || (size_t)out_size != O_END || ws_size < WS_END) { fprintf(stderr, "kernel_launch: unexpected shapes: n_in %d out %d ws %zu\n", n_in, out_size, ws_size); grid = -1; return; }
        int dev = 0, cus = 0, per_cu = 0;
        if (hipGetDevice(&dev) != hipSuccess || hipDeviceGetAttribute(&cus, hipDeviceAttributeMultiprocessorCount, dev) != hipSuccess) { grid = -1; return; }
        if (hipFuncSetAttribute((const void*)fwd_kernel, hipFuncAttributeMaxDynamicSharedMemorySize, LDS_BYTES) != hipSuccess) { fprintf(stderr, "kernel_launch: hipFuncSetAttribute failed\n"); grid = -1; return; }
        if (hipOccupancyMaxActiveBlocksPerMultiprocessor(&per_cu, (const void*)fwd_kernel, NWAVES * 64, LDS_BYTES) != hipSuccess || per_cu < 1) { fprintf(stderr, "kernel_launch: occupancy query says %d\n", per_cu); per_cu = 1; }
        (void)hipGetLastError();
        grid = cus;
    }
    if (grid < 0) return;
    if (hipMemsetAsync((char*)d_ws + WS_CTL, 0, 16384, stream) != hipSuccess) { fprintf(stderr, "kernel_launch: hipMemsetAsync failed\n"); return; }
    Args a{};
    for (int i = 0; i < 26; ++i) a.in[i] = (const float*)d_in[i];
    a.out = (float*)d_out; a.ws = (unsigned char*)d_ws;
#if MK_N_LAUNCHES == 1
    a.ph_lo = 0; a.ph_hi = NPHASE;
    void* kargs[] = {&a};
    hipError_t e = hipLaunchCooperativeKernel((const void*)fwd_kernel, dim3(grid), dim3(NWAVES * 64), kargs, LDS_BYTES, stream);
    if (e != hipSuccess) fprintf(stderr, "kernel_launch: cooperative launch failed: %s (grid %d)\n", hipGetErrorString(e), grid);
#else
    for (int p = 0; p < NPHASE; ++p) {
        a.ph_lo = p; a.ph_hi = p + 1;
        hipLaunchKernelGGL(fwd_kernel, dim3(grid), dim3(NWAVES * 64), LDS_BYTES, stream, a);
    }
#endif
}
```

```cpp
#include <hip/hip_runtime.h>
#include <hip/hip_cooperative_groups.h>
#include <cstdio>
#include <cstdint>
namespace cg = cooperative_groups;
#define MK_N_LAUNCHES 1
namespace pg8 {
#define PG8_LAS __attribute__((address_space(3)))
typedef unsigned short bf16_t;
typedef short bf16x8 __attribute__((ext_vector_type(8)));
typedef float f32x4 __attribute__((ext_vector_type(4)));
typedef unsigned u32x4 __attribute__((ext_vector_type(4)));
typedef unsigned u32x2 __attribute__((ext_vector_type(2)));
constexpr int BM = 256, BK = 64, HALF = 128, HTB = HALF * BK * 2  , STAGE_BYTES = 8 * HTB, NXCD = 8, WGM = 8;

__host__ __device__ __forceinline__ int lds_byte(int r, int c) { const int st = (r >> 4) * 2 + (c >> 5), rr = r & 15, cc = c & 31, ob = rr * 64 + cc * 2; return st * 1024 + (ob ^ (((ob >> 9) & 1) << 5)); }
__host__ __device__ __forceinline__ void stage_rc(int b, int& R, int& C) { const int st = b / 1024, sb = b % 1024, swz = sb ^ (((sb >> 9) & 1) << 5); R = (st >> 1) * 16 + swz / 64; C = (st & 1) * 32 + (swz % 64) / 2; }
__host__ __device__ __forceinline__ int perm32(int rho) { const int n = rho >> 4, i = rho & 15; return 8 * (i >> 2) + 4 * n + (i & 3); }

struct Unit { int pm, pn; };
struct Gemm { const bf16_t* A; const bf16_t* Bt; int M, N, K; };

struct StaticOrder {
    int nM, nN, nwg, G, c;
    __host__ __device__ void init(int M, int N, int G_, int c_) { nM = M / BM; nN = N / BM; nwg = nM * nN; G = G_; c = c_; }
    __host__ __device__ bool next(int i, Unit& u) const {
        const long L = (long)i * G + c; if (L >= nwg) return false;
        int wgid = (int)L; { const int q = nwg / NXCD, r = nwg % NXCD, xcd = wgid % NXCD, off = wgid / NXCD; wgid = (xcd < r ? xcd * (q + 1) : r * (q + 1) + (xcd - r) * q) + off; }
        const int nig = WGM * nN, gid = wgid / nig, fm = gid * WGM, gsz = (nM - fm) < WGM ? (nM - fm) : WGM;
        u.pm = fm + ((wgid % nig) % gsz); u.pn = (wgid % nig) / gsz; return true;
    }
    __device__ __forceinline__ void a_ready(const Unit&) const {}
    __device__ __forceinline__ void done(const Unit&) const {}
};

__device__ __forceinline__ unsigned cvt_pk_bf16(float lo, float hi) { unsigned r; asm volatile("v_cvt_pk_bf16_f32 %0, %1, %2" : "=v"(r) : "v"(lo), "v"(hi)); return r; }

__device__ __forceinline__ float row_rs(const float* ssq, int row, int fq) {
    const f32x4 a = *(const f32x4*)(ssq + (size_t)row * 16 + 4 * fq);
    float s = (a[0] + a[1]) + (a[2] + a[3]); s += __shfl_xor(s, 16); s += __shfl_xor(s, 32);
    return __builtin_amdgcn_rsqf(s * (1.0f / 1024.0f) + 1e-6f);
}
struct EpiBf16 {
    static constexpr bool PERM = true, AFTER_DRAIN = false;
    bf16_t* O; int ldc; const float* ssq;
    __device__ __forceinline__ void operator()(f32x4 (&acc)[2][2][4][2], const Unit& u, int wr, int wc, int fr, int fq) const {
        const int row0 = u.pm * BM + wr * 64 + fr; const int col0 = u.pn * BM + wc * 32 + 8 * fq;
        float rsv[2][4];
#pragma unroll
        for (int ai = 0; ai < 2; ++ai)
#pragma unroll
            for (int m = 0; m < 4; ++m) rsv[ai][m] = ssq ? row_rs(ssq, row0 + ai * HALF + m * 16, fq) : 1.0f;
#pragma unroll
        for (int ai = 0; ai < 2; ++ai)
#pragma unroll
            for (int m = 0; m < 4; ++m) { const int row = row0 + ai * HALF + m * 16; bf16_t* rowp = O + (size_t)row * ldc + col0;
                const float rs = rsv[ai][m];
#pragma unroll
                for (int bj = 0; bj < 2; ++bj) { const f32x4 v0 = acc[ai][bj][m][0] * rs, v1 = acc[ai][bj][m][1] * rs;
                    u32x4 w; w.x = cvt_pk_bf16(v0[0], v0[1]); w.y = cvt_pk_bf16(v0[2], v0[3]); w.z = cvt_pk_bf16(v1[0], v1[1]); w.w = cvt_pk_bf16(v1[2], v1[3]);
                    *(u32x4*)(rowp + bj * HALF) = w; } }
    }
};

struct EpiResid {
    static constexpr bool PERM = true, AFTER_DRAIN = false;
    float* X0; float* X1; int pm_split; int ldc; bf16_t* XG; const float* gain; float* ssq;
    __device__ __forceinline__ void operator()(f32x4 (&acc)[2][2][4][2], const Unit& u, int wr, int wc, int fr, int fq) const {
        float* C = (u.pm < pm_split) ? X0 : X1;
        const int row0 = u.pm * BM + wr * 64 + fr, col0 = u.pn * BM + wc * 32 + 8 * fq;
        f32x4 gv[2][2];
#pragma unroll
        for (int bj = 0; bj < 2; ++bj)
#pragma unroll
            for (int n = 0; n < 2; ++n) gv[bj][n] = XG ? *(const f32x4*)(gain + col0 + bj * HALF + 4 * n) : (f32x4){0.f, 0.f, 0.f, 0.f};
#pragma unroll
        for (int ai = 0; ai < 2; ++ai)
#pragma unroll
            for (int mp = 0; mp < 2; ++mp) {
                f32x4 t[2][2][2];
#pragma unroll
                for (int mm = 0; mm < 2; ++mm) { const float* rowp = C + (size_t)(row0 + ai * HALF + (2 * mp + mm) * 16) * ldc + col0;
#pragma unroll
                    for (int bj = 0; bj < 2; ++bj)
#pragma unroll
                        for (int n = 0; n < 2; ++n) t[mm][bj][n] = *(const f32x4*)(rowp + bj * HALF + 4 * n); }
#pragma unroll
                for (int mm = 0; mm < 2; ++mm) { const int m = 2 * mp + mm; const int row = row0 + ai * HALF + m * 16; float* rowp = C + (size_t)row * ldc + col0; float sq = 0.f;
#pragma unroll
                    for (int bj = 0; bj < 2; ++bj) { f32x4 v[2];
#pragma unroll
                        for (int n = 0; n < 2; ++n) { v[n] = t[mm][bj][n] + acc[ai][bj][m][n]; *(f32x4*)(rowp + bj * HALF + 4 * n) = v[n];
                            sq += (v[n][0] * v[n][0] + v[n][1] * v[n][1]) + (v[n][2] * v[n][2] + v[n][3] * v[n][3]); }
                        if (XG) { const f32x4 y0 = v[0] * gv[bj][0], y1 = v[1] * gv[bj][1]; u32x4 w; w.x = cvt_pk_bf16(y0[0], y0[1]); w.y = cvt_pk_bf16(y0[2], y0[3]); w.z = cvt_pk_bf16(y1[0], y1[1]); w.w = cvt_pk_bf16(y1[2], y1[3]);
                            *(u32x4*)(XG + (size_t)row * ldc + col0 + bj * HALF) = w; } }
                    if (XG) { sq += __shfl_xor(sq, 16); sq += __shfl_xor(sq, 32); if (fq == 0) ssq[(size_t)row * 16 + u.pn * 4 + wc] = sq; } }
                asm volatile("" ::: "memory"); }
    }
};

template <class Epi, class Sched, bool APERM>
__device__ __forceinline__ void gemm_phase(PG8_LAS unsigned char* lds, const Gemm g, const Sched& S, const Epi& E) {
    int tid_ = threadIdx.x; asm volatile("" : "+v"(tid_));
    const int tid = tid_, wid = __builtin_amdgcn_readfirstlane(tid >> 6), lane = tid & 63, wr = wid >> 2, wc = wid & 3, fr = lane & 15, fq = lane >> 4;
    const int K = g.K, nt = K / BK;
    unsigned voffA[2], voffB[2];
#pragma unroll
    for (int i = 0; i < 2; ++i) { int R, C; stage_rc(tid * 16 + i * 8192, R, C); const int Rb = Epi::PERM ? ((R & ~31) + perm32(R & 31)) : R;
        const int Ra = APERM ? (128 * (R >> 6) + 8 * (R & 15) + ((R >> 4) & 3)) : R;
        voffA[i] = (unsigned)(Ra * K + C) * 2u; voffB[i] = (unsigned)(Rb * K + C) * 2u; }
    const size_t kstep = (size_t)(BK * 2);
    const size_t hstep = (size_t)HALF * K * 2;
    const size_t hstepA = APERM ? (size_t)4 * K * 2 : hstep;
    const size_t tstep = 2 * hstep;
    const unsigned ldsw = (unsigned)wid * 1024u;
    const int aoff = lds_byte(wr * 64 + fr, fq * 8), boff = lds_byte(wc * 32 + fr, fq * 8);
#define PG8_SA(b, h) (((b) * 2 + (h)) * HTB)
#define PG8_SB(b, h) ((4 + (b) * 2 + (h)) * HTB)
#define PG8_STAGE(bufoff, gbase, voff) do { _Pragma("unroll") for (int _i = 0; _i < 2; ++_i) \
        __builtin_amdgcn_global_load_lds((const unsigned*)((const char*)(gbase) + (voff)[_i]), (PG8_LAS unsigned*)(lds + (bufoff) + ldsw + _i * 8192), 16, 0, 0); } while (0)
#define PG8_LDA(dst, b, h) do { _Pragma("unroll") for (int m = 0; m < 4; ++m) _Pragma("unroll") for (int k = 0; k < 2; ++k) dst[m][k] = *(const PG8_LAS bf16x8*)(lds + PG8_SA(b, h) + aoff + m * 2048 + k * 1024); } while (0)
#define PG8_LDB(dst, b, h) do { _Pragma("unroll") for (int n = 0; n < 2; ++n) _Pragma("unroll") for (int k = 0; k < 2; ++k) dst[n][k] = *(const PG8_LAS bf16x8*)(lds + PG8_SB(b, h) + boff + n * 2048 + k * 1024); } while (0)
#define PG8_MMA(ai, bj, At, Bt) do { __builtin_amdgcn_s_setprio(1); _Pragma("unroll") for (int m = 0; m < 4; ++m) _Pragma("unroll") for (int n = 0; n < 2; ++n) _Pragma("unroll") for (int k = 0; k < 2; ++k) \
        acc[ai][bj][m][n] = __builtin_amdgcn_mfma_f32_16x16x32_bf16(Bt[n][k], At[m][k], acc[ai][bj][m][n], 0, 0, 0); __builtin_amdgcn_s_setprio(0); } while (0)
#define PG8_WAIT_V(n) asm volatile("s_waitcnt vmcnt(" #n ")" ::: "memory")
#define PG8_WAIT_L(n) asm volatile("s_waitcnt lgkmcnt(" #n ")" ::: "memory")
#define PG8_BAR __builtin_amdgcn_s_barrier()
#define PG8_SCHED __builtin_amdgcn_sched_barrier(0)
    Unit cur, nxt; int ui = 0;
    if (!S.next(0, cur)) return;
    f32x4 acc[2][2][4][2];
#pragma unroll
    for (int a = 0; a < 2; ++a)
#pragma unroll
        for (int b = 0; b < 2; ++b)
#pragma unroll
            for (int m = 0; m < 4; ++m)
#pragma unroll
                for (int n = 0; n < 2; ++n) acc[a][b][m][n] = (f32x4){0.f, 0.f, 0.f, 0.f};
    bf16x8 At[4][2], B0[2][2], B1[2][2];
    const char* cA = (const char*)g.A + (size_t)cur.pm * tstep; const char* cB = (const char*)g.Bt + (size_t)cur.pn * tstep;
    S.a_ready(cur);
    PG8_STAGE(PG8_SB(0, 0), cB, voffB); PG8_STAGE(PG8_SB(0, 1), cB + hstep, voffB); PG8_STAGE(PG8_SA(0, 0), cA, voffA); PG8_STAGE(PG8_SA(0, 1), cA + hstepA, voffA);
    if (wr == 1) PG8_BAR;
    PG8_WAIT_V(2); PG8_BAR;
    PG8_STAGE(PG8_SB(1, 0), cB + kstep, voffB); PG8_STAGE(PG8_SA(1, 0), cA + kstep, voffA); PG8_STAGE(PG8_SB(1, 1), cB + hstep + kstep, voffB);
    PG8_WAIT_V(6); PG8_BAR;
    for (;;) {
        const bool has_next = S.next(ui + 1, nxt);
        const char* nA = has_next ? (const char*)g.A + (size_t)nxt.pm * tstep : cA; const char* nB = has_next ? (const char*)g.Bt + (size_t)nxt.pn * tstep : cB;
        for (int t = 0; t < nt; t += 2) {
            const bool last = (t == nt - 2);
            const char* a1 = cA + (size_t)(t + 1) * kstep;
            const char* a2 = last ? nA : cA + (size_t)(t + 2) * kstep; const char* b2 = last ? nB : cB + (size_t)(t + 2) * kstep;
            const char* a3 = a2 + kstep; const char* b3 = b2 + kstep;
            if (last && has_next) S.a_ready(nxt);
            PG8_LDB(B0, 0, 0); PG8_LDB(B1, 0, 1); PG8_SCHED; PG8_LDA(At, 0, 0); PG8_STAGE(PG8_SA(1, 1), a1 + hstepA, voffA);
            PG8_WAIT_V(8); PG8_WAIT_L(0); PG8_BAR; PG8_MMA(0, 0, At, B0); PG8_MMA(0, 1, At, B1); PG8_BAR; PG8_SCHED;
            PG8_LDA(At, 0, 1); PG8_STAGE(PG8_SB(0, 0), b2, voffB); PG8_STAGE(PG8_SB(0, 1), b2 + hstep, voffB); PG8_STAGE(PG8_SA(0, 0), a2, voffA);
            PG8_WAIT_V(8); PG8_WAIT_L(0); PG8_BAR; PG8_MMA(1, 0, At, B0); PG8_MMA(1, 1, At, B1); PG8_BAR; PG8_SCHED;
            PG8_LDB(B0, 1, 0); PG8_LDB(B1, 1, 1); PG8_SCHED; PG8_LDA(At, 1, 0); PG8_STAGE(PG8_SA(0, 1), a2 + hstepA, voffA);
            PG8_WAIT_V(8); PG8_WAIT_L(0); PG8_BAR; PG8_MMA(0, 0, At, B0); PG8_MMA(0, 1, At, B1); PG8_BAR; PG8_SCHED;
            PG8_LDA(At, 1, 1); PG8_STAGE(PG8_SB(1, 0), b3, voffB); PG8_STAGE(PG8_SB(1, 1), b3 + hstep, voffB); PG8_STAGE(PG8_SA(1, 0), a3, voffA);
            PG8_WAIT_V(8); PG8_WAIT_L(0); PG8_BAR; PG8_MMA(1, 0, At, B0); PG8_MMA(1, 1, At, B1); PG8_BAR; PG8_SCHED;
        }
        if (wr == 0) PG8_BAR;
        E(acc, cur, wr, wc, fr, fq); S.done(cur);
        if (!has_next) break;
#pragma unroll
        for (int a = 0; a < 2; ++a)
#pragma unroll
            for (int b = 0; b < 2; ++b)
#pragma unroll
                for (int m = 0; m < 4; ++m)
#pragma unroll
                    for (int n = 0; n < 2; ++n) acc[a][b][m][n] = (f32x4){0.f, 0.f, 0.f, 0.f};
        cur = nxt; cA = nA; cB = nB; ++ui;
        if (wr == 1) PG8_BAR;
    }
    PG8_WAIT_V(0);
    PG8_BAR;
#undef PG8_SA
#undef PG8_SB
#undef PG8_STAGE
#undef PG8_LDA
#undef PG8_LDB
#undef PG8_MMA
#undef PG8_WAIT_V
#undef PG8_WAIT_L
#undef PG8_BAR
#undef PG8_SCHED
}
}
constexpr int DM = 1024;
constexpr int ROW_S = 16384;
constexpr int ROW_M = 17408;
constexpr int NREAL = 17424;
constexpr int MPAD = 17664;
constexpr int PM_META = 68;
constexpr int NAB = 4096, NCC = 4096, DFF = 2816, NFF = 5632, ABW = 4104;
constexpr int NGRP = 138, GRP_META = 136;
constexpr float EPS = 1e-6f;
constexpr float KSCALE = 0.08838834764831845f;

constexpr size_t O_YP = 0, O_YS = 16777216, O_CP = 17825792, O_CS = 18350080, O_NP = 26738688, O_NS = 26742784, O_MP = 26808320, O_MS = 26808352,
                 O_RP = 26808864, O_RS = 27333152, O_HP = 35721760, O_HS = 36770336, O_FP = 53547552, O_FS = 53637664, O_END = 55079456;

constexpr size_t MiB = 1u << 20;
constexpr size_t WS_CTL = 0, CTL_ZERO_BYTES = 1 * MiB;
constexpr size_t WS_WAB = 1 * MiB, WS_WOAB = 9 * MiB, WS_WC = 11 * MiB, WS_WOC = 19 * MiB, WS_WF1 = 21 * MiB  , WS_WF2 = 43 * MiB  ;
constexpr size_t WS_XN = 54 * MiB;
constexpr size_t WS_Z = 89 * MiB;
constexpr size_t WS_XM = 227 * MiB;
constexpr size_t WS_G = 228 * MiB;
constexpr size_t WS_SBL = 229 * MiB;
constexpr size_t WS_SBF = 233 * MiB;
constexpr size_t WS_ROT = 240 * MiB;
constexpr size_t WS_XG = 242 * MiB;
constexpr size_t WS_SSQ = 277 * MiB;
constexpr size_t WS_END = 279 * MiB;
static_assert(WS_XN + (size_t)MPAD * DM * 2 <= WS_Z && WS_Z + (size_t)MPAD * 4096 * 2 <= WS_XM && WS_SBL + (size_t)NGRP * 2 * DFF * 4 <= WS_SBF && WS_SBF + (size_t)NGRP * 4 * DFF * 4 <= WS_END, "ws map");

constexpr int LDS_BYTES = 147456;
constexpr int NWAVES = 8;

#define GAS __attribute__((address_space(1)))
#define LAS __attribute__((address_space(3)))
typedef unsigned short bf16;
typedef float f32x4 __attribute__((ext_vector_type(4)));
typedef unsigned u32x2 __attribute__((ext_vector_type(2)));
typedef unsigned u32x4 __attribute__((ext_vector_type(4)));
#define LDS_WAIT() asm volatile("s_waitcnt lgkmcnt(0)" ::: "memory")

__device__ __forceinline__ unsigned f2bf(float f) { unsigned u = __builtin_bit_cast(unsigned, f); return (u + 0x7fffu + ((u >> 16) & 1u)) >> 16; }
__device__ __forceinline__ unsigned pk2(float lo, float hi) { return f2bf(lo) | (f2bf(hi) << 16); }
__device__ __forceinline__ float bf2f(unsigned short b) { return __builtin_bit_cast(float, ((unsigned)b) << 16); }
__device__ __forceinline__ float bflo(unsigned w) { return __builtin_bit_cast(float, w << 16); }
__device__ __forceinline__ float bfhi(unsigned w) { return __builtin_bit_cast(float, w & 0xffff0000u); }
__device__ __forceinline__ f32x4 ld_bf4(const bf16* p) { const u32x2 w = *(const u32x2*)p; return (f32x4){bflo(w.x), bfhi(w.x), bflo(w.y), bfhi(w.y)}; }
__device__ __forceinline__ float wave_sum(float v) {
#pragma unroll
    for (int o = 1; o < 64; o <<= 1) v += __shfl_xor(v, o);
    return v;
}
__device__ __forceinline__ float half_sum(float v) {
#pragma unroll
    for (int o = 1; o < 32; o <<= 1) v += __shfl_xor(v, o);
    return v;
}
__device__ __forceinline__ float sigmoidf_(float x) { return 1.f / (1.f + __expf(-x)); }
__device__ __forceinline__ float siluf_(float x) { return x / (1.f + __expf(-x)); }
__device__ __forceinline__ float logsigmoidf_(float x) { return fminf(x, 0.f) - log1pf(__expf(-fabsf(x))); }

struct Args { const float* in[26]; float* out; unsigned char* ws; int ph_lo, ph_hi; };

struct Frame {
    LAS unsigned char* lds;
    int tid, lane, wave, G, gw, NGW;
    const float* const* in; float* out; unsigned char* ws;
};
#define F_X0(F) ((F).out)
#define F_X1(F) ((float*)((F).ws + WS_XM) - (size_t)ROW_M * DM)
#define F_XN(F) ((bf16*)((F).ws + WS_XN))
#define F_XG(F) ((bf16*)((F).ws + WS_XG))
#define F_SSQ(F) ((float*)((F).ws + WS_SSQ))
#define F_Z(F) ((bf16*)((F).ws + WS_Z))
#define F_GT(F) ((float*)((F).ws + WS_G))
#define F_SBL(F) ((float*)((F).ws + WS_SBL))
#define F_SBF(F) ((float*)((F).ws + WS_SBF))
__device__ __forceinline__ float* xrow(const Frame& F, int r) { return (r < ROW_M ? F_X0(F) : F_X1(F)) + (size_t)r * DM; }

__device__ __forceinline__ void p0_transpose_item(const float* W, int K, int Nsrc, int n0src, bf16* WT, int dstrow0, LAS float* scr, int kb, int lane) {
    const int k0 = 64 * kb;
#pragma unroll 8
    for (int i = 0; i < 32; ++i) { const int kk = 2 * i + (lane >> 5); scr[kk * 33 + (lane & 31)] = W[(size_t)(k0 + kk) * Nsrc + n0src + (lane & 31)]; }
    LDS_WAIT(); asm volatile("" ::: "memory");
    const int c = lane & 7;
#pragma unroll
    for (int j = 0; j < 4; ++j) { const int n = (lane >> 3) + 8 * j; const LAS float* s = scr + (8 * c) * 33 + n;
        u32x4 o; o.x = pk2(s[0 * 33], s[1 * 33]); o.y = pk2(s[2 * 33], s[3 * 33]); o.z = pk2(s[4 * 33], s[5 * 33]); o.w = pk2(s[6 * 33], s[7 * 33]);
        *(u32x4*)(WT + (size_t)(dstrow0 + n) * K + k0 + 8 * c) = o; }
    LDS_WAIT(); asm volatile("" ::: "memory");
}

__device__ __forceinline__ void p0_weights(Frame& F) {
    LAS float* scr = (LAS float*)(F.lds + F.wave * 16384);
    constexpr int I_AB = 16 * 128, I_O = 16 * 32, I_C = 16 * 128, I_F1 = 16 * 176, I_F2 = 44 * 32;
    constexpr int NIT = I_AB + I_O + I_C + I_O + 2 * I_F1 + 2 * I_F2;
    for (int it = F.gw; it < NIT; it += F.NGW) {
        int r = it;
        if (r < I_AB) { const int kb = r / 128, nb = r % 128; p0_transpose_item(F.in[10], 1024, ABW, nb < 64 ? 32 * nb : 32 * nb + 8, (bf16*)(F.ws + WS_WAB), 32 * nb, scr, kb, F.lane); continue; } r -= I_AB;
        if (r < I_O) { const int kb = r / 32, nb = r % 32; p0_transpose_item(F.in[15], 1024, 1024, 32 * nb, (bf16*)(F.ws + WS_WOAB), 32 * nb, scr, kb, F.lane); continue; } r -= I_O;
        if (r < I_C) { const int kb = r / 128, nb = r % 128; p0_transpose_item(F.in[17], 1024, 4096, 32 * nb, (bf16*)(F.ws + WS_WC), 32 * nb, scr, kb, F.lane); continue; } r -= I_C;
        if (r < I_O) { const int kb = r / 32, nb = r % 32; p0_transpose_item(F.in[19], 1024, 1024, 32 * nb, (bf16*)(F.ws + WS_WOC), 32 * nb, scr, kb, F.lane); continue; } r -= I_O;
        if (r < 2 * I_F1) { const int l = r / I_F1; r -= l * I_F1; const int kb = r / 176, nb = r % 176; const int c = 32 * nb;
            const int ch = c < DFF ? c : c - DFF; const int dst = 256 * (ch / 128) + (c < DFF ? 0 : 128) + (ch % 128);
            p0_transpose_item(F.in[21] + (size_t)l * 1024 * NFF, 1024, NFF, c, (bf16*)(F.ws + WS_WF1) + (size_t)l * NFF * 1024, dst, scr, kb, F.lane); continue; } r -= 2 * I_F1;
        { const int l = r / I_F2; r -= l * I_F2; const int kb = r / 32, nb = r % 32;
            p0_transpose_item(F.in[24] + (size_t)l * DFF * 1024, DFF, 1024, 32 * nb, (bf16*)(F.ws + WS_WF2) + (size_t)l * 1024 * DFF, 32 * nb, scr, kb, F.lane); }
    }
}

__device__ __forceinline__ void p0_rows(Frame& F) {
    LAS float* wg = (LAS float*)F.lds;
    for (int i = F.tid; i < 8192; i += NWAVES * 64) { const int k = i >> 3, c = i & 7; wg[c * 1024 + k] = F.in[10][(size_t)k * ABW + 2048 + c]; }
    __syncthreads();
    const float* gain = F.in[9];
    for (int r = F.gw; r < MPAD; r += F.NGW) {
        const float* src = nullptr;
        if (r < ROW_S) src = F.in[0] + (size_t)r * DM; else if (r < ROW_M) src = F.in[1] + (size_t)(r - ROW_S) * DM; else if (r < NREAL) src = F.in[8] + (size_t)(r - ROW_M) * DM;
        f32x4 v[4]; float ss = 0.f;
#pragma unroll
        for (int j = 0; j < 4; ++j) { v[j] = src ? *(const f32x4*)(src + 4 * F.lane + 256 * j) : (f32x4){0.f, 0.f, 0.f, 0.f}; ss += (v[j].x * v[j].x + v[j].y * v[j].y) + (v[j].z * v[j].z + v[j].w * v[j].w); }
        const float rs = rsqrtf(wave_sum(ss) * (1.f / DM) + EPS);
        float* xr = xrow(F, r); bf16* xn = F_XG(F) + (size_t)r * DM;
        float ga[8];
#pragma unroll
        for (int c = 0; c < 8; ++c) ga[c] = 0.f;
#pragma unroll
        for (int j = 0; j < 4; ++j) {
            *(f32x4*)(xr + 4 * F.lane + 256 * j) = v[j];
            const f32x4 gn = *(const f32x4*)(gain + 4 * F.lane + 256 * j);
            const f32x4 y = v[j] * rs * gn;
            u32x2 w; w.x = pk2(y.x, y.y); w.y = pk2(y.z, y.w);
            *(u32x2*)(xn + 4 * F.lane + 256 * j) = w;
#pragma unroll
            for (int c = 0; c < 8; ++c) { const f32x4 wv = *(const LAS f32x4*)(wg + c * 1024 + 4 * F.lane + 256 * j); ga[c] += (y.x * wv.x + y.y * wv.y) + (y.z * wv.z + y.w * wv.w); }
        }
#pragma unroll
        for (int c = 0; c < 8; ++c) ga[c] = wave_sum(ga[c]);
        if (F.lane == 0) { *(f32x4*)(F_GT(F) + (size_t)r * 8) = (f32x4){ga[0], ga[1], ga[2], ga[3]}; *(f32x4*)(F_GT(F) + (size_t)r * 8 + 4) = (f32x4){ga[4], ga[5], ga[6], ga[7]}; }
    }
}

__device__ __forceinline__ void rms_final(Frame& F, const float* gain) {
    for (int r = F.gw; r < ROW_M; r += F.NGW) {
        float* xr = F_X0(F) + (size_t)r * DM; f32x4 v[4]; float ss = 0.f;
#pragma unroll
        for (int j = 0; j < 4; ++j) { v[j] = *(const f32x4*)(xr + 4 * F.lane + 256 * j); ss += (v[j].x * v[j].x + v[j].y * v[j].y) + (v[j].z * v[j].z + v[j].w * v[j].w); }
        const float rs = rsqrtf(wave_sum(ss) * (1.f / DM) + EPS);
#pragma unroll
        for (int j = 0; j < 4; ++j) { const f32x4 gn = *(const f32x4*)(gain + 4 * F.lane + 256 * j); *(f32x4*)(xr + 4 * F.lane + 256 * j) = v[j] * rs * gn; }
    }
}

struct EpiFfn {
    static constexpr bool PERM = true, AFTER_DRAIN = false;
    bf16* H; const float* cw; const float* cb; const float* cst; float* cso; float* sbl; float* sbf; const float* ssq;
    __device__ __forceinline__ void operator()(f32x4 (&acc)[2][2][4][2], const pg8::Unit& u, int wr, int wc, int fr, int fq) const {
        const int ch0 = 128 * u.pn + 32 * wc + 8 * fq;
        const int tok0 = 256 * u.pm + 128 * wr + 8 * fr;
        const int grp = 2 * u.pm + wr;
        const bool samp = (u.pm >= 64 && u.pm < PM_META), meta = (u.pm == PM_META);
        const int sb = 32 * (u.pm - 64) + 16 * wr + fr;
        const bool defer = (!samp && !meta && fr == 0);
        const bool lastlane = meta ? (wr == 0 && fr == 1) : (!samp && fr == 15);
#pragma unroll
        for (int k = 0; k < 8; ++k) { const float rs = pg8::row_rs(ssq, tok0 + k, fq);
#pragma unroll
            for (int bj = 0; bj < 2; ++bj)
#pragma unroll
                for (int n = 0; n < 2; ++n) acc[k >> 2][bj][k & 3][n] = acc[k >> 2][bj][k & 3][n] * rs; }
#pragma unroll
        for (int n = 0; n < 2; ++n) {
            const int c4 = ch0 + 4 * n;
            const f32x4 w0 = *(const f32x4*)(cw + c4), w1 = *(const f32x4*)(cw + DFF + c4), w2 = *(const f32x4*)(cw + 2 * DFF + c4), bb = *(const f32x4*)(cb + c4);
            f32x4 p6, p7;
#pragma unroll
            for (int e = 0; e < 4; ++e) { p6[e] = __shfl_up(acc[1][0][2][n][e], 1, 16); p7[e] = __shfl_up(acc[1][0][3][n][e], 1, 16); }
            if (samp) { p6 = *(const f32x4*)(cst + (size_t)(sb * 2 + 0) * DFF + c4); p7 = *(const f32x4*)(cst + (size_t)(sb * 2 + 1) * DFF + c4); }
            if (meta && wr == 0 && fr == 0) { p6 = (f32x4){0.f, 0.f, 0.f, 0.f}; p7 = p6; }
#pragma unroll
            for (int k = 0; k < 8; ++k) {
                const f32x4 uk = acc[k >> 2][0][k & 3][n], gk = acc[k >> 2][1][k & 3][n];
                const f32x4 um1 = (k >= 1) ? acc[(k - 1 < 0 ? 0 : k - 1) >> 2][0][(k - 1 < 0 ? 0 : k - 1) & 3][n] : p7;
                const f32x4 um2 = (k >= 2) ? acc[(k - 2 < 0 ? 0 : k - 2) >> 2][0][(k - 2 < 0 ? 0 : k - 2) & 3][n] : (k == 1 ? p7 : p6);
                const f32x4 cv = bb + w0 * um2 + w1 * um1 + w2 * uk;
                f32x4 hv;
#pragma unroll
                for (int e = 0; e < 4; ++e) hv[e] = siluf_(cv[e]) * gk[e];
                if (defer && k < 2) {
                    *(f32x4*)(sbf + (size_t)((grp * 2 + k) * 2 + 0) * DFF + c4) = uk;
                    *(f32x4*)(sbf + (size_t)((grp * 2 + k) * 2 + 1) * DFF + c4) = gk;
                } else {
                    u32x2 w; w.x = pg8::cvt_pk_bf16(hv[0], hv[1]); w.y = pg8::cvt_pk_bf16(hv[2], hv[3]);
                    *(u32x2*)(H + (size_t)(tok0 + k) * DFF + c4) = w;
                }
            }
            if (lastlane) { *(f32x4*)(sbl + (size_t)(grp * 2 + 0) * DFF + c4) = acc[1][0][2][n]; *(f32x4*)(sbl + (size_t)(grp * 2 + 1) * DFF + c4) = acc[1][0][3][n]; }
            if (samp) { *(f32x4*)(cso + (size_t)(sb * 2 + 0) * DFF + c4) = acc[1][0][2][n]; *(f32x4*)(cso + (size_t)(sb * 2 + 1) * DFF + c4) = acc[1][0][3][n]; }
        }
    }
};

__device__ __forceinline__ void ffn_fixup(Frame& F, int layer) {
    const float* cw = F.in[22] + (size_t)layer * 3 * DFF; const float* cb = F.in[23] + (size_t)layer * DFF;
    bf16* H = F_Z(F);
    const int gt = blockIdx.x * (NWAVES * 64) + F.tid, NT = F.G * NWAVES * 64;
    for (int i = gt; i < 128 * DFF; i += NT) {
        const int grp = i / DFF, ch = i - grp * DFF;
        const int r0 = 128 * grp;
        const int pg = (r0 % 2048 == 0) ? GRP_META : grp - 1;
        const float um2 = F_SBL(F)[(size_t)(pg * 2 + 0) * DFF + ch], um1 = F_SBL(F)[(size_t)(pg * 2 + 1) * DFF + ch];
        const float u0 = F_SBF(F)[(size_t)((grp * 2 + 0) * 2 + 0) * DFF + ch], g0 = F_SBF(F)[(size_t)((grp * 2 + 0) * 2 + 1) * DFF + ch];
        const float u1 = F_SBF(F)[(size_t)((grp * 2 + 1) * 2 + 0) * DFF + ch], g1 = F_SBF(F)[(size_t)((grp * 2 + 1) * 2 + 1) * DFF + ch];
        const float w0 = cw[ch], w1 = cw[DFF + ch], w2 = cw[2 * DFF + ch], bb = cb[ch];
        const float c0 = bb + w0 * um2 + w1 * um1 + w2 * u0, c1 = bb + w0 * um1 + w1 * u0 + w2 * u1;
        H[(size_t)r0 * DFF + ch] = (bf16)f2bf(siluf_(c0) * g0);
        H[(size_t)(r0 + 1) * DFF + ch] = (bf16)f2bf(siluf_(c1) * g1);
    }
    float* fo = F.out + O_FP + (size_t)layer * 8 * 2 * DFF;
    for (int i = gt; i < 8 * 2 * DFF; i += NT) {
        const int b = i / (2 * DFF), rem = i - b * 2 * DFF, j = rem / DFF, ch = rem - j * DFF;
        const int grp = 2 * (8 * b + 7) + 1;
        fo[i] = F_SBL(F)[(size_t)(grp * 2 + j) * DFF + ch];
    }
}
typedef short bf16x8 __attribute__((ext_vector_type(8)));
typedef short v4i16_t __attribute__((ext_vector_type(4)));
constexpr int MX_PITCH = 272;
constexpr int MX_Q = 0, MX_K = 17408, MX_KH = 34816, MX_V = 52224, MX_GD = 69632  , MX_SC = 71680  , MX_OB = 74752  , MX_RP = 108544  , MX_DI = 110592  , MX_GN = 110848  , MX_LB = 111360  , MX_END = 111872;
constexpr int MX_OP = 132;
constexpr float LNKS = -2.4260151319598084f;
static_assert(MX_END <= 139264, "mixer LDS map");

__device__ __forceinline__ bf16x8 mk8(unsigned a, unsigned b, unsigned c, unsigned d) { const u32x4 v = {a, b, c, d}; return __builtin_bit_cast(bf16x8, v); }
__device__ __forceinline__ u32x2 tr16(const LAS unsigned char* p) { return __builtin_bit_cast(u32x2, __builtin_amdgcn_ds_read_tr16_b64_v4i16((LAS v4i16_t*)p)); }
__device__ __forceinline__ unsigned pkbf(float lo, float hi) { return pg8::cvt_pk_bf16(lo, hi); }
#define MFMA16(a, b, c) __builtin_amdgcn_mfma_f32_16x16x32_bf16((a), (b), (c), 0, 0, 0)
template <int CTRL> __device__ __forceinline__ float dppf(float ident, float x) { return __builtin_bit_cast(float, __builtin_amdgcn_update_dpp(__builtin_bit_cast(int, ident), __builtin_bit_cast(int, x), CTRL, 0xf, 0xf, false)); }
__device__ __forceinline__ float row_prefix_sum(float x) { x += dppf<0x111>(0.f, x); x += dppf<0x112>(0.f, x); x += dppf<0x114>(0.f, x); x += dppf<0x118>(0.f, x); return x; }
__device__ __forceinline__ float row_prefix_max(float x) { x = fmaxf(x, dppf<0x111>(-3e38f, x)); x = fmaxf(x, dppf<0x112>(-3e38f, x)); x = fmaxf(x, dppf<0x114>(-3e38f, x)); x = fmaxf(x, dppf<0x118>(-3e38f, x)); return x; }
__device__ __forceinline__ float row_prefix_prod(float x) { x *= dppf<0x111>(1.f, x); x *= dppf<0x112>(1.f, x); x *= dppf<0x114>(1.f, x); x *= dppf<0x118>(1.f, x); return x; }
__device__ __forceinline__ float row_suffix_prod(float x) { x *= dppf<0x101>(1.f, x); x *= dppf<0x102>(1.f, x); x *= dppf<0x104>(1.f, x); x *= dppf<0x108>(1.f, x); return x; }
__device__ __forceinline__ float rdlane(float x, int l) { return __builtin_bit_cast(float, __builtin_amdgcn_readlane(__builtin_bit_cast(int, x), l)); }

constexpr int ROT_N = 2072;
__device__ __forceinline__ void p0_rotary(Frame& F, float* tab) {
    const int gt = blockIdx.x * (NWAVES * 64) + F.tid, NT = F.G * NWAVES * 64;
    for (int i = gt; i < ROT_N * 64; i += NT) {
        const int pi = i >> 6, fi = i & 63;
        const float pos = pi < 2064 ? (float)pi : (float)(16384 + pi - 2064);
        const float inv = 1.0f / powf(10000.0f, (float)fi * (1.0f / 63.0f));
        float sn, cs; sincosf(pos * inv, &sn, &cs);
        tab[2 * i] = cs; tab[2 * i + 1] = sn;
    }
}

#define MX_SC_PARAMS(scv, row0, ntok, nmc, pos0) do { if (prompt) { if ((scv) == 0) { row0 = ROW_M; ntok = 16; nmc = 1; pos0 = 0; } else { row0 = b * 2048 + ((scv) - 1) * 64; ntok = 64; nmc = 4; pos0 = 16 + ((scv) - 1) * 64; } } \
        else { row0 = ROW_S + 8 * b; ntok = 8; nmc = 1; pos0 = 2064; } } while (0)

template <int TYPE>
__device__ __forceinline__ void mix_sg_unit(Frame& F, int b, int h, bool prompt, const float* rot) {
    const int tid = F.tid, lane = F.lane, w = F.wave, r16 = lane & 15, q = lane >> 4;
    const int tk = tid >> 3, p = tid & 7;
    LAS unsigned char* L = F.lds;
    LAS float* OB = (LAS float*)(L + MX_OB); LAS float* RP = (LAS float*)(L + MX_RP); LAS float* DI = (LAS float*)(L + MX_DI);
    const bf16* Z = F_Z(F); bf16* MIX = F_XN(F);
    const int qcol = (TYPE == 0 ? 0 : 2048) + 128 * h, kcol = (TYPE == 0 ? 512 : 2560) + 128 * h, vcol = (TYPE == 0 ? 1024 : 3072) + 128 * h, gcol = (TYPE == 0 ? 1536 : 3584) + 128 * h, mcol = (TYPE == 0 ? 0 : 512) + 128 * h;
    f32x4 S[8]; f32x4 nacc = {0.f, 0.f, 0.f, 0.f}; float m0 = 0.f;
#pragma unroll
    for (int mt = 0; mt < 8; ++mt) S[mt] = (f32x4){0.f, 0.f, 0.f, 0.f};
    if (!prompt) {
        const float* Sin = (TYPE == 0 ? F.in[2] : F.in[5]) + (size_t)(b * 4 + h) * 16384;
#pragma unroll
        for (int mt = 0; mt < 8; ++mt)
#pragma unroll
            for (int r = 0; r < 4; ++r) S[mt][r] = Sin[(16 * mt + 4 * q + r) * 128 + 16 * w + r16];
        if (TYPE == 0) {
#pragma unroll
            for (int r = 0; r < 4; ++r) nacc[r] = F.in[3][(size_t)(b * 4 + h) * 128 + 16 * w + 4 * q + r];
            m0 = F.in[4][b * 4 + h];
        }
    }
    const float lgam = (TYPE == 1) ? log1pf(-exp2f(-5.f - (float)h)) : 0.f;
    const float bias_i = (TYPE == 0) ? F.in[11][h] : 0.f, bias_f = (TYPE == 0) ? F.in[12][h] : 0.f;
    LAS float* GN = (LAS float*)(L + MX_GN);
    if (tid < 128) GN[tid] = (TYPE == 0 ? F.in[13] : F.in[14])[128 * h + tid];
    const int nsc = prompt ? 33 : 1;
    u32x4 pa[6]; f32x4 pr[4]; float pli = 0.f, plf = 0.f; u32x4 pg[2];
    const u32x4 z4 = {0u, 0u, 0u, 0u};
#define SG_LOAD(scv) do { int row0_, ntok_, nmc_, pos0_; MX_SC_PARAMS(scv, row0_, ntok_, nmc_, pos0_); (void)nmc_; \
        const bool valid_ = tk < ntok_; const bf16* zr_ = Z + (size_t)(row0_ + (valid_ ? tk : 0)) * 4096; \
        _Pragma("unroll") for (int i_ = 0; i_ < 6; ++i_) pa[i_] = z4; \
        if (valid_) { pa[4] = *(const u32x4*)(zr_ + vcol + 16 * p); pa[5] = *(const u32x4*)(zr_ + vcol + 16 * p + 8); \
            if (TYPE == 0) { pa[0] = *(const u32x4*)(zr_ + qcol + 16 * p); pa[1] = *(const u32x4*)(zr_ + qcol + 16 * p + 8); pa[2] = *(const u32x4*)(zr_ + kcol + 16 * p); pa[3] = *(const u32x4*)(zr_ + kcol + 16 * p + 8); } \
            else { pa[0] = *(const u32x4*)(zr_ + qcol + 8 * p); pa[1] = *(const u32x4*)(zr_ + qcol + 64 + 8 * p); pa[2] = *(const u32x4*)(zr_ + kcol + 8 * p); pa[3] = *(const u32x4*)(zr_ + kcol + 64 + 8 * p); } } \
        if (TYPE == 1) { const float* tb_ = rot + ((size_t)(pos0_ + (valid_ ? tk : 0)) * 64 + 8 * p) * 2; _Pragma("unroll") for (int e_ = 0; e_ < 4; ++e_) pr[e_] = *(const f32x4*)(tb_ + 4 * e_); } \
        if (TYPE == 0 && w == 0) { const bool vt_ = lane < ntok_; const float* gp_ = F_GT(F) + (size_t)(row0_ + (vt_ ? lane : 0)) * 8; pli = gp_[h]; plf = gp_[4 + h]; } } while (0)
    SG_LOAD(0);
#pragma unroll 1
    for (int sc = 0; sc < nsc; ++sc) {
        int row0, ntok, nmc, pos0; MX_SC_PARAMS(sc, row0, ntok, nmc, pos0); (void)pos0;
        LAS float* SC = (LAS float*)(L + MX_SC) + (sc & 1) * 384;
        if (tk < 16 * nmc) {
            *(LAS u32x4*)(L + MX_V + tk * MX_PITCH + 32 * p) = pa[4]; *(LAS u32x4*)(L + MX_V + tk * MX_PITCH + 32 * p + 16) = pa[5];
            if (TYPE == 0) {
                *(LAS u32x4*)(L + MX_Q + tk * MX_PITCH + 32 * p) = pa[0]; *(LAS u32x4*)(L + MX_Q + tk * MX_PITCH + 32 * p + 16) = pa[1];
                *(LAS u32x4*)(L + MX_K + tk * MX_PITCH + 32 * p) = pa[2]; *(LAS u32x4*)(L + MX_K + tk * MX_PITCH + 32 * p + 16) = pa[3];
            } else {
                u32x4 q1, q2, k1, k2;
#pragma unroll
                for (int e2 = 0; e2 < 4; ++e2) {
                    const f32x4 cs = pr[e2];
                    { const float x1l = bflo(pa[0][e2]), x1h = bfhi(pa[0][e2]), x2l = bflo(pa[1][e2]), x2h = bfhi(pa[1][e2]);
                      q1[e2] = pkbf(x1l * cs[0] - x2l * cs[1], x1h * cs[2] - x2h * cs[3]); q2[e2] = pkbf(x2l * cs[0] + x1l * cs[1], x2h * cs[2] + x1h * cs[3]); }
                    { const float x1l = bflo(pa[2][e2]), x1h = bfhi(pa[2][e2]), x2l = bflo(pa[3][e2]), x2h = bfhi(pa[3][e2]);
                      k1[e2] = pkbf(x1l * cs[0] - x2l * cs[1], x1h * cs[2] - x2h * cs[3]); k2[e2] = pkbf(x2l * cs[0] + x1l * cs[1], x2h * cs[2] + x1h * cs[3]); }
                }
                *(LAS u32x4*)(L + MX_Q + tk * MX_PITCH + 16 * p) = q1; *(LAS u32x4*)(L + MX_Q + tk * MX_PITCH + 128 + 16 * p) = q2;
                *(LAS u32x4*)(L + MX_K + tk * MX_PITCH + 16 * p) = k1; *(LAS u32x4*)(L + MX_K + tk * MX_PITCH + 128 + 16 * p) = k2;
            }
        }
        if (w == 0) {
            const bool valid = lane < ntok;
            float li = -1e30f, lf = 0.f;
            if (TYPE == 0) { if (valid) { li = pli + bias_i; lf = logsigmoidf_(plf + bias_f); } } else { if (valid) { li = 0.f; lf = lgam; } }
            const float bb = row_prefix_sum(lf);
            const float y = li - bb;
            const float am = row_prefix_max(y);
            const float a = bb + am;
            const float B0 = rdlane(bb, 15), B1 = rdlane(bb, 31), B2 = rdlane(bb, 47), B3 = rdlane(bb, 63);
            float M1 = 0.f, M2 = 0.f, M3 = 0.f, M4 = 0.f;
            if (TYPE == 0) { const float A0 = rdlane(a, 15), A1 = rdlane(a, 31), A2 = rdlane(a, 47), A3 = rdlane(a, 63);
                M1 = fmaxf(B0 + m0, A0); M2 = fmaxf(B1 + M1, A1); M3 = fmaxf(B2 + M2, A2); M4 = fmaxf(B3 + M3, A3); }
            const float m0q = q == 0 ? m0 : q == 1 ? M1 : q == 2 ? M2 : M3;
            const float mnq = q == 0 ? M1 : q == 1 ? M2 : q == 2 ? M3 : M4;
            const float b15 = q == 0 ? B0 : q == 1 ? B1 : q == 2 ? B2 : B3;
            const float m = (TYPE == 0) ? fmaxf(bb + m0q, a) : 0.f;
            SC[lane] = bb - m; SC[64 + lane] = y + LNKS; SC[128 + lane] = __expf(bb + m0q - m);
            SC[192 + lane] = __expf(y + LNKS + b15 - mnq); SC[256 + lane] = __expf(-m);
            if (r16 == 0) SC[320 + q] = __expf(b15 + m0q - mnq);
            m0 = (nmc == 4) ? M4 : M1;
        }
        __syncthreads();
        if (sc + 1 < nsc) SG_LOAD(sc + 1);
        { const bool valid = tk < ntok; const bf16* zr = Z + (size_t)(row0 + (valid ? tk : 0)) * 4096 + gcol + 16 * p; pg[0] = *(const u32x4*)zr; pg[1] = *(const u32x4*)(zr + 8); }
#pragma unroll 1
        for (int mc = 0; mc < nmc; ++mc) {
            {
                const LAS unsigned char* Qb = L + MX_Q + 16 * mc * MX_PITCH; const LAS unsigned char* Kb = L + MX_K + 16 * mc * MX_PITCH; const LAS unsigned char* Vb = L + MX_V + 16 * mc * MX_PITCH;
                f32x4 g = {0.f, 0.f, 0.f, 0.f};
#pragma unroll
                for (int ks = 0; ks < 4; ++ks) {
                    const u32x2 ka = *(const LAS u32x2*)(Kb + r16 * MX_PITCH + (32 * ks + 4 * q) * 2), kb = *(const LAS u32x2*)(Kb + r16 * MX_PITCH + (32 * ks + 16 + 4 * q) * 2);
                    const u32x2 qa = *(const LAS u32x2*)(Qb + r16 * MX_PITCH + (32 * ks + 4 * q) * 2), qb = *(const LAS u32x2*)(Qb + r16 * MX_PITCH + (32 * ks + 16 + 4 * q) * 2);
                    g = MFMA16(mk8(ka.x, ka.y, kb.x, kb.y), mk8(qa.x, qa.y, qb.x, qb.y), g);
                }
                const float xi = SC[mc * 16 + r16]; const f32x4 y4 = *(const LAS f32x4*)(SC + 64 + mc * 16 + 4 * q);
                f32x4 P;
#pragma unroll
                for (int r = 0; r < 4; ++r) P[r] = (4 * q + r <= r16) ? g[r] * __expf(xi + y4[r]) : 0.f;
                if (TYPE == 0) { float ps = (P[0] + P[1]) + (P[2] + P[3]); ps += __shfl_xor(ps, 16); ps += __shfl_xor(ps, 32); if (w == 0 && q == 0) DI[16 * mc + r16] = ps; }
                const u32x2 vt = tr16(Vb + (4 * q + (r16 >> 2)) * MX_PITCH + (16 * w + 4 * (r16 & 3)) * 2);
                f32x4 o1 = {0.f, 0.f, 0.f, 0.f}; o1 = MFMA16(mk8(pkbf(P[0], P[1]), pkbf(P[2], P[3]), 0u, 0u), mk8(vt.x, vt.y, 0u, 0u), o1);
#pragma unroll
                for (int r = 0; r < 4; ++r) OB[(16 * mc + 4 * q + r) * MX_OP + 16 * w + r16] = o1[r];
            }
        }
#pragma unroll 1
        for (int mc = 0; mc < nmc; ++mc) {
            {
                const LAS unsigned char* Qb = L + MX_Q + 16 * mc * MX_PITCH; const LAS unsigned char* Kb = L + MX_K + 16 * mc * MX_PITCH;
                const u32x2 vt = tr16(L + MX_V + 16 * mc * MX_PITCH + (4 * q + (r16 >> 2)) * MX_PITCH + (16 * w + 4 * (r16 & 3)) * 2);
                f32x4 o2 = {0.f, 0.f, 0.f, 0.f};
#pragma unroll
                for (int ks = 0; ks < 4; ++ks) {
                    const u32x2 qa = *(const LAS u32x2*)(Qb + r16 * MX_PITCH + (32 * ks + 4 * q) * 2), qb = *(const LAS u32x2*)(Qb + r16 * MX_PITCH + (32 * ks + 16 + 4 * q) * 2);
                    const bf16x8 SB = mk8(pkbf(S[2 * ks][0], S[2 * ks][1]), pkbf(S[2 * ks][2], S[2 * ks][3]), pkbf(S[2 * ks + 1][0], S[2 * ks + 1][1]), pkbf(S[2 * ks + 1][2], S[2 * ks + 1][3]));
                    o2 = MFMA16(mk8(qa.x, qa.y, qb.x, qb.y), SB, o2);
                }
                const f32x4 in4 = *(const LAS f32x4*)(SC + 128 + mc * 16 + 4 * q);
#pragma unroll
                for (int r = 0; r < 4; ++r) { LAS float* op = OB + (16 * mc + 4 * q + r) * MX_OP + 16 * w + r16; *op = *op + in4[r] * o2[r]; }
                const f32x4 w4 = *(const LAS f32x4*)(SC + 192 + mc * 16 + 4 * q); const float carry = SC[320 + mc];
                if (TYPE == 0) {
                    const u32x2 qn = *(const LAS u32x2*)(Qb + r16 * MX_PITCH + (16 * w + 4 * q) * 2);
                    f32x4 rr = {0.f, 0.f, 0.f, 0.f}; rr = MFMA16(mk8(qn.x, qn.y, 0u, 0u), mk8(pkbf(nacc[0], nacc[1]), pkbf(nacc[2], nacc[3]), 0u, 0u), rr);
                    if (r16 == 0) {
#pragma unroll
                        for (int r = 0; r < 4; ++r) RP[w * 64 + 16 * mc + 4 * q + r] = rr[r]; }
                }
                const bf16x8 VH = mk8(pkbf(bflo(vt.x) * w4[0], bfhi(vt.x) * w4[1]), pkbf(bflo(vt.y) * w4[2], bfhi(vt.y) * w4[3]), 0u, 0u);
#pragma unroll
                for (int mt = 0; mt < 8; ++mt) {
                    const u32x2 kt = tr16(Kb + (4 * q + (r16 >> 2)) * MX_PITCH + (16 * mt + 4 * (r16 & 3)) * 2);
                    S[mt] = S[mt] * carry; S[mt] = MFMA16(mk8(kt.x, kt.y, 0u, 0u), VH, S[mt]);
                }
                if (TYPE == 0) {
                    const u32x2 kt = tr16(Kb + (4 * q + (r16 >> 2)) * MX_PITCH + (16 * w + 4 * (r16 & 3)) * 2);
                    nacc = nacc * carry; nacc = MFMA16(mk8(kt.x, kt.y, 0u, 0u), mk8(pkbf(w4[0], w4[1]), pkbf(w4[2], w4[3]), 0u, 0u), nacc);
                }
            }
        }
        __syncthreads();
        {
            const bool valid = tk < ntok; const int row = row0 + (valid ? tk : 0);
            f32x4 o[4];
#pragma unroll
            for (int c = 0; c < 4; ++c) o[c] = *(const LAS f32x4*)(OB + tk * MX_OP + 16 * p + 4 * c);
            if (tk >= 16 * nmc) {
#pragma unroll
                for (int c = 0; c < 4; ++c) o[c] = (f32x4){0.f, 0.f, 0.f, 0.f}; }
            if (TYPE == 0) {
                float rs = 0.f;
#pragma unroll
                for (int ww = 0; ww < 8; ++ww) rs += RP[ww * 64 + tk];
                const float den = DI[tk] + SC[128 + tk] * rs;
                float dn = fmaxf(fabsf(den), SC[256 + tk]); if (tk >= 16 * nmc) dn = 1.f;
                const float rd = 1.f / dn;
#pragma unroll
                for (int c = 0; c < 4; ++c) o[c] = o[c] * rd;
            }
            float sm = 0.f;
#pragma unroll
            for (int c = 0; c < 4; ++c) sm += (o[c].x + o[c].y) + (o[c].z + o[c].w);
            sm += __shfl_xor(sm, 1); sm += __shfl_xor(sm, 2); sm += __shfl_xor(sm, 4);
            const float mu = sm * (1.f / 128.f); float vs = 0.f;
#pragma unroll
            for (int c = 0; c < 4; ++c) { o[c] = o[c] - mu; vs += (o[c].x * o[c].x + o[c].y * o[c].y) + (o[c].z * o[c].z + o[c].w * o[c].w); }
            vs += __shfl_xor(vs, 1); vs += __shfl_xor(vs, 2); vs += __shfl_xor(vs, 4);
            const float rstd = rsqrtf(vs * (1.f / 128.f) + EPS);
            if (valid) {
                unsigned ow[8];
#pragma unroll
                for (int c = 0; c < 4; ++c) {
                    const unsigned ga = c < 2 ? pg[0][2 * c] : pg[1][2 * c - 4], gb = c < 2 ? pg[0][2 * c + 1] : pg[1][2 * c - 3];
                    f32x4 gt = {bflo(ga), bfhi(ga), bflo(gb), bfhi(gb)};
#pragma unroll
                    for (int e = 0; e < 4; ++e) gt[e] = (TYPE == 0) ? sigmoidf_(gt[e]) : siluf_(gt[e]);
                    const f32x4 r = o[c] * rstd * *(const LAS f32x4*)(GN + 16 * p + 4 * c) * gt;
                    ow[2 * c] = pkbf(r.x, r.y); ow[2 * c + 1] = pkbf(r.z, r.w);
                }
                bf16* mp = MIX + (size_t)row * DM + mcol + 16 * p;
                *(u32x4*)mp = (u32x4){ow[0], ow[1], ow[2], ow[3]}; *(u32x4*)(mp + 8) = (u32x4){ow[4], ow[5], ow[6], ow[7]};
            }
        }
    }
#undef SG_LOAD
    __syncthreads();
    {
        float* So = F.out + (TYPE == 0 ? (prompt ? O_CP : O_CS) : (prompt ? O_RP : O_RS)) + (size_t)(b * 4 + h) * 16384;
#pragma unroll
        for (int mt = 0; mt < 8; ++mt)
#pragma unroll
            for (int r = 0; r < 4; ++r) So[(16 * mt + 4 * q + r) * 128 + 16 * w + r16] = S[mt][r];
        if (TYPE == 0) {
            if (r16 == 0) { float* No = F.out + (prompt ? O_NP : O_NS) + (size_t)(b * 4 + h) * 128;
#pragma unroll
                for (int r = 0; r < 4; ++r) No[16 * w + 4 * q + r] = nacc[r]; }
            if (w == 0 && lane == 0) F.out[(prompt ? O_MP : O_MS) + b * 4 + h] = m0;
        }
    }
}

__device__ __forceinline__ void mix_hg_unit(Frame& F, int b, int h, bool prompt) {
    const int tid = F.tid, lane = F.lane, w = F.wave, r16 = lane & 15, q = lane >> 4;
    const int tk = tid >> 3, p = tid & 7;
    const int amc = w >> 1, app = q + 4 * (w & 1);
    LAS unsigned char* L = F.lds;
    LAS float* GD = (LAS float*)(L + MX_GD); LAS float* OB = (LAS float*)(L + MX_OB);
    const bf16* Z = F_Z(F); bf16* MIX = F_XN(F);
    f32x4 S[8];
#pragma unroll
    for (int mt = 0; mt < 8; ++mt) S[mt] = (f32x4){0.f, 0.f, 0.f, 0.f};
    if (!prompt) {
        const float* Sin = F.in[6] + (size_t)(b * 8 + h) * 16384;
#pragma unroll
        for (int mt = 0; mt < 8; ++mt)
#pragma unroll
            for (int r = 0; r < 4; ++r) S[mt][r] = Sin[(16 * mt + 4 * q + r) * 128 + 16 * w + r16];
    }
    LAS float* GN = (LAS float*)(L + MX_GN); LAS float* LB = (LAS float*)(L + MX_LB);
    if (tid < 128) { GN[tid] = F.in[18][128 * h + tid]; LB[tid] = sigmoidf_(F.in[16][1024 + 128 * h + tid] - F.in[16][128 * h + tid]); }
    __syncthreads();
    const int nsc = prompt ? 33 : 1;
    u32x4 pa[6]; u32x4 pg[2];
    const u32x4 z4 = {0u, 0u, 0u, 0u};
#define HG_LOAD(scv) do { int row0_, ntok_, nmc_, pos0_; MX_SC_PARAMS(scv, row0_, ntok_, nmc_, pos0_); (void)pos0_; \
        const int t_ = 16 * amc + r16; const bool valid_ = (amc < nmc_) && (t_ < ntok_); const bf16* zr_ = Z + (size_t)(row0_ + (valid_ ? t_ : 0)) * 4096 + 128 * h + 16 * app; \
        _Pragma("unroll") for (int i_ = 0; i_ < 6; ++i_) pa[i_] = z4; \
        if (valid_) { pa[0] = *(const u32x4*)zr_; pa[1] = *(const u32x4*)(zr_ + 8); pa[2] = *(const u32x4*)(zr_ + 1024); pa[3] = *(const u32x4*)(zr_ + 1032); pa[4] = *(const u32x4*)(zr_ + 2048); pa[5] = *(const u32x4*)(zr_ + 2056); } } while (0)
    HG_LOAD(0);
#pragma unroll 1
    for (int sc = 0; sc < nsc; ++sc) {
        int row0, ntok, nmc, pos0; MX_SC_PARAMS(sc, row0, ntok, nmc, pos0); (void)pos0;
        if (amc < nmc) {
            const bool valid = (16 * amc + r16) < ntok;
            unsigned wq[8], wk[8], wh[8]; float Aend[16]; float lbv[16];
#pragma unroll
            for (int c = 0; c < 4; ++c) { const f32x4 t4 = *(const LAS f32x4*)(LB + 16 * app + 4 * c); lbv[4 * c] = t4[0]; lbv[4 * c + 1] = t4[1]; lbv[4 * c + 2] = t4[2]; lbv[4 * c + 3] = t4[3]; }
#pragma unroll
            for (int e2 = 0; e2 < 8; ++e2) {
                const unsigned qw = e2 < 4 ? pa[0][e2] : pa[1][e2 - 4], fw = e2 < 4 ? pa[2][e2] : pa[3][e2 - 4];
                float qo[2], ko[2], ho[2];
#pragma unroll
                for (int hh = 0; hh < 2; ++hh) {
                    const int e = 2 * e2 + hh;
                    const float qv = hh ? bfhi(qw) : bflo(qw), fv = hh ? bfhi(fw) : bflo(fw);
                    const float sg = sigmoidf_(fv);
                    const float a = valid ? lbv[e] + (1.f - lbv[e]) * sg : 1.f;
                    const float kk = valid ? (1.f - lbv[e]) * (1.f - sg) : 0.f;
                    const float A = row_prefix_prod(a);
                    const float Sx = row_suffix_prod(a);
                    const float R = dppf<0x101>(1.f, Sx);
                    qo[hh] = qv * A; ko[hh] = kk * __builtin_amdgcn_rcpf(fmaxf(A, 1e-30f)); ho[hh] = kk * R; Aend[e] = A;
                }
                wq[e2] = pkbf(qo[0], qo[1]); wk[e2] = pkbf(ko[0], ko[1]); wh[e2] = pkbf(ho[0], ho[1]);
            }
            const int ro = (16 * amc + r16) * MX_PITCH + 32 * app;
            *(LAS u32x4*)(L + MX_Q + ro) = (u32x4){wq[0], wq[1], wq[2], wq[3]}; *(LAS u32x4*)(L + MX_Q + ro + 16) = (u32x4){wq[4], wq[5], wq[6], wq[7]};
            *(LAS u32x4*)(L + MX_K + ro) = (u32x4){wk[0], wk[1], wk[2], wk[3]}; *(LAS u32x4*)(L + MX_K + ro + 16) = (u32x4){wk[4], wk[5], wk[6], wk[7]};
            *(LAS u32x4*)(L + MX_KH + ro) = (u32x4){wh[0], wh[1], wh[2], wh[3]}; *(LAS u32x4*)(L + MX_KH + ro + 16) = (u32x4){wh[4], wh[5], wh[6], wh[7]};
            *(LAS u32x4*)(L + MX_V + ro) = pa[4]; *(LAS u32x4*)(L + MX_V + ro + 16) = pa[5];
            if (r16 == 15) {
#pragma unroll
                for (int c = 0; c < 4; ++c) *(LAS f32x4*)(GD + amc * 128 + 16 * app + 4 * c) = (f32x4){Aend[4 * c], Aend[4 * c + 1], Aend[4 * c + 2], Aend[4 * c + 3]}; }
        }
        __syncthreads();
        if (sc + 1 < nsc) HG_LOAD(sc + 1);
        { const bool valid = tk < ntok; const bf16* zr = Z + (size_t)(row0 + (valid ? tk : 0)) * 4096 + 3072 + 128 * h + 16 * p; pg[0] = *(const u32x4*)zr; pg[1] = *(const u32x4*)(zr + 8); }
#pragma unroll 1
        for (int mc = 0; mc < nmc; ++mc) {
            {
                const LAS unsigned char* Qb = L + MX_Q + 16 * mc * MX_PITCH; const LAS unsigned char* Kb = L + MX_K + 16 * mc * MX_PITCH; const LAS unsigned char* Vb = L + MX_V + 16 * mc * MX_PITCH;
                f32x4 g = {0.f, 0.f, 0.f, 0.f};
#pragma unroll
                for (int ks = 0; ks < 4; ++ks) {
                    const u32x2 ka = *(const LAS u32x2*)(Kb + r16 * MX_PITCH + (32 * ks + 4 * q) * 2), kb = *(const LAS u32x2*)(Kb + r16 * MX_PITCH + (32 * ks + 16 + 4 * q) * 2);
                    const u32x2 qa = *(const LAS u32x2*)(Qb + r16 * MX_PITCH + (32 * ks + 4 * q) * 2), qb = *(const LAS u32x2*)(Qb + r16 * MX_PITCH + (32 * ks + 16 + 4 * q) * 2);
                    g = MFMA16(mk8(ka.x, ka.y, kb.x, kb.y), mk8(qa.x, qa.y, qb.x, qb.y), g);
                }
                f32x4 P;
#pragma unroll
                for (int r = 0; r < 4; ++r) P[r] = (4 * q + r <= r16) ? g[r] : 0.f;
                const u32x2 vt = tr16(Vb + (4 * q + (r16 >> 2)) * MX_PITCH + (16 * w + 4 * (r16 & 3)) * 2);
                f32x4 o1 = {0.f, 0.f, 0.f, 0.f}; o1 = MFMA16(mk8(pkbf(P[0], P[1]), pkbf(P[2], P[3]), 0u, 0u), mk8(vt.x, vt.y, 0u, 0u), o1);
#pragma unroll
                for (int r = 0; r < 4; ++r) OB[(16 * mc + 4 * q + r) * MX_OP + 16 * w + r16] = o1[r];
            }
        }
#pragma unroll 1
        for (int mc = 0; mc < nmc; ++mc) {
            {
                const LAS unsigned char* Qb = L + MX_Q + 16 * mc * MX_PITCH; const LAS unsigned char* Hb = L + MX_KH + 16 * mc * MX_PITCH;
                const u32x2 vt = tr16(L + MX_V + 16 * mc * MX_PITCH + (4 * q + (r16 >> 2)) * MX_PITCH + (16 * w + 4 * (r16 & 3)) * 2);
                f32x4 oo;
#pragma unroll
                for (int r = 0; r < 4; ++r) oo[r] = OB[(16 * mc + 4 * q + r) * MX_OP + 16 * w + r16];
#pragma unroll
                for (int ks = 0; ks < 4; ++ks) {
                    const u32x2 qa = *(const LAS u32x2*)(Qb + r16 * MX_PITCH + (32 * ks + 4 * q) * 2), qb = *(const LAS u32x2*)(Qb + r16 * MX_PITCH + (32 * ks + 16 + 4 * q) * 2);
                    const bf16x8 SB = mk8(pkbf(S[2 * ks][0], S[2 * ks][1]), pkbf(S[2 * ks][2], S[2 * ks][3]), pkbf(S[2 * ks + 1][0], S[2 * ks + 1][1]), pkbf(S[2 * ks + 1][2], S[2 * ks + 1][3]));
                    oo = MFMA16(mk8(qa.x, qa.y, qb.x, qb.y), SB, oo);
                }
#pragma unroll
                for (int r = 0; r < 4; ++r) OB[(16 * mc + 4 * q + r) * MX_OP + 16 * w + r16] = oo[r];
                const bf16x8 VB = mk8(vt.x, vt.y, 0u, 0u);
#pragma unroll
                for (int mt = 0; mt < 8; ++mt) {
                    const f32x4 gd = *(const LAS f32x4*)(GD + mc * 128 + 16 * mt + 4 * q);
                    const u32x2 kt = tr16(Hb + (4 * q + (r16 >> 2)) * MX_PITCH + (16 * mt + 4 * (r16 & 3)) * 2);
                    S[mt] = S[mt] * gd; S[mt] = MFMA16(mk8(kt.x, kt.y, 0u, 0u), VB, S[mt]);
                }
            }
        }
        __syncthreads();
        {
            const bool valid = tk < ntok; const int row = row0 + (valid ? tk : 0);
            f32x4 o[4];
#pragma unroll
            for (int c = 0; c < 4; ++c) o[c] = *(const LAS f32x4*)(OB + tk * MX_OP + 16 * p + 4 * c);
            if (tk >= 16 * nmc) {
#pragma unroll
                for (int c = 0; c < 4; ++c) o[c] = (f32x4){0.f, 0.f, 0.f, 0.f}; }
            float vs = 0.f;
#pragma unroll
            for (int c = 0; c < 4; ++c) vs += (o[c].x * o[c].x + o[c].y * o[c].y) + (o[c].z * o[c].z + o[c].w * o[c].w);
            vs += __shfl_xor(vs, 1); vs += __shfl_xor(vs, 2); vs += __shfl_xor(vs, 4);
            const float rstd = rsqrtf(vs * (1.f / 128.f) + EPS);
            if (valid) {
                unsigned ow[8];
#pragma unroll
                for (int c = 0; c < 4; ++c) {
                    const unsigned ga = c < 2 ? pg[0][2 * c] : pg[1][2 * c - 4], gb = c < 2 ? pg[0][2 * c + 1] : pg[1][2 * c - 3];
                    f32x4 gt = {bflo(ga), bfhi(ga), bflo(gb), bfhi(gb)};
#pragma unroll
                    for (int e = 0; e < 4; ++e) gt[e] = siluf_(gt[e]);
                    const f32x4 r = o[c] * rstd * *(const LAS f32x4*)(GN + 16 * p + 4 * c) * gt;
                    ow[2 * c] = pkbf(r.x, r.y); ow[2 * c + 1] = pkbf(r.z, r.w);
                }
                bf16* mp = MIX + (size_t)row * DM + 128 * h + 16 * p;
                *(u32x4*)mp = (u32x4){ow[0], ow[1], ow[2], ow[3]}; *(u32x4*)(mp + 8) = (u32x4){ow[4], ow[5], ow[6], ow[7]};
            }
        }
    }
#undef HG_LOAD
    __syncthreads();
    {
        float* So = F.out + (prompt ? O_HP : O_HS) + (size_t)(b * 8 + h) * 16384;
#pragma unroll
        for (int mt = 0; mt < 8; ++mt)
#pragma unroll
            for (int r = 0; r < 4; ++r) So[(16 * mt + 4 * q + r) * 128 + 16 * w + r16] = S[mt][r];
    }
}

__device__ __forceinline__ void mixer_layer0(Frame& F) {
    constexpr int NU = 64 + 1024;
    const float* rot = (const float*)(F.ws + WS_ROT);
    int u0, ustep, uend;
    if (F.G > 128) { if (blockIdx.x < 64) { u0 = blockIdx.x; ustep = NU; uend = 64; } else { u0 = 64 + (blockIdx.x - 64); ustep = F.G - 64; uend = NU; } } else { u0 = blockIdx.x; ustep = F.G; uend = NU; }
#pragma unroll 1
    for (int u = u0; u < uend; u += ustep) {
        int ty, bh; const bool prompt = u < 64;
        if (prompt) { ty = u >> 5; bh = u & 31; } else { const int su = u - 64; ty = su >> 9; bh = su & 511; }
        if (ty == 0) mix_sg_unit<0>(F, bh >> 2, bh & 3, prompt, rot); else mix_sg_unit<1>(F, bh >> 2, bh & 3, prompt, rot);
    }
}
__device__ __forceinline__ void mixer_layer1(Frame& F) {
    constexpr int NU = 64 + 1024;
    int u0, ustep, uend;
    if (F.G > 128) { if (blockIdx.x < 64) { u0 = blockIdx.x; ustep = NU; uend = 64; } else { u0 = 64 + (blockIdx.x - 64); ustep = F.G - 64; uend = NU; } } else { u0 = blockIdx.x; ustep = F.G; uend = NU; }
#pragma unroll 1
    for (int u = u0; u < uend; u += ustep) {
        const bool prompt = u < 64; const int bh = prompt ? u : u - 64;
        mix_hg_unit(F, bh >> 3, bh & 7, prompt);
    }
}
constexpr int NPHASE = 14;
constexpr int LDSCTL_OFF = 139264;
#define RLX_AGENT __ATOMIC_RELAXED, __HIP_MEMORY_SCOPE_AGENT
#define XB_TMO      128
#define XB_XCNT(j)  (256  + 64 * (j))
#define XB_XSUB(j)  (1280 + 64 * (j))
#define XB_XGEN(j)  (2304 + 64 * (j))
#define XB_TOP      3328
#define XB_TOPGEN   3392
#define XCD_BAR_WORDS 3456
#define XB_SPIN_CAP (1u << 18)

__device__ __forceinline__ unsigned xb_ld(unsigned* p)              { return __hip_atomic_load(p, __ATOMIC_RELAXED, __HIP_MEMORY_SCOPE_AGENT); }
__device__ __forceinline__ unsigned xb_add(unsigned* p, unsigned v) { return __hip_atomic_fetch_add(p, v, __ATOMIC_RELAXED, __HIP_MEMORY_SCOPE_AGENT); }
__device__ __forceinline__ unsigned xb_xcc_id() { return (unsigned)__builtin_amdgcn_s_getreg((3 << 11) | 20) & 0xFu; }
#define XB_SPIN(cond, bar) do { unsigned _sp = 0; while (cond) { __builtin_amdgcn_s_sleep(1); \
    if ((++_sp & 255u) == 0u) { if (xb_ld(&(bar)[XB_TMO])) break; if (_sp > XB_SPIN_CAP) { atomicAdd(&(bar)[XB_TMO], 1u); break; } } } } while (0)

struct XcdBarrier {
    unsigned* bar; unsigned x;
    volatile LAS unsigned* st;
};

__device__ __forceinline__ XcdBarrier xcd_barrier_post(unsigned* bar, volatile LAS unsigned* st) {
    XcdBarrier b; b.bar = bar; b.x = xb_xcc_id(); b.st = st;
    if (threadIdx.x == 0) (void)xb_add(&bar[XB_XCNT(b.x)], 1u);
    return b;
}
__device__ __forceinline__ void xcd_barrier_complete(unsigned* bar, unsigned x, unsigned& nloc, unsigned& nx) {
    const unsigned G = gridDim.x * gridDim.y * gridDim.z;
    unsigned sum, cnt, mine, sp = 0u;
    for (;;) {
        sum = 0u; cnt = 0u; mine = 0u;
#pragma unroll
        for (unsigned j = 0; j < 16; ++j) { const unsigned c = xb_ld(&bar[XB_XCNT(j)]); sum += c; cnt += (c > 0u) ? 1u : 0u; mine = (j == x) ? c : mine; }
        if (sum == G) break;
        __builtin_amdgcn_s_sleep(1);
        if ((++sp & 255u) == 0u) { if (xb_ld(&bar[XB_TMO])) break; if (sp > XB_SPIN_CAP) { atomicAdd(&bar[XB_TMO], 1u); break; } }
    }
    nloc = mine > 0u ? mine : 1u; nx = cnt > 0u ? cnt : 1u;
}

__device__ __forceinline__ void xcd_barrier(const XcdBarrier& b) {
    asm volatile("s_waitcnt vmcnt(0)" ::: "memory");
    __syncthreads();
    if (threadIdx.x == 0) {
        unsigned* bar = b.bar;
        __builtin_amdgcn_s_waitcnt(0);
        unsigned nloc = b.st[0], nx = b.st[1];
        if (nloc == 0u) { xcd_barrier_complete(bar, b.x, nloc, nx); b.st[0] = nloc; b.st[1] = nx; }
        const unsigned old = xb_add(&bar[XB_XSUB(b.x)], 1u);
        const unsigned gen = old / nloc;
        if (old + 1u == (gen + 1u) * nloc) {
            __builtin_amdgcn_fence(__ATOMIC_RELEASE, "agent");
            asm volatile("s_waitcnt vmcnt(0)" ::: "memory");
            const unsigned og = xb_add(&bar[XB_TOP], 1u);
            const unsigned tg = og / nx;
            if (og + 1u == (tg + 1u) * nx) xb_add(&bar[XB_TOPGEN], 1u);
            else XB_SPIN(xb_ld(&bar[XB_TOPGEN]) == tg, bar);
            __builtin_amdgcn_fence(__ATOMIC_ACQUIRE, "agent");
            xb_add(&bar[XB_XGEN(b.x)], 1u);
            asm volatile("s_waitcnt vmcnt(0)" ::: "memory");
        } else {
            XB_SPIN(xb_ld(&bar[XB_XGEN(b.x)]) == gen, bar);
            __builtin_amdgcn_fence(__ATOMIC_ACQUIRE, "agent");
            asm volatile("s_waitcnt vmcnt(0)" ::: "memory");
        }
    }
    __syncthreads();
}

#ifndef MK_N_LAUNCHES
#define MK_N_LAUNCHES 1
#endif

__global__ void __launch_bounds__(NWAVES * 64, 2) fwd_kernel(Args args) {
    extern __shared__ __attribute__((aligned(16))) unsigned char lds_raw[];
    cg::grid_group grid = cg::this_grid();
    Frame F;
    F.lds = (LAS unsigned char*)lds_raw;
#define REFRESH() do { int t_ = threadIdx.x; asm volatile("" : "+v"(t_)); F.tid = t_; F.lane = t_ & 63; F.wave = __builtin_amdgcn_readfirstlane(t_ >> 6); F.gw = blockIdx.x * NWAVES + F.wave; } while (0)
    F.G = gridDim.x; F.NGW = F.G * NWAVES; REFRESH();
    F.in = args.in; F.out = args.out; F.ws = args.ws;
    const int lo = args.ph_lo, hi = args.ph_hi;
    volatile LAS unsigned* MISC = (volatile LAS unsigned*)(F.lds + LDSCTL_OFF);
    if (threadIdx.x < 16) MISC[threadIdx.x] = 0u;
    __syncthreads();
    (void)xcd_barrier_post((unsigned*)(args.ws + WS_CTL), MISC + 8);
#ifndef KMASK
#define KMASK 0x1ff
#endif
#define IN(k) (lo <= (k) && (k) < hi)
#define INK(kind, k) ((((KMASK) >> (kind)) & 1) && IN(k))
#define SEAM(k) do { if (IN(k) && IN((k) + 1)) { if ((k) == 0) grid.sync(); else { XcdBarrier bar_; bar_.bar = (unsigned*)(args.ws + WS_CTL); bar_.x = xb_xcc_id(); bar_.st = (volatile LAS unsigned*)(F.lds + LDSCTL_OFF) + 8; xcd_barrier(bar_); } } } while (0)

    if (INK(0, 0)) { p0_weights(F); __syncthreads(); REFRESH(); p0_rows(F); REFRESH(); p0_rotary(F, (float*)(args.ws + WS_ROT)); }
    SEAM(0);
#pragma unroll 1
    for (int layer = 0; layer < 2; ++layer) {
        const int pb = 1 + 6 * layer;
        if (INK(1, pb)) {
            pg8::Gemm g{F_XG(F), (const bf16*)(args.ws + (layer == 0 ? WS_WAB : WS_WC)), MPAD, 4096, 1024}; pg8::StaticOrder S; S.init(MPAD, 4096, F.G, (int)blockIdx.x);
            pg8::EpiBf16 E{F_Z(F), 4096, layer == 0 ? (const float*)nullptr : (const float*)F_SSQ(F)};
            pg8::gemm_phase<pg8::EpiBf16, pg8::StaticOrder, false>(F.lds, g, S, E);
        }
        SEAM(pb);
        if (INK(2, pb + 1)) { REFRESH(); if (layer == 0) mixer_layer0(F); else mixer_layer1(F); }
        SEAM(pb + 1);
        if (INK(3, pb + 2)) {
            pg8::Gemm g{F_XN(F), (const bf16*)(args.ws + (layer == 0 ? WS_WOAB : WS_WOC)), MPAD, 1024, 1024}; pg8::StaticOrder S; S.init(MPAD, 1024, F.G, (int)blockIdx.x);
            pg8::EpiResid E{F_X0(F), F_X1(F), PM_META, DM, F_XG(F), F.in[20] + (size_t)layer * DM, F_SSQ(F)};
            pg8::gemm_phase<pg8::EpiResid, pg8::StaticOrder, false>(F.lds, g, S, E);
        }
        SEAM(pb + 2);
        if (INK(5, pb + 3)) {
            pg8::Gemm g{F_XG(F), (const bf16*)(args.ws + WS_WF1) + (size_t)layer * NFF * 1024, MPAD, NFF, 1024}; pg8::StaticOrder S; S.init(MPAD, NFF, F.G, (int)blockIdx.x);
            EpiFfn E{F_Z(F), F.in[22] + (size_t)layer * 3 * DFF, F.in[23] + (size_t)layer * DFF, F.in[7] + (size_t)layer * 128 * 2 * DFF, F.out + O_FS + (size_t)layer * 128 * 2 * DFF, F_SBL(F), F_SBF(F), F_SSQ(F)};
            pg8::gemm_phase<EpiFfn, pg8::StaticOrder, true>(F.lds, g, S, E);
        }
        SEAM(pb + 3);
        if (INK(6, pb + 4)) { REFRESH(); ffn_fixup(F, layer); }
        SEAM(pb + 4);
        if (INK(7, pb + 5)) {
            pg8::Gemm g{F_Z(F), (const bf16*)(args.ws + WS_WF2) + (size_t)layer * 1024 * DFF, MPAD, 1024, DFF}; pg8::StaticOrder S; S.init(MPAD, 1024, F.G, (int)blockIdx.x);
            pg8::EpiResid E{F_X0(F), F_X1(F), PM_META, DM, layer == 0 ? F_XG(F) : (bf16*)nullptr, F.in[9] + DM, F_SSQ(F)};
            pg8::gemm_phase<pg8::EpiResid, pg8::StaticOrder, false>(F.lds, g, S, E);
        }
        SEAM(pb + 5);
    }
    if (INK(8, 13)) { REFRESH(); rms_final(F, F.in[25]); }
#undef IN
#undef REFRESH
#undef INK
#undef SEAM
}

extern "C" void kernel_launch(void* const* d_in, const int* in_sizes, int n_in, void* d_out, int out_size, void* d_ws, size_t ws_size, hipStream_t stream) {
    static int grid = 0;
    if (grid == 0) {
        if (n_in != 26 || (size_t)out_size != O_END || ws_size < WS_END) { fprintf(stderr, "kernel_launch: unexpected shapes: n_in %d out %d ws %zu\n", n_in, out_size, ws_size); grid = -1; return; }
        int dev = 0, cus = 0, per_cu = 0;
        if (hipGetDevice(&dev) != hipSuccess || hipDeviceGetAttribute(&cus, hipDeviceAttributeMultiprocessorCount, dev) != hipSuccess) { grid = -1; return; }
        if (hipFuncSetAttribute((const void*)fwd_kernel, hipFuncAttributeMaxDynamicSharedMemorySize, LDS_BYTES) != hipSuccess) { fprintf(stderr, "kernel_launch: hipFuncSetAttribute failed\n"); grid = -1; return; }
        if (hipOccupancyMaxActiveBlocksPerMultiprocessor(&per_cu, (const void*)fwd_kernel, NWAVES * 64, LDS_BYTES) != hipSuccess || per_cu < 1) { fprintf(stderr, "kernel_launch: occupancy query says %d\n", per_cu); per_cu = 1; }
        (void)hipGetLastError();
        grid = cus;
    }
    if (grid < 0) return;
    if (hipMemsetAsync((char*)d_ws + WS_CTL, 0, 16384, stream) != hipSuccess) { fprintf(stderr, "kernel_launch: hipMemsetAsync failed\n"); return; }
    Args a{};
    for (int i = 0; i < 26; ++i) a.in[i] = (const float*)d_in[i];
    a.out = (float*)d_out; a.ws = (unsigned char*)d_ws;
#if MK_N_LAUNCHES == 1
    a.ph_lo = 0; a.ph_hi = NPHASE;
    void* kargs[] = {&a};
    hipError_t e = hipLaunchCooperativeKernel((const void*)fwd_kernel, dim3(grid), dim3(NWAVES * 64), kargs, LDS_BYTES, stream);
    if (e != hipSuccess) fprintf(stderr, "kernel_launch: cooperative launch failed: %s (grid %d)\n", hipGetErrorString(e), grid);
#else
    for (int p = 0; p < NPHASE; ++p) {
        a.ph_lo = p; a.ph_hi = p + 1;
        hipLaunchKernelGGL(fwd_kernel, dim3(grid), dim3(NWAVES * 64), LDS_BYTES, stream, a);
    }
#endif
}
```

```cpp
#include <hip/hip_runtime.h>
#include <hip/hip_cooperative_groups.h>
#include <cstdio>
#include <cstdint>
namespace cg = cooperative_groups;

namespace pg8 {
#define PG8_LAS __attribute__((address_space(3)))
typedef unsigned short bf16_t;
typedef short bf16x8 __attribute__((ext_vector_type(8)));
typedef float f32x4 __attribute__((ext_vector_type(4)));
typedef unsigned u32x4 __attribute__((ext_vector_type(4)));
typedef unsigned u32x2 __attribute__((ext_vector_type(2)));
constexpr int BM = 256, BK = 64, HALF = 128, HTB = HALF * BK * 2  , STAGE_BYTES = 8 * HTB, NXCD = 8, WGM = 8;

__host__ __device__ __forceinline__ int lds_byte(int r, int c) { const int st = (r >> 4) * 2 + (c >> 5), rr = r & 15, cc = c & 31, ob = rr * 64 + cc * 2; return st * 1024 + (ob ^ (((ob >> 9) & 1) << 5)); }
__host__ __device__ __forceinline__ void stage_rc(int b, int& R, int& C) { const int st = b / 1024, sb = b % 1024, swz = sb ^ (((sb >> 9) & 1) << 5); R = (st >> 1) * 16 + swz / 64; C = (st & 1) * 32 + (swz % 64) / 2; }
__host__ __device__ __forceinline__ int perm32(int rho) { const int n = rho >> 4, i = rho & 15; return 8 * (i >> 2) + 4 * n + (i & 3); }

struct Unit { int pm, pn; };
struct Gemm { const bf16_t* A; const bf16_t* Bt; int M, N, K; };

struct StaticOrder {
    int nM, nN, nwg, G, c, pm0;
    __host__ __device__ void init(int nMt, int N, int G_, int c_, int pm0_) { nM = nMt; nN = N / BM; nwg = nM * nN; G = G_; c = c_; pm0 = pm0_; }
    __host__ __device__ bool next(int i, Unit& u) const {
        const long L = (long)i * G + c; if (L >= nwg) return false;
        int wgid = (int)L; { const int q = nwg / NXCD, r = nwg % NXCD, xcd = wgid % NXCD, off = wgid / NXCD; wgid = (xcd < r ? xcd * (q + 1) : r * (q + 1) + (xcd - r) * q) + off; }
        const int nig = WGM * nN, gid = wgid / nig, fm = gid * WGM, gsz = (nM - fm) < WGM ? (nM - fm) : WGM;
        u.pm = pm0 + fm + ((wgid % nig) % gsz); u.pn = (wgid % nig) / gsz; return true;
    }
    __device__ __forceinline__ void a_ready(const Unit&) const {}
    __device__ __forceinline__ void done(const Unit&) const {}
};

__device__ __forceinline__ unsigned cvt_pk_bf16(float lo, float hi) { unsigned r; asm volatile("v_cvt_pk_bf16_f32 %0, %1, %2" : "=v"(r) : "v"(lo), "v"(hi)); return r; }

__device__ __forceinline__ float row_rs(const float* ssq, int row, int fq) {
    const f32x4 a = *(const f32x4*)(ssq + (size_t)row * 16 + 4 * fq);
    float s = (a[0] + a[1]) + (a[2] + a[3]); s += __shfl_xor(s, 16); s += __shfl_xor(s, 32);
    return __builtin_amdgcn_rsqf(s * (1.0f / 1024.0f) + 1e-6f);
}
struct EpiBf16 {
    static constexpr bool PERM = true, AFTER_DRAIN = false;
    bf16_t* O0; bf16_t* O1; int pm_split; int ldc; const float* ssq;
    __device__ __forceinline__ void operator()(f32x4 (&acc)[2][2][4][2], const Unit& u, int wr, int wc, int fr, int fq) const {
        bf16_t* O = (u.pm < pm_split) ? O0 : O1;
        const int row0 = u.pm * BM + wr * 64 + fr; const int col0 = u.pn * BM + wc * 32 + 8 * fq;
        float rsv[2][4];
#pragma unroll
        for (int ai = 0; ai < 2; ++ai)
#pragma unroll
            for (int m = 0; m < 4; ++m) rsv[ai][m] = ssq ? row_rs(ssq, row0 + ai * HALF + m * 16, fq) : 1.0f;
#pragma unroll
        for (int ai = 0; ai < 2; ++ai)
#pragma unroll
            for (int m = 0; m < 4; ++m) { const int row = row0 + ai * HALF + m * 16; bf16_t* rowp = O + (size_t)row * ldc + col0;
                const float rs = rsv[ai][m];
#pragma unroll
                for (int bj = 0; bj < 2; ++bj) { const f32x4 v0 = acc[ai][bj][m][0] * rs, v1 = acc[ai][bj][m][1] * rs;
                    u32x4 w; w.x = cvt_pk_bf16(v0[0], v0[1]); w.y = cvt_pk_bf16(v0[2], v0[3]); w.z = cvt_pk_bf16(v1[0], v1[1]); w.w = cvt_pk_bf16(v1[2], v1[3]);
                    *(u32x4*)(rowp + bj * HALF) = w; } }
    }
};

struct EpiResid {
    static constexpr bool PERM = true, AFTER_DRAIN = false;
    float* X0; float* X1; int pm_split; int ldc; bf16_t* XG; const float* gain; float* ssq;
    __device__ __forceinline__ void operator()(f32x4 (&acc)[2][2][4][2], const Unit& u, int wr, int wc, int fr, int fq) const {
        float* C = (u.pm < pm_split) ? X0 : X1;
        const int row0 = u.pm * BM + wr * 64 + fr, col0 = u.pn * BM + wc * 32 + 8 * fq;
        f32x4 gv[2][2];
#pragma unroll
        for (int bj = 0; bj < 2; ++bj)
#pragma unroll
            for (int n = 0; n < 2; ++n) gv[bj][n] = XG ? *(const f32x4*)(gain + col0 + bj * HALF + 4 * n) : (f32x4){0.f, 0.f, 0.f, 0.f};
#pragma unroll
        for (int ai = 0; ai < 2; ++ai)
#pragma unroll
            for (int mp = 0; mp < 2; ++mp) {
                f32x4 t[2][2][2];
#pragma unroll
                for (int mm = 0; mm < 2; ++mm) { const float* rowp = C + (size_t)(row0 + ai * HALF + (2 * mp + mm) * 16) * ldc + col0;
#pragma unroll
                    for (int bj = 0; bj < 2; ++bj)
#pragma unroll
                        for (int n = 0; n < 2; ++n) t[mm][bj][n] = *(const f32x4*)(rowp + bj * HALF + 4 * n); }
#pragma unroll
                for (int mm = 0; mm < 2; ++mm) { const int m = 2 * mp + mm; const int row = row0 + ai * HALF + m * 16; float* rowp = C + (size_t)row * ldc + col0; float sq = 0.f;
#pragma unroll
                    for (int bj = 0; bj < 2; ++bj) { f32x4 v[2];
#pragma unroll
                        for (int n = 0; n < 2; ++n) { v[n] = t[mm][bj][n] + acc[ai][bj][m][n]; *(f32x4*)(rowp + bj * HALF + 4 * n) = v[n];
                            sq += (v[n][0] * v[n][0] + v[n][1] * v[n][1]) + (v[n][2] * v[n][2] + v[n][3] * v[n][3]); }
                        if (XG) { const f32x4 y0 = v[0] * gv[bj][0], y1 = v[1] * gv[bj][1]; u32x4 w; w.x = cvt_pk_bf16(y0[0], y0[1]); w.y = cvt_pk_bf16(y0[2], y0[3]); w.z = cvt_pk_bf16(y1[0], y1[1]); w.w = cvt_pk_bf16(y1[2], y1[3]);
                            *(u32x4*)(XG + (size_t)row * ldc + col0 + bj * HALF) = w; } }
                    if (XG) { sq += __shfl_xor(sq, 16); sq += __shfl_xor(sq, 32); if (fq == 0) ssq[(size_t)row * 16 + u.pn * 4 + wc] = sq; } }
                asm volatile("" ::: "memory"); }
    }
};

template <class Epi, class Sched, bool APERM>
__device__ __forceinline__ void gemm_phase(PG8_LAS unsigned char* lds, const Gemm g, const Sched& S, const Epi& E) {
    int tid_ = threadIdx.x; asm volatile("" : "+v"(tid_));
    const int tid = tid_, wid = __builtin_amdgcn_readfirstlane(tid >> 6), lane = tid & 63, wr = wid >> 2, wc = wid & 3, fr = lane & 15, fq = lane >> 4;
    const int K = g.K, nt = K / BK;
    unsigned voffA[2], voffB[2];
#pragma unroll
    for (int i = 0; i < 2; ++i) { int R, C; stage_rc(tid * 16 + i * 8192, R, C); const int Rb = Epi::PERM ? ((R & ~31) + perm32(R & 31)) : R;
        const int Ra = APERM ? (128 * (R >> 6) + 8 * (R & 15) + ((R >> 4) & 3)) : R;
        voffA[i] = (unsigned)(Ra * K + C) * 2u; voffB[i] = (unsigned)(Rb * K + C) * 2u; }
    const size_t kstep = (size_t)(BK * 2);
    const size_t hstep = (size_t)HALF * K * 2;
    const size_t hstepA = APERM ? (size_t)4 * K * 2 : hstep;
    const size_t tstep = 2 * hstep;
    const unsigned ldsw = (unsigned)wid * 1024u;
    const int aoff = lds_byte(wr * 64 + fr, fq * 8), boff = lds_byte(wc * 32 + fr, fq * 8);
#define PG8_SA(b, h) (((b) * 2 + (h)) * HTB)
#define PG8_SB(b, h) ((4 + (b) * 2 + (h)) * HTB)
#define PG8_STAGE(bufoff, gbase, voff) do { _Pragma("unroll") for (int _i = 0; _i < 2; ++_i) \
        __builtin_amdgcn_global_load_lds((const unsigned*)((const char*)(gbase) + (voff)[_i]), (PG8_LAS unsigned*)(lds + (bufoff) + ldsw + _i * 8192), 16, 0, 0); } while (0)
#define PG8_LDA(dst, b, h) do { _Pragma("unroll") for (int m = 0; m < 4; ++m) _Pragma("unroll") for (int k = 0; k < 2; ++k) dst[m][k] = *(const PG8_LAS bf16x8*)(lds + PG8_SA(b, h) + aoff + m * 2048 + k * 1024); } while (0)
#define PG8_LDB(dst, b, h) do { _Pragma("unroll") for (int n = 0; n < 2; ++n) _Pragma("unroll") for (int k = 0; k < 2; ++k) dst[n][k] = *(const PG8_LAS bf16x8*)(lds + PG8_SB(b, h) + boff + n * 2048 + k * 1024); } while (0)
#define PG8_MMA(ai, bj, At, Bt) do { __builtin_amdgcn_s_setprio(1); _Pragma("unroll") for (int m = 0; m < 4; ++m) _Pragma("unroll") for (int n = 0; n < 2; ++n) _Pragma("unroll") for (int k = 0; k < 2; ++k) \
        acc[ai][bj][m][n] = __builtin_amdgcn_mfma_f32_16x16x32_bf16(Bt[n][k], At[m][k], acc[ai][bj][m][n], 0, 0, 0); __builtin_amdgcn_s_setprio(0); } while (0)
#define PG8_WAIT_V(n) asm volatile("s_waitcnt vmcnt(" #n ")" ::: "memory")
#define PG8_WAIT_L(n) asm volatile("s_waitcnt lgkmcnt(" #n ")" ::: "memory")
#define PG8_BAR __builtin_amdgcn_s_barrier()
#define PG8_SCHED __builtin_amdgcn_sched_barrier(0)
    Unit cur, nxt; int ui = 0;
    if (!S.next(0, cur)) return;
    f32x4 acc[2][2][4][2];
#pragma unroll
    for (int a = 0; a < 2; ++a)
#pragma unroll
        for (int b = 0; b < 2; ++b)
#pragma unroll
            for (int m = 0; m < 4; ++m)
#pragma unroll
                for (int n = 0; n < 2; ++n) acc[a][b][m][n] = (f32x4){0.f, 0.f, 0.f, 0.f};
    bf16x8 At[4][2], B0[2][2], B1[2][2];
    const char* cA = (const char*)g.A + (size_t)cur.pm * tstep; const char* cB = (const char*)g.Bt + (size_t)cur.pn * tstep;
    S.a_ready(cur);
    PG8_STAGE(PG8_SB(0, 0), cB, voffB); PG8_STAGE(PG8_SB(0, 1), cB + hstep, voffB); PG8_STAGE(PG8_SA(0, 0), cA, voffA); PG8_STAGE(PG8_SA(0, 1), cA + hstepA, voffA);
    if (wr == 1) PG8_BAR;
    PG8_WAIT_V(2); PG8_BAR;
    PG8_STAGE(PG8_SB(1, 0), cB + kstep, voffB); PG8_STAGE(PG8_SA(1, 0), cA + kstep, voffA); PG8_STAGE(PG8_SB(1, 1), cB + hstep + kstep, voffB);
    PG8_WAIT_V(6); PG8_BAR;
    for (;;) {
        const bool has_next = S.next(ui + 1, nxt);
        const char* nA = has_next ? (const char*)g.A + (size_t)nxt.pm * tstep : cA; const char* nB = has_next ? (const char*)g.Bt + (size_t)nxt.pn * tstep : cB;
        for (int t = 0; t < nt; t += 2) {
            const bool last = (t == nt - 2);
            const char* a1 = cA + (size_t)(t + 1) * kstep;
            const char* a2 = last ? nA : cA + (size_t)(t + 2) * kstep; const char* b2 = last ? nB : cB + (size_t)(t + 2) * kstep;
            const char* a3 = a2 + kstep; const char* b3 = b2 + kstep;
            if (last && has_next) S.a_ready(nxt);
            PG8_LDB(B0, 0, 0); PG8_LDB(B1, 0, 1); PG8_SCHED; PG8_LDA(At, 0, 0); PG8_STAGE(PG8_SA(1, 1), a1 + hstepA, voffA);
            PG8_WAIT_V(8); PG8_WAIT_L(0); PG8_BAR; PG8_MMA(0, 0, At, B0); PG8_MMA(0, 1, At, B1); PG8_BAR; PG8_SCHED;
            PG8_LDA(At, 0, 1); PG8_STAGE(PG8_SB(0, 0), b2, voffB); PG8_STAGE(PG8_SB(0, 1), b2 + hstep, voffB); PG8_STAGE(PG8_SA(0, 0), a2, voffA);
            PG8_WAIT_V(8); PG8_WAIT_L(0); PG8_BAR; PG8_MMA(1, 0, At, B0); PG8_MMA(1, 1, At, B1); PG8_BAR; PG8_SCHED;
            PG8_LDB(B0, 1, 0); PG8_LDB(B1, 1, 1); PG8_SCHED; PG8_LDA(At, 1, 0); PG8_STAGE(PG8_SA(0, 1), a2 + hstepA, voffA);
            PG8_WAIT_V(8); PG8_WAIT_L(0); PG8_BAR; PG8_MMA(0, 0, At, B0); PG8_MMA(0, 1, At, B1); PG8_BAR; PG8_SCHED;
            PG8_LDA(At, 1, 1); PG8_STAGE(PG8_SB(1, 0), b3, voffB); PG8_STAGE(PG8_SB(1, 1), b3 + hstep, voffB); PG8_STAGE(PG8_SA(1, 0), a3, voffA);
            PG8_WAIT_V(8); PG8_WAIT_L(0); PG8_BAR; PG8_MMA(1, 0, At, B0); PG8_MMA(1, 1, At, B1); PG8_BAR; PG8_SCHED;
        }
        if (wr == 0) PG8_BAR;
        E(acc, cur, wr, wc, fr, fq); S.done(cur);
        if (!has_next) break;
#pragma unroll
        for (int a = 0; a < 2; ++a)
#pragma unroll
            for (int b = 0; b < 2; ++b)
#pragma unroll
                for (int m = 0; m < 4; ++m)
#pragma unroll
                    for (int n = 0; n < 2; ++n) acc[a][b][m][n] = (f32x4){0.f, 0.f, 0.f, 0.f};
        cur = nxt; cA = nA; cB = nB; ++ui;
        if (wr == 1) PG8_BAR;
    }
    PG8_WAIT_V(0);
    PG8_BAR;
#undef PG8_SA
#undef PG8_SB
#undef PG8_STAGE
#undef PG8_LDA
#undef PG8_LDB
#undef PG8_MMA
#undef PG8_WAIT_V
#undef PG8_WAIT_L
#undef PG8_BAR
#undef PG8_SCHED
}
}
constexpr int DM = 1024;
constexpr int ROW_S = 16384;
constexpr int ROW_M = 17408;
constexpr int NREAL = 17424;
constexpr int MPAD = 17664;
constexpr int PM_META = 68;
constexpr int NAB = 4096, NCC = 4096, DFF = 2816, NFF = 5632, ABW = 4104;
constexpr int NGRP = 138, GRP_META = 136;
constexpr float EPS = 1e-6f;
constexpr float KSCALE = 0.08838834764831845f;

constexpr size_t O_YP = 0, O_YS = 16777216, O_CP = 17825792, O_CS = 18350080, O_NP = 26738688, O_NS = 26742784, O_MP = 26808320, O_MS = 26808352,
                 O_RP = 26808864, O_RS = 27333152, O_HP = 35721760, O_HS = 36770336, O_FP = 53547552, O_FS = 53637664, O_END = 55079456;

constexpr size_t MiB = 1u << 20;
constexpr size_t WS_CTL = 0, CTL_ZERO_BYTES = 1 * MiB;
constexpr size_t WS_WAB = 1 * MiB, WS_WOAB = 9 * MiB, WS_WC = 11 * MiB, WS_WOC = 19 * MiB, WS_WF1 = 21 * MiB  , WS_WF2 = 43 * MiB  ;
constexpr size_t WS_XN = 54 * MiB;
constexpr size_t WS_Z = 89 * MiB;
constexpr size_t WS_XM = 227 * MiB;
constexpr size_t WS_G = 228 * MiB;
constexpr size_t WS_SBL = 229 * MiB;
constexpr size_t WS_SBF = 233 * MiB;
constexpr size_t WS_ROT = 240 * MiB;
constexpr size_t WS_XG = 242 * MiB;
constexpr size_t WS_SSQ = 277 * MiB;
constexpr size_t WS_ZS = 279 * MiB;
constexpr size_t WS_ZS2 = 290 * MiB;
constexpr size_t WS_HS = 301 * MiB;
constexpr size_t WS_END = 309 * MiB;
static_assert(WS_XN + (size_t)MPAD * DM * 2 <= WS_Z && WS_Z + (size_t)MPAD * 4096 * 2 <= WS_XM && WS_SBL + (size_t)NGRP * 2 * DFF * 4 <= WS_SBF && WS_SBF + (size_t)NGRP * 4 * DFF * 4 <= WS_END, "ws map");

constexpr int LDS_BYTES = 147456;
constexpr int NWAVES = 8;

#define GAS __attribute__((address_space(1)))
#define LAS __attribute__((address_space(3)))
typedef unsigned short bf16;
typedef float f32x4 __attribute__((ext_vector_type(4)));
typedef unsigned u32x2 __attribute__((ext_vector_type(2)));
typedef unsigned u32x4 __attribute__((ext_vector_type(4)));
#define LDS_WAIT() asm volatile("s_waitcnt lgkmcnt(0)" ::: "memory")

__device__ __forceinline__ unsigned f2bf(float f) { unsigned u = __builtin_bit_cast(unsigned, f); return (u + 0x7fffu + ((u >> 16) & 1u)) >> 16; }
__device__ __forceinline__ unsigned pk2(float lo, float hi) { return f2bf(lo) | (f2bf(hi) << 16); }
__device__ __forceinline__ float bf2f(unsigned short b) { return __builtin_bit_cast(float, ((unsigned)b) << 16); }
__device__ __forceinline__ float bflo(unsigned w) { return __builtin_bit_cast(float, w << 16); }
__device__ __forceinline__ float bfhi(unsigned w) { return __builtin_bit_cast(float, w & 0xffff0000u); }
__device__ __forceinline__ f32x4 ld_bf4(const bf16* p) { const u32x2 w = *(const u32x2*)p; return (f32x4){bflo(w.x), bfhi(w.x), bflo(w.y), bfhi(w.y)}; }
__device__ __forceinline__ float wave_sum(float v) {
#pragma unroll
    for (int o = 1; o < 64; o <<= 1) v += __shfl_xor(v, o);
    return v;
}
__device__ __forceinline__ float half_sum(float v) {
#pragma unroll
    for (int o = 1; o < 32; o <<= 1) v += __shfl_xor(v, o);
    return v;
}
__device__ __forceinline__ float sigmoidf_(float x) { return 1.f / (1.f + __expf(-x)); }
__device__ __forceinline__ float siluf_(float x) { return x / (1.f + __expf(-x)); }
__device__ __forceinline__ float logsigmoidf_(float x) { return fminf(x, 0.f) - log1pf(__expf(-fabsf(x))); }

struct Args { const float* in[26]; float* out; unsigned char* ws; int ph_lo, ph_hi; };

struct Frame {
    LAS unsigned char* lds;
    int tid, lane, wave, G, gw, NGW;
    const float* const* in; float* out; unsigned char* ws;
};
#define F_X0(F) ((F).out)
#define F_X1(F) ((float*)((F).ws + WS_XM) - (size_t)ROW_M * DM)
#define F_XN(F) ((bf16*)((F).ws + WS_XN))
#define F_XG(F) ((bf16*)((F).ws + WS_XG))
#define F_SSQ(F) ((float*)((F).ws + WS_SSQ))
#define F_Z(F) ((bf16*)((F).ws + WS_Z))
#define F_ZS1(F, layer) ((bf16*)((F).ws + ((layer) == 0 ? WS_ZS : WS_ZS2)) - (size_t)ROW_S * 4096)
#define F_HS1(F) ((bf16*)((F).ws + WS_HS) - (size_t)ROW_S * DFF)
#define ZROW(F, row, layer) (((row) < ROW_S ? F_Z(F) : F_ZS1(F, layer)) + (size_t)(row) * 4096)
#define F_GT(F) ((float*)((F).ws + WS_G))
#define F_SBL(F) ((float*)((F).ws + WS_SBL))
#define F_SBF(F) ((float*)((F).ws + WS_SBF))
__device__ __forceinline__ float* xrow(const Frame& F, int r) { return (r < ROW_M ? F_X0(F) : F_X1(F)) + (size_t)r * DM; }

__device__ __forceinline__ void p0_transpose_item(const float* W, int K, int Nsrc, int n0src, bf16* WT, int dstrow0, LAS float* scr, int kb, int lane) {
    const int k0 = 64 * kb;
#pragma unroll 8
    for (int i = 0; i < 32; ++i) { const int kk = 2 * i + (lane >> 5); scr[kk * 33 + (lane & 31)] = W[(size_t)(k0 + kk) * Nsrc + n0src + (lane & 31)]; }
    LDS_WAIT(); asm volatile("" ::: "memory");
    const int c = lane & 7;
#pragma unroll
    for (int j = 0; j < 4; ++j) { const int n = (lane >> 3) + 8 * j; const LAS float* s = scr + (8 * c) * 33 + n;
        u32x4 o; o.x = pk2(s[0 * 33], s[1 * 33]); o.y = pk2(s[2 * 33], s[3 * 33]); o.z = pk2(s[4 * 33], s[5 * 33]); o.w = pk2(s[6 * 33], s[7 * 33]);
        *(u32x4*)(WT + (size_t)(dstrow0 + n) * K + k0 + 8 * c) = o; }
    LDS_WAIT(); asm volatile("" ::: "memory");
}

__device__ __forceinline__ void p0_weights(Frame& F) {
    LAS float* scr = (LAS float*)(F.lds + F.wave * 16384);
    constexpr int I_AB = 16 * 128, I_O = 16 * 32, I_C = 16 * 128, I_F1 = 16 * 176, I_F2 = 44 * 32;
    constexpr int NIT = I_AB + I_O + I_C + I_O + 2 * I_F1 + 2 * I_F2;
    for (int it = F.gw; it < NIT; it += F.NGW) {
        int r = it;
        if (r < I_AB) { const int kb = r / 128, nb = r % 128; p0_transpose_item(F.in[10], 1024, ABW, nb < 64 ? 32 * nb : 32 * nb + 8, (bf16*)(F.ws + WS_WAB), 32 * nb, scr, kb, F.lane); continue; } r -= I_AB;
        if (r < I_O) { const int kb = r / 32, nb = r % 32; p0_transpose_item(F.in[15], 1024, 1024, 32 * nb, (bf16*)(F.ws + WS_WOAB), 32 * nb, scr, kb, F.lane); continue; } r -= I_O;
        if (r < I_C) { const int kb = r / 128, nb = r % 128; p0_transpose_item(F.in[17], 1024, 4096, 32 * nb, (bf16*)(F.ws + WS_WC), 32 * nb, scr, kb, F.lane); continue; } r -= I_C;
        if (r < I_O) { const int kb = r / 32, nb = r % 32; p0_transpose_item(F.in[19], 1024, 1024, 32 * nb, (bf16*)(F.ws + WS_WOC), 32 * nb, scr, kb, F.lane); continue; } r -= I_O;
        if (r < 2 * I_F1) { const int l = r / I_F1; r -= l * I_F1; const int kb = r / 176, nb = r % 176; const int c = 32 * nb;
            const int ch = c < DFF ? c : c - DFF; const int dst = 256 * (ch / 128) + (c < DFF ? 0 : 128) + (ch % 128);
            p0_transpose_item(F.in[21] + (size_t)l * 1024 * NFF, 1024, NFF, c, (bf16*)(F.ws + WS_WF1) + (size_t)l * NFF * 1024, dst, scr, kb, F.lane); continue; } r -= 2 * I_F1;
        { const int l = r / I_F2; r -= l * I_F2; const int kb = r / 32, nb = r % 32;
            p0_transpose_item(F.in[24] + (size_t)l * DFF * 1024, DFF, 1024, 32 * nb, (bf16*)(F.ws + WS_WF2) + (size_t)l * 1024 * DFF, 32 * nb, scr, kb, F.lane); }
    }
}

__device__ __forceinline__ void p0_rows(Frame& F) {
    LAS float* wg = (LAS float*)F.lds;
    for (int i = F.tid; i < 8192; i += NWAVES * 64) { const int k = i >> 3, c = i & 7; wg[c * 1024 + k] = F.in[10][(size_t)k * ABW + 2048 + c]; }
    __syncthreads();
    const float* gain = F.in[9];
    for (int r = F.gw; r < MPAD; r += F.NGW) {
        const float* src = nullptr;
        if (r < ROW_S) src = F.in[0] + (size_t)r * DM; else if (r < ROW_M) src = F.in[1] + (size_t)(r - ROW_S) * DM; else if (r < NREAL) src = F.in[8] + (size_t)(r - ROW_M) * DM;
        f32x4 v[4]; float ss = 0.f;
#pragma unroll
        for (int j = 0; j < 4; ++j) { v[j] = src ? *(const f32x4*)(src + 4 * F.lane + 256 * j) : (f32x4){0.f, 0.f, 0.f, 0.f}; ss += (v[j].x * v[j].x + v[j].y * v[j].y) + (v[j].z * v[j].z + v[j].w * v[j].w); }
        const float rs = rsqrtf(wave_sum(ss) * (1.f / DM) + EPS);
        float* xr = xrow(F, r); bf16* xn = F_XG(F) + (size_t)r * DM;
        float ga[8];
#pragma unroll
        for (int c = 0; c < 8; ++c) ga[c] = 0.f;
#pragma unroll
        for (int j = 0; j < 4; ++j) {
            *(f32x4*)(xr + 4 * F.lane + 256 * j) = v[j];
            const f32x4 gn = *(const f32x4*)(gain + 4 * F.lane + 256 * j);
            const f32x4 y = v[j] * rs * gn;
            u32x2 w; w.x = pk2(y.x, y.y); w.y = pk2(y.z, y.w);
            *(u32x2*)(xn + 4 * F.lane + 256 * j) = w;
#pragma unroll
            for (int c = 0; c < 8; ++c) { const f32x4 wv = *(const LAS f32x4*)(wg + c * 1024 + 4 * F.lane + 256 * j); ga[c] += (y.x * wv.x + y.y * wv.y) + (y.z * wv.z + y.w * wv.w); }
        }
#pragma unroll
        for (int c = 0; c < 8; ++c) ga[c] = wave_sum(ga[c]);
        if (F.lane == 0) { *(f32x4*)(F_GT(F) + (size_t)r * 8) = (f32x4){ga[0], ga[1], ga[2], ga[3]}; *(f32x4*)(F_GT(F) + (size_t)r * 8 + 4) = (f32x4){ga[4], ga[5], ga[6], ga[7]}; }
    }
}

__device__ __forceinline__ void rms_final(Frame& F, const float* gain) {
    for (int r = F.gw; r < ROW_M; r += F.NGW) {
        float* xr = F_X0(F) + (size_t)r * DM; f32x4 v[4]; float ss = 0.f;
#pragma unroll
        for (int j = 0; j < 4; ++j) { v[j] = *(const f32x4*)(xr + 4 * F.lane + 256 * j); ss += (v[j].x * v[j].x + v[j].y * v[j].y) + (v[j].z * v[j].z + v[j].w * v[j].w); }
        const float rs = rsqrtf(wave_sum(ss) * (1.f / DM) + EPS);
#pragma unroll
        for (int j = 0; j < 4; ++j) { const f32x4 gn = *(const f32x4*)(gain + 4 * F.lane + 256 * j); *(f32x4*)(xr + 4 * F.lane + 256 * j) = v[j] * rs * gn; }
    }
}

struct EpiFfn {
    static constexpr bool PERM = true, AFTER_DRAIN = false;
    bf16* H0; bf16* H1; const float* cw; const float* cb; const float* cst; float* cso; float* sbl; float* sbf; const float* ssq;
    __device__ __forceinline__ void operator()(f32x4 (&acc)[2][2][4][2], const pg8::Unit& u, int wr, int wc, int fr, int fq) const {
        bf16* H = (u.pm < 64) ? H0 : H1;
        const int ch0 = 128 * u.pn + 32 * wc + 8 * fq;
        const int tok0 = 256 * u.pm + 128 * wr + 8 * fr;
        const int grp = 2 * u.pm + wr;
        const bool samp = (u.pm >= 64 && u.pm < PM_META), meta = (u.pm == PM_META);
        const int sb = 32 * (u.pm - 64) + 16 * wr + fr;
        const bool defer = (!samp && !meta && fr == 0);
        const bool lastlane = meta ? (wr == 0 && fr == 1) : (!samp && fr == 15);
#pragma unroll
        for (int k = 0; k < 8; ++k) { const float rs = pg8::row_rs(ssq, tok0 + k, fq);
#pragma unroll
            for (int bj = 0; bj < 2; ++bj)
#pragma unroll
                for (int n = 0; n < 2; ++n) acc[k >> 2][bj][k & 3][n] = acc[k >> 2][bj][k & 3][n] * rs; }
#pragma unroll
        for (int n = 0; n < 2; ++n) {
            const int c4 = ch0 + 4 * n;
            const f32x4 w0 = *(const f32x4*)(cw + c4), w1 = *(const f32x4*)(cw + DFF + c4), w2 = *(const f32x4*)(cw + 2 * DFF + c4), bb = *(const f32x4*)(cb + c4);
            f32x4 p6, p7;
#pragma unroll
            for (int e = 0; e < 4; ++e) { p6[e] = __shfl_up(acc[1][0][2][n][e], 1, 16); p7[e] = __shfl_up(acc[1][0][3][n][e], 1, 16); }
            if (samp) { p6 = *(const f32x4*)(cst + (size_t)(sb * 2 + 0) * DFF + c4); p7 = *(const f32x4*)(cst + (size_t)(sb * 2 + 1) * DFF + c4); }
            if (meta && wr == 0 && fr == 0) { p6 = (f32x4){0.f, 0.f, 0.f, 0.f}; p7 = p6; }
#pragma unroll
            for (int k = 0; k < 8; ++k) {
                const f32x4 uk = acc[k >> 2][0][k & 3][n], gk = acc[k >> 2][1][k & 3][n];
                const f32x4 um1 = (k >= 1) ? acc[(k - 1 < 0 ? 0 : k - 1) >> 2][0][(k - 1 < 0 ? 0 : k - 1) & 3][n] : p7;
                const f32x4 um2 = (k >= 2) ? acc[(k - 2 < 0 ? 0 : k - 2) >> 2][0][(k - 2 < 0 ? 0 : k - 2) & 3][n] : (k == 1 ? p7 : p6);
                const f32x4 cv = bb + w0 * um2 + w1 * um1 + w2 * uk;
                f32x4 hv;
#pragma unroll
                for (int e = 0; e < 4; ++e) hv[e] = siluf_(cv[e]) * gk[e];
                if (defer && k < 2) {
                    *(f32x4*)(sbf + (size_t)((grp * 2 + k) * 2 + 0) * DFF + c4) = uk;
                    *(f32x4*)(sbf + (size_t)((grp * 2 + k) * 2 + 1) * DFF + c4) = gk;
                } else {
                    u32x2 w; w.x = pg8::cvt_pk_bf16(hv[0], hv[1]); w.y = pg8::cvt_pk_bf16(hv[2], hv[3]);
                    *(u32x2*)(H + (size_t)(tok0 + k) * DFF + c4) = w;
                }
            }
            if (lastlane) { *(f32x4*)(sbl + (size_t)(grp * 2 + 0) * DFF + c4) = acc[1][0][2][n]; *(f32x4*)(sbl + (size_t)(grp * 2 + 1) * DFF + c4) = acc[1][0][3][n]; }
            if (samp) { *(f32x4*)(cso + (size_t)(sb * 2 + 0) * DFF + c4) = acc[1][0][2][n]; *(f32x4*)(cso + (size_t)(sb * 2 + 1) * DFF + c4) = acc[1][0][3][n]; }
        }
    }
};

__device__ __forceinline__ void ffn_fixup(Frame& F, int layer) {
    const float* cw = F.in[22] + (size_t)layer * 3 * DFF; const float* cb = F.in[23] + (size_t)layer * DFF;
    bf16* H = F_Z(F);
    const int gt = blockIdx.x * (NWAVES * 64) + F.tid, NT = F.G * NWAVES * 64;
    for (int i = gt; i < 128 * DFF; i += NT) {
        const int grp = i / DFF, ch = i - grp * DFF;
        const int r0 = 128 * grp;
        const int pg = (r0 % 2048 == 0) ? GRP_META : grp - 1;
        const float um2 = F_SBL(F)[(size_t)(pg * 2 + 0) * DFF + ch], um1 = F_SBL(F)[(size_t)(pg * 2 + 1) * DFF + ch];
        const float u0 = F_SBF(F)[(size_t)((grp * 2 + 0) * 2 + 0) * DFF + ch], g0 = F_SBF(F)[(size_t)((grp * 2 + 0) * 2 + 1) * DFF + ch];
        const float u1 = F_SBF(F)[(size_t)((grp * 2 + 1) * 2 + 0) * DFF + ch], g1 = F_SBF(F)[(size_t)((grp * 2 + 1) * 2 + 1) * DFF + ch];
        const float w0 = cw[ch], w1 = cw[DFF + ch], w2 = cw[2 * DFF + ch], bb = cb[ch];
        const float c0 = bb + w0 * um2 + w1 * um1 + w2 * u0, c1 = bb + w0 * um1 + w1 * u0 + w2 * u1;
        H[(size_t)r0 * DFF + ch] = (bf16)f2bf(siluf_(c0) * g0);
        H[(size_t)(r0 + 1) * DFF + ch] = (bf16)f2bf(siluf_(c1) * g1);
    }
    float* fo = F.out + O_FP + (size_t)layer * 8 * 2 * DFF;
    for (int i = gt; i < 8 * 2 * DFF; i += NT) {
        const int b = i / (2 * DFF), rem = i - b * 2 * DFF, j = rem / DFF, ch = rem - j * DFF;
        const int grp = 2 * (8 * b + 7) + 1;
        fo[i] = F_SBL(F)[(size_t)(grp * 2 + j) * DFF + ch];
    }
}
typedef short bf16x8 __attribute__((ext_vector_type(8)));
typedef short v4i16_t __attribute__((ext_vector_type(4)));
constexpr int MX_PITCH = 272;
constexpr int MX_Q = 0, MX_K = 17408, MX_KH = 34816, MX_V = 52224, MX_GD = 69632  , MX_SC = 71680  , MX_OB = 74752  , MX_RP = 108544  , MX_DI = 110592  , MX_GN = 110848  , MX_LB = 111360  , MX_END = 111872;
constexpr int MX_OP = 132;
constexpr float LNKS = -2.4260151319598084f;
static_assert(MX_END <= 139264, "mixer LDS map");

__device__ __forceinline__ bf16x8 mk8(unsigned a, unsigned b, unsigned c, unsigned d) { const u32x4 v = {a, b, c, d}; return __builtin_bit_cast(bf16x8, v); }
__device__ __forceinline__ u32x2 tr16(const LAS unsigned char* p) { return __builtin_bit_cast(u32x2, __builtin_amdgcn_ds_read_tr16_b64_v4i16((LAS v4i16_t*)p)); }
__device__ __forceinline__ unsigned pkbf(float lo, float hi) { return pg8::cvt_pk_bf16(lo, hi); }
#define MFMA16(a, b, c) __builtin_amdgcn_mfma_f32_16x16x32_bf16((a), (b), (c), 0, 0, 0)
template <int CTRL> __device__ __forceinline__ float dppf(float ident, float x) { return __builtin_bit_cast(float, __builtin_amdgcn_update_dpp(__builtin_bit_cast(int, ident), __builtin_bit_cast(int, x), CTRL, 0xf, 0xf, false)); }
__device__ __forceinline__ float row_prefix_sum(float x) { x += dppf<0x111>(0.f, x); x += dppf<0x112>(0.f, x); x += dppf<0x114>(0.f, x); x += dppf<0x118>(0.f, x); return x; }
__device__ __forceinline__ float row_prefix_max(float x) { x = fmaxf(x, dppf<0x111>(-3e38f, x)); x = fmaxf(x, dppf<0x112>(-3e38f, x)); x = fmaxf(x, dppf<0x114>(-3e38f, x)); x = fmaxf(x, dppf<0x118>(-3e38f, x)); return x; }
__device__ __forceinline__ float row_prefix_prod(float x) { x *= dppf<0x111>(1.f, x); x *= dppf<0x112>(1.f, x); x *= dppf<0x114>(1.f, x); x *= dppf<0x118>(1.f, x); return x; }
__device__ __forceinline__ float row_suffix_prod(float x) { x *= dppf<0x101>(1.f, x); x *= dppf<0x102>(1.f, x); x *= dppf<0x104>(1.f, x); x *= dppf<0x108>(1.f, x); return x; }
__device__ __forceinline__ float rdlane(float x, int l) { return __builtin_bit_cast(float, __builtin_amdgcn_readlane(__builtin_bit_cast(int, x), l)); }

constexpr int ROT_N = 2072;
__device__ __forceinline__ void p0_rotary(Frame& F, float* tab) {
    const int gt = blockIdx.x * (NWAVES * 64) + F.tid, NT = F.G * NWAVES * 64;
    for (int i = gt; i < ROT_N * 64; i += NT) {
        const int pi = i >> 6, fi = i & 63;
        const float pos = pi < 2064 ? (float)pi : (float)(16384 + pi - 2064);
        const float inv = 1.0f / powf(10000.0f, (float)fi * (1.0f / 63.0f));
        float sn, cs; sincosf(pos * inv, &sn, &cs);
        tab[2 * i] = cs; tab[2 * i + 1] = sn;
    }
}

#define MX_SC_PARAMS(scv, row0, ntok, nmc, pos0) do { if (mode != 1) { if ((scv) == 0) { row0 = ROW_M; ntok = 16; nmc = 1; pos0 = 0; } else { row0 = b * 2048 + ((scv) - 1) * 64; ntok = 64; nmc = 4; pos0 = 16 + ((scv) - 1) * 64; } } \
        else { row0 = ROW_S + 8 * b; ntok = 8; nmc = 1; pos0 = 2064; } } while (0)

template <int TYPE>
__device__ __forceinline__ void mix_sg_unit(Frame& F, int b, int h, int mode  , const float* rot) {
    const bool prompt = (mode != 1);
    const int tid = F.tid, lane = F.lane, w = F.wave, r16 = lane & 15, q = lane >> 4;
    const int tk = tid >> 3, p = tid & 7;
    LAS unsigned char* L = F.lds;
    LAS float* OB = (LAS float*)(L + MX_OB); LAS float* RP = (LAS float*)(L + MX_RP); LAS float* DI = (LAS float*)(L + MX_DI);
    bf16* MIX = F_XN(F);
    const int qcol = (TYPE == 0 ? 0 : 2048) + 128 * h, kcol = (TYPE == 0 ? 512 : 2560) + 128 * h, vcol = (TYPE == 0 ? 1024 : 3072) + 128 * h, gcol = (TYPE == 0 ? 1536 : 3584) + 128 * h, mcol = (TYPE == 0 ? 0 : 512) + 128 * h;
    f32x4 S[8]; f32x4 nacc = {0.f, 0.f, 0.f, 0.f}; float m0 = 0.f;
#pragma unroll
    for (int mt = 0; mt < 8; ++mt) S[mt] = (f32x4){0.f, 0.f, 0.f, 0.f};
    if (!prompt) {
        const float* Sin = (TYPE == 0 ? F.in[2] : F.in[5]) + (size_t)(b * 4 + h) * 16384;
#pragma unroll
        for (int mt = 0; mt < 8; ++mt)
#pragma unroll
            for (int r = 0; r < 4; ++r) S[mt][r] = Sin[(16 * mt + 4 * q + r) * 128 + 16 * w + r16];
        if (TYPE == 0) {
#pragma unroll
            for (int r = 0; r < 4; ++r) nacc[r] = F.in[3][(size_t)(b * 4 + h) * 128 + 16 * w + 4 * q + r];
            m0 = F.in[4][b * 4 + h];
        }
    }
    const float lgam = (TYPE == 1) ? log1pf(-exp2f(-5.f - (float)h)) : 0.f;
    const float bias_i = (TYPE == 0) ? F.in[11][h] : 0.f, bias_f = (TYPE == 0) ? F.in[12][h] : 0.f;
    LAS float* GN = (LAS float*)(L + MX_GN);
    if (tid < 128) GN[tid] = (TYPE == 0 ? F.in[13] : F.in[14])[128 * h + tid];
    const int nsc = (mode == 0) ? 33 : 1;
    u32x4 pa[6]; f32x4 pr[4]; float pli = 0.f, plf = 0.f; u32x4 pg[2];
    const u32x4 z4 = {0u, 0u, 0u, 0u};
#define SG_LOAD(scv) do { int row0_, ntok_, nmc_, pos0_; MX_SC_PARAMS(scv, row0_, ntok_, nmc_, pos0_); (void)nmc_; \
        const bool valid_ = tk < ntok_; const bf16* zr_ = ZROW(F, row0_ + (valid_ ? tk : 0), 0); \
        _Pragma("unroll") for (int i_ = 0; i_ < 6; ++i_) pa[i_] = z4; \
        if (valid_) { pa[4] = *(const u32x4*)(zr_ + vcol + 16 * p); pa[5] = *(const u32x4*)(zr_ + vcol + 16 * p + 8); \
            if (TYPE == 0) { pa[0] = *(const u32x4*)(zr_ + qcol + 16 * p); pa[1] = *(const u32x4*)(zr_ + qcol + 16 * p + 8); pa[2] = *(const u32x4*)(zr_ + kcol + 16 * p); pa[3] = *(const u32x4*)(zr_ + kcol + 16 * p + 8); } \
            else { pa[0] = *(const u32x4*)(zr_ + qcol + 8 * p); pa[1] = *(const u32x4*)(zr_ + qcol + 64 + 8 * p); pa[2] = *(const u32x4*)(zr_ + kcol + 8 * p); pa[3] = *(const u32x4*)(zr_ + kcol + 64 + 8 * p); } } \
        if (TYPE == 1) { const float* tb_ = rot + ((size_t)(pos0_ + (valid_ ? tk : 0)) * 64 + 8 * p) * 2; _Pragma("unroll") for (int e_ = 0; e_ < 4; ++e_) pr[e_] = *(const f32x4*)(tb_ + 4 * e_); } \
        if (TYPE == 0 && w == 0) { const bool vt_ = lane < ntok_; const float* gp_ = F_GT(F) + (size_t)(row0_ + (vt_ ? lane : 0)) * 8; pli = gp_[h]; plf = gp_[4 + h]; } } while (0)
    SG_LOAD(0);
#pragma unroll 1
    for (int sc = 0; sc < nsc; ++sc) {
        int row0, ntok, nmc, pos0; MX_SC_PARAMS(sc, row0, ntok, nmc, pos0); (void)pos0;
        LAS float* SC = (LAS float*)(L + MX_SC) + (sc & 1) * 384;
        if (tk < 16 * nmc) {
            *(LAS u32x4*)(L + MX_V + tk * MX_PITCH + 32 * p) = pa[4]; *(LAS u32x4*)(L + MX_V + tk * MX_PITCH + 32 * p + 16) = pa[5];
            if (TYPE == 0) {
                *(LAS u32x4*)(L + MX_Q + tk * MX_PITCH + 32 * p) = pa[0]; *(LAS u32x4*)(L + MX_Q + tk * MX_PITCH + 32 * p + 16) = pa[1];
                *(LAS u32x4*)(L + MX_K + tk * MX_PITCH + 32 * p) = pa[2]; *(LAS u32x4*)(L + MX_K + tk * MX_PITCH + 32 * p + 16) = pa[3];
            } else {
                u32x4 q1, q2, k1, k2;
#pragma unroll
                for (int e2 = 0; e2 < 4; ++e2) {
                    const f32x4 cs = pr[e2];
                    { const float x1l = bflo(pa[0][e2]), x1h = bfhi(pa[0][e2]), x2l = bflo(pa[1][e2]), x2h = bfhi(pa[1][e2]);
                      q1[e2] = pkbf(x1l * cs[0] - x2l * cs[1], x1h * cs[2] - x2h * cs[3]); q2[e2] = pkbf(x2l * cs[0] + x1l * cs[1], x2h * cs[2] + x1h * cs[3]); }
                    { const float x1l = bflo(pa[2][e2]), x1h = bfhi(pa[2][e2]), x2l = bflo(pa[3][e2]), x2h = bfhi(pa[3][e2]);
                      k1[e2] = pkbf(x1l * cs[0] - x2l * cs[1], x1h * cs[2] - x2h * cs[3]); k2[e2] = pkbf(x2l * cs[0] + x1l * cs[1], x2h * cs[2] + x1h * cs[3]); }
                }
                *(LAS u32x4*)(L + MX_Q + tk * MX_PITCH + 16 * p) = q1; *(LAS u32x4*)(L + MX_Q + tk * MX_PITCH + 128 + 16 * p) = q2;
                *(LAS u32x4*)(L + MX_K + tk * MX_PITCH + 16 * p) = k1; *(LAS u32x4*)(L + MX_K + tk * MX_PITCH + 128 + 16 * p) = k2;
            }
        }
        if (w == 0) {
            const bool valid = lane < ntok;
            float li = -1e30f, lf = 0.f;
            if (TYPE == 0) { if (valid) { li = pli + bias_i; lf = logsigmoidf_(plf + bias_f); } } else { if (valid) { li = 0.f; lf = lgam; } }
            const float bb = row_prefix_sum(lf);
            const float y = li - bb;
            const float am = row_prefix_max(y);
            const float a = bb + am;
            const float B0 = rdlane(bb, 15), B1 = rdlane(bb, 31), B2 = rdlane(bb, 47), B3 = rdlane(bb, 63);
            float M1 = 0.f, M2 = 0.f, M3 = 0.f, M4 = 0.f;
            if (TYPE == 0) { const float A0 = rdlane(a, 15), A1 = rdlane(a, 31), A2 = rdlane(a, 47), A3 = rdlane(a, 63);
                M1 = fmaxf(B0 + m0, A0); M2 = fmaxf(B1 + M1, A1); M3 = fmaxf(B2 + M2, A2); M4 = fmaxf(B3 + M3, A3); }
            const float m0q = q == 0 ? m0 : q == 1 ? M1 : q == 2 ? M2 : M3;
            const float mnq = q == 0 ? M1 : q == 1 ? M2 : q == 2 ? M3 : M4;
            const float b15 = q == 0 ? B0 : q == 1 ? B1 : q == 2 ? B2 : B3;
            const float m = (TYPE == 0) ? fmaxf(bb + m0q, a) : 0.f;
            SC[lane] = bb - m; SC[64 + lane] = y + LNKS; SC[128 + lane] = __expf(bb + m0q - m);
            SC[192 + lane] = __expf(y + LNKS + b15 - mnq); SC[256 + lane] = __expf(-m);
            if (r16 == 0) SC[320 + q] = __expf(b15 + m0q - mnq);
            m0 = (nmc == 4) ? M4 : M1;
        }
        __syncthreads();
        if (sc + 1 < nsc) SG_LOAD(sc + 1);
        { const bool valid = tk < ntok; const bf16* zr = ZROW(F, row0 + (valid ? tk : 0), 0) + gcol + 16 * p; pg[0] = *(const u32x4*)zr; pg[1] = *(const u32x4*)(zr + 8); }
#pragma unroll 1
        for (int mc = 0; mc < nmc; ++mc) {
            {
                const LAS unsigned char* Qb = L + MX_Q + 16 * mc * MX_PITCH; const LAS unsigned char* Kb = L + MX_K + 16 * mc * MX_PITCH; const LAS unsigned char* Vb = L + MX_V + 16 * mc * MX_PITCH;
                f32x4 g = {0.f, 0.f, 0.f, 0.f};
#pragma unroll
                for (int ks = 0; ks < 4; ++ks) {
                    const u32x2 ka = *(const LAS u32x2*)(Kb + r16 * MX_PITCH + (32 * ks + 4 * q) * 2), kb = *(const LAS u32x2*)(Kb + r16 * MX_PITCH + (32 * ks + 16 + 4 * q) * 2);
                    const u32x2 qa = *(const LAS u32x2*)(Qb + r16 * MX_PITCH + (32 * ks + 4 * q) * 2), qb = *(const LAS u32x2*)(Qb + r16 * MX_PITCH + (32 * ks + 16 + 4 * q) * 2);
                    g = MFMA16(mk8(ka.x, ka.y, kb.x, kb.y), mk8(qa.x, qa.y, qb.x, qb.y), g);
                }
                const float xi = SC[mc * 16 + r16]; const f32x4 y4 = *(const LAS f32x4*)(SC + 64 + mc * 16 + 4 * q);
                f32x4 P;
#pragma unroll
                for (int r = 0; r < 4; ++r) P[r] = (4 * q + r <= r16) ? g[r] * __expf(xi + y4[r]) : 0.f;
                if (TYPE == 0) { float ps = (P[0] + P[1]) + (P[2] + P[3]); ps += __shfl_xor(ps, 16); ps += __shfl_xor(ps, 32); if (w == 0 && q == 0) DI[16 * mc + r16] = ps; }
                const u32x2 vt = tr16(Vb + (4 * q + (r16 >> 2)) * MX_PITCH + (16 * w + 4 * (r16 & 3)) * 2);
                f32x4 o1 = {0.f, 0.f, 0.f, 0.f}; o1 = MFMA16(mk8(pkbf(P[0], P[1]), pkbf(P[2], P[3]), 0u, 0u), mk8(vt.x, vt.y, 0u, 0u), o1);
#pragma unroll
                for (int r = 0; r < 4; ++r) OB[(16 * mc + 4 * q + r) * MX_OP + 16 * w + r16] = o1[r];
            }
        }
#pragma unroll 1
        for (int mc = 0; mc < nmc; ++mc) {
            {
                const LAS unsigned char* Qb = L + MX_Q + 16 * mc * MX_PITCH; const LAS unsigned char* Kb = L + MX_K + 16 * mc * MX_PITCH;
                const u32x2 vt = tr16(L + MX_V + 16 * mc * MX_PITCH + (4 * q + (r16 >> 2)) * MX_PITCH + (16 * w + 4 * (r16 & 3)) * 2);
                f32x4 o2 = {0.f, 0.f, 0.f, 0.f};
#pragma unroll
                for (int ks = 0; ks < 4; ++ks) {
                    const u32x2 qa = *(const LAS u32x2*)(Qb + r16 * MX_PITCH + (32 * ks + 4 * q) * 2), qb = *(const LAS u32x2*)(Qb + r16 * MX_PITCH + (32 * ks + 16 + 4 * q) * 2);
                    const bf16x8 SB = mk8(pkbf(S[2 * ks][0], S[2 * ks][1]), pkbf(S[2 * ks][2], S[2 * ks][3]), pkbf(S[2 * ks + 1][0], S[2 * ks + 1][1]), pkbf(S[2 * ks + 1][2], S[2 * ks + 1][3]));
                    o2 = MFMA16(mk8(qa.x, qa.y, qb.x, qb.y), SB, o2);
                }
                const f32x4 in4 = *(const LAS f32x4*)(SC + 128 + mc * 16 + 4 * q);
#pragma unroll
                for (int r = 0; r < 4; ++r) { LAS float* op = OB + (16 * mc + 4 * q + r) * MX_OP + 16 * w + r16; *op = *op + in4[r] * o2[r]; }
                const f32x4 w4 = *(const LAS f32x4*)(SC + 192 + mc * 16 + 4 * q); const float carry = SC[320 + mc];
                if (TYPE == 0) {
                    const u32x2 qn = *(const LAS u32x2*)(Qb + r16 * MX_PITCH + (16 * w + 4 * q) * 2);
                    f32x4 rr = {0.f, 0.f, 0.f, 0.f}; rr = MFMA16(mk8(qn.x, qn.y, 0u, 0u), mk8(pkbf(nacc[0], nacc[1]), pkbf(nacc[2], nacc[3]), 0u, 0u), rr);
                    if (r16 == 0) {
#pragma unroll
                        for (int r = 0; r < 4; ++r) RP[w * 64 + 16 * mc + 4 * q + r] = rr[r]; }
                }
                const bf16x8 VH = mk8(pkbf(bflo(vt.x) * w4[0], bfhi(vt.x) * w4[1]), pkbf(bflo(vt.y) * w4[2], bfhi(vt.y) * w4[3]), 0u, 0u);
#pragma unroll
                for (int mt = 0; mt < 8; ++mt) {
                    const u32x2 kt = tr16(Kb + (4 * q + (r16 >> 2)) * MX_PITCH + (16 * mt + 4 * (r16 & 3)) * 2);
                    S[mt] = S[mt] * carry; S[mt] = MFMA16(mk8(kt.x, kt.y, 0u, 0u), VH, S[mt]);
                }
                if (TYPE == 0) {
                    const u32x2 kt = tr16(Kb + (4 * q + (r16 >> 2)) * MX_PITCH + (16 * w + 4 * (r16 & 3)) * 2);
                    nacc = nacc * carry; nacc = MFMA16(mk8(kt.x, kt.y, 0u, 0u), mk8(pkbf(w4[0], w4[1]), pkbf(w4[2], w4[3]), 0u, 0u), nacc);
                }
            }
        }
        __syncthreads();
        {
            const bool valid = tk < ntok; const int row = row0 + (valid ? tk : 0);
            f32x4 o[4];
#pragma unroll
            for (int c = 0; c < 4; ++c) o[c] = *(const LAS f32x4*)(OB + tk * MX_OP + 16 * p + 4 * c);
            if (tk >= 16 * nmc) {
#pragma unroll
                for (int c = 0; c < 4; ++c) o[c] = (f32x4){0.f, 0.f, 0.f, 0.f}; }
            if (TYPE == 0) {
                float rs = 0.f;
#pragma unroll
                for (int ww = 0; ww < 8; ++ww) rs += RP[ww * 64 + tk];
                const float den = DI[tk] + SC[128 + tk] * rs;
                float dn = fmaxf(fabsf(den), SC[256 + tk]); if (tk >= 16 * nmc) dn = 1.f;
                const float rd = 1.f / dn;
#pragma unroll
                for (int c = 0; c < 4; ++c) o[c] = o[c] * rd;
            }
            float sm = 0.f;
#pragma unroll
            for (int c = 0; c < 4; ++c) sm += (o[c].x + o[c].y) + (o[c].z + o[c].w);
            sm += __shfl_xor(sm, 1); sm += __shfl_xor(sm, 2); sm += __shfl_xor(sm, 4);
            const float mu = sm * (1.f / 128.f); float vs = 0.f;
#pragma unroll
            for (int c = 0; c < 4; ++c) { o[c] = o[c] - mu; vs += (o[c].x * o[c].x + o[c].y * o[c].y) + (o[c].z * o[c].z + o[c].w * o[c].w); }
            vs += __shfl_xor(vs, 1); vs += __shfl_xor(vs, 2); vs += __shfl_xor(vs, 4);
            const float rstd = rsqrtf(vs * (1.f / 128.f) + EPS);
            if (valid && !(mode == 0 && sc == 0)) {
                unsigned ow[8];
#pragma unroll
                for (int c = 0; c < 4; ++c) {
                    const unsigned ga = c < 2 ? pg[0][2 * c] : pg[1][2 * c - 4], gb = c < 2 ? pg[0][2 * c + 1] : pg[1][2 * c - 3];
                    f32x4 gt = {bflo(ga), bfhi(ga), bflo(gb), bfhi(gb)};
#pragma unroll
                    for (int e = 0; e < 4; ++e) gt[e] = (TYPE == 0) ? sigmoidf_(gt[e]) : siluf_(gt[e]);
                    const f32x4 r = o[c] * rstd * *(const LAS f32x4*)(GN + 16 * p + 4 * c) * gt;
                    ow[2 * c] = pkbf(r.x, r.y); ow[2 * c + 1] = pkbf(r.z, r.w);
                }
                bf16* mp = MIX + (size_t)row * DM + mcol + 16 * p;
                *(u32x4*)mp = (u32x4){ow[0], ow[1], ow[2], ow[3]}; *(u32x4*)(mp + 8) = (u32x4){ow[4], ow[5], ow[6], ow[7]};
            }
        }
    }
#undef SG_LOAD
    __syncthreads();
    if (mode != 2) {
        float* So = F.out + (TYPE == 0 ? (prompt ? O_CP : O_CS) : (prompt ? O_RP : O_RS)) + (size_t)(b * 4 + h) * 16384;
#pragma unroll
        for (int mt = 0; mt < 8; ++mt)
#pragma unroll
            for (int r = 0; r < 4; ++r) So[(16 * mt + 4 * q + r) * 128 + 16 * w + r16] = S[mt][r];
        if (TYPE == 0) {
            if (r16 == 0) { float* No = F.out + (prompt ? O_NP : O_NS) + (size_t)(b * 4 + h) * 128;
#pragma unroll
                for (int r = 0; r < 4; ++r) No[16 * w + 4 * q + r] = nacc[r]; }
            if (w == 0 && lane == 0) F.out[(prompt ? O_MP : O_MS) + b * 4 + h] = m0;
        }
    }
}

__device__ __forceinline__ void mix_hg_unit(Frame& F, int b, int h, int mode) {
    const bool prompt = (mode != 1);
    const int tid = F.tid, lane = F.lane, w = F.wave, r16 = lane & 15, q = lane >> 4;
    const int tk = tid >> 3, p = tid & 7;
    const int amc = w >> 1, app = q + 4 * (w & 1);
    LAS unsigned char* L = F.lds;
    LAS float* GD = (LAS float*)(L + MX_GD); LAS float* OB = (LAS float*)(L + MX_OB);
    bf16* MIX = F_XN(F);
    f32x4 S[8];
#pragma unroll
    for (int mt = 0; mt < 8; ++mt) S[mt] = (f32x4){0.f, 0.f, 0.f, 0.f};
    if (!prompt) {
        const float* Sin = F.in[6] + (size_t)(b * 8 + h) * 16384;
#pragma unroll
        for (int mt = 0; mt < 8; ++mt)
#pragma unroll
            for (int r = 0; r < 4; ++r) S[mt][r] = Sin[(16 * mt + 4 * q + r) * 128 + 16 * w + r16];
    }
    LAS float* GN = (LAS float*)(L + MX_GN); LAS float* LB = (LAS float*)(L + MX_LB);
    if (tid < 128) { GN[tid] = F.in[18][128 * h + tid]; LB[tid] = sigmoidf_(F.in[16][1024 + 128 * h + tid] - F.in[16][128 * h + tid]); }
    __syncthreads();
    const int nsc = (mode == 0) ? 33 : 1;
    u32x4 pa[6]; u32x4 pg[2];
    const u32x4 z4 = {0u, 0u, 0u, 0u};
#define HG_LOAD(scv) do { int row0_, ntok_, nmc_, pos0_; MX_SC_PARAMS(scv, row0_, ntok_, nmc_, pos0_); (void)pos0_; \
        const int t_ = 16 * amc + r16; const bool valid_ = (amc < nmc_) && (t_ < ntok_); const bf16* zr_ = ZROW(F, row0_ + (valid_ ? t_ : 0), 1) + 128 * h + 16 * app; \
        _Pragma("unroll") for (int i_ = 0; i_ < 6; ++i_) pa[i_] = z4; \
        if (valid_) { pa[0] = *(const u32x4*)zr_; pa[1] = *(const u32x4*)(zr_ + 8); pa[2] = *(const u32x4*)(zr_ + 1024); pa[3] = *(const u32x4*)(zr_ + 1032); pa[4] = *(const u32x4*)(zr_ + 2048); pa[5] = *(const u32x4*)(zr_ + 2056); } } while (0)
    HG_LOAD(0);
#pragma unroll 1
    for (int sc = 0; sc < nsc; ++sc) {
        int row0, ntok, nmc, pos0; MX_SC_PARAMS(sc, row0, ntok, nmc, pos0); (void)pos0;
        if (amc < nmc) {
            const bool valid = (16 * amc + r16) < ntok;
            unsigned wq[8], wk[8], wh[8]; float Aend[16]; float lbv[16];
#pragma unroll
            for (int c = 0; c < 4; ++c) { const f32x4 t4 = *(const LAS f32x4*)(LB + 16 * app + 4 * c); lbv[4 * c] = t4[0]; lbv[4 * c + 1] = t4[1]; lbv[4 * c + 2] = t4[2]; lbv[4 * c + 3] = t4[3]; }
#pragma unroll
            for (int e2 = 0; e2 < 8; ++e2) {
                const unsigned qw = e2 < 4 ? pa[0][e2] : pa[1][e2 - 4], fw = e2 < 4 ? pa[2][e2] : pa[3][e2 - 4];
                float qo[2], ko[2], ho[2];
#pragma unroll
                for (int hh = 0; hh < 2; ++hh) {
                    const int e = 2 * e2 + hh;
                    const float qv = hh ? bfhi(qw) : bflo(qw), fv = hh ? bfhi(fw) : bflo(fw);
                    const float sg = sigmoidf_(fv);
                    const float a = valid ? lbv[e] + (1.f - lbv[e]) * sg : 1.f;
                    const float kk = valid ? (1.f - lbv[e]) * (1.f - sg) : 0.f;
                    const float A = row_prefix_prod(a);
                    const float Sx = row_suffix_prod(a);
                    const float R = dppf<0x101>(1.f, Sx);
                    qo[hh] = qv * A; ko[hh] = kk * __builtin_amdgcn_rcpf(fmaxf(A, 1e-30f)); ho[hh] = kk * R; Aend[e] = A;
                }
                wq[e2] = pkbf(qo[0], qo[1]); wk[e2] = pkbf(ko[0], ko[1]); wh[e2] = pkbf(ho[0], ho[1]);
            }
            const int ro = (16 * amc + r16) * MX_PITCH + 32 * app;
            *(LAS u32x4*)(L + MX_Q + ro) = (u32x4){wq[0], wq[1], wq[2], wq[3]}; *(LAS u32x4*)(L + MX_Q + ro + 16) = (u32x4){wq[4], wq[5], wq[6], wq[7]};
            *(LAS u32x4*)(L + MX_K + ro) = (u32x4){wk[0], wk[1], wk[2], wk[3]}; *(LAS u32x4*)(L + MX_K + ro + 16) = (u32x4){wk[4], wk[5], wk[6], wk[7]};
            *(LAS u32x4*)(L + MX_KH + ro) = (u32x4){wh[0], wh[1], wh[2], wh[3]}; *(LAS u32x4*)(L + MX_KH + ro + 16) = (u32x4){wh[4], wh[5], wh[6], wh[7]};
            *(LAS u32x4*)(L + MX_V + ro) = pa[4]; *(LAS u32x4*)(L + MX_V + ro + 16) = pa[5];
            if (r16 == 15) {
#pragma unroll
                for (int c = 0; c < 4; ++c) *(LAS f32x4*)(GD + amc * 128 + 16 * app + 4 * c) = (f32x4){Aend[4 * c], Aend[4 * c + 1], Aend[4 * c + 2], Aend[4 * c + 3]}; }
        }
        __syncthreads();
        if (sc + 1 < nsc) HG_LOAD(sc + 1);
        { const bool valid = tk < ntok; const bf16* zr = ZROW(F, row0 + (valid ? tk : 0), 1) + 3072 + 128 * h + 16 * p; pg[0] = *(const u32x4*)zr; pg[1] = *(const u32x4*)(zr + 8); }
#pragma unroll 1
        for (int mc = 0; mc < nmc; ++mc) {
            {
                const LAS unsigned char* Qb = L + MX_Q + 16 * mc * MX_PITCH; const LAS unsigned char* Kb = L + MX_K + 16 * mc * MX_PITCH; const LAS unsigned char* Vb = L + MX_V + 16 * mc * MX_PITCH;
                f32x4 g = {0.f, 0.f, 0.f, 0.f};
#pragma unroll
                for (int ks = 0; ks < 4; ++ks) {
                    const u32x2 ka = *(const LAS u32x2*)(Kb + r16 * MX_PITCH + (32 * ks + 4 * q) * 2), kb = *(const LAS u32x2*)(Kb + r16 * MX_PITCH + (32 * ks + 16 + 4 * q) * 2);
                    const u32x2 qa = *(const LAS u32x2*)(Qb + r16 * MX_PITCH + (32 * ks + 4 * q) * 2), qb = *(const LAS u32x2*)(Qb + r16 * MX_PITCH + (32 * ks + 16 + 4 * q) * 2);
                    g = MFMA16(mk8(ka.x, ka.y, kb.x, kb.y), mk8(qa.x, qa.y, qb.x, qb.y), g);
                }
                f32x4 P;
#pragma unroll
                for (int r = 0; r < 4; ++r) P[r] = (4 * q + r <= r16) ? g[r] : 0.f;
                const u32x2 vt = tr16(Vb + (4 * q + (r16 >> 2)) * MX_PITCH + (16 * w + 4 * (r16 & 3)) * 2);
                f32x4 o1 = {0.f, 0.f, 0.f, 0.f}; o1 = MFMA16(mk8(pkbf(P[0], P[1]), pkbf(P[2], P[3]), 0u, 0u), mk8(vt.x, vt.y, 0u, 0u), o1);
#pragma unroll
                for (int r = 0; r < 4; ++r) OB[(16 * mc + 4 * q + r) * MX_OP + 16 * w + r16] = o1[r];
            }
        }
#pragma unroll 1
        for (int mc = 0; mc < nmc; ++mc) {
            {
                const LAS unsigned char* Qb = L + MX_Q + 16 * mc * MX_PITCH; const LAS unsigned char* Hb = L + MX_KH + 16 * mc * MX_PITCH;
                const u32x2 vt = tr16(L + MX_V + 16 * mc * MX_PITCH + (4 * q + (r16 >> 2)) * MX_PITCH + (16 * w + 4 * (r16 & 3)) * 2);
                f32x4 oo;
#pragma unroll
                for (int r = 0; r < 4; ++r) oo[r] = OB[(16 * mc + 4 * q + r) * MX_OP + 16 * w + r16];
#pragma unroll
                for (int ks = 0; ks < 4; ++ks) {
                    const u32x2 qa = *(const LAS u32x2*)(Qb + r16 * MX_PITCH + (32 * ks + 4 * q) * 2), qb = *(const LAS u32x2*)(Qb + r16 * MX_PITCH + (32 * ks + 16 + 4 * q) * 2);
                    const bf16x8 SB = mk8(pkbf(S[2 * ks][0], S[2 * ks][1]), pkbf(S[2 * ks][2], S[2 * ks][3]), pkbf(S[2 * ks + 1][0], S[2 * ks + 1][1]), pkbf(S[2 * ks + 1][2], S[2 * ks + 1][3]));
                    oo = MFMA16(mk8(qa.x, qa.y, qb.x, qb.y), SB, oo);
                }
#pragma unroll
                for (int r = 0; r < 4; ++r) OB[(16 * mc + 4 * q + r) * MX_OP + 16 * w + r16] = oo[r];
                const bf16x8 VB = mk8(vt.x, vt.y, 0u, 0u);
#pragma unroll
                for (int mt = 0; mt < 8; ++mt) {
                    const f32x4 gd = *(const LAS f32x4*)(GD + mc * 128 + 16 * mt + 4 * q);
                    const u32x2 kt = tr16(Hb + (4 * q + (r16 >> 2)) * MX_PITCH + (16 * mt + 4 * (r16 & 3)) * 2);
                    S[mt] = S[mt] * gd; S[mt] = MFMA16(mk8(kt.x, kt.y, 0u, 0u), VB, S[mt]);
                }
            }
        }
        __syncthreads();
        {
            const bool valid = tk < ntok; const int row = row0 + (valid ? tk : 0);
            f32x4 o[4];
#pragma unroll
            for (int c = 0; c < 4; ++c) o[c] = *(const LAS f32x4*)(OB + tk * MX_OP + 16 * p + 4 * c);
            if (tk >= 16 * nmc) {
#pragma unroll
                for (int c = 0; c < 4; ++c) o[c] = (f32x4){0.f, 0.f, 0.f, 0.f}; }
            float vs = 0.f;
#pragma unroll
            for (int c = 0; c < 4; ++c) vs += (o[c].x * o[c].x + o[c].y * o[c].y) + (o[c].z * o[c].z + o[c].w * o[c].w);
            vs += __shfl_xor(vs, 1); vs += __shfl_xor(vs, 2); vs += __shfl_xor(vs, 4);
            const float rstd = rsqrtf(vs * (1.f / 128.f) + EPS);
            if (valid && !(mode == 0 && sc == 0)) {
                unsigned ow[8];
#pragma unroll
                for (int c = 0; c < 4; ++c) {
                    const unsigned ga = c < 2 ? pg[0][2 * c] : pg[1][2 * c - 4], gb = c < 2 ? pg[0][2 * c + 1] : pg[1][2 * c - 3];
                    f32x4 gt = {bflo(ga), bfhi(ga), bflo(gb), bfhi(gb)};
#pragma unroll
                    for (int e = 0; e < 4; ++e) gt[e] = siluf_(gt[e]);
                    const f32x4 r = o[c] * rstd * *(const LAS f32x4*)(GN + 16 * p + 4 * c) * gt;
                    ow[2 * c] = pkbf(r.x, r.y); ow[2 * c + 1] = pkbf(r.z, r.w);
                }
                bf16* mp = MIX + (size_t)row * DM + 128 * h + 16 * p;
                *(u32x4*)mp = (u32x4){ow[0], ow[1], ow[2], ow[3]}; *(u32x4*)(mp + 8) = (u32x4){ow[4], ow[5], ow[6], ow[7]};
            }
        }
    }
#undef HG_LOAD
    __syncthreads();
    if (mode != 2) {
        float* So = F.out + (prompt ? O_HP : O_HS) + (size_t)(b * 8 + h) * 16384;
#pragma unroll
        for (int mt = 0; mt < 8; ++mt)
#pragma unroll
            for (int r = 0; r < 4; ++r) So[(16 * mt + 4 * q + r) * 128 + 16 * w + r16] = S[mt][r];
    }
}

__device__ __forceinline__ void mixer_layer0(Frame& F) {
    const float* rot = (const float*)(F.ws + WS_ROT);
    if (blockIdx.x < 64) { const int u = blockIdx.x, ty = u >> 5, bh = u & 31; if (ty == 0) mix_sg_unit<0>(F, bh >> 2, bh & 3, 0, rot); else mix_sg_unit<1>(F, bh >> 2, bh & 3, 0, rot); return; }
#pragma unroll 1
    for (int u = blockIdx.x - 64; u < 1024 + 8; u += F.G - 64) {
        int ty, bh, mode;
        if (u < 1024) { ty = u >> 9; bh = u & 511; mode = 1; } else { ty = (u - 1024) >> 2; bh = (u - 1024) & 3; mode = 2; }
        if (ty == 0) mix_sg_unit<0>(F, bh >> 2, bh & 3, mode, rot); else mix_sg_unit<1>(F, bh >> 2, bh & 3, mode, rot);
    }
}
__device__ __forceinline__ void mixer_layer1(Frame& F) {
    if (blockIdx.x < 64) { mix_hg_unit(F, blockIdx.x >> 3, blockIdx.x & 7, 0); return; }
#pragma unroll 1
    for (int u = blockIdx.x - 64; u < 1024 + 8; u += F.G - 64) {
        if (u < 1024) mix_hg_unit(F, u >> 3, u & 7, 1); else mix_hg_unit(F, 0, u - 1024, 2);
    }
}
constexpr int NSTEP = 21;
constexpr int LDSCTL_OFF = 139264;
#define RLX_AGENT __ATOMIC_RELAXED, __HIP_MEMORY_SCOPE_AGENT
#define XB_TMO      128
#define XB_XCNT(j)  (256  + 64 * (j))
#define XB_XSUB(j)  (1280 + 64 * (j))
#define XB_XGEN(j)  (2304 + 64 * (j))
#define XB_TOP      3328
#define XB_TOPGEN   3392
#define XCD_BAR_WORDS 3456
#define XB_SPIN_CAP (1u << 18)

__device__ __forceinline__ unsigned xb_ld(unsigned* p)              { return __hip_atomic_load(p, __ATOMIC_RELAXED, __HIP_MEMORY_SCOPE_AGENT); }
__device__ __forceinline__ unsigned xb_add(unsigned* p, unsigned v) { return __hip_atomic_fetch_add(p, v, __ATOMIC_RELAXED, __HIP_MEMORY_SCOPE_AGENT); }
__device__ __forceinline__ unsigned xb_xcc_id() { return (unsigned)__builtin_amdgcn_s_getreg((3 << 11) | 20) & 0xFu; }
#define XB_SPIN(cond, bar) do { unsigned _sp = 0; while (cond) { __builtin_amdgcn_s_sleep(1); \
    if ((++_sp & 255u) == 0u) { if (xb_ld(&(bar)[XB_TMO])) break; if (_sp > XB_SPIN_CAP) { atomicAdd(&(bar)[XB_TMO], 1u); break; } } } } while (0)

struct XcdBarrier {
    unsigned gsz;
    unsigned* bar; unsigned x;
    volatile LAS unsigned* st;
};

__device__ __forceinline__ XcdBarrier xcd_barrier_post(unsigned* bar, volatile LAS unsigned* st, unsigned gsz) {
    XcdBarrier b; b.gsz = gsz; b.bar = bar; b.x = xb_xcc_id(); b.st = st;
    if (threadIdx.x == 0) (void)xb_add(&bar[XB_XCNT(b.x)], 1u);
    return b;
}
__device__ __forceinline__ void xcd_barrier_complete(unsigned* bar, unsigned x, unsigned G, unsigned& nloc, unsigned& nx) {
    unsigned sum, cnt, mine, sp = 0u;
    for (;;) {
        sum = 0u; cnt = 0u; mine = 0u;
#pragma unroll
        for (unsigned j = 0; j < 16; ++j) { const unsigned c = xb_ld(&bar[XB_XCNT(j)]); sum += c; cnt += (c > 0u) ? 1u : 0u; mine = (j == x) ? c : mine; }
        if (sum == G) break;
        __builtin_amdgcn_s_sleep(1);
        if ((++sp & 255u) == 0u) { if (xb_ld(&bar[XB_TMO])) break; if (sp > XB_SPIN_CAP) { atomicAdd(&bar[XB_TMO], 1u); break; } }
    }
    nloc = mine > 0u ? mine : 1u; nx = cnt > 0u ? cnt : 1u;
}

__device__ __forceinline__ void xcd_barrier(const XcdBarrier& b) {
    asm volatile("s_waitcnt vmcnt(0)" ::: "memory");
    __syncthreads();
    if (threadIdx.x == 0) {
        unsigned* bar = b.bar;
        __builtin_amdgcn_s_waitcnt(0);
        unsigned nloc = b.st[0], nx = b.st[1];
        if (nloc == 0u) { xcd_barrier_complete(bar, b.x, b.gsz, nloc, nx); b.st[0] = nloc; b.st[1] = nx; }
        const unsigned old = xb_add(&bar[XB_XSUB(b.x)], 1u);
        const unsigned gen = old / nloc;
        if (old + 1u == (gen + 1u) * nloc) {
            __builtin_amdgcn_fence(__ATOMIC_RELEASE, "agent");
            asm volatile("s_waitcnt vmcnt(0)" ::: "memory");
            const unsigned og = xb_add(&bar[XB_TOP], 1u);
            const unsigned tg = og / nx;
            if (og + 1u == (tg + 1u) * nx) xb_add(&bar[XB_TOPGEN], 1u);
            else XB_SPIN(xb_ld(&bar[XB_TOPGEN]) == tg, bar);
            __builtin_amdgcn_fence(__ATOMIC_ACQUIRE, "agent");
            xb_add(&bar[XB_XGEN(b.x)], 1u);
            asm volatile("s_waitcnt vmcnt(0)" ::: "memory");
        } else {
            XB_SPIN(xb_ld(&bar[XB_XGEN(b.x)]) == gen, bar);
            __builtin_amdgcn_fence(__ATOMIC_ACQUIRE, "agent");
            asm volatile("s_waitcnt vmcnt(0)" ::: "memory");
        }
    }
    __syncthreads();
}


enum { K_P0 = 0, K_IN = 1, K_MIX = 2, K_OUT = 3, K_UP = 5, K_FIX = 6, K_DOWN = 7, K_FINAL = 8 };
struct Step { int kind, layer, side, tile0, nt, pre; };
__device__ __forceinline__ Step get_step(int pc) {
    switch (pc) {
        case 0:  return Step{K_P0, 0, 0, 0, 0, 0};
        case 1:  return Step{K_IN, 0, 0, 0, 69, 1};
        case 2:  return Step{K_MIX, 0, 0, 0, 0, 1};
        case 3:  return Step{K_OUT, 0, 1, 64, 5, 2};
        case 4:  return Step{K_UP, 0, 1, 64, 5, 2};
        case 5:  return Step{K_DOWN, 0, 1, 64, 5, 2};
        case 6:  return Step{K_IN, 1, 1, 64, 5, 2};
        case 7:  return Step{K_OUT, 0, 0, 0, 64, 1};
        case 8:  return Step{K_UP, 0, 0, 0, 64, 1};
        case 9:  return Step{K_FIX, 0, 0, 0, 0, 1};
        case 10: return Step{K_DOWN, 0, 0, 0, 64, 1};
        case 11: return Step{K_IN, 1, 0, 0, 64, 1};
        case 12: return Step{K_MIX, 1, 0, 0, 0, 1};
        case 13: return Step{K_OUT, 1, 1, 64, 5, 2};
        case 14: return Step{K_UP, 1, 1, 64, 5, 2};
        case 15: return Step{K_DOWN, 1, 1, 64, 5, 2};
        case 16: return Step{K_OUT, 1, 0, 0, 64, 1};
        case 17: return Step{K_UP, 1, 0, 0, 64, 1};
        case 18: return Step{K_FIX, 1, 0, 0, 0, 1};
        case 19: return Step{K_DOWN, 1, 0, 0, 64, 1};
        default: return Step{K_FINAL, 0, 0, 0, 0, 1};
    }
}

__global__ void __launch_bounds__(NWAVES * 64, 2) fwd_kernel(Args args) {
    extern __shared__ __attribute__((aligned(16))) unsigned char lds_raw[];
    cg::grid_group grid = cg::this_grid();
    Frame F;
    F.lds = (LAS unsigned char*)lds_raw;
#define REFRESH() do { int t_ = threadIdx.x; asm volatile("" : "+v"(t_)); F.tid = t_; F.lane = t_ & 63; F.wave = __builtin_amdgcn_readfirstlane(t_ >> 6); F.gw = blockIdx.x * NWAVES + F.wave; } while (0)
    F.G = gridDim.x; F.NGW = F.G * NWAVES; REFRESH();
    F.in = args.in; F.out = args.out; F.ws = args.ws;
    volatile LAS unsigned* MISC = (volatile LAS unsigned*)(F.lds + LDSCTL_OFF);
    if (threadIdx.x < 16) MISC[threadIdx.x] = 0u;
    __syncthreads();
    const bool side_wg = blockIdx.x >= 64;
    (void)xcd_barrier_post((unsigned*)(args.ws + WS_CTL), MISC + 8, F.G);
    if (side_wg) (void)xcd_barrier_post((unsigned*)(args.ws + WS_CTL) + 4096, MISC + 10, F.G - 64);
#ifndef KMASK
#define KMASK 0x1ff
#endif
#define INK(kind) ((((KMASK) >> (kind)) & 1) != 0)
#pragma unroll 1
    for (int pc = 0; pc < NSTEP; ++pc) {
        const Step st = get_step(pc);
        if (st.pre == 1) { if (pc == 1) grid.sync(); else { XcdBarrier bar_; bar_.gsz = F.G; bar_.bar = (unsigned*)(args.ws + WS_CTL); bar_.x = xb_xcc_id(); bar_.st = (volatile LAS unsigned*)(F.lds + LDSCTL_OFF) + 8; xcd_barrier(bar_); } }
        if (st.side && !side_wg) continue;
        if (st.pre == 2) { XcdBarrier bar_; bar_.gsz = F.G - 64; bar_.bar = (unsigned*)(args.ws + WS_CTL) + 4096; bar_.x = xb_xcc_id(); bar_.st = (volatile LAS unsigned*)(F.lds + LDSCTL_OFF) + 10; xcd_barrier(bar_); }
        const int layer = st.layer;
        const int Gs = st.side ? F.G - 64 : F.G, cs = st.side ? (int)blockIdx.x - 64 : (int)blockIdx.x;
        if (st.kind == K_P0) { if (INK(0)) { REFRESH(); p0_weights(F); __syncthreads(); REFRESH(); p0_rows(F); REFRESH(); p0_rotary(F, (float*)(args.ws + WS_ROT)); } }
        else if (st.kind == K_IN) { if (INK(1)) {
            pg8::Gemm g{F_XG(F), (const bf16*)(args.ws + (layer == 0 ? WS_WAB : WS_WC)), MPAD, 4096, 1024}; pg8::StaticOrder S; S.init(st.nt, 4096, Gs, cs, st.tile0);
            pg8::EpiBf16 E{F_Z(F), F_ZS1(F, layer), 64, 4096, layer == 0 ? (const float*)nullptr : (const float*)F_SSQ(F)};
            pg8::gemm_phase<pg8::EpiBf16, pg8::StaticOrder, false>(F.lds, g, S, E); } }
        else if (st.kind == K_MIX) { if (INK(2)) { REFRESH(); if (layer == 0) mixer_layer0(F); else mixer_layer1(F); } }
        else if (st.kind == K_OUT) { if (INK(3)) {
            pg8::Gemm g{F_XN(F), (const bf16*)(args.ws + (layer == 0 ? WS_WOAB : WS_WOC)), MPAD, 1024, 1024}; pg8::StaticOrder S; S.init(st.nt, 1024, Gs, cs, st.tile0);
            pg8::EpiResid E{F_X0(F), F_X1(F), PM_META, DM, F_XG(F), F.in[20] + (size_t)layer * DM, F_SSQ(F)};
            pg8::gemm_phase<pg8::EpiResid, pg8::StaticOrder, false>(F.lds, g, S, E); } }
        else if (st.kind == K_UP) { if (INK(5)) {
            pg8::Gemm g{F_XG(F), (const bf16*)(args.ws + WS_WF1) + (size_t)layer * NFF * 1024, MPAD, NFF, 1024}; pg8::StaticOrder S; S.init(st.nt, NFF, Gs, cs, st.tile0);
            EpiFfn E{F_Z(F), F_HS1(F), F.in[22] + (size_t)layer * 3 * DFF, F.in[23] + (size_t)layer * DFF, F.in[7] + (size_t)layer * 128 * 2 * DFF, F.out + O_FS + (size_t)layer * 128 * 2 * DFF, F_SBL(F), F_SBF(F), F_SSQ(F)};
            pg8::gemm_phase<EpiFfn, pg8::StaticOrder, true>(F.lds, g, S, E); } }
        else if (st.kind == K_FIX) { if (INK(6)) { REFRESH(); ffn_fixup(F, layer); } }
        else if (st.kind == K_DOWN) { if (INK(7)) {
            pg8::Gemm g{st.side ? F_HS1(F) : F_Z(F), (const bf16*)(args.ws + WS_WF2) + (size_t)layer * 1024 * DFF, MPAD, 1024, DFF}; pg8::StaticOrder S; S.init(st.nt, 1024, Gs, cs, st.tile0);
            pg8::EpiResid E{F_X0(F), F_X1(F), PM_META, DM, layer == 0 ? F_XG(F) : (bf16*)nullptr, F.in[9] + DM, F_SSQ(F)};
            pg8::gemm_phase<pg8::EpiResid, pg8::StaticOrder, false>(F.lds, g, S, E); } }
        else { if (INK(8)) { REFRESH(); rms_final(F, F.in[25]); } }
    }
#undef INK
#undef REFRESH
}

extern "C" void kernel_launch(void* const* d_in, const int* in_sizes, int n_in, void* d_out, int out_size, void* d_ws, size_t ws_size, hipStream_t stream) {
    static int grid = 0;
    if (grid == 0) {
        if (n_in != 26 || (size_t)out_size != O_END || ws_size < WS_END) { fprintf(stderr, "kernel_launch: unexpected shapes: n_in %d out %d ws %zu\n", n_in, out_size, ws_size); grid = -1; return; }
        int dev = 0, cus = 0, per_cu = 0;
        if (hipGetDevice(&dev) != hipSuccess || hipDeviceGetAttribute(&cus, hipDeviceAttributeMultiprocessorCount, dev) != hipSuccess) { grid = -1; return; }
        if (hipFuncSetAttribute((const void*)fwd_kernel, hipFuncAttributeMaxDynamicSharedMemorySize, LDS_BYTES) != hipSuccess) { fprintf(stderr, "kernel_launch: hipFuncSetAttribute failed\n"); grid = -1; return; }
        if (hipOccupancyMaxActiveBlocksPerMultiprocessor(&per_cu, (const void*)fwd_kernel, NWAVES * 64, LDS_BYTES) != hipSuccess || per_cu < 1) { fprintf(stderr, "kernel_launch: occupancy query says %d\n", per_cu); per_cu = 1; }
        (void)hipGetLastError();
        grid = cus;
        if (grid < 128) { fprintf(stderr, "kernel_launch: this kernel's static work split needs >= 128 CUs (got %d)\n", grid); grid = -1; return; }
    }
    if (grid < 0) return;
    if (hipMemsetAsync((char*)d_ws + WS_CTL, 0, 32768, stream) != hipSuccess) { fprintf(stderr, "kernel_launch: hipMemsetAsync failed\n"); return; }
    Args a{};
    for (int i = 0; i < 26; ++i) a.in[i] = (const float*)d_in[i];
    a.out = (float*)d_out; a.ws = (unsigned char*)d_ws;
    a.ph_lo = 0; a.ph_hi = NSTEP;
    void* kargs[] = {&a};
    hipError_t e = hipLaunchCooperativeKernel((const void*)fwd_kernel, dim3(grid), dim3(NWAVES * 64), kargs, LDS_BYTES, stream);
    if (e != hipSuccess) fprintf(stderr, "kernel_launch: cooperative launch failed: %s (grid %d)\n", hipGetErrorString(e), grid);
}
```

```cpp
#include <hip/hip_runtime.h>
#include <hip/hip_cooperative_groups.h>
#include <cstdio>
#include <cstdint>
namespace cg = cooperative_groups;

namespace pg8 {
#define PG8_LAS __attribute__((address_space(3)))
typedef unsigned short bf16_t;
typedef short bf16x8 __attribute__((ext_vector_type(8)));
typedef float f32x4 __attribute__((ext_vector_type(4)));
typedef unsigned u32x4 __attribute__((ext_vector_type(4)));
typedef unsigned u32x2 __attribute__((ext_vector_type(2)));
constexpr int BM = 256, BK = 64, HALF = 128, HTB = HALF * BK * 2  , STAGE_BYTES = 8 * HTB, NXCD = 8, WGM = 8;

__host__ __device__ __forceinline__ int lds_byte(int r, int c) { const int st = (r >> 4) * 2 + (c >> 5), rr = r & 15, cc = c & 31, ob = rr * 64 + cc * 2; return st * 1024 + (ob ^ (((ob >> 9) & 1) << 5)); }
__host__ __device__ __forceinline__ void stage_rc(int b, int& R, int& C) { const int st = b / 1024, sb = b % 1024, swz = sb ^ (((sb >> 9) & 1) << 5); R = (st >> 1) * 16 + swz / 64; C = (st & 1) * 32 + (swz % 64) / 2; }
__host__ __device__ __forceinline__ int perm32(int rho) { const int n = rho >> 4, i = rho & 15; return 8 * (i >> 2) + 4 * n + (i & 3); }

struct Unit { int pm, pn; };
struct Gemm { const bf16_t* A; const bf16_t* Bt; int M, N, K; };

struct StaticOrder {
    int nM, nN, nwg, G, c, pm0;
    __host__ __device__ void init(int nMt, int N, int G_, int c_, int pm0_) { nM = nMt; nN = N / BM; nwg = nM * nN; G = G_; c = c_; pm0 = pm0_; }
    __host__ __device__ bool next(int i, Unit& u) const {
        const long L = (long)i * G + c; if (L >= nwg) return false;
        int wgid = (int)L; { const int q = nwg / NXCD, r = nwg % NXCD, xcd = wgid % NXCD, off = wgid / NXCD; wgid = (xcd < r ? xcd * (q + 1) : r * (q + 1) + (xcd - r) * q) + off; }
        const int nig = WGM * nN, gid = wgid / nig, fm = gid * WGM, gsz = (nM - fm) < WGM ? (nM - fm) : WGM;
        u.pm = pm0 + fm + ((wgid % nig) % gsz); u.pn = (wgid % nig) / gsz; return true;
    }
    __device__ __forceinline__ void a_ready(const Unit&) const {}
    __device__ __forceinline__ void done(const Unit&) const {}
};

__device__ __forceinline__ unsigned cvt_pk_bf16(float lo, float hi) { unsigned r; asm volatile("v_cvt_pk_bf16_f32 %0, %1, %2" : "=v"(r) : "v"(lo), "v"(hi)); return r; }

__device__ __forceinline__ float row_rs(const float* ssq, int row, int fq) {
    const f32x4 a = *(const f32x4*)(ssq + (size_t)row * 16 + 4 * fq);
    float s = (a[0] + a[1]) + (a[2] + a[3]); s += __shfl_xor(s, 16); s += __shfl_xor(s, 32);
    return __builtin_amdgcn_rsqf(s * (1.0f / 1024.0f) + 1e-6f);
}
struct EpiBf16 {
    static constexpr bool PERM = true, AFTER_DRAIN = false;
    bf16_t* O0; bf16_t* O1; int pm_split; int ldc; const float* ssq;
    __device__ __forceinline__ void operator()(f32x4 (&acc)[2][2][4][2], const Unit& u, int wr, int wc, int fr, int fq) const {
        bf16_t* O = (u.pm < pm_split) ? O0 : O1;
        const int row0 = u.pm * BM + wr * 64 + fr; const int col0 = u.pn * BM + wc * 32 + 8 * fq;
        float rsv[2][4];
#pragma unroll
        for (int ai = 0; ai < 2; ++ai)
#pragma unroll
            for (int m = 0; m < 4; ++m) rsv[ai][m] = ssq ? row_rs(ssq, row0 + ai * HALF + m * 16, fq) : 1.0f;
#pragma unroll
        for (int ai = 0; ai < 2; ++ai)
#pragma unroll
            for (int m = 0; m < 4; ++m) { const int row = row0 + ai * HALF + m * 16; bf16_t* rowp = O + (size_t)row * ldc + col0;
                const float rs = rsv[ai][m];
#pragma unroll
                for (int bj = 0; bj < 2; ++bj) { const f32x4 v0 = acc[ai][bj][m][0] * rs, v1 = acc[ai][bj][m][1] * rs;
                    u32x4 w; w.x = cvt_pk_bf16(v0[0], v0[1]); w.y = cvt_pk_bf16(v0[2], v0[3]); w.z = cvt_pk_bf16(v1[0], v1[1]); w.w = cvt_pk_bf16(v1[2], v1[3]);
                    *(u32x4*)(rowp + bj * HALF) = w; } }
    }
};

struct EpiResid {
    static constexpr bool PERM = true, AFTER_DRAIN = false;
    float* X0; float* X1; int pm_split; int ldc; bf16_t* XG; const float* gain; float* ssq;
    __device__ __forceinline__ void operator()(f32x4 (&acc)[2][2][4][2], const Unit& u, int wr, int wc, int fr, int fq) const {
        float* C = (u.pm < pm_split) ? X0 : X1;
        const int row0 = u.pm * BM + wr * 64 + fr, col0 = u.pn * BM + wc * 32 + 8 * fq;
        f32x4 gv[2][2];
#pragma unroll
        for (int bj = 0; bj < 2; ++bj)
#pragma unroll
            for (int n = 0; n < 2; ++n) gv[bj][n] = XG ? *(const f32x4*)(gain + col0 + bj * HALF + 4 * n) : (f32x4){0.f, 0.f, 0.f, 0.f};
#pragma unroll
        for (int ai = 0; ai < 2; ++ai)
#pragma unroll
            for (int mp = 0; mp < 2; ++mp) {
                f32x4 t[2][2][2];
#pragma unroll
                for (int mm = 0; mm < 2; ++mm) { const float* rowp = C + (size_t)(row0 + ai * HALF + (2 * mp + mm) * 16) * ldc + col0;
#pragma unroll
                    for (int bj = 0; bj < 2; ++bj)
#pragma unroll
                        for (int n = 0; n < 2; ++n) t[mm][bj][n] = *(const f32x4*)(rowp + bj * HALF + 4 * n); }
#pragma unroll
                for (int mm = 0; mm < 2; ++mm) { const int m = 2 * mp + mm; const int row = row0 + ai * HALF + m * 16; float* rowp = C + (size_t)row * ldc + col0; float sq = 0.f;
#pragma unroll
                    for (int bj = 0; bj < 2; ++bj) { f32x4 v[2];
#pragma unroll
                        for (int n = 0; n < 2; ++n) { v[n] = t[mm][bj][n] + acc[ai][bj][m][n]; *(f32x4*)(rowp + bj * HALF + 4 * n) = v[n];
                            sq += (v[n][0] * v[n][0] + v[n][1] * v[n][1]) + (v[n][2] * v[n][2] + v[n][3] * v[n][3]); }
                        if (XG) { const f32x4 y0 = v[0] * gv[bj][0], y1 = v[1] * gv[bj][1]; u32x4 w; w.x = cvt_pk_bf16(y0[0], y0[1]); w.y = cvt_pk_bf16(y0[2], y0[3]); w.z = cvt_pk_bf16(y1[0], y1[1]); w.w = cvt_pk_bf16(y1[2], y1[3]);
                            *(u32x4*)(XG + (size_t)row * ldc + col0 + bj * HALF) = w; } }
                    if (XG) { sq += __shfl_xor(sq, 16); sq += __shfl_xor(sq, 32); if (fq == 0) ssq[(size_t)row * 16 + u.pn * 4 + wc] = sq; } }
                asm volatile("" ::: "memory"); }
    }
};

template <class Epi, class Sched, bool APERM>
__device__ __forceinline__ void gemm_phase(PG8_LAS unsigned char* lds, const Gemm g, const Sched& S, const Epi& E) {
    int tid_ = threadIdx.x; asm volatile("" : "+v"(tid_));
    const int tid = tid_, wid = __builtin_amdgcn_readfirstlane(tid >> 6), lane = tid & 63, wr = wid >> 2, wc = wid & 3, fr = lane & 15, fq = lane >> 4;
    const int K = g.K, nt = K / BK;
    unsigned voffA[2], voffB[2];
#pragma unroll
    for (int i = 0; i < 2; ++i) { int R, C; stage_rc(tid * 16 + i * 8192, R, C); const int Rb = Epi::PERM ? ((R & ~31) + perm32(R & 31)) : R;
        const int Ra = APERM ? (128 * (R >> 6) + 8 * (R & 15) + ((R >> 4) & 3)) : R;
        voffA[i] = (unsigned)(Ra * K + C) * 2u; voffB[i] = (unsigned)(Rb * K + C) * 2u; }
    const size_t kstep = (size_t)(BK * 2);
    const size_t hstep = (size_t)HALF * K * 2;
    const size_t hstepA = APERM ? (size_t)4 * K * 2 : hstep;
    const size_t tstep = 2 * hstep;
    const unsigned ldsw = (unsigned)wid * 1024u;
    const int aoff = lds_byte(wr * 64 + fr, fq * 8), boff = lds_byte(wc * 32 + fr, fq * 8);
#define PG8_SA(b, h) (((b) * 2 + (h)) * HTB)
#define PG8_SB(b, h) ((4 + (b) * 2 + (h)) * HTB)
#define PG8_STAGE(bufoff, gbase, voff) do { _Pragma("unroll") for (int _i = 0; _i < 2; ++_i) \
        __builtin_amdgcn_global_load_lds((const unsigned*)((const char*)(gbase) + (voff)[_i]), (PG8_LAS unsigned*)(lds + (bufoff) + ldsw + _i * 8192), 16, 0, 0); } while (0)
#define PG8_LDA(dst, b, h) do { _Pragma("unroll") for (int m = 0; m < 4; ++m) _Pragma("unroll") for (int k = 0; k < 2; ++k) dst[m][k] = *(const PG8_LAS bf16x8*)(lds + PG8_SA(b, h) + aoff + m * 2048 + k * 1024); } while (0)
#define PG8_LDB(dst, b, h) do { _Pragma("unroll") for (int n = 0; n < 2; ++n) _Pragma("unroll") for (int k = 0; k < 2; ++k) dst[n][k] = *(const PG8_LAS bf16x8*)(lds + PG8_SB(b, h) + boff + n * 2048 + k * 1024); } while (0)
#define PG8_MMA(ai, bj, At, Bt) do { __builtin_amdgcn_s_setprio(1); _Pragma("unroll") for (int m = 0; m < 4; ++m) _Pragma("unroll") for (int n = 0; n < 2; ++n) _Pragma("unroll") for (int k = 0; k < 2; ++k) \
        acc[ai][bj][m][n] = __builtin_amdgcn_mfma_f32_16x16x32_bf16(Bt[n][k], At[m][k], acc[ai][bj][m][n], 0, 0, 0); __builtin_amdgcn_s_setprio(0); } while (0)
#define PG8_WAIT_V(n) asm volatile("s_waitcnt vmcnt(" #n ")" ::: "memory")
#define PG8_WAIT_L(n) asm volatile("s_waitcnt lgkmcnt(" #n ")" ::: "memory")
#define PG8_BAR __builtin_amdgcn_s_barrier()
#define PG8_SCHED __builtin_amdgcn_sched_barrier(0)
    Unit cur, nxt; int ui = 0;
    if (!S.next(0, cur)) return;
    f32x4 acc[2][2][4][2];
#pragma unroll
    for (int a = 0; a < 2; ++a)
#pragma unroll
        for (int b = 0; b < 2; ++b)
#pragma unroll
            for (int m = 0; m < 4; ++m)
#pragma unroll
                for (int n = 0; n < 2; ++n) acc[a][b][m][n] = (f32x4){0.f, 0.f, 0.f, 0.f};
    bf16x8 At[4][2], B0[2][2], B1[2][2];
    const char* cA = (const char*)g.A + (size_t)cur.pm * tstep; const char* cB = (const char*)g.Bt + (size_t)cur.pn * tstep;
    S.a_ready(cur);
    PG8_STAGE(PG8_SB(0, 0), cB, voffB); PG8_STAGE(PG8_SB(0, 1), cB + hstep, voffB); PG8_STAGE(PG8_SA(0, 0), cA, voffA); PG8_STAGE(PG8_SA(0, 1), cA + hstepA, voffA);
    if (wr == 1) PG8_BAR;
    PG8_WAIT_V(2); PG8_BAR;
    PG8_STAGE(PG8_SB(1, 0), cB + kstep, voffB); PG8_STAGE(PG8_SA(1, 0), cA + kstep, voffA); PG8_STAGE(PG8_SB(1, 1), cB + hstep + kstep, voffB);
    PG8_WAIT_V(6); PG8_BAR;
    for (;;) {
        const bool has_next = S.next(ui + 1, nxt);
        const char* nA = has_next ? (const char*)g.A + (size_t)nxt.pm * tstep : cA; const char* nB = has_next ? (const char*)g.Bt + (size_t)nxt.pn * tstep : cB;
        for (int t = 0; t < nt; t += 2) {
            const bool last = (t == nt - 2);
            const char* a1 = cA + (size_t)(t + 1) * kstep;
            const char* a2 = last ? nA : cA + (size_t)(t + 2) * kstep; const char* b2 = last ? nB : cB + (size_t)(t + 2) * kstep;
            const char* a3 = a2 + kstep; const char* b3 = b2 + kstep;
            if (last && has_next) S.a_ready(nxt);
            PG8_LDB(B0, 0, 0); PG8_LDB(B1, 0, 1); PG8_SCHED; PG8_LDA(At, 0, 0); PG8_STAGE(PG8_SA(1, 1), a1 + hstepA, voffA);
            PG8_WAIT_V(8); PG8_WAIT_L(0); PG8_BAR; PG8_MMA(0, 0, At, B0); PG8_MMA(0, 1, At, B1); PG8_BAR; PG8_SCHED;
            PG8_LDA(At, 0, 1); PG8_STAGE(PG8_SB(0, 0), b2, voffB); PG8_STAGE(PG8_SB(0, 1), b2 + hstep, voffB); PG8_STAGE(PG8_SA(0, 0), a2, voffA);
            PG8_WAIT_V(8); PG8_WAIT_L(0); PG8_BAR; PG8_MMA(1, 0, At, B0); PG8_MMA(1, 1, At, B1); PG8_BAR; PG8_SCHED;
            PG8_LDB(B0, 1, 0); PG8_LDB(B1, 1, 1); PG8_SCHED; PG8_LDA(At, 1, 0); PG8_STAGE(PG8_SA(0, 1), a2 + hstepA, voffA);
            PG8_WAIT_V(8); PG8_WAIT_L(0); PG8_BAR; PG8_MMA(0, 0, At, B0); PG8_MMA(0, 1, At, B1); PG8_BAR; PG8_SCHED;
            PG8_LDA(At, 1, 1); PG8_STAGE(PG8_SB(1, 0), b3, voffB); PG8_STAGE(PG8_SB(1, 1), b3 + hstep, voffB); PG8_STAGE(PG8_SA(1, 0), a3, voffA);
            PG8_WAIT_V(8); PG8_WAIT_L(0); PG8_BAR; PG8_MMA(1, 0, At, B0); PG8_MMA(1, 1, At, B1); PG8_BAR; PG8_SCHED;
        }
        if (wr == 0) PG8_BAR;
        E(acc, cur, wr, wc, fr, fq); S.done(cur);
        if (!has_next) break;
#pragma unroll
        for (int a = 0; a < 2; ++a)
#pragma unroll
            for (int b = 0; b < 2; ++b)
#pragma unroll
                for (int m = 0; m < 4; ++m)
#pragma unroll
                    for (int n = 0; n < 2; ++n) acc[a][b][m][n] = (f32x4){0.f, 0.f, 0.f, 0.f};
        cur = nxt; cA = nA; cB = nB; ++ui;
        if (wr == 1) PG8_BAR;
    }
    PG8_WAIT_V(0);
    PG8_BAR;
#undef PG8_SA
#undef PG8_SB
#undef PG8_STAGE
#undef PG8_LDA
#undef PG8_LDB
#undef PG8_MMA
#undef PG8_WAIT_V
#undef PG8_WAIT_L
#undef PG8_BAR
#undef PG8_SCHED
}
}
constexpr int DM = 1024;
constexpr int ROW_S = 16384;
constexpr int ROW_M = 17408;
constexpr int NREAL = 17424;
constexpr int MPAD = 17664;
constexpr int PM_META = 68;
constexpr int NAB = 4096, NCC = 4096, DFF = 2816, NFF = 5632, ABW = 4104;
constexpr int NGRP = 138, GRP_META = 136;
constexpr float EPS = 1e-6f;
constexpr float KSCALE = 0.08838834764831845f;

constexpr size_t O_YP = 0, O_YS = 16777216, O_CP = 17825792, O_CS = 18350080, O_NP = 26738688, O_NS = 26742784, O_MP = 26808320, O_MS = 26808352,
                 O_RP = 26808864, O_RS = 27333152, O_HP = 35721760, O_HS = 36770336, O_FP = 53547552, O_FS = 53637664, O_END = 55079456;

constexpr size_t MiB = 1u << 20;
constexpr size_t WS_CTL = 0, CTL_ZERO_BYTES = 1 * MiB;
constexpr size_t WS_WAB = 1 * MiB, WS_WOAB = 9 * MiB, WS_WC = 11 * MiB, WS_WOC = 19 * MiB, WS_WF1 = 21 * MiB  , WS_WF2 = 43 * MiB  ;
constexpr size_t WS_XN = 54 * MiB;
constexpr size_t WS_Z = 89 * MiB;
constexpr size_t WS_XM = 227 * MiB;
constexpr size_t WS_G = 228 * MiB;
constexpr size_t WS_SBL = 229 * MiB;
constexpr size_t WS_SBF = 233 * MiB;
constexpr size_t WS_ROT = 240 * MiB;
constexpr size_t WS_XG = 242 * MiB;
constexpr size_t WS_SSQ = 277 * MiB;
constexpr size_t WS_ZS = 279 * MiB;
constexpr size_t WS_ZS2 = 290 * MiB;
constexpr size_t WS_HS = 301 * MiB;
constexpr size_t WS_END = 309 * MiB;
static_assert(WS_XN + (size_t)MPAD * DM * 2 <= WS_Z && WS_Z + (size_t)MPAD * 4096 * 2 <= WS_XM && WS_SBL + (size_t)NGRP * 2 * DFF * 4 <= WS_SBF && WS_SBF + (size_t)NGRP * 4 * DFF * 4 <= WS_END, "ws map");

constexpr int LDS_BYTES = 147456;
constexpr int NWAVES = 8;

#define GAS __attribute__((address_space(1)))
#define LAS __attribute__((address_space(3)))
typedef unsigned short bf16;
typedef float f32x4 __attribute__((ext_vector_type(4)));
typedef unsigned u32x2 __attribute__((ext_vector_type(2)));
typedef unsigned u32x4 __attribute__((ext_vector_type(4)));
#define LDS_WAIT() asm volatile("s_waitcnt lgkmcnt(0)" ::: "memory")

__device__ __forceinline__ unsigned f2bf(float f) { unsigned u = __builtin_bit_cast(unsigned, f); return (u + 0x7fffu + ((u >> 16) & 1u)) >> 16; }
__device__ __forceinline__ unsigned pk2(float lo, float hi) { return f2bf(lo) | (f2bf(hi) << 16); }
__device__ __forceinline__ float bf2f(unsigned short b) { return __builtin_bit_cast(float, ((unsigned)b) << 16); }
__device__ __forceinline__ float bflo(unsigned w) { return __builtin_bit_cast(float, w << 16); }
__device__ __forceinline__ float bfhi(unsigned w) { return __builtin_bit_cast(float, w & 0xffff0000u); }
__device__ __forceinline__ f32x4 ld_bf4(const bf16* p) { const u32x2 w = *(const u32x2*)p; return (f32x4){bflo(w.x), bfhi(w.x), bflo(w.y), bfhi(w.y)}; }
__device__ __forceinline__ float wave_sum(float v) {
#pragma unroll
    for (int o = 1; o < 64; o <<= 1) v += __shfl_xor(v, o);
    return v;
}
__device__ __forceinline__ float half_sum(float v) {
#pragma unroll
    for (int o = 1; o < 32; o <<= 1) v += __shfl_xor(v, o);
    return v;
}
__device__ __forceinline__ float sigmoidf_(float x) { return 1.f / (1.f + __expf(-x)); }
__device__ __forceinline__ float siluf_(float x) { return x / (1.f + __expf(-x)); }
__device__ __forceinline__ float logsigmoidf_(float x) { return fminf(x, 0.f) - __logf(1.f + __expf(-fabsf(x))); }

struct Args { const float* in[26]; float* out; unsigned char* ws; int ph_lo, ph_hi; };

struct Frame {
    LAS unsigned char* lds;
    int tid, lane, wave, G, gw, NGW;
    const float* const* in; float* out; unsigned char* ws;
};
#define F_X0(F) ((F).out)
#define F_X1(F) ((float*)((F).ws + WS_XM) - (size_t)ROW_M * DM)
#define F_XN(F) ((bf16*)((F).ws + WS_XN))
#define F_XG(F) ((bf16*)((F).ws + WS_XG))
#define F_SSQ(F) ((float*)((F).ws + WS_SSQ))
#define F_Z(F) ((bf16*)((F).ws + WS_Z))
#define F_ZS1(F, layer) ((bf16*)((F).ws + ((layer) == 0 ? WS_ZS : WS_ZS2)) - (size_t)ROW_S * 4096)
#define F_HS1(F) ((bf16*)((F).ws + WS_HS) - (size_t)ROW_S * DFF)
#define ZROW(F, row, layer) (((row) < ROW_S ? F_Z(F) : F_ZS1(F, layer)) + (size_t)(row) * 4096)
#define F_GT(F) ((float*)((F).ws + WS_G))
#define F_SBL(F) ((float*)((F).ws + WS_SBL))
#define F_SBF(F) ((float*)((F).ws + WS_SBF))
__device__ __forceinline__ float* xrow(const Frame& F, int r) { return (r < ROW_M ? F_X0(F) : F_X1(F)) + (size_t)r * DM; }

__device__ __forceinline__ void p0_transpose_item(const float* W, int K, int Nsrc, int n0src, bf16* WT, int dstrow0, LAS float* scr, int kb, int lane) {
    const int k0 = 64 * kb;
#pragma unroll 8
    for (int i = 0; i < 32; ++i) { const int kk = 2 * i + (lane >> 5); scr[kk * 33 + (lane & 31)] = W[(size_t)(k0 + kk) * Nsrc + n0src + (lane & 31)]; }
    LDS_WAIT(); asm volatile("" ::: "memory");
    const int c = lane & 7;
#pragma unroll
    for (int j = 0; j < 4; ++j) { const int n = (lane >> 3) + 8 * j; const LAS float* s = scr + (8 * c) * 33 + n;
        u32x4 o; o.x = pk2(s[0 * 33], s[1 * 33]); o.y = pk2(s[2 * 33], s[3 * 33]); o.z = pk2(s[4 * 33], s[5 * 33]); o.w = pk2(s[6 * 33], s[7 * 33]);
        *(u32x4*)(WT + (size_t)(dstrow0 + n) * K + k0 + 8 * c) = o; }
    LDS_WAIT(); asm volatile("" ::: "memory");
}

__device__ __forceinline__ void p0_weights(Frame& F) {
    LAS float* scr = (LAS float*)(F.lds + F.wave * 16384);
    constexpr int I_AB = 16 * 128, I_O = 16 * 32, I_C = 16 * 128, I_F1 = 16 * 176, I_F2 = 44 * 32;
    constexpr int NIT = I_AB + I_O + I_C + I_O + 2 * I_F1 + 2 * I_F2;
    for (int it = F.gw; it < NIT; it += F.NGW) {
        int r = it;
        if (r < I_AB) { const int kb = r / 128, nb = r % 128; p0_transpose_item(F.in[10], 1024, ABW, nb < 64 ? 32 * nb : 32 * nb + 8, (bf16*)(F.ws + WS_WAB), 32 * nb, scr, kb, F.lane); continue; } r -= I_AB;
        if (r < I_O) { const int kb = r / 32, nb = r % 32; p0_transpose_item(F.in[15], 1024, 1024, 32 * nb, (bf16*)(F.ws + WS_WOAB), 32 * nb, scr, kb, F.lane); continue; } r -= I_O;
        if (r < I_C) { const int kb = r / 128, nb = r % 128; p0_transpose_item(F.in[17], 1024, 4096, 32 * nb, (bf16*)(F.ws + WS_WC), 32 * nb, scr, kb, F.lane); continue; } r -= I_C;
        if (r < I_O) { const int kb = r / 32, nb = r % 32; p0_transpose_item(F.in[19], 1024, 1024, 32 * nb, (bf16*)(F.ws + WS_WOC), 32 * nb, scr, kb, F.lane); continue; } r -= I_O;
        if (r < 2 * I_F1) { const int l = r / I_F1; r -= l * I_F1; const int kb = r / 176, nb = r % 176; const int c = 32 * nb;
            const int ch = c < DFF ? c : c - DFF; const int dst = 256 * (ch / 128) + (c < DFF ? 0 : 128) + (ch % 128);
            p0_transpose_item(F.in[21] + (size_t)l * 1024 * NFF, 1024, NFF, c, (bf16*)(F.ws + WS_WF1) + (size_t)l * NFF * 1024, dst, scr, kb, F.lane); continue; } r -= 2 * I_F1;
        { const int l = r / I_F2; r -= l * I_F2; const int kb = r / 32, nb = r % 32;
            p0_transpose_item(F.in[24] + (size_t)l * DFF * 1024, DFF, 1024, 32 * nb, (bf16*)(F.ws + WS_WF2) + (size_t)l * 1024 * DFF, 32 * nb, scr, kb, F.lane); }
    }
}

__device__ __forceinline__ void p0_rows(Frame& F) {
    LAS float* wg = (LAS float*)F.lds;
    for (int i = F.tid; i < 8192; i += NWAVES * 64) { const int k = i >> 3, c = i & 7; wg[c * 1024 + k] = F.in[10][(size_t)k * ABW + 2048 + c]; }
    __syncthreads();
    const float* gain = F.in[9];
    for (int r = F.gw; r < MPAD; r += F.NGW) {
        const float* src = nullptr;
        if (r < ROW_S) src = F.in[0] + (size_t)r * DM; else if (r < ROW_M) src = F.in[1] + (size_t)(r - ROW_S) * DM; else if (r < NREAL) src = F.in[8] + (size_t)(r - ROW_M) * DM;
        f32x4 v[4]; float ss = 0.f;
#pragma unroll
        for (int j = 0; j < 4; ++j) { v[j] = src ? *(const f32x4*)(src + 4 * F.lane + 256 * j) : (f32x4){0.f, 0.f, 0.f, 0.f}; ss += (v[j].x * v[j].x + v[j].y * v[j].y) + (v[j].z * v[j].z + v[j].w * v[j].w); }
        const float rs = rsqrtf(wave_sum(ss) * (1.f / DM) + EPS);
        float* xr = xrow(F, r); bf16* xn = F_XG(F) + (size_t)r * DM;
        float ga[8];
#pragma unroll
        for (int c = 0; c < 8; ++c) ga[c] = 0.f;
#pragma unroll
        for (int j = 0; j < 4; ++j) {
            *(f32x4*)(xr + 4 * F.lane + 256 * j) = v[j];
            const f32x4 gn = *(const f32x4*)(gain + 4 * F.lane + 256 * j);
            const f32x4 y = v[j] * rs * gn;
            u32x2 w; w.x = pk2(y.x, y.y); w.y = pk2(y.z, y.w);
            *(u32x2*)(xn + 4 * F.lane + 256 * j) = w;
#pragma unroll
            for (int c = 0; c < 8; ++c) { const f32x4 wv = *(const LAS f32x4*)(wg + c * 1024 + 4 * F.lane + 256 * j); ga[c] += (y.x * wv.x + y.y * wv.y) + (y.z * wv.z + y.w * wv.w); }
        }
#pragma unroll
        for (int c = 0; c < 8; ++c) ga[c] = wave_sum(ga[c]);
        if (F.lane == 0) { *(f32x4*)(F_GT(F) + (size_t)r * 8) = (f32x4){ga[0], ga[1], ga[2], ga[3]}; *(f32x4*)(F_GT(F) + (size_t)r * 8 + 4) = (f32x4){ga[4], ga[5], ga[6], ga[7]}; }
    }
}

__device__ __forceinline__ void rms_final(Frame& F, const float* gain) {
    for (int r = F.gw; r < ROW_M; r += F.NGW) {
        float* xr = F_X0(F) + (size_t)r * DM; f32x4 v[4]; float ss = 0.f;
#pragma unroll
        for (int j = 0; j < 4; ++j) { v[j] = *(const f32x4*)(xr + 4 * F.lane + 256 * j); ss += (v[j].x * v[j].x + v[j].y * v[j].y) + (v[j].z * v[j].z + v[j].w * v[j].w); }
        const float rs = rsqrtf(wave_sum(ss) * (1.f / DM) + EPS);
#pragma unroll
        for (int j = 0; j < 4; ++j) { const f32x4 gn = *(const f32x4*)(gain + 4 * F.lane + 256 * j); *(f32x4*)(xr + 4 * F.lane + 256 * j) = v[j] * rs * gn; }
    }
}

struct EpiFfn {
    static constexpr bool PERM = true, AFTER_DRAIN = false;
    bf16* H0; bf16* H1; const float* cw; const float* cb; const float* cst; float* cso; float* sbl; float* sbf; const float* ssq;
    __device__ __forceinline__ void operator()(f32x4 (&acc)[2][2][4][2], const pg8::Unit& u, int wr, int wc, int fr, int fq) const {
        bf16* H = (u.pm < 64) ? H0 : H1;
        const int ch0 = 128 * u.pn + 32 * wc + 8 * fq;
        const int tok0 = 256 * u.pm + 128 * wr + 8 * fr;
        const int grp = 2 * u.pm + wr;
        const bool samp = (u.pm >= 64 && u.pm < PM_META), meta = (u.pm == PM_META);
        const int sb = 32 * (u.pm - 64) + 16 * wr + fr;
        const bool defer = (!samp && !meta && fr == 0);
        const bool lastlane = meta ? (wr == 0 && fr == 1) : (!samp && fr == 15);
#pragma unroll
        for (int k = 0; k < 8; ++k) { const float rs = pg8::row_rs(ssq, tok0 + k, fq);
#pragma unroll
            for (int bj = 0; bj < 2; ++bj)
#pragma unroll
                for (int n = 0; n < 2; ++n) acc[k >> 2][bj][k & 3][n] = acc[k >> 2][bj][k & 3][n] * rs; }
#pragma unroll
        for (int n = 0; n < 2; ++n) {
            const int c4 = ch0 + 4 * n;
            const f32x4 w0 = *(const f32x4*)(cw + c4), w1 = *(const f32x4*)(cw + DFF + c4), w2 = *(const f32x4*)(cw + 2 * DFF + c4), bb = *(const f32x4*)(cb + c4);
            f32x4 p6, p7;
#pragma unroll
            for (int e = 0; e < 4; ++e) { p6[e] = __shfl_up(acc[1][0][2][n][e], 1, 16); p7[e] = __shfl_up(acc[1][0][3][n][e], 1, 16); }
            if (samp) { p6 = *(const f32x4*)(cst + (size_t)(sb * 2 + 0) * DFF + c4); p7 = *(const f32x4*)(cst + (size_t)(sb * 2 + 1) * DFF + c4); }
            if (meta && wr == 0 && fr == 0) { p6 = (f32x4){0.f, 0.f, 0.f, 0.f}; p7 = p6; }
#pragma unroll
            for (int k = 0; k < 8; ++k) {
                const f32x4 uk = acc[k >> 2][0][k & 3][n], gk = acc[k >> 2][1][k & 3][n];
                const f32x4 um1 = (k >= 1) ? acc[(k - 1 < 0 ? 0 : k - 1) >> 2][0][(k - 1 < 0 ? 0 : k - 1) & 3][n] : p7;
                const f32x4 um2 = (k >= 2) ? acc[(k - 2 < 0 ? 0 : k - 2) >> 2][0][(k - 2 < 0 ? 0 : k - 2) & 3][n] : (k == 1 ? p7 : p6);
                const f32x4 cv = bb + w0 * um2 + w1 * um1 + w2 * uk;
                f32x4 hv;
#pragma unroll
                for (int e = 0; e < 4; ++e) hv[e] = siluf_(cv[e]) * gk[e];
                if (defer && k < 2) {
                    *(f32x4*)(sbf + (size_t)((grp * 2 + k) * 2 + 0) * DFF + c4) = uk;
                    *(f32x4*)(sbf + (size_t)((grp * 2 + k) * 2 + 1) * DFF + c4) = gk;
                } else {
                    u32x2 w; w.x = pg8::cvt_pk_bf16(hv[0], hv[1]); w.y = pg8::cvt_pk_bf16(hv[2], hv[3]);
                    *(u32x2*)(H + (size_t)(tok0 + k) * DFF + c4) = w;
                }
            }
            if (lastlane) { *(f32x4*)(sbl + (size_t)(grp * 2 + 0) * DFF + c4) = acc[1][0][2][n]; *(f32x4*)(sbl + (size_t)(grp * 2 + 1) * DFF + c4) = acc[1][0][3][n]; }
            if (samp) { *(f32x4*)(cso + (size_t)(sb * 2 + 0) * DFF + c4) = acc[1][0][2][n]; *(f32x4*)(cso + (size_t)(sb * 2 + 1) * DFF + c4) = acc[1][0][3][n]; }
        }
    }
};

__device__ __forceinline__ void ffn_fixup(Frame& F, int layer) {
    const float* cw = F.in[22] + (size_t)layer * 3 * DFF; const float* cb = F.in[23] + (size_t)layer * DFF;
    bf16* H = F_Z(F);
    const int gt = blockIdx.x * (NWAVES * 64) + F.tid, NT = F.G * NWAVES * 64;
    for (int i = gt; i < 128 * DFF; i += NT) {
        const int grp = i / DFF, ch = i - grp * DFF;
        const int r0 = 128 * grp;
        const int pg = (r0 % 2048 == 0) ? GRP_META : grp - 1;
        const float um2 = F_SBL(F)[(size_t)(pg * 2 + 0) * DFF + ch], um1 = F_SBL(F)[(size_t)(pg * 2 + 1) * DFF + ch];
        const float u0 = F_SBF(F)[(size_t)((grp * 2 + 0) * 2 + 0) * DFF + ch], g0 = F_SBF(F)[(size_t)((grp * 2 + 0) * 2 + 1) * DFF + ch];
        const float u1 = F_SBF(F)[(size_t)((grp * 2 + 1) * 2 + 0) * DFF + ch], g1 = F_SBF(F)[(size_t)((grp * 2 + 1) * 2 + 1) * DFF + ch];
        const float w0 = cw[ch], w1 = cw[DFF + ch], w2 = cw[2 * DFF + ch], bb = cb[ch];
        const float c0 = bb + w0 * um2 + w1 * um1 + w2 * u0, c1 = bb + w0 * um1 + w1 * u0 + w2 * u1;
        H[(size_t)r0 * DFF + ch] = (bf16)f2bf(siluf_(c0) * g0);
        H[(size_t)(r0 + 1) * DFF + ch] = (bf16)f2bf(siluf_(c1) * g1);
    }
    float* fo = F.out + O_FP + (size_t)layer * 8 * 2 * DFF;
    for (int i = gt; i < 8 * 2 * DFF; i += NT) {
        const int b = i / (2 * DFF), rem = i - b * 2 * DFF, j = rem / DFF, ch = rem - j * DFF;
        const int grp = 2 * (8 * b + 7) + 1;
        fo[i] = F_SBL(F)[(size_t)(grp * 2 + j) * DFF + ch];
    }
}
typedef short bf16x8 __attribute__((ext_vector_type(8)));
typedef short v4i16_t __attribute__((ext_vector_type(4)));
constexpr int MX_PITCH = 272;
constexpr int MX_Q = 0, MX_K = 17408, MX_KH = 34816, MX_V = 52224, MX_GD = 69632  , MX_SC = 71680  , MX_OB = 74752  , MX_RP = 108544  , MX_DI = 110592  , MX_GN = 110848  , MX_LB = 111360  , MX_END = 111872;
constexpr int MX_OP = 132;
constexpr float LNKS = -2.4260151319598084f;
static_assert(MX_END <= 139264, "mixer LDS map");

__device__ __forceinline__ bf16x8 mk8(unsigned a, unsigned b, unsigned c, unsigned d) { const u32x4 v = {a, b, c, d}; return __builtin_bit_cast(bf16x8, v); }
__device__ __forceinline__ u32x2 tr16(const LAS unsigned char* p) { return __builtin_bit_cast(u32x2, __builtin_amdgcn_ds_read_tr16_b64_v4i16((LAS v4i16_t*)p)); }
typedef float f32x2_t __attribute__((ext_vector_type(2))); typedef __bf16 bf16x2_t __attribute__((ext_vector_type(2)));
__device__ __forceinline__ unsigned pkbf(float lo, float hi) { const f32x2_t v = {lo, hi}; const bf16x2_t b = __builtin_convertvector(v, bf16x2_t); return __builtin_bit_cast(unsigned, b); }
#define MFMA16(a, b, c) __builtin_amdgcn_mfma_f32_16x16x32_bf16((a), (b), (c), 0, 0, 0)
template <int CTRL> __device__ __forceinline__ float dppf(float ident, float x) { return __builtin_bit_cast(float, __builtin_amdgcn_update_dpp(__builtin_bit_cast(int, ident), __builtin_bit_cast(int, x), CTRL, 0xf, 0xf, false)); }
__device__ __forceinline__ float row_prefix_sum(float x) { x += dppf<0x111>(0.f, x); x += dppf<0x112>(0.f, x); x += dppf<0x114>(0.f, x); x += dppf<0x118>(0.f, x); return x; }
__device__ __forceinline__ float row_prefix_max(float x) { x = fmaxf(x, dppf<0x111>(-3e38f, x)); x = fmaxf(x, dppf<0x112>(-3e38f, x)); x = fmaxf(x, dppf<0x114>(-3e38f, x)); x = fmaxf(x, dppf<0x118>(-3e38f, x)); return x; }
__device__ __forceinline__ float row_prefix_prod(float x) { x *= dppf<0x111>(1.f, x); x *= dppf<0x112>(1.f, x); x *= dppf<0x114>(1.f, x); x *= dppf<0x118>(1.f, x); return x; }
__device__ __forceinline__ float row_suffix_prod(float x) { x *= dppf<0x101>(1.f, x); x *= dppf<0x102>(1.f, x); x *= dppf<0x104>(1.f, x); x *= dppf<0x108>(1.f, x); return x; }
__device__ __forceinline__ float rdlane(float x, int l) { return __builtin_bit_cast(float, __builtin_amdgcn_readlane(__builtin_bit_cast(int, x), l)); }

constexpr int ROT_N = 2072;
__device__ __forceinline__ void p0_rotary(Frame& F, float* tab) {
    const int gt = blockIdx.x * (NWAVES * 64) + F.tid, NT = F.G * NWAVES * 64;
    for (int i = gt; i < ROT_N * 64; i += NT) {
        const int pi = i >> 6, fi = i & 63;
        const float pos = pi < 2064 ? (float)pi : (float)(16384 + pi - 2064);
        const float inv = exp2f((float)fi * (-13.287712379549449f / 63.0f));
        float sn, cs; sincosf(pos * inv, &sn, &cs);
        tab[2 * i] = cs; tab[2 * i + 1] = sn;
    }
}

#ifdef PROBE_BLOCK
#define MSTAMP_DECL unsigned long long t_last_ = __builtin_amdgcn_s_memrealtime();
#define MSTAMP(id) do { if (blockIdx.x == PROBE_BLOCK && tid == 0) { const unsigned long long t_now_ = __builtin_amdgcn_s_memrealtime(); volatile LAS unsigned long long* a_ = (volatile LAS unsigned long long*)(F.lds + 139264 + 128) + 48 + (id); *a_ = *a_ + (t_now_ - t_last_); t_last_ = t_now_; } } while (0)
#else
#define MSTAMP_DECL
#define MSTAMP(id) do { } while (0)
#endif
#define MX_SC_PARAMS(scv, row0, ntok, nmc, pos0) do { if (mode != 1) { if ((scv) == 0) { row0 = ROW_M; ntok = 16; nmc = 1; pos0 = 0; } else { row0 = b * 2048 + ((scv) - 1) * 64; ntok = 64; nmc = 4; pos0 = 16 + ((scv) - 1) * 64; } } \
        else { row0 = ROW_S + 8 * b; ntok = 8; nmc = 1; pos0 = 2064; } } while (0)

template <int TYPE, int NMC>
__device__ __forceinline__ void sg_chain(LAS unsigned char* L, LAS float* SC, f32x4 (&S)[8], f32x4& nacc, int w, int r16, int q) {
    LAS float* OB = (LAS float*)(L + MX_OB); LAS float* RP = (LAS float*)(L + MX_RP); LAS float* DI = (LAS float*)(L + MX_DI);
    f32x4 oo[4];
#pragma unroll
    for (int mc = 0; mc < NMC; ++mc) {
        oo[mc] = (f32x4){0.f, 0.f, 0.f, 0.f};
        {
            const LAS unsigned char* Qb = L + MX_Q + 16 * mc * MX_PITCH; const LAS unsigned char* Kb = L + MX_K + 16 * mc * MX_PITCH; const LAS unsigned char* Vb = L + MX_V + 16 * mc * MX_PITCH;
            f32x4 g0 = {0.f, 0.f, 0.f, 0.f}, g1 = {0.f, 0.f, 0.f, 0.f};
#pragma unroll
            for (int ks = 0; ks < 4; ++ks) {
                const u32x2 ka = *(const LAS u32x2*)(Kb + r16 * MX_PITCH + (32 * ks + 4 * q) * 2), kb = *(const LAS u32x2*)(Kb + r16 * MX_PITCH + (32 * ks + 16 + 4 * q) * 2);
                const u32x2 qa = *(const LAS u32x2*)(Qb + r16 * MX_PITCH + (32 * ks + 4 * q) * 2), qb = *(const LAS u32x2*)(Qb + r16 * MX_PITCH + (32 * ks + 16 + 4 * q) * 2);
                if (ks & 1) g1 = MFMA16(mk8(ka.x, ka.y, kb.x, kb.y), mk8(qa.x, qa.y, qb.x, qb.y), g1); else g0 = MFMA16(mk8(ka.x, ka.y, kb.x, kb.y), mk8(qa.x, qa.y, qb.x, qb.y), g0);
            }
            const f32x4 g = g0 + g1;
            const float xi = SC[mc * 16 + r16]; const f32x4 y4 = *(const LAS f32x4*)(SC + 64 + mc * 16 + 4 * q);
            f32x4 P;
#pragma unroll
            for (int r = 0; r < 4; ++r) P[r] = (4 * q + r <= r16) ? g[r] * __expf(xi + y4[r]) : 0.f;
            if (TYPE == 0) { float ps = (P[0] + P[1]) + (P[2] + P[3]); ps += __shfl_xor(ps, 16); ps += __shfl_xor(ps, 32); if (w == 0 && q == 0) DI[16 * mc + r16] = ps; }
            const u32x2 vt = tr16(Vb + (4 * q + (r16 >> 2)) * MX_PITCH + (16 * w + 4 * (r16 & 3)) * 2);
            oo[mc] = MFMA16(mk8(pkbf(P[0], P[1]), pkbf(P[2], P[3]), 0u, 0u), mk8(vt.x, vt.y, 0u, 0u), oo[mc]);
        }
        if (mc == 1 || TYPE == 1) __builtin_amdgcn_sched_barrier(0);
    }
#pragma unroll
    for (int mc = 0; mc < NMC; ++mc) {
        {
            const LAS unsigned char* Qb = L + MX_Q + 16 * mc * MX_PITCH; const LAS unsigned char* Kb = L + MX_K + 16 * mc * MX_PITCH;
            const u32x2 vt = tr16(L + MX_V + 16 * mc * MX_PITCH + (4 * q + (r16 >> 2)) * MX_PITCH + (16 * w + 4 * (r16 & 3)) * 2);
            f32x4 o2a = {0.f, 0.f, 0.f, 0.f}, o2b = {0.f, 0.f, 0.f, 0.f};
#pragma unroll
            for (int ks = 0; ks < 4; ++ks) {
                const u32x2 qa = *(const LAS u32x2*)(Qb + r16 * MX_PITCH + (32 * ks + 4 * q) * 2), qb = *(const LAS u32x2*)(Qb + r16 * MX_PITCH + (32 * ks + 16 + 4 * q) * 2);
                const bf16x8 SB = mk8(pkbf(S[2 * ks][0], S[2 * ks][1]), pkbf(S[2 * ks][2], S[2 * ks][3]), pkbf(S[2 * ks + 1][0], S[2 * ks + 1][1]), pkbf(S[2 * ks + 1][2], S[2 * ks + 1][3]));
                if (ks & 1) o2b = MFMA16(mk8(qa.x, qa.y, qb.x, qb.y), SB, o2b); else o2a = MFMA16(mk8(qa.x, qa.y, qb.x, qb.y), SB, o2a);
            }
            const f32x4 in4 = *(const LAS f32x4*)(SC + 128 + mc * 16 + 4 * q);
            oo[mc] = oo[mc] + in4 * (o2a + o2b);
            const f32x4 w4 = *(const LAS f32x4*)(SC + 192 + mc * 16 + 4 * q); const float carry = SC[320 + mc];
            if (TYPE == 0) {
                const u32x2 qn = *(const LAS u32x2*)(Qb + r16 * MX_PITCH + (16 * w + 4 * q) * 2);
                f32x4 rr = {0.f, 0.f, 0.f, 0.f}; rr = MFMA16(mk8(qn.x, qn.y, 0u, 0u), mk8(pkbf(nacc[0], nacc[1]), pkbf(nacc[2], nacc[3]), 0u, 0u), rr);
                if (r16 == 0) {
#pragma unroll
                    for (int r = 0; r < 4; ++r) RP[w * 64 + 16 * mc + 4 * q + r] = rr[r]; }
            }
#pragma unroll
            for (int r = 0; r < 4; ++r) OB[(16 * mc + 4 * q + r) * MX_OP + 16 * w + r16] = oo[mc][r];
            const bf16x8 VH = mk8(pkbf(bflo(vt.x) * w4[0], bfhi(vt.x) * w4[1]), pkbf(bflo(vt.y) * w4[2], bfhi(vt.y) * w4[3]), 0u, 0u);
#pragma unroll
            for (int mt = 0; mt < 8; ++mt) {
                const u32x2 kt = tr16(Kb + (4 * q + (r16 >> 2)) * MX_PITCH + (16 * mt + 4 * (r16 & 3)) * 2);
                S[mt] = S[mt] * carry; S[mt] = MFMA16(mk8(kt.x, kt.y, 0u, 0u), VH, S[mt]);
            }
            if (TYPE == 0) {
                const u32x2 kt = tr16(Kb + (4 * q + (r16 >> 2)) * MX_PITCH + (16 * w + 4 * (r16 & 3)) * 2);
                nacc = nacc * carry; nacc = MFMA16(mk8(kt.x, kt.y, 0u, 0u), mk8(pkbf(w4[0], w4[1]), pkbf(w4[2], w4[3]), 0u, 0u), nacc);
            }
        }
        if (mc + 1 < NMC) __builtin_amdgcn_sched_barrier(0);
    }
}

template <int TYPE>
__device__ __forceinline__ void mix_sg_unit(Frame& F, int b, int h, int mode  , const float* rot) {
    const bool prompt = (mode != 1);
    const int tid = F.tid, lane = F.lane, w = F.wave, r16 = lane & 15, q = lane >> 4;
    const int tk = tid >> 3, p = tid & 7;
    LAS unsigned char* L = F.lds;
    LAS float* OB = (LAS float*)(L + MX_OB); LAS float* RP = (LAS float*)(L + MX_RP); LAS float* DI = (LAS float*)(L + MX_DI);
    bf16* MIX = F_XN(F);
    const int qcol = (TYPE == 0 ? 0 : 2048) + 128 * h, kcol = (TYPE == 0 ? 512 : 2560) + 128 * h, vcol = (TYPE == 0 ? 1024 : 3072) + 128 * h, gcol = (TYPE == 0 ? 1536 : 3584) + 128 * h, mcol = (TYPE == 0 ? 0 : 512) + 128 * h;
    f32x4 S[8]; f32x4 nacc = {0.f, 0.f, 0.f, 0.f}; float m0 = 0.f;
#pragma unroll
    for (int mt = 0; mt < 8; ++mt) S[mt] = (f32x4){0.f, 0.f, 0.f, 0.f};
    if (!prompt) {
        const float* Sin = (TYPE == 0 ? F.in[2] : F.in[5]) + (size_t)(b * 4 + h) * 16384;
#pragma unroll
        for (int mt = 0; mt < 8; ++mt)
#pragma unroll
            for (int r = 0; r < 4; ++r) S[mt][r] = Sin[(16 * mt + 4 * q + r) * 128 + 16 * w + r16];
        if (TYPE == 0) {
#pragma unroll
            for (int r = 0; r < 4; ++r) nacc[r] = F.in[3][(size_t)(b * 4 + h) * 128 + 16 * w + 4 * q + r];
            m0 = F.in[4][b * 4 + h];
        }
    }
    const float lgam = (TYPE != 1) ? 0.f : h == 0 ? -0.031748698314580298f : h == 1 ? -0.015748356968139168f : h == 2 ? -0.0078431774610258928f : -0.0039138993211363287f;
    const float bias_i = (TYPE == 0) ? F.in[11][h] : 0.f, bias_f = (TYPE == 0) ? F.in[12][h] : 0.f;
    LAS float* GN = (LAS float*)(L + MX_GN);
    if (tid < 128) GN[tid] = (TYPE == 0 ? F.in[13] : F.in[14])[128 * h + tid];
    const int nsc = (mode == 0) ? 33 : 1;
    u32x4 pa[6]; f32x4 pr[4]; float pli = 0.f, plf = 0.f; u32x4 pg[2];
    const u32x4 z4 = {0u, 0u, 0u, 0u};
#define SG_LOAD(scv) do { int row0_, ntok_, nmc_, pos0_; MX_SC_PARAMS(scv, row0_, ntok_, nmc_, pos0_); (void)nmc_; \
        const bool valid_ = tk < ntok_; const bf16* zr_ = ZROW(F, row0_ + (valid_ ? tk : 0), 0); \
        _Pragma("unroll") for (int i_ = 0; i_ < 6; ++i_) pa[i_] = z4; \
        if (valid_) { pa[4] = *(const u32x4*)(zr_ + vcol + 16 * p); pa[5] = *(const u32x4*)(zr_ + vcol + 16 * p + 8); \
            if (TYPE == 0) { pa[0] = *(const u32x4*)(zr_ + qcol + 16 * p); pa[1] = *(const u32x4*)(zr_ + qcol + 16 * p + 8); pa[2] = *(const u32x4*)(zr_ + kcol + 16 * p); pa[3] = *(const u32x4*)(zr_ + kcol + 16 * p + 8); } \
            else { pa[0] = *(const u32x4*)(zr_ + qcol + 8 * p); pa[1] = *(const u32x4*)(zr_ + qcol + 64 + 8 * p); pa[2] = *(const u32x4*)(zr_ + kcol + 8 * p); pa[3] = *(const u32x4*)(zr_ + kcol + 64 + 8 * p); } } \
        if (TYPE == 1) { const float* tb_ = rot + ((size_t)(pos0_ + (valid_ ? tk : 0)) * 64 + 8 * p) * 2; _Pragma("unroll") for (int e_ = 0; e_ < 4; ++e_) pr[e_] = *(const f32x4*)(tb_ + 4 * e_); } \
        if (TYPE == 0 && w == 0) { const bool vt_ = lane < ntok_; const float* gp_ = F_GT(F) + (size_t)(row0_ + (vt_ ? lane : 0)) * 8; pli = gp_[h]; plf = gp_[4 + h]; } } while (0)
    SG_LOAD(0);
    MSTAMP_DECL
#pragma unroll 1
    for (int sc = 0; sc < nsc; ++sc) {
        int row0, ntok, nmc, pos0; MX_SC_PARAMS(sc, row0, ntok, nmc, pos0); (void)pos0;
        LAS float* SC = (LAS float*)(L + MX_SC) + (sc & 1) * 384;
        MSTAMP(0);
        {
            *(LAS u32x4*)(L + MX_V + tk * MX_PITCH + 32 * p) = pa[4]; *(LAS u32x4*)(L + MX_V + tk * MX_PITCH + 32 * p + 16) = pa[5];
            if (TYPE == 0) {
                *(LAS u32x4*)(L + MX_Q + tk * MX_PITCH + 32 * p) = pa[0]; *(LAS u32x4*)(L + MX_Q + tk * MX_PITCH + 32 * p + 16) = pa[1];
                *(LAS u32x4*)(L + MX_K + tk * MX_PITCH + 32 * p) = pa[2]; *(LAS u32x4*)(L + MX_K + tk * MX_PITCH + 32 * p + 16) = pa[3];
            } else {
                u32x4 q1, q2, k1, k2;
#pragma unroll
                for (int e2 = 0; e2 < 4; ++e2) {
                    const f32x4 cs = pr[e2];
                    { const float x1l = bflo(pa[0][e2]), x1h = bfhi(pa[0][e2]), x2l = bflo(pa[1][e2]), x2h = bfhi(pa[1][e2]);
                      q1[e2] = pkbf(x1l * cs[0] - x2l * cs[1], x1h * cs[2] - x2h * cs[3]); q2[e2] = pkbf(x2l * cs[0] + x1l * cs[1], x2h * cs[2] + x1h * cs[3]); }
                    { const float x1l = bflo(pa[2][e2]), x1h = bfhi(pa[2][e2]), x2l = bflo(pa[3][e2]), x2h = bfhi(pa[3][e2]);
                      k1[e2] = pkbf(x1l * cs[0] - x2l * cs[1], x1h * cs[2] - x2h * cs[3]); k2[e2] = pkbf(x2l * cs[0] + x1l * cs[1], x2h * cs[2] + x1h * cs[3]); }
                }
                *(LAS u32x4*)(L + MX_Q + tk * MX_PITCH + 16 * p) = q1; *(LAS u32x4*)(L + MX_Q + tk * MX_PITCH + 128 + 16 * p) = q2;
                *(LAS u32x4*)(L + MX_K + tk * MX_PITCH + 16 * p) = k1; *(LAS u32x4*)(L + MX_K + tk * MX_PITCH + 128 + 16 * p) = k2;
            }
        }
        if (w == 0) {
            const bool valid = lane < ntok;
            float li = -1e30f, lf = 0.f;
            if (TYPE == 0) { if (valid) { li = pli + bias_i; lf = logsigmoidf_(plf + bias_f); } } else { if (valid) { li = 0.f; lf = lgam; } }
            const float bb = row_prefix_sum(lf);
            const float y = li - bb;
            const float am = row_prefix_max(y);
            const float a = bb + am;
            const float B0 = rdlane(bb, 15), B1 = rdlane(bb, 31), B2 = rdlane(bb, 47), B3 = rdlane(bb, 63);
            float M1 = 0.f, M2 = 0.f, M3 = 0.f, M4 = 0.f;
            if (TYPE == 0) { const float A0 = rdlane(a, 15), A1 = rdlane(a, 31), A2 = rdlane(a, 47), A3 = rdlane(a, 63);
                M1 = fmaxf(B0 + m0, A0); M2 = fmaxf(B1 + M1, A1); M3 = fmaxf(B2 + M2, A2); M4 = fmaxf(B3 + M3, A3); }
            const float m0q = q == 0 ? m0 : q == 1 ? M1 : q == 2 ? M2 : M3;
            const float mnq = q == 0 ? M1 : q == 1 ? M2 : q == 2 ? M3 : M4;
            const float b15 = q == 0 ? B0 : q == 1 ? B1 : q == 2 ? B2 : B3;
            const float m = (TYPE == 0) ? fmaxf(bb + m0q, a) : 0.f;
            SC[lane] = bb - m; SC[64 + lane] = y + LNKS; SC[128 + lane] = __expf(bb + m0q - m);
            SC[192 + lane] = __expf(y + LNKS + b15 - mnq); SC[256 + lane] = __expf(-m);
            if (r16 == 0) SC[320 + q] = __expf(b15 + m0q - mnq);
            m0 = (nmc == 4) ? M4 : M1;
        }
        MSTAMP(1);
        __syncthreads();
        MSTAMP(2);
        if (sc + 1 < nsc) SG_LOAD(sc + 1);
        { const bool valid = tk < ntok; const bf16* zr = ZROW(F, row0 + (valid ? tk : 0), 0) + gcol + 16 * p; pg[0] = *(const u32x4*)zr; pg[1] = *(const u32x4*)(zr + 8); }
        MSTAMP(8);
        if (nmc == 4) sg_chain<TYPE, 4>(L, SC, S, nacc, w, r16, q); else sg_chain<TYPE, 1>(L, SC, S, nacc, w, r16, q);
        MSTAMP(4);
        MSTAMP(5);
        __syncthreads();
        MSTAMP(6);
        {
            const bool valid = tk < ntok; const int row = row0 + (valid ? tk : 0);
            f32x4 o[4];
#pragma unroll
            for (int c = 0; c < 4; ++c) o[c] = *(const LAS f32x4*)(OB + tk * MX_OP + 16 * p + 4 * c);
            if (tk >= 16 * nmc) {
#pragma unroll
                for (int c = 0; c < 4; ++c) o[c] = (f32x4){0.f, 0.f, 0.f, 0.f}; }
            if (TYPE == 0) {
                float rs = 0.f;
#pragma unroll
                for (int ww = 0; ww < 8; ++ww) rs += RP[ww * 64 + tk];
                const float den = DI[tk] + SC[128 + tk] * rs;
                float dn = fmaxf(fabsf(den), SC[256 + tk]); if (tk >= 16 * nmc) dn = 1.f;
                const float rd = 1.f / dn;
#pragma unroll
                for (int c = 0; c < 4; ++c) o[c] = o[c] * rd;
            }
            float sm = 0.f;
#pragma unroll
            for (int c = 0; c < 4; ++c) sm += (o[c].x + o[c].y) + (o[c].z + o[c].w);
            sm += __shfl_xor(sm, 1); sm += __shfl_xor(sm, 2); sm += __shfl_xor(sm, 4);
            const float mu = sm * (1.f / 128.f); float vs = 0.f;
#pragma unroll
            for (int c = 0; c < 4; ++c) { o[c] = o[c] - mu; vs += (o[c].x * o[c].x + o[c].y * o[c].y) + (o[c].z * o[c].z + o[c].w * o[c].w); }
            vs += __shfl_xor(vs, 1); vs += __shfl_xor(vs, 2); vs += __shfl_xor(vs, 4);
            const float rstd = rsqrtf(vs * (1.f / 128.f) + EPS);
            if (valid && !(mode == 0 && sc == 0)) {
                unsigned ow[8];
#pragma unroll
                for (int c = 0; c < 4; ++c) {
                    const unsigned ga = c < 2 ? pg[0][2 * c] : pg[1][2 * c - 4], gb = c < 2 ? pg[0][2 * c + 1] : pg[1][2 * c - 3];
                    f32x4 gt = {bflo(ga), bfhi(ga), bflo(gb), bfhi(gb)};
#pragma unroll
                    for (int e = 0; e < 4; ++e) gt[e] = (TYPE == 0) ? sigmoidf_(gt[e]) : siluf_(gt[e]);
                    const f32x4 r = o[c] * rstd * *(const LAS f32x4*)(GN + 16 * p + 4 * c) * gt;
                    ow[2 * c] = pkbf(r.x, r.y); ow[2 * c + 1] = pkbf(r.z, r.w);
                }
                bf16* mp = MIX + (size_t)row * DM + mcol + 16 * p;
                *(u32x4*)mp = (u32x4){ow[0], ow[1], ow[2], ow[3]}; *(u32x4*)(mp + 8) = (u32x4){ow[4], ow[5], ow[6], ow[7]};
            }
        }
        MSTAMP(7);
    }
#undef SG_LOAD
    __syncthreads();
    if (mode != 2) {
        int l2 = F.lane; asm volatile("" : "+v"(l2)); const int r16 = l2 & 15, q = l2 >> 4;
        float* So = F.out + (TYPE == 0 ? (prompt ? O_CP : O_CS) : (prompt ? O_RP : O_RS)) + (size_t)(b * 4 + h) * 16384;
#pragma unroll
        for (int mt = 0; mt < 8; ++mt)
#pragma unroll
            for (int r = 0; r < 4; ++r) So[(16 * mt + 4 * q + r) * 128 + 16 * w + r16] = S[mt][r];
        if (TYPE == 0) {
            if (r16 == 0) { float* No = F.out + (prompt ? O_NP : O_NS) + (size_t)(b * 4 + h) * 128;
#pragma unroll
                for (int r = 0; r < 4; ++r) No[16 * w + 4 * q + r] = nacc[r]; }
            if (w == 0 && lane == 0) F.out[(prompt ? O_MP : O_MS) + b * 4 + h] = m0;
        }
    }
}

template <int NMC>
__device__ __forceinline__ void hg_chain(LAS unsigned char* L, f32x4 (&S)[8], int w, int r16, int q) {
    LAS float* GD = (LAS float*)(L + MX_GD); LAS float* OB = (LAS float*)(L + MX_OB);
    f32x4 oo[4];
#pragma unroll
    for (int mc = 0; mc < NMC; ++mc) {
        oo[mc] = (f32x4){0.f, 0.f, 0.f, 0.f};
        {
            const LAS unsigned char* Qb = L + MX_Q + 16 * mc * MX_PITCH; const LAS unsigned char* Kb = L + MX_K + 16 * mc * MX_PITCH; const LAS unsigned char* Vb = L + MX_V + 16 * mc * MX_PITCH;
            f32x4 g0 = {0.f, 0.f, 0.f, 0.f}, g1 = {0.f, 0.f, 0.f, 0.f};
#pragma unroll
            for (int ks = 0; ks < 4; ++ks) {
                const u32x2 ka = *(const LAS u32x2*)(Kb + r16 * MX_PITCH + (32 * ks + 4 * q) * 2), kb = *(const LAS u32x2*)(Kb + r16 * MX_PITCH + (32 * ks + 16 + 4 * q) * 2);
                const u32x2 qa = *(const LAS u32x2*)(Qb + r16 * MX_PITCH + (32 * ks + 4 * q) * 2), qb = *(const LAS u32x2*)(Qb + r16 * MX_PITCH + (32 * ks + 16 + 4 * q) * 2);
                if (ks & 1) g1 = MFMA16(mk8(ka.x, ka.y, kb.x, kb.y), mk8(qa.x, qa.y, qb.x, qb.y), g1); else g0 = MFMA16(mk8(ka.x, ka.y, kb.x, kb.y), mk8(qa.x, qa.y, qb.x, qb.y), g0);
            }
            const f32x4 g = g0 + g1;
            f32x4 P;
#pragma unroll
            for (int r = 0; r < 4; ++r) P[r] = (4 * q + r <= r16) ? g[r] : 0.f;
            const u32x2 vt = tr16(Vb + (4 * q + (r16 >> 2)) * MX_PITCH + (16 * w + 4 * (r16 & 3)) * 2);
            oo[mc] = MFMA16(mk8(pkbf(P[0], P[1]), pkbf(P[2], P[3]), 0u, 0u), mk8(vt.x, vt.y, 0u, 0u), oo[mc]);
        }
        if (mc == 1) __builtin_amdgcn_sched_barrier(0);
    }
#pragma unroll
    for (int mc = 0; mc < NMC; ++mc) {
        {
            const LAS unsigned char* Qb = L + MX_Q + 16 * mc * MX_PITCH; const LAS unsigned char* Hb = L + MX_KH + 16 * mc * MX_PITCH;
            const u32x2 vt = tr16(L + MX_V + 16 * mc * MX_PITCH + (4 * q + (r16 >> 2)) * MX_PITCH + (16 * w + 4 * (r16 & 3)) * 2);
            f32x4 o2b = {0.f, 0.f, 0.f, 0.f};
#pragma unroll
            for (int ks = 0; ks < 4; ++ks) {
                const u32x2 qa = *(const LAS u32x2*)(Qb + r16 * MX_PITCH + (32 * ks + 4 * q) * 2), qb = *(const LAS u32x2*)(Qb + r16 * MX_PITCH + (32 * ks + 16 + 4 * q) * 2);
                const bf16x8 SB = mk8(pkbf(S[2 * ks][0], S[2 * ks][1]), pkbf(S[2 * ks][2], S[2 * ks][3]), pkbf(S[2 * ks + 1][0], S[2 * ks + 1][1]), pkbf(S[2 * ks + 1][2], S[2 * ks + 1][3]));
                if (ks & 1) o2b = MFMA16(mk8(qa.x, qa.y, qb.x, qb.y), SB, o2b); else oo[mc] = MFMA16(mk8(qa.x, qa.y, qb.x, qb.y), SB, oo[mc]);
            }
            oo[mc] = oo[mc] + o2b;
            const bf16x8 VB = mk8(vt.x, vt.y, 0u, 0u);
#pragma unroll
            for (int mt = 0; mt < 8; ++mt) {
                const f32x4 gd = *(const LAS f32x4*)(GD + mc * 128 + 16 * mt + 4 * q);
                const u32x2 kt = tr16(Hb + (4 * q + (r16 >> 2)) * MX_PITCH + (16 * mt + 4 * (r16 & 3)) * 2);
                S[mt] = S[mt] * gd; S[mt] = MFMA16(mk8(kt.x, kt.y, 0u, 0u), VB, S[mt]);
            }
        }
    }
#pragma unroll
    for (int mc = 0; mc < NMC; ++mc) {
        {
#pragma unroll
            for (int r = 0; r < 4; ++r) OB[(16 * mc + 4 * q + r) * MX_OP + 16 * w + r16] = oo[mc][r];
        }
    }
}

__device__ __forceinline__ void mix_hg_unit(Frame& F, int b, int h, int mode) {
    const bool prompt = (mode != 1);
    const int tid = F.tid, lane = F.lane, w = F.wave, r16 = lane & 15, q = lane >> 4;
    const int tk = tid >> 3, p = tid & 7;
    const int amc = w >> 1, app = q + 4 * (w & 1);
    LAS unsigned char* L = F.lds;
    LAS float* GD = (LAS float*)(L + MX_GD); LAS float* OB = (LAS float*)(L + MX_OB);
    bf16* MIX = F_XN(F);
    f32x4 S[8];
#pragma unroll
    for (int mt = 0; mt < 8; ++mt) S[mt] = (f32x4){0.f, 0.f, 0.f, 0.f};
    if (!prompt) {
        const float* Sin = F.in[6] + (size_t)(b * 8 + h) * 16384;
#pragma unroll
        for (int mt = 0; mt < 8; ++mt)
#pragma unroll
            for (int r = 0; r < 4; ++r) S[mt][r] = Sin[(16 * mt + 4 * q + r) * 128 + 16 * w + r16];
    }
    LAS float* GN = (LAS float*)(L + MX_GN); LAS float* LB = (LAS float*)(L + MX_LB);
    if (tid < 128) { GN[tid] = F.in[18][128 * h + tid]; LB[tid] = sigmoidf_(F.in[16][1024 + 128 * h + tid] - F.in[16][128 * h + tid]); }
    __syncthreads();
    const int nsc = (mode == 0) ? 33 : 1;
    u32x4 pa[6]; u32x4 pg[2];
    const u32x4 z4 = {0u, 0u, 0u, 0u};
#define HG_LOAD(scv) do { int row0_, ntok_, nmc_, pos0_; MX_SC_PARAMS(scv, row0_, ntok_, nmc_, pos0_); (void)pos0_; \
        const int t_ = 16 * amc + r16; const bool valid_ = (amc < nmc_) && (t_ < ntok_); const bf16* zr_ = ZROW(F, row0_ + (valid_ ? t_ : 0), 1) + 128 * h + 16 * app; \
        _Pragma("unroll") for (int i_ = 0; i_ < 6; ++i_) pa[i_] = z4; \
        if (valid_) { pa[0] = *(const u32x4*)zr_; pa[1] = *(const u32x4*)(zr_ + 8); pa[2] = *(const u32x4*)(zr_ + 1024); pa[3] = *(const u32x4*)(zr_ + 1032); pa[4] = *(const u32x4*)(zr_ + 2048); pa[5] = *(const u32x4*)(zr_ + 2056); } } while (0)
    HG_LOAD(0);
#pragma unroll 1
    for (int sc = 0; sc < nsc; ++sc) {
        int row0, ntok, nmc, pos0; MX_SC_PARAMS(sc, row0, ntok, nmc, pos0); (void)pos0;
        if (amc < nmc) {
            const bool valid = (16 * amc + r16) < ntok;
            unsigned wq[8], wk[8], wh[8]; float Aend[16]; float lbv[16];
#pragma unroll
            for (int c = 0; c < 4; ++c) { const f32x4 t4 = *(const LAS f32x4*)(LB + 16 * app + 4 * c); lbv[4 * c] = t4[0]; lbv[4 * c + 1] = t4[1]; lbv[4 * c + 2] = t4[2]; lbv[4 * c + 3] = t4[3]; }
#pragma unroll
            for (int e2 = 0; e2 < 8; ++e2) {
                const unsigned qw = e2 < 4 ? pa[0][e2] : pa[1][e2 - 4], fw = e2 < 4 ? pa[2][e2] : pa[3][e2 - 4];
                float qo[2], ko[2], ho[2];
#pragma unroll
                for (int hh = 0; hh < 2; ++hh) {
                    const int e = 2 * e2 + hh;
                    const float qv = hh ? bfhi(qw) : bflo(qw), fv = hh ? bfhi(fw) : bflo(fw);
                    const float sg = sigmoidf_(fv);
                    const float a = valid ? lbv[e] + (1.f - lbv[e]) * sg : 1.f;
                    const float kk = valid ? (1.f - lbv[e]) * (1.f - sg) : 0.f;
                    const float A = row_prefix_prod(a);
                    const float Sx = row_suffix_prod(a);
                    const float R = dppf<0x101>(1.f, Sx);
                    qo[hh] = qv * A; ko[hh] = kk * __builtin_amdgcn_rcpf(fmaxf(A, 1e-30f)); ho[hh] = kk * R; Aend[e] = A;
                }
                wq[e2] = pkbf(qo[0], qo[1]); wk[e2] = pkbf(ko[0], ko[1]); wh[e2] = pkbf(ho[0], ho[1]);
            }
            const int ro = (16 * amc + r16) * MX_PITCH + 32 * app;
            *(LAS u32x4*)(L + MX_Q + ro) = (u32x4){wq[0], wq[1], wq[2], wq[3]}; *(LAS u32x4*)(L + MX_Q + ro + 16) = (u32x4){wq[4], wq[5], wq[6], wq[7]};
            *(LAS u32x4*)(L + MX_K + ro) = (u32x4){wk[0], wk[1], wk[2], wk[3]}; *(LAS u32x4*)(L + MX_K + ro + 16) = (u32x4){wk[4], wk[5], wk[6], wk[7]};
            *(LAS u32x4*)(L + MX_KH + ro) = (u32x4){wh[0], wh[1], wh[2], wh[3]}; *(LAS u32x4*)(L + MX_KH + ro + 16) = (u32x4){wh[4], wh[5], wh[6], wh[7]};
            *(LAS u32x4*)(L + MX_V + ro) = pa[4]; *(LAS u32x4*)(L + MX_V + ro + 16) = pa[5];
            if (r16 == 15) {
#pragma unroll
                for (int c = 0; c < 4; ++c) *(LAS f32x4*)(GD + amc * 128 + 16 * app + 4 * c) = (f32x4){Aend[4 * c], Aend[4 * c + 1], Aend[4 * c + 2], Aend[4 * c + 3]}; }
        }
        __syncthreads();
        if (sc + 1 < nsc) HG_LOAD(sc + 1);
        { const bool valid = tk < ntok; const bf16* zr = ZROW(F, row0 + (valid ? tk : 0), 1) + 3072 + 128 * h + 16 * p; pg[0] = *(const u32x4*)zr; pg[1] = *(const u32x4*)(zr + 8); }
        if (nmc == 4) hg_chain<4>(L, S, w, r16, q); else hg_chain<1>(L, S, w, r16, q);
        __syncthreads();
        {
            const bool valid = tk < ntok; const int row = row0 + (valid ? tk : 0);
            f32x4 o[4];
#pragma unroll
            for (int c = 0; c < 4; ++c) o[c] = *(const LAS f32x4*)(OB + tk * MX_OP + 16 * p + 4 * c);
            if (tk >= 16 * nmc) {
#pragma unroll
                for (int c = 0; c < 4; ++c) o[c] = (f32x4){0.f, 0.f, 0.f, 0.f}; }
            float vs = 0.f;
#pragma unroll
            for (int c = 0; c < 4; ++c) vs += (o[c].x * o[c].x + o[c].y * o[c].y) + (o[c].z * o[c].z + o[c].w * o[c].w);
            vs += __shfl_xor(vs, 1); vs += __shfl_xor(vs, 2); vs += __shfl_xor(vs, 4);
            const float rstd = rsqrtf(vs * (1.f / 128.f) + EPS);
            if (valid && !(mode == 0 && sc == 0)) {
                unsigned ow[8];
#pragma unroll
                for (int c = 0; c < 4; ++c) {
                    const unsigned ga = c < 2 ? pg[0][2 * c] : pg[1][2 * c - 4], gb = c < 2 ? pg[0][2 * c + 1] : pg[1][2 * c - 3];
                    f32x4 gt = {bflo(ga), bfhi(ga), bflo(gb), bfhi(gb)};
#pragma unroll
                    for (int e = 0; e < 4; ++e) gt[e] = siluf_(gt[e]);
                    const f32x4 r = o[c] * rstd * *(const LAS f32x4*)(GN + 16 * p + 4 * c) * gt;
                    ow[2 * c] = pkbf(r.x, r.y); ow[2 * c + 1] = pkbf(r.z, r.w);
                }
                bf16* mp = MIX + (size_t)row * DM + 128 * h + 16 * p;
                *(u32x4*)mp = (u32x4){ow[0], ow[1], ow[2], ow[3]}; *(u32x4*)(mp + 8) = (u32x4){ow[4], ow[5], ow[6], ow[7]};
            }
        }
    }
#undef HG_LOAD
    __syncthreads();
    if (mode != 2) {
        int l2 = F.lane; asm volatile("" : "+v"(l2)); const int r16 = l2 & 15, q = l2 >> 4;
        float* So = F.out + (prompt ? O_HP : O_HS) + (size_t)(b * 8 + h) * 16384;
#pragma unroll
        for (int mt = 0; mt < 8; ++mt)
#pragma unroll
            for (int r = 0; r < 4; ++r) So[(16 * mt + 4 * q + r) * 128 + 16 * w + r16] = S[mt][r];
    }
}

__device__ __forceinline__ void mixer_layer0(Frame& F) {
    const float* rot = (const float*)(F.ws + WS_ROT);
    int bid = blockIdx.x; asm volatile("" : "+s"(bid));
    if (bid < 64) { const int u = bid, ty = u >> 5, bh = u & 31; if (ty == 0) mix_sg_unit<0>(F, bh >> 2, bh & 3, 0, rot); else mix_sg_unit<1>(F, bh >> 2, bh & 3, 0, rot); return; }
#pragma unroll 1
    for (int u = bid - 64; u < 1024 + 8; u += F.G - 64) {
        int ty, bh, mode;
        if (u < 1024) { ty = u >> 9; bh = u & 511; mode = 1; } else { ty = (u - 1024) >> 2; bh = (u - 1024) & 3; mode = 2; }
        if (ty == 0) mix_sg_unit<0>(F, bh >> 2, bh & 3, mode, rot); else mix_sg_unit<1>(F, bh >> 2, bh & 3, mode, rot);
    }
}
__device__ __forceinline__ void mixer_layer1(Frame& F) {
    int bid = blockIdx.x; asm volatile("" : "+s"(bid));
    if (bid < 64) { mix_hg_unit(F, bid >> 3, bid & 7, 0); return; }
#pragma unroll 1
    for (int u = bid - 64; u < 1024 + 8; u += F.G - 64) {
        if (u < 1024) mix_hg_unit(F, u >> 3, u & 7, 1); else mix_hg_unit(F, 0, u - 1024, 2);
    }
}
constexpr int NSTEP = 21;
constexpr int LDSCTL_OFF = 139264;
#define RLX_AGENT __ATOMIC_RELAXED, __HIP_MEMORY_SCOPE_AGENT
#define XB_TMO      128
#define XB_XCNT(j)  (256  + 64 * (j))
#define XB_XSUB(j)  (1280 + 64 * (j))
#define XB_XGEN(j)  (2304 + 64 * (j))
#define XB_TOP      3328
#define XB_TOPGEN   3392
#define XCD_BAR_WORDS 3456
#define XB_SPIN_CAP (1u << 18)

__device__ __forceinline__ unsigned xb_ld(unsigned* p)              { return __hip_atomic_load(p, __ATOMIC_RELAXED, __HIP_MEMORY_SCOPE_AGENT); }
__device__ __forceinline__ unsigned xb_add(unsigned* p, unsigned v) { return __hip_atomic_fetch_add(p, v, __ATOMIC_RELAXED, __HIP_MEMORY_SCOPE_AGENT); }
__device__ __forceinline__ unsigned xb_xcc_id() { return (unsigned)__builtin_amdgcn_s_getreg((3 << 11) | 20) & 0xFu; }
#define XB_SPIN(cond, bar) do { unsigned _sp = 0; while (cond) { __builtin_amdgcn_s_sleep(1); \
    if ((++_sp & 255u) == 0u) { if (xb_ld(&(bar)[XB_TMO])) break; if (_sp > XB_SPIN_CAP) { atomicAdd(&(bar)[XB_TMO], 1u); break; } } } } while (0)

struct XcdBarrier {
    unsigned gsz;
    unsigned* bar; unsigned x;
    volatile LAS unsigned* st;
};

__device__ __forceinline__ XcdBarrier xcd_barrier_post(unsigned* bar, volatile LAS unsigned* st, unsigned gsz) {
    XcdBarrier b; b.gsz = gsz; b.bar = bar; b.x = xb_xcc_id(); b.st = st;
    if (threadIdx.x == 0) (void)xb_add(&bar[XB_XCNT(b.x)], 1u);
    return b;
}
__device__ __forceinline__ void xcd_barrier_complete(unsigned* bar, unsigned x, unsigned G, unsigned& nloc, unsigned& nx) {
    unsigned sum, cnt, mine, sp = 0u;
    for (;;) {
        sum = 0u; cnt = 0u; mine = 0u;
#pragma unroll
        for (unsigned j = 0; j < 16; ++j) { const unsigned c = xb_ld(&bar[XB_XCNT(j)]); sum += c; cnt += (c > 0u) ? 1u : 0u; mine = (j == x) ? c : mine; }
        if (sum == G) break;
        __builtin_amdgcn_s_sleep(1);
        if ((++sp & 255u) == 0u) { if (xb_ld(&bar[XB_TMO])) break; if (sp > XB_SPIN_CAP) { atomicAdd(&bar[XB_TMO], 1u); break; } }
    }
    nloc = mine > 0u ? mine : 1u; nx = cnt > 0u ? cnt : 1u;
}

__device__ __forceinline__ void xcd_barrier(const XcdBarrier& b) {
    asm volatile("s_waitcnt vmcnt(0)" ::: "memory");
    __syncthreads();
    if (threadIdx.x == 0) {
        unsigned* bar = b.bar;
        __builtin_amdgcn_s_waitcnt(0);
        unsigned nloc = b.st[0], nx = b.st[1];
        if (nloc == 0u) { xcd_barrier_complete(bar, b.x, b.gsz, nloc, nx); b.st[0] = nloc; b.st[1] = nx; }
        const unsigned old = xb_add(&bar[XB_XSUB(b.x)], 1u);
        const unsigned gen = old / nloc;
        if (old + 1u == (gen + 1u) * nloc) {
            __builtin_amdgcn_fence(__ATOMIC_RELEASE, "agent");
            asm volatile("s_waitcnt vmcnt(0)" ::: "memory");
            const unsigned og = xb_add(&bar[XB_TOP], 1u);
            const unsigned tg = og / nx;
            if (og + 1u == (tg + 1u) * nx) xb_add(&bar[XB_TOPGEN], 1u);
            else XB_SPIN(xb_ld(&bar[XB_TOPGEN]) == tg, bar);
            __builtin_amdgcn_fence(__ATOMIC_ACQUIRE, "agent");
            xb_add(&bar[XB_XGEN(b.x)], 1u);
            asm volatile("s_waitcnt vmcnt(0)" ::: "memory");
        } else {
            XB_SPIN(xb_ld(&bar[XB_XGEN(b.x)]) == gen, bar);
            __builtin_amdgcn_fence(__ATOMIC_ACQUIRE, "agent");
            asm volatile("s_waitcnt vmcnt(0)" ::: "memory");
        }
    }
    __syncthreads();
}


enum { K_P0 = 0, K_IN = 1, K_MIX = 2, K_OUT = 3, K_UP = 5, K_FIX = 6, K_DOWN = 7, K_FINAL = 8 };
struct Step { int kind, layer, side, tile0, nt, pre; };
__device__ __forceinline__ Step get_step(int pc) {
    switch (pc) {
        case 0:  return Step{K_P0, 0, 0, 0, 0, 0};
        case 1:  return Step{K_IN, 0, 0, 0, 69, 1};
        case 2:  return Step{K_MIX, 0, 0, 0, 0, 1};
        case 3:  return Step{K_OUT, 0, 1, 64, 5, 2};
        case 4:  return Step{K_UP, 0, 1, 64, 5, 2};
        case 5:  return Step{K_DOWN, 0, 1, 64, 5, 2};
        case 6:  return Step{K_IN, 1, 1, 64, 5, 2};
        case 7:  return Step{K_OUT, 0, 0, 0, 64, 1};
        case 8:  return Step{K_UP, 0, 0, 0, 64, 1};
        case 9:  return Step{K_FIX, 0, 0, 0, 0, 1};
        case 10: return Step{K_DOWN, 0, 0, 0, 64, 1};
        case 11: return Step{K_IN, 1, 0, 0, 64, 1};
        case 12: return Step{K_MIX, 1, 0, 0, 0, 1};
        case 13: return Step{K_OUT, 1, 1, 64, 5, 2};
        case 14: return Step{K_UP, 1, 1, 64, 5, 2};
        case 15: return Step{K_DOWN, 1, 1, 64, 5, 2};
        case 16: return Step{K_OUT, 1, 0, 0, 64, 1};
        case 17: return Step{K_UP, 1, 0, 0, 64, 1};
        case 18: return Step{K_FIX, 1, 0, 0, 0, 1};
        case 19: return Step{K_DOWN, 1, 0, 0, 64, 1};
        default: return Step{K_FINAL, 0, 0, 0, 0, 1};
    }
}

__global__ void __launch_bounds__(NWAVES * 64, 2) fwd_kernel(Args args) {
    extern __shared__ __attribute__((aligned(16))) unsigned char lds_raw[];
    cg::grid_group grid = cg::this_grid();
    Frame F;
    F.lds = (LAS unsigned char*)lds_raw;
#define REFRESH() do { int t_ = threadIdx.x; asm volatile("" : "+v"(t_)); F.tid = t_; F.lane = t_ & 63; F.wave = __builtin_amdgcn_readfirstlane(t_ >> 6); F.gw = blockIdx.x * NWAVES + F.wave; } while (0)
    F.G = gridDim.x; F.NGW = F.G * NWAVES; REFRESH();
    F.in = args.in; F.out = args.out; F.ws = args.ws;
    volatile LAS unsigned* MISC = (volatile LAS unsigned*)(F.lds + LDSCTL_OFF);
    if (threadIdx.x < 16) MISC[threadIdx.x] = 0u;
    __syncthreads();
    const bool side_wg = blockIdx.x >= 64;
    (void)xcd_barrier_post((unsigned*)(args.ws + WS_CTL), MISC + 8, F.G);
    if (side_wg) (void)xcd_barrier_post((unsigned*)(args.ws + WS_CTL) + 4096, MISC + 10, F.G - 64);
#ifndef KMASK
#define KMASK 0x1ff
#endif
#define INK(kind) ((((KMASK) >> (kind)) & 1) != 0)
#ifndef PROBE_MULT
#define PROBE_MULT 1
#endif
#ifdef PROBE_BLOCK
    volatile LAS unsigned long long* STMP = (volatile LAS unsigned long long*)(F.lds + LDSCTL_OFF + 128);
    if (threadIdx.x < 64) STMP[threadIdx.x] = 0ull;
    __syncthreads();
#define STAMP(id) do { if (blockIdx.x == PROBE_BLOCK && threadIdx.x == 0) STMP[(id)] = __builtin_amdgcn_s_memrealtime(); } while (0)
#else
#define STAMP(id) do { } while (0)
#endif
#pragma unroll 1
    for (int pc = 0; pc < NSTEP; ++pc) {
        const Step st = get_step(pc);
        if (st.pre == 1) { if (pc == 1) grid.sync(); else { XcdBarrier bar_; bar_.gsz = F.G; bar_.bar = (unsigned*)(args.ws + WS_CTL); bar_.x = xb_xcc_id(); bar_.st = (volatile LAS unsigned*)(F.lds + LDSCTL_OFF) + 8; xcd_barrier(bar_); } }
        if (st.side && !side_wg) continue;
        if (st.pre == 2) { XcdBarrier bar_; bar_.gsz = F.G - 64; bar_.bar = (unsigned*)(args.ws + WS_CTL) + 4096; bar_.x = xb_xcc_id(); bar_.st = (volatile LAS unsigned*)(F.lds + LDSCTL_OFF) + 10; xcd_barrier(bar_); }
        const int layer = st.layer;
        STAMP(2 * pc);
        const int Gs = st.side ? F.G - 64 : F.G, cs = st.side ? (int)blockIdx.x - 64 : (int)blockIdx.x;
        if (st.kind == K_P0) { if (INK(0)) { REFRESH(); p0_weights(F); __syncthreads(); REFRESH(); p0_rows(F); REFRESH(); p0_rotary(F, (float*)(args.ws + WS_ROT)); } }
        else if (st.kind == K_IN) { if (INK(1)) {
            pg8::Gemm g{F_XG(F), (const bf16*)(args.ws + (layer == 0 ? WS_WAB : WS_WC)), MPAD, 4096, 1024}; pg8::StaticOrder S; S.init(st.nt, 4096, Gs, cs, st.tile0);
            pg8::EpiBf16 E{F_Z(F), F_ZS1(F, layer), 64, 4096, layer == 0 ? (const float*)nullptr : (const float*)F_SSQ(F)};
            pg8::gemm_phase<pg8::EpiBf16, pg8::StaticOrder, false>(F.lds, g, S, E); } }
        else if (st.kind == K_MIX) { if (INK(2)) { REFRESH(); if (layer == 0) mixer_layer0(F); else mixer_layer1(F); } }
        else if (st.kind == K_OUT) { if (INK(3)) {
            pg8::Gemm g{F_XN(F), (const bf16*)(args.ws + (layer == 0 ? WS_WOAB : WS_WOC)), MPAD, 1024, 1024}; pg8::StaticOrder S; S.init(st.nt, 1024, Gs, cs, st.tile0);
            pg8::EpiResid E{F_X0(F), F_X1(F), PM_META, DM, F_XG(F), F.in[20] + (size_t)layer * DM, F_SSQ(F)};
            pg8::gemm_phase<pg8::EpiResid, pg8::StaticOrder, false>(F.lds, g, S, E); } }
        else if (st.kind == K_UP) { if (INK(5)) {
            pg8::Gemm g{F_XG(F), (const bf16*)(args.ws + WS_WF1) + (size_t)layer * NFF * 1024, MPAD, NFF, 1024}; pg8::StaticOrder S; S.init(st.nt, NFF, Gs, cs, st.tile0);
            EpiFfn E{F_Z(F), F_HS1(F), F.in[22] + (size_t)layer * 3 * DFF, F.in[23] + (size_t)layer * DFF, F.in[7] + (size_t)layer * 128 * 2 * DFF, F.out + O_FS + (size_t)layer * 128 * 2 * DFF, F_SBL(F), F_SBF(F), F_SSQ(F)};
            pg8::gemm_phase<EpiFfn, pg8::StaticOrder, true>(F.lds, g, S, E); } }
        else if (st.kind == K_FIX) { if (INK(6)) { REFRESH(); ffn_fixup(F, layer); } }
        else if (st.kind == K_DOWN) { if (INK(7)) {
            pg8::Gemm g{st.side ? F_HS1(F) : F_Z(F), (const bf16*)(args.ws + WS_WF2) + (size_t)layer * 1024 * DFF, MPAD, 1024, DFF}; pg8::StaticOrder S; S.init(st.nt, 1024, Gs, cs, st.tile0);
            pg8::EpiResid E{F_X0(F), F_X1(F), PM_META, DM, layer == 0 ? F_XG(F) : (bf16*)nullptr, F.in[9] + DM, F_SSQ(F)};
            pg8::gemm_phase<pg8::EpiResid, pg8::StaticOrder, false>(F.lds, g, S, E); } }
        else { if (INK(8)) { REFRESH(); rms_final(F, F.in[25]); } }
        STAMP(2 * pc + 1);
    }
#ifdef PROBE_BLOCK
    if (blockIdx.x == PROBE_BLOCK && threadIdx.x == 0) { const unsigned long long d = (STMP[PROBE_B] - STMP[PROBE_A]) * PROBE_MULT, t0 = __builtin_amdgcn_s_memrealtime(); while (__builtin_amdgcn_s_memrealtime() - t0 < d) __builtin_amdgcn_s_sleep(8); }
#endif
#undef INK
#undef REFRESH
}

extern "C" void kernel_launch(void* const* d_in, const int* in_sizes, int n_in, void* d_out, int out_size, void* d_ws, size_t ws_size, hipStream_t stream) {
    static int grid = 0;
    if (grid == 0) {
        if (n_in != 26 || (size_t)out_size != O_END || ws_size < WS_END) { fprintf(stderr, "kernel_launch: unexpected shapes: n_in %d out %d ws %zu\n", n_in, out_size, ws_size); grid = -1; return; }
        int dev = 0, cus = 0, per_cu = 0;
        if (hipGetDevice(&dev) != hipSuccess || hipDeviceGetAttribute(&cus, hipDeviceAttributeMultiprocessorCount, dev) != hipSuccess) { grid = -1; return; }
        if (hipFuncSetAttribute((const void*)fwd_kernel, hipFuncAttributeMaxDynamicSharedMemorySize, LDS_BYTES) != hipSuccess) { fprintf(stderr, "kernel_launch: hipFuncSetAttribute failed\n"); grid = -1; return; }
        if (hipOccupancyMaxActiveBlocksPerMultiprocessor(&per_cu, (const void*)fwd_kernel, NWAVES * 64, LDS_BYTES) != hipSuccess || per_cu < 1) { fprintf(stderr, "kernel_launch: occupancy query says %d\n", per_cu); per_cu = 1; }
        (void)hipGetLastError();
        grid = cus;
        if (grid < 128) { fprintf(stderr, "kernel_launch: this kernel's static work split needs >= 128 CUs (got %d)\n", grid); grid = -1; return; }
    }
    if (grid < 0) return;
    if (hipMemsetAsync((char*)d_ws + WS_CTL, 0, 32768, stream) != hipSuccess) { fprintf(stderr, "kernel_launch: hipMemsetAsync failed\n"); return; }
    Args a{};
    for (int i = 0; i < 26; ++i) a.in[i] = (const float*)d_in[i];
    a.out = (float*)d_out; a.ws = (unsigned char*)d_ws;
    a.ph_lo = 0; a.ph_hi = NSTEP;
    void* kargs[] = {&a};
    hipError_t e = hipLaunchCooperativeKernel((const void*)fwd_kernel, dim3(grid), dim3(NWAVES * 64), kargs, LDS_BYTES, stream);
    if (e != hipSuccess) fprintf(stderr, "kernel_launch: cooperative launch failed: %s (grid %d)\n", hipGetErrorString(e), grid);
}
```

```cpp
#include <hip/hip_runtime.h>
#include <hip/hip_cooperative_groups.h>
#include <cstdio>
#include <cstdint>
namespace cg = cooperative_groups;

namespace pg8 {
#define PG8_LAS __attribute__((address_space(3)))
typedef unsigned short bf16_t;
typedef short bf16x8 __attribute__((ext_vector_type(8)));
typedef float f32x4 __attribute__((ext_vector_type(4)));
typedef unsigned u32x4 __attribute__((ext_vector_type(4)));
typedef unsigned u32x2 __attribute__((ext_vector_type(2)));
constexpr int BM = 256, BK = 64, HALF = 128, HTB = HALF * BK * 2  , STAGE_BYTES = 8 * HTB, NXCD = 8, WGM = 8;

__host__ __device__ __forceinline__ int lds_byte(int r, int c) { const int st = (r >> 4) * 2 + (c >> 5), rr = r & 15, cc = c & 31, ob = rr * 64 + cc * 2; return st * 1024 + (ob ^ (((ob >> 9) & 1) << 5)); }
__host__ __device__ __forceinline__ void stage_rc(int b, int& R, int& C) { const int st = b / 1024, sb = b % 1024, swz = sb ^ (((sb >> 9) & 1) << 5); R = (st >> 1) * 16 + swz / 64; C = (st & 1) * 32 + (swz % 64) / 2; }
__host__ __device__ __forceinline__ int perm32(int rho) { const int n = rho >> 4, i = rho & 15; return 8 * (i >> 2) + 4 * n + (i & 3); }

struct Unit { int pm, pn; };
struct Gemm { const bf16_t* A; const bf16_t* Bt; int M, N, K; };

struct StaticOrder {
    int nM, nN, nwg, G, c, pm0;
    __host__ __device__ void init(int nMt, int N, int G_, int c_, int pm0_) { nM = nMt; nN = N / BM; nwg = nM * nN; G = G_; c = c_; pm0 = pm0_; }
    __host__ __device__ bool next(int i, Unit& u) const {
        const long L = (long)i * G + c; if (L >= nwg) return false;
        int wgid = (int)L; { const int q = nwg / NXCD, r = nwg % NXCD, xcd = wgid % NXCD, off = wgid / NXCD; wgid = (xcd < r ? xcd * (q + 1) : r * (q + 1) + (xcd - r) * q) + off; }
        const int nig = WGM * nN, gid = wgid / nig, fm = gid * WGM, gsz = (nM - fm) < WGM ? (nM - fm) : WGM;
        u.pm = pm0 + fm + ((wgid % nig) % gsz); u.pn = (wgid % nig) / gsz; return true;
    }
    __device__ __forceinline__ void a_ready(const Unit&) const {}
    __device__ __forceinline__ void done(const Unit&) const {}
};

__device__ __forceinline__ unsigned cvt_pk_bf16(float lo, float hi) { unsigned r; asm volatile("v_cvt_pk_bf16_f32 %0, %1, %2" : "=v"(r) : "v"(lo), "v"(hi)); return r; }

__device__ __forceinline__ float row_rs(const float* ssq, int row, int fq) {
    const f32x4 a = *(const f32x4*)(ssq + (size_t)row * 16 + 4 * fq);
    float s = (a[0] + a[1]) + (a[2] + a[3]); s += __shfl_xor(s, 16); s += __shfl_xor(s, 32);
    return __builtin_amdgcn_rsqf(s * (1.0f / 1024.0f) + 1e-6f);
}
struct EpiBf16 {
    static constexpr bool PERM = true, AFTER_DRAIN = false;
    bf16_t* O0; bf16_t* O1; int pm_split; int ldc; const float* ssq;
    __device__ __forceinline__ void operator()(f32x4 (&acc)[2][2][4][2], const Unit& u, int wr, int wc, int fr, int fq) const {
        bf16_t* O = (u.pm < pm_split) ? O0 : O1;
        const int row0 = u.pm * BM + wr * 64 + fr; const int col0 = u.pn * BM + wc * 32 + 8 * fq;
        float rsv[2][4];
#pragma unroll
        for (int ai = 0; ai < 2; ++ai)
#pragma unroll
            for (int m = 0; m < 4; ++m) rsv[ai][m] = ssq ? row_rs(ssq, row0 + ai * HALF + m * 16, fq) : 1.0f;
#pragma unroll
        for (int ai = 0; ai < 2; ++ai)
#pragma unroll
            for (int m = 0; m < 4; ++m) { const int row = row0 + ai * HALF + m * 16; bf16_t* rowp = O + (size_t)row * ldc + col0;
                const float rs = rsv[ai][m];
#pragma unroll
                for (int bj = 0; bj < 2; ++bj) { const f32x4 v0 = acc[ai][bj][m][0] * rs, v1 = acc[ai][bj][m][1] * rs;
                    u32x4 w; w.x = cvt_pk_bf16(v0[0], v0[1]); w.y = cvt_pk_bf16(v0[2], v0[3]); w.z = cvt_pk_bf16(v1[0], v1[1]); w.w = cvt_pk_bf16(v1[2], v1[3]);
                    *(u32x4*)(rowp + bj * HALF) = w; } }
    }
};

struct EpiResid {
    static constexpr bool PERM = true, AFTER_DRAIN = false;
    float* X0; float* X1; int pm_split; int ldc; bf16_t* XG; const float* gain; float* ssq;
    __device__ __forceinline__ void operator()(f32x4 (&acc)[2][2][4][2], const Unit& u, int wr, int wc, int fr, int fq) const {
        float* C = (u.pm < pm_split) ? X0 : X1;
        const int row0 = u.pm * BM + wr * 64 + fr, col0 = u.pn * BM + wc * 32 + 8 * fq;
        f32x4 gv[2][2];
#pragma unroll
        for (int bj = 0; bj < 2; ++bj)
#pragma unroll
            for (int n = 0; n < 2; ++n) gv[bj][n] = XG ? *(const f32x4*)(gain + col0 + bj * HALF + 4 * n) : (f32x4){0.f, 0.f, 0.f, 0.f};
#pragma unroll
        for (int ai = 0; ai < 2; ++ai)
#pragma unroll
            for (int mp = 0; mp < 2; ++mp) {
                f32x4 t[2][2][2];
#pragma unroll
                for (int mm = 0; mm < 2; ++mm) { const float* rowp = C + (size_t)(row0 + ai * HALF + (2 * mp + mm) * 16) * ldc + col0;
#pragma unroll
                    for (int bj = 0; bj < 2; ++bj)
#pragma unroll
                        for (int n = 0; n < 2; ++n) t[mm][bj][n] = *(const f32x4*)(rowp + bj * HALF + 4 * n); }
#pragma unroll
                for (int mm = 0; mm < 2; ++mm) { const int m = 2 * mp + mm; const int row = row0 + ai * HALF + m * 16; float* rowp = C + (size_t)row * ldc + col0; float sq = 0.f;
#pragma unroll
                    for (int bj = 0; bj < 2; ++bj) { f32x4 v[2];
#pragma unroll
                        for (int n = 0; n < 2; ++n) { v[n] = t[mm][bj][n] + acc[ai][bj][m][n]; *(f32x4*)(rowp + bj * HALF + 4 * n) = v[n];
                            sq += (v[n][0] * v[n][0] + v[n][1] * v[n][1]) + (v[n][2] * v[n][2] + v[n][3] * v[n][3]); }
                        if (XG) { const f32x4 y0 = v[0] * gv[bj][0], y1 = v[1] * gv[bj][1]; u32x4 w; w.x = cvt_pk_bf16(y0[0], y0[1]); w.y = cvt_pk_bf16(y0[2], y0[3]); w.z = cvt_pk_bf16(y1[0], y1[1]); w.w = cvt_pk_bf16(y1[2], y1[3]);
                            *(u32x4*)(XG + (size_t)row * ldc + col0 + bj * HALF) = w; } }
                    if (XG) { sq += __shfl_xor(sq, 16); sq += __shfl_xor(sq, 32); if (fq == 0) ssq[(size_t)row * 16 + u.pn * 4 + wc] = sq; } }
                asm volatile("" ::: "memory"); }
    }
};

template <class Epi, class Sched, bool APERM>
__device__ __forceinline__ void gemm_phase(PG8_LAS unsigned char* lds, const Gemm g, const Sched& S, const Epi& E) {
    int tid_ = threadIdx.x; asm volatile("" : "+v"(tid_));
    const int tid = tid_, wid = __builtin_amdgcn_readfirstlane(tid >> 6), lane = tid & 63, wr = wid >> 2, wc = wid & 3, fr = lane & 15, fq = lane >> 4;
    const int K = g.K, nt = K / BK;
    unsigned voffA[2], voffB[2];
#pragma unroll
    for (int i = 0; i < 2; ++i) { int R, C; stage_rc(tid * 16 + i * 8192, R, C); const int Rb = Epi::PERM ? ((R & ~31) + perm32(R & 31)) : R;
        const int Ra = APERM ? (128 * (R >> 6) + 8 * (R & 15) + ((R >> 4) & 3)) : R;
        voffA[i] = (unsigned)(Ra * K + C) * 2u; voffB[i] = (unsigned)(Rb * K + C) * 2u; }
    const size_t kstep = (size_t)(BK * 2);
    const size_t hstep = (size_t)HALF * K * 2;
    const size_t hstepA = APERM ? (size_t)4 * K * 2 : hstep;
    const size_t tstep = 2 * hstep;
    const unsigned ldsw = (unsigned)wid * 1024u;
    const int aoff = lds_byte(wr * 64 + fr, fq * 8), boff = lds_byte(wc * 32 + fr, fq * 8);
#define PG8_SA(b, h) (((b) * 2 + (h)) * HTB)
#define PG8_SB(b, h) ((4 + (b) * 2 + (h)) * HTB)
#define PG8_STAGE(bufoff, gbase, voff) do { _Pragma("unroll") for (int _i = 0; _i < 2; ++_i) \
        __builtin_amdgcn_global_load_lds((const unsigned*)((const char*)(gbase) + (voff)[_i]), (PG8_LAS unsigned*)(lds + (bufoff) + ldsw + _i * 8192), 16, 0, 0); } while (0)
#define PG8_LDA(dst, b, h) do { _Pragma("unroll") for (int m = 0; m < 4; ++m) _Pragma("unroll") for (int k = 0; k < 2; ++k) dst[m][k] = *(const PG8_LAS bf16x8*)(lds + PG8_SA(b, h) + aoff + m * 2048 + k * 1024); } while (0)
#define PG8_LDB(dst, b, h) do { _Pragma("unroll") for (int n = 0; n < 2; ++n) _Pragma("unroll") for (int k = 0; k < 2; ++k) dst[n][k] = *(const PG8_LAS bf16x8*)(lds + PG8_SB(b, h) + boff + n * 2048 + k * 1024); } while (0)
#define PG8_MMA(ai, bj, At, Bt) do { __builtin_amdgcn_s_setprio(1); _Pragma("unroll") for (int m = 0; m < 4; ++m) _Pragma("unroll") for (int n = 0; n < 2; ++n) _Pragma("unroll") for (int k = 0; k < 2; ++k) \
        acc[ai][bj][m][n] = __builtin_amdgcn_mfma_f32_16x16x32_bf16(Bt[n][k], At[m][k], acc[ai][bj][m][n], 0, 0, 0); __builtin_amdgcn_s_setprio(0); } while (0)
#define PG8_WAIT_V(n) asm volatile("s_waitcnt vmcnt(" #n ")" ::: "memory")
#define PG8_WAIT_L(n) asm volatile("s_waitcnt lgkmcnt(" #n ")" ::: "memory")
#define PG8_BAR __builtin_amdgcn_s_barrier()
#define PG8_SCHED __builtin_amdgcn_sched_barrier(0)
    Unit cur, nxt; int ui = 0;
    if (!S.next(0, cur)) return;
    f32x4 acc[2][2][4][2];
#pragma unroll
    for (int a = 0; a < 2; ++a)
#pragma unroll
        for (int b = 0; b < 2; ++b)
#pragma unroll
            for (int m = 0; m < 4; ++m)
#pragma unroll
                for (int n = 0; n < 2; ++n) acc[a][b][m][n] = (f32x4){0.f, 0.f, 0.f, 0.f};
    bf16x8 At[4][2], B0[2][2], B1[2][2];
    const char* cA = (const char*)g.A + (size_t)cur.pm * tstep; const char* cB = (const char*)g.Bt + (size_t)cur.pn * tstep;
    S.a_ready(cur);
    PG8_STAGE(PG8_SB(0, 0), cB, voffB); PG8_STAGE(PG8_SB(0, 1), cB + hstep, voffB); PG8_STAGE(PG8_SA(0, 0), cA, voffA); PG8_STAGE(PG8_SA(0, 1), cA + hstepA, voffA);
    if (wr == 1) PG8_BAR;
    PG8_WAIT_V(2); PG8_BAR;
    PG8_STAGE(PG8_SB(1, 0), cB + kstep, voffB); PG8_STAGE(PG8_SA(1, 0), cA + kstep, voffA); PG8_STAGE(PG8_SB(1, 1), cB + hstep + kstep, voffB);
    PG8_WAIT_V(6); PG8_BAR;
    for (;;) {
        const bool has_next = S.next(ui + 1, nxt);
        const char* nA = has_next ? (const char*)g.A + (size_t)nxt.pm * tstep : cA; const char* nB = has_next ? (const char*)g.Bt + (size_t)nxt.pn * tstep : cB;
        for (int t = 0; t < nt; t += 2) {
            const bool last = (t == nt - 2);
            const char* a1 = cA + (size_t)(t + 1) * kstep;
            const char* a2 = last ? nA : cA + (size_t)(t + 2) * kstep; const char* b2 = last ? nB : cB + (size_t)(t + 2) * kstep;
            const char* a3 = a2 + kstep; const char* b3 = b2 + kstep;
            if (last && has_next) S.a_ready(nxt);
            PG8_LDB(B0, 0, 0); PG8_LDB(B1, 0, 1); PG8_SCHED; PG8_LDA(At, 0, 0); PG8_STAGE(PG8_SA(1, 1), a1 + hstepA, voffA);
            PG8_WAIT_V(8); PG8_WAIT_L(0); PG8_BAR; PG8_MMA(0, 0, At, B0); PG8_MMA(0, 1, At, B1); PG8_BAR; PG8_SCHED;
            PG8_LDA(At, 0, 1); PG8_STAGE(PG8_SB(0, 0), b2, voffB); PG8_STAGE(PG8_SB(0, 1), b2 + hstep, voffB); PG8_STAGE(PG8_SA(0, 0), a2, voffA);
            PG8_WAIT_V(8); PG8_WAIT_L(0); PG8_BAR; PG8_MMA(1, 0, At, B0); PG8_MMA(1, 1, At, B1); PG8_BAR; PG8_SCHED;
            PG8_LDB(B0, 1, 0); PG8_LDB(B1, 1, 1); PG8_SCHED; PG8_LDA(At, 1, 0); PG8_STAGE(PG8_SA(0, 1), a2 + hstepA, voffA);
            PG8_WAIT_V(8); PG8_WAIT_L(0); PG8_BAR; PG8_MMA(0, 0, At, B0); PG8_MMA(0, 1, At, B1); PG8_BAR; PG8_SCHED;
            PG8_LDA(At, 1, 1); PG8_STAGE(PG8_SB(1, 0), b3, voffB); PG8_STAGE(PG8_SB(1, 1), b3 + hstep, voffB); PG8_STAGE(PG8_SA(1, 0), a3, voffA);
            PG8_WAIT_V(8); PG8_WAIT_L(0); PG8_BAR; PG8_MMA(1, 0, At, B0); PG8_MMA(1, 1, At, B1); PG8_BAR; PG8_SCHED;
        }
        if (wr == 0) PG8_BAR;
        E(acc, cur, wr, wc, fr, fq); S.done(cur);
        if (!has_next) break;
#pragma unroll
        for (int a = 0; a < 2; ++a)
#pragma unroll
            for (int b = 0; b < 2; ++b)
#pragma unroll
                for (int m = 0; m < 4; ++m)
#pragma unroll
                    for (int n = 0; n < 2; ++n) acc[a][b][m][n] = (f32x4){0.f, 0.f, 0.f, 0.f};
        cur = nxt; cA = nA; cB = nB; ++ui;
        if (wr == 1) PG8_BAR;
    }
    PG8_WAIT_V(0);
    PG8_BAR;
#undef PG8_SA
#undef PG8_SB
#undef PG8_STAGE
#undef PG8_LDA
#undef PG8_LDB
#undef PG8_MMA
#undef PG8_WAIT_V
#undef PG8_WAIT_L
#undef PG8_BAR
#undef PG8_SCHED
}
}
constexpr int DM = 1024;
constexpr int ROW_S = 16384;
constexpr int ROW_M = 17408;
constexpr int NREAL = 17424;
constexpr int MPAD = 17664;
constexpr int PM_META = 68;
constexpr int NAB = 4096, NCC = 4096, DFF = 2816, NFF = 5632, ABW = 4104;
constexpr int NGRP = 138, GRP_META = 136;
constexpr float EPS = 1e-6f;
constexpr float KSCALE = 0.08838834764831845f;

constexpr size_t O_YP = 0, O_YS = 16777216, O_CP = 17825792, O_CS = 18350080, O_NP = 26738688, O_NS = 26742784, O_MP = 26808320, O_MS = 26808352,
                 O_RP = 26808864, O_RS = 27333152, O_HP = 35721760, O_HS = 36770336, O_FP = 53547552, O_FS = 53637664, O_END = 55079456;

constexpr size_t MiB = 1u << 20;
constexpr size_t WS_CTL = 0, CTL_ZERO_BYTES = 1 * MiB;
constexpr size_t WS_WAB = 1 * MiB, WS_WOAB = 9 * MiB, WS_WC = 11 * MiB, WS_WOC = 19 * MiB, WS_WF1 = 21 * MiB  , WS_WF2 = 43 * MiB  ;
constexpr size_t WS_XN = 54 * MiB;
constexpr size_t WS_Z = 89 * MiB;
constexpr size_t WS_XM = 227 * MiB;
constexpr size_t WS_G = 228 * MiB;
constexpr size_t WS_SBL = 229 * MiB;
constexpr size_t WS_SBF = 233 * MiB;
constexpr size_t WS_ROT = 240 * MiB;
constexpr size_t WS_XG = 242 * MiB;
constexpr size_t WS_SSQ = 277 * MiB;
constexpr size_t WS_ZS = 279 * MiB;
constexpr size_t WS_ZS2 = 290 * MiB;
constexpr size_t WS_HS = 301 * MiB;
constexpr size_t WS_END = 309 * MiB;
static_assert(WS_XN + (size_t)MPAD * DM * 2 <= WS_Z && WS_Z + (size_t)MPAD * 4096 * 2 <= WS_XM && WS_SBL + (size_t)NGRP * 2 * DFF * 4 <= WS_SBF && WS_SBF + (size_t)NGRP * 4 * DFF * 4 <= WS_END, "ws map");

constexpr int LDS_BYTES = 147456;
constexpr int NWAVES = 8;

#define GAS __attribute__((address_space(1)))
#define LAS __attribute__((address_space(3)))
typedef unsigned short bf16;
typedef float f32x4 __attribute__((ext_vector_type(4)));
typedef unsigned u32x2 __attribute__((ext_vector_type(2)));
typedef unsigned u32x4 __attribute__((ext_vector_type(4)));
#define LDS_WAIT() asm volatile("s_waitcnt lgkmcnt(0)" ::: "memory")

__device__ __forceinline__ unsigned f2bf(float f) { unsigned u = __builtin_bit_cast(unsigned, f); return (u + 0x7fffu + ((u >> 16) & 1u)) >> 16; }
__device__ __forceinline__ unsigned pk2(float lo, float hi) { return f2bf(lo) | (f2bf(hi) << 16); }
__device__ __forceinline__ float bf2f(unsigned short b) { return __builtin_bit_cast(float, ((unsigned)b) << 16); }
__device__ __forceinline__ float bflo(unsigned w) { return __builtin_bit_cast(float, w << 16); }
__device__ __forceinline__ float bfhi(unsigned w) { return __builtin_bit_cast(float, w & 0xffff0000u); }
__device__ __forceinline__ f32x4 ld_bf4(const bf16* p) { const u32x2 w = *(const u32x2*)p; return (f32x4){bflo(w.x), bfhi(w.x), bflo(w.y), bfhi(w.y)}; }
__device__ __forceinline__ float wave_sum(float v) {
#pragma unroll
    for (int o = 1; o < 64; o <<= 1) v += __shfl_xor(v, o);
    return v;
}
__device__ __forceinline__ float half_sum(float v) {
#pragma unroll
    for (int o = 1; o < 32; o <<= 1) v += __shfl_xor(v, o);
    return v;
}
__device__ __forceinline__ float sigmoidf_(float x) { return 1.f / (1.f + __expf(-x)); }
__device__ __forceinline__ float siluf_(float x) { return x / (1.f + __expf(-x)); }
__device__ __forceinline__ float logsigmoidf_(float x) { return fminf(x, 0.f) - __logf(1.f + __expf(-fabsf(x))); }

struct Args { const float* in[26]; float* out; unsigned char* ws; int ph_lo, ph_hi; };

struct Frame {
    LAS unsigned char* lds;
    int tid, lane, wave, G, gw, NGW;
    const float* const* in; float* out; unsigned char* ws;
};
#define F_X0(F) ((F).out)
#define F_X1(F) ((float*)((F).ws + WS_XM) - (size_t)ROW_M * DM)
#define F_XN(F) ((bf16*)((F).ws + WS_XN))
#define F_XG(F) ((bf16*)((F).ws + WS_XG))
#define F_SSQ(F) ((float*)((F).ws + WS_SSQ))
#define F_Z(F) ((bf16*)((F).ws + WS_Z))
#define F_ZS1(F, layer) ((bf16*)((F).ws + ((layer) == 0 ? WS_ZS : WS_ZS2)) - (size_t)ROW_S * 4096)
#define F_HS1(F) ((bf16*)((F).ws + WS_HS) - (size_t)ROW_S * DFF)
#define ZROW(F, row, layer) (((row) < ROW_S ? F_Z(F) : F_ZS1(F, layer)) + (size_t)(row) * 4096)
#define F_GT(F) ((float*)((F).ws + WS_G))
#define F_SBL(F) ((float*)((F).ws + WS_SBL))
#define F_SBF(F) ((float*)((F).ws + WS_SBF))
__device__ __forceinline__ float* xrow(const Frame& F, int r) { return (r < ROW_M ? F_X0(F) : F_X1(F)) + (size_t)r * DM; }

__device__ __forceinline__ void p0_transpose_item(const float* W, int K, int Nsrc, int n0src, bf16* WT, int dstrow0, LAS float* scr, int kb, int lane) {
    const int k0 = 64 * kb;
#pragma unroll 8
    for (int i = 0; i < 32; ++i) { const int kk = 2 * i + (lane >> 5); scr[kk * 33 + (lane & 31)] = W[(size_t)(k0 + kk) * Nsrc + n0src + (lane & 31)]; }
    LDS_WAIT(); asm volatile("" ::: "memory");
    const int c = lane & 7;
#pragma unroll
    for (int j = 0; j < 4; ++j) { const int n = (lane >> 3) + 8 * j; const LAS float* s = scr + (8 * c) * 33 + n;
        u32x4 o; o.x = pk2(s[0 * 33], s[1 * 33]); o.y = pk2(s[2 * 33], s[3 * 33]); o.z = pk2(s[4 * 33], s[5 * 33]); o.w = pk2(s[6 * 33], s[7 * 33]);
        *(u32x4*)(WT + (size_t)(dstrow0 + n) * K + k0 + 8 * c) = o; }
    LDS_WAIT(); asm volatile("" ::: "memory");
}

__device__ __forceinline__ void p0_weights(Frame& F) {
    LAS float* scr = (LAS float*)(F.lds + F.wave * 16384);
    constexpr int I_AB = 16 * 128, I_O = 16 * 32, I_C = 16 * 128, I_F1 = 16 * 176, I_F2 = 44 * 32;
    constexpr int NIT = I_AB + I_O + I_C + I_O + 2 * I_F1 + 2 * I_F2;
    for (int it = F.gw; it < NIT; it += F.NGW) {
        int r = it;
        if (r < I_AB) { const int kb = r / 128, nb = r % 128; p0_transpose_item(F.in[10], 1024, ABW, nb < 64 ? 32 * nb : 32 * nb + 8, (bf16*)(F.ws + WS_WAB), 32 * nb, scr, kb, F.lane); continue; } r -= I_AB;
        if (r < I_O) { const int kb = r / 32, nb = r % 32; p0_transpose_item(F.in[15], 1024, 1024, 32 * nb, (bf16*)(F.ws + WS_WOAB), 32 * nb, scr, kb, F.lane); continue; } r -= I_O;
        if (r < I_C) { const int kb = r / 128, nb = r % 128; p0_transpose_item(F.in[17], 1024, 4096, 32 * nb, (bf16*)(F.ws + WS_WC), 32 * nb, scr, kb, F.lane); continue; } r -= I_C;
        if (r < I_O) { const int kb = r / 32, nb = r % 32; p0_transpose_item(F.in[19], 1024, 1024, 32 * nb, (bf16*)(F.ws + WS_WOC), 32 * nb, scr, kb, F.lane); continue; } r -= I_O;
        if (r < 2 * I_F1) { const int l = r / I_F1; r -= l * I_F1; const int kb = r / 176, nb = r % 176; const int c = 32 * nb;
            const int ch = c < DFF ? c : c - DFF; const int dst = 256 * (ch / 128) + (c < DFF ? 0 : 128) + (ch % 128);
            p0_transpose_item(F.in[21] + (size_t)l * 1024 * NFF, 1024, NFF, c, (bf16*)(F.ws + WS_WF1) + (size_t)l * NFF * 1024, dst, scr, kb, F.lane); continue; } r -= 2 * I_F1;
        { const int l = r / I_F2; r -= l * I_F2; const int kb = r / 32, nb = r % 32;
            p0_transpose_item(F.in[24] + (size_t)l * DFF * 1024, DFF, 1024, 32 * nb, (bf16*)(F.ws + WS_WF2) + (size_t)l * 1024 * DFF, 32 * nb, scr, kb, F.lane); }
    }
}

__device__ __forceinline__ void p0_rows(Frame& F) {
    LAS float* wg = (LAS float*)F.lds;
    for (int i = F.tid; i < 8192; i += NWAVES * 64) { const int k = i >> 3, c = i & 7; wg[c * 1024 + k] = F.in[10][(size_t)k * ABW + 2048 + c]; }
    __syncthreads();
    const float* gain = F.in[9];
    for (int r = F.gw; r < MPAD; r += F.NGW) {
        const float* src = nullptr;
        if (r < ROW_S) src = F.in[0] + (size_t)r * DM; else if (r < ROW_M) src = F.in[1] + (size_t)(r - ROW_S) * DM; else if (r < NREAL) src = F.in[8] + (size_t)(r - ROW_M) * DM;
        f32x4 v[4]; float ss = 0.f;
#pragma unroll
        for (int j = 0; j < 4; ++j) { v[j] = src ? *(const f32x4*)(src + 4 * F.lane + 256 * j) : (f32x4){0.f, 0.f, 0.f, 0.f}; ss += (v[j].x * v[j].x + v[j].y * v[j].y) + (v[j].z * v[j].z + v[j].w * v[j].w); }
        const float rs = rsqrtf(wave_sum(ss) * (1.f / DM) + EPS);
        float* xr = xrow(F, r); bf16* xn = F_XG(F) + (size_t)r * DM;
        float ga[8];
#pragma unroll
        for (int c = 0; c < 8; ++c) ga[c] = 0.f;
#pragma unroll
        for (int j = 0; j < 4; ++j) {
            *(f32x4*)(xr + 4 * F.lane + 256 * j) = v[j];
            const f32x4 gn = *(const f32x4*)(gain + 4 * F.lane + 256 * j);
            const f32x4 y = v[j] * rs * gn;
            u32x2 w; w.x = pk2(y.x, y.y); w.y = pk2(y.z, y.w);
            *(u32x2*)(xn + 4 * F.lane + 256 * j) = w;
#pragma unroll
            for (int c = 0; c < 8; ++c) { const f32x4 wv = *(const LAS f32x4*)(wg + c * 1024 + 4 * F.lane + 256 * j); ga[c] += (y.x * wv.x + y.y * wv.y) + (y.z * wv.z + y.w * wv.w); }
        }
#pragma unroll
        for (int c = 0; c < 8; ++c) ga[c] = wave_sum(ga[c]);
        if (F.lane == 0) { *(f32x4*)(F_GT(F) + (size_t)r * 8) = (f32x4){ga[0], ga[1], ga[2], ga[3]}; *(f32x4*)(F_GT(F) + (size_t)r * 8 + 4) = (f32x4){ga[4], ga[5], ga[6], ga[7]}; }
    }
}

__device__ __forceinline__ void rms_final(Frame& F, const float* gain) {
    for (int r = F.gw; r < ROW_M; r += F.NGW) {
        float* xr = F_X0(F) + (size_t)r * DM; f32x4 v[4]; float ss = 0.f;
#pragma unroll
        for (int j = 0; j < 4; ++j) { v[j] = *(const f32x4*)(xr + 4 * F.lane + 256 * j); ss += (v[j].x * v[j].x + v[j].y * v[j].y) + (v[j].z * v[j].z + v[j].w * v[j].w); }
        const float rs = rsqrtf(wave_sum(ss) * (1.f / DM) + EPS);
#pragma unroll
        for (int j = 0; j < 4; ++j) { const f32x4 gn = *(const f32x4*)(gain + 4 * F.lane + 256 * j); *(f32x4*)(xr + 4 * F.lane + 256 * j) = v[j] * rs * gn; }
    }
}

struct EpiFfn {
    static constexpr bool PERM = true, AFTER_DRAIN = false;
    bf16* H0; bf16* H1; const float* cw; const float* cb; const float* cst; float* cso; float* sbl; float* sbf; const float* ssq;
    __device__ __forceinline__ void operator()(f32x4 (&acc)[2][2][4][2], const pg8::Unit& u, int wr, int wc, int fr, int fq) const {
        bf16* H = (u.pm < 64) ? H0 : H1;
        const int ch0 = 128 * u.pn + 32 * wc + 8 * fq;
        const int tok0 = 256 * u.pm + 128 * wr + 8 * fr;
        const int grp = 2 * u.pm + wr;
        const bool samp = (u.pm >= 64 && u.pm < PM_META), meta = (u.pm == PM_META);
        const int sb = 32 * (u.pm - 64) + 16 * wr + fr;
        const bool defer = (!samp && !meta && fr == 0);
        const bool lastlane = meta ? (wr == 0 && fr == 1) : (!samp && fr == 15);
#pragma unroll
        for (int k = 0; k < 8; ++k) { const float rs = pg8::row_rs(ssq, tok0 + k, fq);
#pragma unroll
            for (int bj = 0; bj < 2; ++bj)
#pragma unroll
                for (int n = 0; n < 2; ++n) acc[k >> 2][bj][k & 3][n] = acc[k >> 2][bj][k & 3][n] * rs; }
#pragma unroll
        for (int n = 0; n < 2; ++n) {
            const int c4 = ch0 + 4 * n;
            const f32x4 w0 = *(const f32x4*)(cw + c4), w1 = *(const f32x4*)(cw + DFF + c4), w2 = *(const f32x4*)(cw + 2 * DFF + c4), bb = *(const f32x4*)(cb + c4);
            f32x4 p6, p7;
#pragma unroll
            for (int e = 0; e < 4; ++e) { p6[e] = __shfl_up(acc[1][0][2][n][e], 1, 16); p7[e] = __shfl_up(acc[1][0][3][n][e], 1, 16); }
            if (samp) { p6 = *(const f32x4*)(cst + (size_t)(sb * 2 + 0) * DFF + c4); p7 = *(const f32x4*)(cst + (size_t)(sb * 2 + 1) * DFF + c4); }
            if (meta && wr == 0 && fr == 0) { p6 = (f32x4){0.f, 0.f, 0.f, 0.f}; p7 = p6; }
#pragma unroll
            for (int k = 0; k < 8; ++k) {
                const f32x4 uk = acc[k >> 2][0][k & 3][n], gk = acc[k >> 2][1][k & 3][n];
                const f32x4 um1 = (k >= 1) ? acc[(k - 1 < 0 ? 0 : k - 1) >> 2][0][(k - 1 < 0 ? 0 : k - 1) & 3][n] : p7;
                const f32x4 um2 = (k >= 2) ? acc[(k - 2 < 0 ? 0 : k - 2) >> 2][0][(k - 2 < 0 ? 0 : k - 2) & 3][n] : (k == 1 ? p7 : p6);
                const f32x4 cv = bb + w0 * um2 + w1 * um1 + w2 * uk;
                f32x4 hv;
#pragma unroll
                for (int e = 0; e < 4; ++e) hv[e] = siluf_(cv[e]) * gk[e];
                if (defer && k < 2) {
                    *(f32x4*)(sbf + (size_t)((grp * 2 + k) * 2 + 0) * DFF + c4) = uk;
                    *(f32x4*)(sbf + (size_t)((grp * 2 + k) * 2 + 1) * DFF + c4) = gk;
                } else {
                    u32x2 w; w.x = pg8::cvt_pk_bf16(hv[0], hv[1]); w.y = pg8::cvt_pk_bf16(hv[2], hv[3]);
                    *(u32x2*)(H + (size_t)(tok0 + k) * DFF + c4) = w;
                }
            }
            if (lastlane) { *(f32x4*)(sbl + (size_t)(grp * 2 + 0) * DFF + c4) = acc[1][0][2][n]; *(f32x4*)(sbl + (size_t)(grp * 2 + 1) * DFF + c4) = acc[1][0][3][n]; }
            if (samp) { *(f32x4*)(cso + (size_t)(sb * 2 + 0) * DFF + c4) = acc[1][0][2][n]; *(f32x4*)(cso + (size_t)(sb * 2 + 1) * DFF + c4) = acc[1][0][3][n]; }
        }
    }
};

__device__ __forceinline__ void ffn_fixup(Frame& F, int layer) {
    const float* cw = F.in[22] + (size_t)layer * 3 * DFF; const float* cb = F.in[23] + (size_t)layer * DFF;
    bf16* H = F_Z(F);
    const int gt = blockIdx.x * (NWAVES * 64) + F.tid, NT = F.G * NWAVES * 64;
    for (int i = gt; i < 128 * DFF; i += NT) {
        const int grp = i / DFF, ch = i - grp * DFF;
        const int r0 = 128 * grp;
        const int pg = (r0 % 2048 == 0) ? GRP_META : grp - 1;
        const float um2 = F_SBL(F)[(size_t)(pg * 2 + 0) * DFF + ch], um1 = F_SBL(F)[(size_t)(pg * 2 + 1) * DFF + ch];
        const float u0 = F_SBF(F)[(size_t)((grp * 2 + 0) * 2 + 0) * DFF + ch], g0 = F_SBF(F)[(size_t)((grp * 2 + 0) * 2 + 1) * DFF + ch];
        const float u1 = F_SBF(F)[(size_t)((grp * 2 + 1) * 2 + 0) * DFF + ch], g1 = F_SBF(F)[(size_t)((grp * 2 + 1) * 2 + 1) * DFF + ch];
        const float w0 = cw[ch], w1 = cw[DFF + ch], w2 = cw[2 * DFF + ch], bb = cb[ch];
        const float c0 = bb + w0 * um2 + w1 * um1 + w2 * u0, c1 = bb + w0 * um1 + w1 * u0 + w2 * u1;
        H[(size_t)r0 * DFF + ch] = (bf16)f2bf(siluf_(c0) * g0);
        H[(size_t)(r0 + 1) * DFF + ch] = (bf16)f2bf(siluf_(c1) * g1);
    }
    float* fo = F.out + O_FP + (size_t)layer * 8 * 2 * DFF;
    for (int i = gt; i < 8 * 2 * DFF; i += NT) {
        const int b = i / (2 * DFF), rem = i - b * 2 * DFF, j = rem / DFF, ch = rem - j * DFF;
        const int grp = 2 * (8 * b + 7) + 1;
        fo[i] = F_SBL(F)[(size_t)(grp * 2 + j) * DFF + ch];
    }
}
typedef short bf16x8 __attribute__((ext_vector_type(8)));
typedef short v4i16_t __attribute__((ext_vector_type(4)));
constexpr int MX_PITCH = 272;
constexpr int MX_Q = 0, MX_K = 17408, MX_KH = 34816, MX_V = 52224, MX_GD = 69632  , MX_SC = 71680  , MX_OB = 74752  , MX_RP = 108544  , MX_DI = 110592  , MX_GN = 110848  , MX_LB = 111360  , MX_END = 111872;
constexpr int MX_OP = 132;
constexpr float LNKS = -2.4260151319598084f;
static_assert(MX_END <= 139264, "mixer LDS map");

__device__ __forceinline__ bf16x8 mk8(unsigned a, unsigned b, unsigned c, unsigned d) { const u32x4 v = {a, b, c, d}; return __builtin_bit_cast(bf16x8, v); }
__device__ __forceinline__ u32x2 tr16(const LAS unsigned char* p) { return __builtin_bit_cast(u32x2, __builtin_amdgcn_ds_read_tr16_b64_v4i16((LAS v4i16_t*)p)); }
typedef float f32x2_t __attribute__((ext_vector_type(2))); typedef __bf16 bf16x2_t __attribute__((ext_vector_type(2)));
__device__ __forceinline__ unsigned pkbf(float lo, float hi) { const f32x2_t v = {lo, hi}; const bf16x2_t b = __builtin_convertvector(v, bf16x2_t); return __builtin_bit_cast(unsigned, b); }
#define MFMA16(a, b, c) __builtin_amdgcn_mfma_f32_16x16x32_bf16((a), (b), (c), 0, 0, 0)
typedef short s16x4 __attribute__((ext_vector_type(4)));
__device__ __forceinline__ f32x4 mfma16k16(u32x2 a, u32x2 b, f32x4 c) { const u32x4 a4 = {a.x, a.y, 0u, 0u}, b4 = {b.x, b.y, 0u, 0u}; return __builtin_amdgcn_mfma_f32_16x16x32_bf16(__builtin_bit_cast(bf16x8, a4), __builtin_bit_cast(bf16x8, b4), c, 0, 0, 0); }
__device__ __forceinline__ bf16x8 ld8(const LAS unsigned char* p) { return __builtin_bit_cast(bf16x8, *(const LAS u32x4*)p); }
#define MX_POS4(d) (((d) & ~31) + 8 * ((((d) & 15)) >> 2) + 4 * (((d) >> 4) & 1))
template <int CTRL> __device__ __forceinline__ float dppf(float ident, float x) { return __builtin_bit_cast(float, __builtin_amdgcn_update_dpp(__builtin_bit_cast(int, ident), __builtin_bit_cast(int, x), CTRL, 0xf, 0xf, false)); }
__device__ __forceinline__ float row_prefix_sum(float x) { x += dppf<0x111>(0.f, x); x += dppf<0x112>(0.f, x); x += dppf<0x114>(0.f, x); x += dppf<0x118>(0.f, x); return x; }
__device__ __forceinline__ float row_prefix_max(float x) { x = fmaxf(x, dppf<0x111>(-3e38f, x)); x = fmaxf(x, dppf<0x112>(-3e38f, x)); x = fmaxf(x, dppf<0x114>(-3e38f, x)); x = fmaxf(x, dppf<0x118>(-3e38f, x)); return x; }
__device__ __forceinline__ float row_prefix_prod(float x) { x *= dppf<0x111>(1.f, x); x *= dppf<0x112>(1.f, x); x *= dppf<0x114>(1.f, x); x *= dppf<0x118>(1.f, x); return x; }
__device__ __forceinline__ float row_suffix_prod(float x) { x *= dppf<0x101>(1.f, x); x *= dppf<0x102>(1.f, x); x *= dppf<0x104>(1.f, x); x *= dppf<0x108>(1.f, x); return x; }
__device__ __forceinline__ float rdlane(float x, int l) { return __builtin_bit_cast(float, __builtin_amdgcn_readlane(__builtin_bit_cast(int, x), l)); }

constexpr int ROT_N = 2072;
__device__ __forceinline__ void p0_rotary(Frame& F, float* tab) {
    const int gt = blockIdx.x * (NWAVES * 64) + F.tid, NT = F.G * NWAVES * 64;
    for (int i = gt; i < ROT_N * 64; i += NT) {
        const int pi = i >> 6, fi = i & 63;
        const float pos = pi < 2064 ? (float)pi : (float)(16384 + pi - 2064);
        const float inv = exp2f((float)fi * (-13.287712379549449f / 63.0f));
        float sn, cs; sincosf(pos * inv, &sn, &cs);
        tab[2 * i] = cs; tab[2 * i + 1] = sn;
    }
}

#ifdef PROBE_BLOCK
#define MSTAMP_DECL unsigned long long t_last_ = __builtin_amdgcn_s_memrealtime();
#define MSTAMP(id) do { if (blockIdx.x == PROBE_BLOCK && tid == 0) { const unsigned long long t_now_ = __builtin_amdgcn_s_memrealtime(); volatile LAS unsigned long long* a_ = (volatile LAS unsigned long long*)(F.lds + 139264 + 128) + 48 + (id); *a_ = *a_ + (t_now_ - t_last_); t_last_ = t_now_; } } while (0)
#else
#define MSTAMP_DECL
#define MSTAMP(id) do { } while (0)
#endif
#define MX_SC_PARAMS(scv, row0, ntok, nmc, pos0) do { if (mode != 1) { if ((scv) == 0) { row0 = ROW_M; ntok = 16; nmc = 1; pos0 = 0; } else { row0 = b * 2048 + ((scv) - 1) * 64; ntok = 64; nmc = 4; pos0 = 16 + ((scv) - 1) * 64; } } \
        else { row0 = ROW_S + 8 * b; ntok = 8; nmc = 1; pos0 = 2064; } } while (0)

template <int TYPE, int NMC>
__device__ __forceinline__ void sg_chain(LAS unsigned char* L, LAS float* SC, f32x4 (&S)[8], f32x4& nacc, int w, int r16, int q) {
    LAS float* OB = (LAS float*)(L + MX_OB); LAS float* RP = (LAS float*)(L + MX_RP); LAS float* DI = (LAS float*)(L + MX_DI);
    f32x4 oo[4];
#pragma unroll
    for (int mc = 0; mc < NMC; ++mc) {
        oo[mc] = (f32x4){0.f, 0.f, 0.f, 0.f};
        {
            const LAS unsigned char* Qb = L + MX_Q + 16 * mc * MX_PITCH; const LAS unsigned char* Kb = L + MX_K + 16 * mc * MX_PITCH; const LAS unsigned char* Vb = L + MX_V + 16 * mc * MX_PITCH;
            f32x4 g0 = {0.f, 0.f, 0.f, 0.f}, g1 = {0.f, 0.f, 0.f, 0.f};
#pragma unroll
            for (int ks = 0; ks < 4; ++ks) {
                const bf16x8 kf = ld8(Kb + r16 * MX_PITCH + (32 * ks + 8 * q) * 2), qf = ld8(Qb + r16 * MX_PITCH + (32 * ks + 8 * q) * 2);
                if (ks & 1) g1 = MFMA16(kf, qf, g1); else g0 = MFMA16(kf, qf, g0);
            }
            const f32x4 g = g0 + g1;
            const float xi = SC[mc * 16 + r16]; const f32x4 y4 = *(const LAS f32x4*)(SC + 64 + mc * 16 + 4 * q);
            f32x4 P;
#pragma unroll
            for (int r = 0; r < 4; ++r) P[r] = (4 * q + r <= r16) ? g[r] * __expf(xi + y4[r]) : 0.f;
            if (TYPE == 0) { float ps = (P[0] + P[1]) + (P[2] + P[3]); ps += __shfl_xor(ps, 16); ps += __shfl_xor(ps, 32); if (w == 0 && q == 0) DI[16 * mc + r16] = ps; }
            const u32x2 vt = tr16(Vb + (4 * q + (r16 >> 2)) * MX_PITCH + (16 * w + 4 * (r16 & 3)) * 2);
            oo[mc] = mfma16k16((u32x2){pkbf(P[0], P[1]), pkbf(P[2], P[3])}, vt, oo[mc]);
        }
        if (mc == 1 || TYPE == 1) __builtin_amdgcn_sched_barrier(0);
    }
#pragma unroll
    for (int mc = 0; mc < NMC; ++mc) {
        {
            const LAS unsigned char* Qb = L + MX_Q + 16 * mc * MX_PITCH; const LAS unsigned char* Kb = L + MX_K + 16 * mc * MX_PITCH;
            const u32x2 vt = tr16(L + MX_V + 16 * mc * MX_PITCH + (4 * q + (r16 >> 2)) * MX_PITCH + (16 * w + 4 * (r16 & 3)) * 2);
            f32x4 o2a = {0.f, 0.f, 0.f, 0.f}, o2b = {0.f, 0.f, 0.f, 0.f};
#pragma unroll
            for (int ks = 0; ks < 4; ++ks) {
                const bf16x8 qf = ld8(Qb + r16 * MX_PITCH + (32 * ks + 8 * q) * 2);
                const bf16x8 SB = mk8(pkbf(S[2 * ks][0], S[2 * ks][1]), pkbf(S[2 * ks][2], S[2 * ks][3]), pkbf(S[2 * ks + 1][0], S[2 * ks + 1][1]), pkbf(S[2 * ks + 1][2], S[2 * ks + 1][3]));
                if (ks & 1) o2b = MFMA16(qf, SB, o2b); else o2a = MFMA16(qf, SB, o2a);
            }
            const f32x4 in4 = *(const LAS f32x4*)(SC + 128 + mc * 16 + 4 * q);
            oo[mc] = oo[mc] + in4 * (o2a + o2b);
            const f32x4 w4 = *(const LAS f32x4*)(SC + 192 + mc * 16 + 4 * q); const float carry = SC[320 + mc];
            if (TYPE == 0) {
                const u32x2 qn = *(const LAS u32x2*)(Qb + r16 * MX_PITCH + MX_POS4(16 * w + 4 * q) * 2);
                f32x4 rr = {0.f, 0.f, 0.f, 0.f}; rr = mfma16k16(qn, (u32x2){pkbf(nacc[0], nacc[1]), pkbf(nacc[2], nacc[3])}, rr);
                if (r16 == 0) {
#pragma unroll
                    for (int r = 0; r < 4; ++r) RP[w * 64 + 16 * mc + 4 * q + r] = rr[r]; }
            }
#pragma unroll
            for (int r = 0; r < 4; ++r) OB[(16 * mc + 4 * q + r) * MX_OP + 16 * w + r16] = oo[mc][r];
            const u32x2 VH = {pkbf(bflo(vt.x) * w4[0], bfhi(vt.x) * w4[1]), pkbf(bflo(vt.y) * w4[2], bfhi(vt.y) * w4[3])};
#pragma unroll
            for (int mt = 0; mt < 8; ++mt) {
                const u32x2 kt = tr16(Kb + (4 * q + (r16 >> 2)) * MX_PITCH + MX_POS4(16 * mt + 4 * (r16 & 3)) * 2);
                S[mt] = S[mt] * carry; S[mt] = mfma16k16(kt, VH, S[mt]);
            }
            if (TYPE == 0) {
                const u32x2 kt = tr16(Kb + (4 * q + (r16 >> 2)) * MX_PITCH + MX_POS4(16 * w + 4 * (r16 & 3)) * 2);
                nacc = nacc * carry; nacc = mfma16k16(kt, (u32x2){pkbf(w4[0], w4[1]), pkbf(w4[2], w4[3])}, nacc);
            }
        }
        if (mc + 1 < NMC) __builtin_amdgcn_sched_barrier(0);
    }
}

template <int TYPE>
__device__ __forceinline__ void mix_sg_unit(Frame& F, int b, int h, int mode  , const float* rot) {
    const bool prompt = (mode != 1);
    const int tid = F.tid, lane = F.lane, w = F.wave, r16 = lane & 15, q = lane >> 4;
    const int tk = tid >> 3, p = tid & 7;
    LAS unsigned char* L = F.lds;
    LAS float* OB = (LAS float*)(L + MX_OB); LAS float* RP = (LAS float*)(L + MX_RP); LAS float* DI = (LAS float*)(L + MX_DI);
    bf16* MIX = F_XN(F);
    const int qcol = (TYPE == 0 ? 0 : 2048) + 128 * h, kcol = (TYPE == 0 ? 512 : 2560) + 128 * h, vcol = (TYPE == 0 ? 1024 : 3072) + 128 * h, gcol = (TYPE == 0 ? 1536 : 3584) + 128 * h, mcol = (TYPE == 0 ? 0 : 512) + 128 * h;
    f32x4 S[8]; f32x4 nacc = {0.f, 0.f, 0.f, 0.f}; float m0 = 0.f;
#pragma unroll
    for (int mt = 0; mt < 8; ++mt) S[mt] = (f32x4){0.f, 0.f, 0.f, 0.f};
    if (!prompt) {
        const float* Sin = (TYPE == 0 ? F.in[2] : F.in[5]) + (size_t)(b * 4 + h) * 16384;
#pragma unroll
        for (int mt = 0; mt < 8; ++mt)
#pragma unroll
            for (int r = 0; r < 4; ++r) S[mt][r] = Sin[(16 * mt + 4 * q + r) * 128 + 16 * w + r16];
        if (TYPE == 0) {
#pragma unroll
            for (int r = 0; r < 4; ++r) nacc[r] = F.in[3][(size_t)(b * 4 + h) * 128 + 16 * w + 4 * q + r];
            m0 = F.in[4][b * 4 + h];
        }
    }
    const float lgam = (TYPE != 1) ? 0.f : h == 0 ? -0.031748698314580298f : h == 1 ? -0.015748356968139168f : h == 2 ? -0.0078431774610258928f : -0.0039138993211363287f;
    const float bias_i = (TYPE == 0) ? F.in[11][h] : 0.f, bias_f = (TYPE == 0) ? F.in[12][h] : 0.f;
    LAS float* GN = (LAS float*)(L + MX_GN);
    if (tid < 128) GN[tid] = (TYPE == 0 ? F.in[13] : F.in[14])[128 * h + tid];
    const int nsc = (mode == 0) ? 33 : 1;
    u32x4 pa[6]; f32x4 pr[4]; float pli = 0.f, plf = 0.f; u32x4 pg[2];
    const u32x4 z4 = {0u, 0u, 0u, 0u};
#define SG_LOAD(scv) do { int row0_, ntok_, nmc_, pos0_; MX_SC_PARAMS(scv, row0_, ntok_, nmc_, pos0_); (void)nmc_; \
        const bool valid_ = tk < ntok_; const bf16* zr_ = ZROW(F, row0_ + (valid_ ? tk : 0), 0); \
        _Pragma("unroll") for (int i_ = 0; i_ < 6; ++i_) pa[i_] = z4; \
        if (valid_) { pa[4] = *(const u32x4*)(zr_ + vcol + 16 * p); pa[5] = *(const u32x4*)(zr_ + vcol + 16 * p + 8); \
            if (TYPE == 0) { pa[0] = *(const u32x4*)(zr_ + qcol + 16 * p); pa[1] = *(const u32x4*)(zr_ + qcol + 16 * p + 8); pa[2] = *(const u32x4*)(zr_ + kcol + 16 * p); pa[3] = *(const u32x4*)(zr_ + kcol + 16 * p + 8); } \
            else { pa[0] = *(const u32x4*)(zr_ + qcol + 8 * p); pa[1] = *(const u32x4*)(zr_ + qcol + 64 + 8 * p); pa[2] = *(const u32x4*)(zr_ + kcol + 8 * p); pa[3] = *(const u32x4*)(zr_ + kcol + 64 + 8 * p); } } \
        if (TYPE == 1) { const float* tb_ = rot + ((size_t)(pos0_ + (valid_ ? tk : 0)) * 64 + 8 * p) * 2; _Pragma("unroll") for (int e_ = 0; e_ < 4; ++e_) pr[e_] = *(const f32x4*)(tb_ + 4 * e_); } \
        if (TYPE == 0 && w == 0) { const bool vt_ = lane < ntok_; const float* gp_ = F_GT(F) + (size_t)(row0_ + (vt_ ? lane : 0)) * 8; pli = gp_[h]; plf = gp_[4 + h]; } } while (0)
    SG_LOAD(0);
    MSTAMP_DECL
#pragma unroll 1
    for (int sc = 0; sc < nsc; ++sc) {
        int row0, ntok, nmc, pos0; MX_SC_PARAMS(sc, row0, ntok, nmc, pos0); (void)pos0;
        LAS float* SC = (LAS float*)(L + MX_SC) + (sc & 1) * 384;
        MSTAMP(0);
        {
            *(LAS u32x4*)(L + MX_V + tk * MX_PITCH + 32 * p) = pa[4]; *(LAS u32x4*)(L + MX_V + tk * MX_PITCH + 32 * p + 16) = pa[5];
            if (TYPE == 0) {
                const int c0 = (MX_POS4(16 * p)) * 2;
#pragma unroll
                for (int g = 0; g < 4; ++g) {
                    *(LAS u32x2*)(L + MX_Q + tk * MX_PITCH + c0 + 16 * g) = (u32x2){pa[g >> 1][2 * (g & 1)], pa[g >> 1][2 * (g & 1) + 1]};
                    *(LAS u32x2*)(L + MX_K + tk * MX_PITCH + c0 + 16 * g) = (u32x2){pa[2 + (g >> 1)][2 * (g & 1)], pa[2 + (g >> 1)][2 * (g & 1) + 1]};
                }
            } else {
                u32x4 q1, q2, k1, k2;
#pragma unroll
                for (int e2 = 0; e2 < 4; ++e2) {
                    const f32x4 cs = pr[e2];
                    { const float x1l = bflo(pa[0][e2]), x1h = bfhi(pa[0][e2]), x2l = bflo(pa[1][e2]), x2h = bfhi(pa[1][e2]);
                      q1[e2] = pkbf(x1l * cs[0] - x2l * cs[1], x1h * cs[2] - x2h * cs[3]); q2[e2] = pkbf(x2l * cs[0] + x1l * cs[1], x2h * cs[2] + x1h * cs[3]); }
                    { const float x1l = bflo(pa[2][e2]), x1h = bfhi(pa[2][e2]), x2l = bflo(pa[3][e2]), x2h = bfhi(pa[3][e2]);
                      k1[e2] = pkbf(x1l * cs[0] - x2l * cs[1], x1h * cs[2] - x2h * cs[3]); k2[e2] = pkbf(x2l * cs[0] + x1l * cs[1], x2h * cs[2] + x1h * cs[3]); }
                }
                const int c0 = (MX_POS4(8 * p)) * 2;
                *(LAS u32x2*)(L + MX_Q + tk * MX_PITCH + c0) = (u32x2){q1[0], q1[1]}; *(LAS u32x2*)(L + MX_Q + tk * MX_PITCH + c0 + 16) = (u32x2){q1[2], q1[3]};
                *(LAS u32x2*)(L + MX_Q + tk * MX_PITCH + c0 + 128) = (u32x2){q2[0], q2[1]}; *(LAS u32x2*)(L + MX_Q + tk * MX_PITCH + c0 + 144) = (u32x2){q2[2], q2[3]};
                *(LAS u32x2*)(L + MX_K + tk * MX_PITCH + c0) = (u32x2){k1[0], k1[1]}; *(LAS u32x2*)(L + MX_K + tk * MX_PITCH + c0 + 16) = (u32x2){k1[2], k1[3]};
                *(LAS u32x2*)(L + MX_K + tk * MX_PITCH + c0 + 128) = (u32x2){k2[0], k2[1]}; *(LAS u32x2*)(L + MX_K + tk * MX_PITCH + c0 + 144) = (u32x2){k2[2], k2[3]};
            }
        }
        if (w == 0) {
            const bool valid = lane < ntok;
            float li = -1e30f, lf = 0.f;
            if (TYPE == 0) { if (valid) { li = pli + bias_i; lf = logsigmoidf_(plf + bias_f); } } else { if (valid) { li = 0.f; lf = lgam; } }
            const float bb = row_prefix_sum(lf);
            const float y = li - bb;
            const float am = row_prefix_max(y);
            const float a = bb + am;
            const float B0 = rdlane(bb, 15), B1 = rdlane(bb, 31), B2 = rdlane(bb, 47), B3 = rdlane(bb, 63);
            float M1 = 0.f, M2 = 0.f, M3 = 0.f, M4 = 0.f;
            if (TYPE == 0) { const float A0 = rdlane(a, 15), A1 = rdlane(a, 31), A2 = rdlane(a, 47), A3 = rdlane(a, 63);
                M1 = fmaxf(B0 + m0, A0); M2 = fmaxf(B1 + M1, A1); M3 = fmaxf(B2 + M2, A2); M4 = fmaxf(B3 + M3, A3); }
            const float m0q = q == 0 ? m0 : q == 1 ? M1 : q == 2 ? M2 : M3;
            const float mnq = q == 0 ? M1 : q == 1 ? M2 : q == 2 ? M3 : M4;
            const float b15 = q == 0 ? B0 : q == 1 ? B1 : q == 2 ? B2 : B3;
            const float m = (TYPE == 0) ? fmaxf(bb + m0q, a) : 0.f;
            SC[lane] = bb - m; SC[64 + lane] = y + LNKS; SC[128 + lane] = __expf(bb + m0q - m);
            SC[192 + lane] = __expf(y + LNKS + b15 - mnq); SC[256 + lane] = __expf(-m);
            if (r16 == 0) SC[320 + q] = __expf(b15 + m0q - mnq);
            m0 = (nmc == 4) ? M4 : M1;
        }
        MSTAMP(1);
        __syncthreads();
        MSTAMP(2);
        if (sc + 1 < nsc) SG_LOAD(sc + 1);
        { const bool valid = tk < ntok; const bf16* zr = ZROW(F, row0 + (valid ? tk : 0), 0) + gcol + 16 * p; pg[0] = *(const u32x4*)zr; pg[1] = *(const u32x4*)(zr + 8); }
        MSTAMP(3);
        if (nmc == 4) sg_chain<TYPE, 4>(L, SC, S, nacc, w, r16, q); else sg_chain<TYPE, 1>(L, SC, S, nacc, w, r16, q);
        MSTAMP(4);
        __syncthreads();
        MSTAMP(6);
        {
            const bool valid = tk < ntok; const int row = row0 + (valid ? tk : 0);
            f32x4 o[4];
#pragma unroll
            for (int c = 0; c < 4; ++c) o[c] = *(const LAS f32x4*)(OB + tk * MX_OP + 16 * p + 4 * c);
            if (tk >= 16 * nmc) {
#pragma unroll
                for (int c = 0; c < 4; ++c) o[c] = (f32x4){0.f, 0.f, 0.f, 0.f}; }
            if (TYPE == 0) {
                float rs = 0.f;
#pragma unroll
                for (int ww = 0; ww < 8; ++ww) rs += RP[ww * 64 + tk];
                const float den = DI[tk] + SC[128 + tk] * rs;
                float dn = fmaxf(fabsf(den), SC[256 + tk]); if (tk >= 16 * nmc) dn = 1.f;
                const float rd = 1.f / dn;
#pragma unroll
                for (int c = 0; c < 4; ++c) o[c] = o[c] * rd;
            }
            float sm = 0.f;
#pragma unroll
            for (int c = 0; c < 4; ++c) sm += (o[c].x + o[c].y) + (o[c].z + o[c].w);
            sm += __shfl_xor(sm, 1); sm += __shfl_xor(sm, 2); sm += __shfl_xor(sm, 4);
            const float mu = sm * (1.f / 128.f); float vs = 0.f;
#pragma unroll
            for (int c = 0; c < 4; ++c) { o[c] = o[c] - mu; vs += (o[c].x * o[c].x + o[c].y * o[c].y) + (o[c].z * o[c].z + o[c].w * o[c].w); }
            vs += __shfl_xor(vs, 1); vs += __shfl_xor(vs, 2); vs += __shfl_xor(vs, 4);
            const float rstd = rsqrtf(vs * (1.f / 128.f) + EPS);
            if (valid && !(mode == 0 && sc == 0)) {
                unsigned ow[8];
#pragma unroll
                for (int c = 0; c < 4; ++c) {
                    const unsigned ga = c < 2 ? pg[0][2 * c] : pg[1][2 * c - 4], gb = c < 2 ? pg[0][2 * c + 1] : pg[1][2 * c - 3];
                    f32x4 gt = {bflo(ga), bfhi(ga), bflo(gb), bfhi(gb)};
#pragma unroll
                    for (int e = 0; e < 4; ++e) gt[e] = (TYPE == 0) ? sigmoidf_(gt[e]) : siluf_(gt[e]);
                    const f32x4 r = o[c] * rstd * *(const LAS f32x4*)(GN + 16 * p + 4 * c) * gt;
                    ow[2 * c] = pkbf(r.x, r.y); ow[2 * c + 1] = pkbf(r.z, r.w);
                }
                bf16* mp = MIX + (size_t)row * DM + mcol + 16 * p;
                *(u32x4*)mp = (u32x4){ow[0], ow[1], ow[2], ow[3]}; *(u32x4*)(mp + 8) = (u32x4){ow[4], ow[5], ow[6], ow[7]};
            }
        }
        MSTAMP(7);
    }
#undef SG_LOAD
    __syncthreads();
    if (mode != 2) {
        int l2 = F.lane; asm volatile("" : "+v"(l2)); const int r16 = l2 & 15, q = l2 >> 4;
        float* So = F.out + (TYPE == 0 ? (prompt ? O_CP : O_CS) : (prompt ? O_RP : O_RS)) + (size_t)(b * 4 + h) * 16384;
#pragma unroll
        for (int mt = 0; mt < 8; ++mt)
#pragma unroll
            for (int r = 0; r < 4; ++r) So[(16 * mt + 4 * q + r) * 128 + 16 * w + r16] = S[mt][r];
        if (TYPE == 0) {
            if (r16 == 0) { float* No = F.out + (prompt ? O_NP : O_NS) + (size_t)(b * 4 + h) * 128;
#pragma unroll
                for (int r = 0; r < 4; ++r) No[16 * w + 4 * q + r] = nacc[r]; }
            if (w == 0 && lane == 0) F.out[(prompt ? O_MP : O_MS) + b * 4 + h] = m0;
        }
    }
}

template <int NMC>
__device__ __forceinline__ void hg_chain(LAS unsigned char* L, f32x4 (&S)[8], int w, int r16, int q) {
    LAS float* GD = (LAS float*)(L + MX_GD); LAS float* OB = (LAS float*)(L + MX_OB);
    f32x4 oo[4];
#pragma unroll
    for (int mc = 0; mc < NMC; ++mc) {
        oo[mc] = (f32x4){0.f, 0.f, 0.f, 0.f};
        {
            const LAS unsigned char* Qb = L + MX_Q + 16 * mc * MX_PITCH; const LAS unsigned char* Kb = L + MX_K + 16 * mc * MX_PITCH; const LAS unsigned char* Vb = L + MX_V + 16 * mc * MX_PITCH;
            f32x4 g0 = {0.f, 0.f, 0.f, 0.f}, g1 = {0.f, 0.f, 0.f, 0.f};
#pragma unroll
            for (int ks = 0; ks < 4; ++ks) {
                const bf16x8 kf = ld8(Kb + r16 * MX_PITCH + (32 * ks + 8 * q) * 2), qf = ld8(Qb + r16 * MX_PITCH + (32 * ks + 8 * q) * 2);
                if (ks & 1) g1 = MFMA16(kf, qf, g1); else g0 = MFMA16(kf, qf, g0);
            }
            const f32x4 g = g0 + g1;
            f32x4 P;
#pragma unroll
            for (int r = 0; r < 4; ++r) P[r] = (4 * q + r <= r16) ? g[r] : 0.f;
            const u32x2 vt = tr16(Vb + (4 * q + (r16 >> 2)) * MX_PITCH + (16 * w + 4 * (r16 & 3)) * 2);
            oo[mc] = mfma16k16((u32x2){pkbf(P[0], P[1]), pkbf(P[2], P[3])}, vt, oo[mc]);
        }
        if (mc == 1) __builtin_amdgcn_sched_barrier(0);
    }
#pragma unroll
    for (int mc = 0; mc < NMC; ++mc) {
        {
            const LAS unsigned char* Qb = L + MX_Q + 16 * mc * MX_PITCH; const LAS unsigned char* Hb = L + MX_KH + 16 * mc * MX_PITCH;
            const u32x2 vt = tr16(L + MX_V + 16 * mc * MX_PITCH + (4 * q + (r16 >> 2)) * MX_PITCH + (16 * w + 4 * (r16 & 3)) * 2);
            f32x4 o2b = {0.f, 0.f, 0.f, 0.f};
#pragma unroll
            for (int ks = 0; ks < 4; ++ks) {
                const bf16x8 qf = ld8(Qb + r16 * MX_PITCH + (32 * ks + 8 * q) * 2);
                const bf16x8 SB = mk8(pkbf(S[2 * ks][0], S[2 * ks][1]), pkbf(S[2 * ks][2], S[2 * ks][3]), pkbf(S[2 * ks + 1][0], S[2 * ks + 1][1]), pkbf(S[2 * ks + 1][2], S[2 * ks + 1][3]));
                if (ks & 1) o2b = MFMA16(qf, SB, o2b); else oo[mc] = MFMA16(qf, SB, oo[mc]);
            }
            oo[mc] = oo[mc] + o2b;
#pragma unroll
            for (int mt = 0; mt < 8; ++mt) {
                const f32x4 gd = *(const LAS f32x4*)(GD + mc * 128 + 16 * mt + 4 * q);
                const u32x2 kt = tr16(Hb + (4 * q + (r16 >> 2)) * MX_PITCH + (16 * mt + 4 * (r16 & 3)) * 2);
                S[mt] = S[mt] * gd; S[mt] = mfma16k16(kt, vt, S[mt]);
            }
        }
        if (mc + 1 < NMC) __builtin_amdgcn_sched_barrier(0);
    }
#pragma unroll
    for (int mc = 0; mc < NMC; ++mc) {
        {
#pragma unroll
            for (int r = 0; r < 4; ++r) OB[(16 * mc + 4 * q + r) * MX_OP + 16 * w + r16] = oo[mc][r];
        }
    }
}

__device__ __forceinline__ void mix_hg_unit(Frame& F, int b, int h, int mode) {
    const bool prompt = (mode != 1);
    const int tid = F.tid, lane = F.lane, w = F.wave, r16 = lane & 15, q = lane >> 4;
    const int tk = tid >> 3, p = tid & 7;
    const int amc = w >> 1, app = q + 4 * (w & 1);
    LAS unsigned char* L = F.lds;
    LAS float* GD = (LAS float*)(L + MX_GD); LAS float* OB = (LAS float*)(L + MX_OB);
    bf16* MIX = F_XN(F);
    f32x4 S[8];
#pragma unroll
    for (int mt = 0; mt < 8; ++mt) S[mt] = (f32x4){0.f, 0.f, 0.f, 0.f};
    if (!prompt) {
        const float* Sin = F.in[6] + (size_t)(b * 8 + h) * 16384;
#pragma unroll
        for (int mt = 0; mt < 8; ++mt)
#pragma unroll
            for (int r = 0; r < 4; ++r) S[mt][r] = Sin[(16 * mt + 4 * q + r) * 128 + 16 * w + r16];
    }
    LAS float* GN = (LAS float*)(L + MX_GN); LAS float* LB = (LAS float*)(L + MX_LB);
    if (tid < 128) { GN[tid] = F.in[18][128 * h + tid]; LB[tid] = sigmoidf_(F.in[16][1024 + 128 * h + tid] - F.in[16][128 * h + tid]); }
    __syncthreads();
    const int nsc = (mode == 0) ? 33 : 1;
    u32x4 pa[6]; u32x4 pg[2];
    const u32x4 z4 = {0u, 0u, 0u, 0u};
#define HG_LOAD(scv) do { int row0_, ntok_, nmc_, pos0_; MX_SC_PARAMS(scv, row0_, ntok_, nmc_, pos0_); (void)pos0_; \
        const int t_ = 16 * amc + r16; const bool valid_ = (amc < nmc_) && (t_ < ntok_); const bf16* zr_ = ZROW(F, row0_ + (valid_ ? t_ : 0), 1) + 128 * h + 16 * app; \
        _Pragma("unroll") for (int i_ = 0; i_ < 6; ++i_) pa[i_] = z4; \
        if (valid_) { pa[0] = *(const u32x4*)zr_; pa[1] = *(const u32x4*)(zr_ + 8); pa[2] = *(const u32x4*)(zr_ + 1024); pa[3] = *(const u32x4*)(zr_ + 1032); pa[4] = *(const u32x4*)(zr_ + 2048); pa[5] = *(const u32x4*)(zr_ + 2056); } } while (0)
    HG_LOAD(0);
    MSTAMP_DECL
#pragma unroll 1
    for (int sc = 0; sc < nsc; ++sc) {
        int row0, ntok, nmc, pos0; MX_SC_PARAMS(sc, row0, ntok, nmc, pos0); (void)pos0;
        MSTAMP(8);
        {
            const bool valid = (amc < nmc) && (16 * amc + r16) < ntok;
            unsigned wq[8], wk[8], wh[8]; float Aend[16]; float lbv[16];
#pragma unroll
            for (int c = 0; c < 4; ++c) { const f32x4 t4 = *(const LAS f32x4*)(LB + 16 * app + 4 * c); lbv[4 * c] = t4[0]; lbv[4 * c + 1] = t4[1]; lbv[4 * c + 2] = t4[2]; lbv[4 * c + 3] = t4[3]; }
#pragma unroll
            for (int e2 = 0; e2 < 8; ++e2) {
                const unsigned qw = e2 < 4 ? pa[0][e2] : pa[1][e2 - 4], fw = e2 < 4 ? pa[2][e2] : pa[3][e2 - 4];
                float qo[2], ko[2], ho[2];
#pragma unroll
                for (int hh = 0; hh < 2; ++hh) {
                    const int e = 2 * e2 + hh;
                    const float qv = hh ? bfhi(qw) : bflo(qw), fv = hh ? bfhi(fw) : bflo(fw);
                    const float sg = sigmoidf_(fv);
                    const float a = valid ? lbv[e] + (1.f - lbv[e]) * sg : 1.f;
                    const float kk = valid ? (1.f - lbv[e]) * (1.f - sg) : 0.f;
                    const float A = row_prefix_prod(a);
                    const float Sx = row_suffix_prod(a);
                    const float R = dppf<0x101>(1.f, Sx);
                    qo[hh] = qv * A; ko[hh] = kk * __builtin_amdgcn_rcpf(fmaxf(A, 1e-30f)); ho[hh] = kk * R; Aend[e] = A;
                }
                wq[e2] = pkbf(qo[0], qo[1]); wk[e2] = pkbf(ko[0], ko[1]); wh[e2] = pkbf(ho[0], ho[1]);
            }
            const int ro = (16 * amc + r16) * MX_PITCH + 32 * app;
            { const int rf = (16 * amc + r16) * MX_PITCH + (MX_POS4(16 * app)) * 2;
#pragma unroll
              for (int g = 0; g < 4; ++g) { *(LAS u32x2*)(L + MX_Q + rf + 16 * g) = (u32x2){wq[2 * g], wq[2 * g + 1]}; *(LAS u32x2*)(L + MX_K + rf + 16 * g) = (u32x2){wk[2 * g], wk[2 * g + 1]}; } }
            *(LAS u32x4*)(L + MX_KH + ro) = (u32x4){wh[0], wh[1], wh[2], wh[3]}; *(LAS u32x4*)(L + MX_KH + ro + 16) = (u32x4){wh[4], wh[5], wh[6], wh[7]};
            *(LAS u32x4*)(L + MX_V + ro) = pa[4]; *(LAS u32x4*)(L + MX_V + ro + 16) = pa[5];
            if (r16 == 15) {
#pragma unroll
                for (int c = 0; c < 4; ++c) *(LAS f32x4*)(GD + amc * 128 + 16 * app + 4 * c) = (f32x4){Aend[4 * c], Aend[4 * c + 1], Aend[4 * c + 2], Aend[4 * c + 3]}; }
        }
        MSTAMP(9);
        __syncthreads();
        MSTAMP(10);
        if (sc + 1 < nsc) HG_LOAD(sc + 1);
        { const bool valid = tk < ntok; const bf16* zr = ZROW(F, row0 + (valid ? tk : 0), 1) + 3072 + 128 * h + 16 * p; pg[0] = *(const u32x4*)zr; pg[1] = *(const u32x4*)(zr + 8); }
        MSTAMP(11);
        if (nmc == 4) hg_chain<4>(L, S, w, r16, q); else hg_chain<1>(L, S, w, r16, q);
        MSTAMP(12);
        __syncthreads();
        MSTAMP(13);
        {
            const bool valid = tk < ntok; const int row = row0 + (valid ? tk : 0);
            f32x4 o[4];
#pragma unroll
            for (int c = 0; c < 4; ++c) o[c] = *(const LAS f32x4*)(OB + tk * MX_OP + 16 * p + 4 * c);
            if (tk >= 16 * nmc) {
#pragma unroll
                for (int c = 0; c < 4; ++c) o[c] = (f32x4){0.f, 0.f, 0.f, 0.f}; }
            float vs = 0.f;
#pragma unroll
            for (int c = 0; c < 4; ++c) vs += (o[c].x * o[c].x + o[c].y * o[c].y) + (o[c].z * o[c].z + o[c].w * o[c].w);
            vs += __shfl_xor(vs, 1); vs += __shfl_xor(vs, 2); vs += __shfl_xor(vs, 4);
            const float rstd = rsqrtf(vs * (1.f / 128.f) + EPS);
            if (valid && !(mode == 0 && sc == 0)) {
                unsigned ow[8];
#pragma unroll
                for (int c = 0; c < 4; ++c) {
                    const unsigned ga = c < 2 ? pg[0][2 * c] : pg[1][2 * c - 4], gb = c < 2 ? pg[0][2 * c + 1] : pg[1][2 * c - 3];
                    f32x4 gt = {bflo(ga), bfhi(ga), bflo(gb), bfhi(gb)};
#pragma unroll
                    for (int e = 0; e < 4; ++e) gt[e] = siluf_(gt[e]);
                    const f32x4 r = o[c] * rstd * *(const LAS f32x4*)(GN + 16 * p + 4 * c) * gt;
                    ow[2 * c] = pkbf(r.x, r.y); ow[2 * c + 1] = pkbf(r.z, r.w);
                }
                bf16* mp = MIX + (size_t)row * DM + 128 * h + 16 * p;
                *(u32x4*)mp = (u32x4){ow[0], ow[1], ow[2], ow[3]}; *(u32x4*)(mp + 8) = (u32x4){ow[4], ow[5], ow[6], ow[7]};
            }
        }
        MSTAMP(14);
    }
#undef HG_LOAD
    __syncthreads();
    if (mode != 2) {
        int l2 = F.lane; asm volatile("" : "+v"(l2)); const int r16 = l2 & 15, q = l2 >> 4;
        float* So = F.out + (prompt ? O_HP : O_HS) + (size_t)(b * 8 + h) * 16384;
#pragma unroll
        for (int mt = 0; mt < 8; ++mt)
#pragma unroll
            for (int r = 0; r < 4; ++r) So[(16 * mt + 4 * q + r) * 128 + 16 * w + r16] = S[mt][r];
    }
}

__device__ __forceinline__ void mixer_layer0(Frame& F) {
    const float* rot = (const float*)(F.ws + WS_ROT);
    int bid = blockIdx.x; asm volatile("" : "+s"(bid));
    if (bid < 64) { const int u = bid, ty = u >> 5, bh = u & 31; if (ty == 0) mix_sg_unit<0>(F, bh >> 2, bh & 3, 0, rot); else mix_sg_unit<1>(F, bh >> 2, bh & 3, 0, rot); return; }
#pragma unroll 1
    for (int u = bid - 64; u < 1024 + 8; u += F.G - 64) {
        int ty, bh, mode;
        if (u < 1024) { ty = u >> 9; bh = u & 511; mode = 1; } else { ty = (u - 1024) >> 2; bh = (u - 1024) & 3; mode = 2; }
        if (ty == 0) mix_sg_unit<0>(F, bh >> 2, bh & 3, mode, rot); else mix_sg_unit<1>(F, bh >> 2, bh & 3, mode, rot);
    }
}
__device__ __forceinline__ void mixer_layer1(Frame& F) {
    int bid = blockIdx.x; asm volatile("" : "+s"(bid));
    if (bid < 64) { mix_hg_unit(F, bid >> 3, bid & 7, 0); return; }
#pragma unroll 1
    for (int u = bid - 64; u < 1024 + 8; u += F.G - 64) {
        if (u < 1024) mix_hg_unit(F, u >> 3, u & 7, 1); else mix_hg_unit(F, 0, u - 1024, 2);
    }
}
constexpr int NSTEP = 21;
constexpr int LDSCTL_OFF = 139264;
#define RLX_AGENT __ATOMIC_RELAXED, __HIP_MEMORY_SCOPE_AGENT
#define XB_TMO      128
#define XB_XCNT(j)  (256  + 64 * (j))
#define XB_XSUB(j)  (1280 + 64 * (j))
#define XB_XGEN(j)  (2304 + 64 * (j))
#define XB_TOP      3328
#define XB_TOPGEN   3392
#define XCD_BAR_WORDS 3456
#define XB_SPIN_CAP (1u << 18)

__device__ __forceinline__ unsigned xb_ld(unsigned* p)              { return __hip_atomic_load(p, __ATOMIC_RELAXED, __HIP_MEMORY_SCOPE_AGENT); }
__device__ __forceinline__ unsigned xb_add(unsigned* p, unsigned v) { return __hip_atomic_fetch_add(p, v, __ATOMIC_RELAXED, __HIP_MEMORY_SCOPE_AGENT); }
__device__ __forceinline__ unsigned xb_xcc_id() { return (unsigned)__builtin_amdgcn_s_getreg((3 << 11) | 20) & 0xFu; }
#define XB_SPIN(cond, bar) do { unsigned _sp = 0; while (cond) { __builtin_amdgcn_s_sleep(1); \
    if ((++_sp & 255u) == 0u) { if (xb_ld(&(bar)[XB_TMO])) break; if (_sp > XB_SPIN_CAP) { atomicAdd(&(bar)[XB_TMO], 1u); break; } } } } while (0)

struct XcdBarrier {
    unsigned gsz;
    unsigned* bar; unsigned x;
    volatile LAS unsigned* st;
};

__device__ __forceinline__ XcdBarrier xcd_barrier_post(unsigned* bar, volatile LAS unsigned* st, unsigned gsz) {
    XcdBarrier b; b.gsz = gsz; b.bar = bar; b.x = xb_xcc_id(); b.st = st;
    if (threadIdx.x == 0) (void)xb_add(&bar[XB_XCNT(b.x)], 1u);
    return b;
}
__device__ __forceinline__ void xcd_barrier_complete(unsigned* bar, unsigned x, unsigned G, unsigned& nloc, unsigned& nx) {
    unsigned sum, cnt, mine, sp = 0u;
    for (;;) {
        sum = 0u; cnt = 0u; mine = 0u;
#pragma unroll
        for (unsigned j = 0; j < 16; ++j) { const unsigned c = xb_ld(&bar[XB_XCNT(j)]); sum += c; cnt += (c > 0u) ? 1u : 0u; mine = (j == x) ? c : mine; }
        if (sum == G) break;
        __builtin_amdgcn_s_sleep(1);
        if ((++sp & 255u) == 0u) { if (xb_ld(&bar[XB_TMO])) break; if (sp > XB_SPIN_CAP) { atomicAdd(&bar[XB_TMO], 1u); break; } }
    }
    nloc = mine > 0u ? mine : 1u; nx = cnt > 0u ? cnt : 1u;
}

__device__ __forceinline__ void xcd_barrier(const XcdBarrier& b) {
    asm volatile("s_waitcnt vmcnt(0)" ::: "memory");
    __syncthreads();
    if (threadIdx.x == 0) {
        unsigned* bar = b.bar;
        __builtin_amdgcn_s_waitcnt(0);
        unsigned nloc = b.st[0], nx = b.st[1];
        if (nloc == 0u) { xcd_barrier_complete(bar, b.x, b.gsz, nloc, nx); b.st[0] = nloc; b.st[1] = nx; }
        const unsigned old = xb_add(&bar[XB_XSUB(b.x)], 1u);
        const unsigned gen = old / nloc;
        if (old + 1u == (gen + 1u) * nloc) {
            __builtin_amdgcn_fence(__ATOMIC_RELEASE, "agent");
            asm volatile("s_waitcnt vmcnt(0)" ::: "memory");
            const unsigned og = xb_add(&bar[XB_TOP], 1u);
            const unsigned tg = og / nx;
            if (og + 1u == (tg + 1u) * nx) xb_add(&bar[XB_TOPGEN], 1u);
            else XB_SPIN(xb_ld(&bar[XB_TOPGEN]) == tg, bar);
            __builtin_amdgcn_fence(__ATOMIC_ACQUIRE, "agent");
            xb_add(&bar[XB_XGEN(b.x)], 1u);
            asm volatile("s_waitcnt vmcnt(0)" ::: "memory");
        } else {
            XB_SPIN(xb_ld(&bar[XB_XGEN(b.x)]) == gen, bar);
            __builtin_amdgcn_fence(__ATOMIC_ACQUIRE, "agent");
            asm volatile("s_waitcnt vmcnt(0)" ::: "memory");
        }
    }
    __syncthreads();
}


enum { K_P0 = 0, K_IN = 1, K_MIX = 2, K_OUT = 3, K_UP = 5, K_FIX = 6, K_DOWN = 7, K_FINAL = 8 };
struct Step { int kind, layer, side, tile0, nt, pre; };
__device__ __forceinline__ Step get_step(int pc) {
    switch (pc) {
        case 0:  return Step{K_P0, 0, 0, 0, 0, 0};
        case 1:  return Step{K_IN, 0, 0, 0, 69, 1};
        case 2:  return Step{K_MIX, 0, 0, 0, 0, 1};
        case 3:  return Step{K_OUT, 0, 1, 64, 5, 2};
        case 4:  return Step{K_UP, 0, 1, 64, 5, 2};
        case 5:  return Step{K_DOWN, 0, 1, 64, 5, 2};
        case 6:  return Step{K_IN, 1, 1, 64, 5, 2};
        case 7:  return Step{K_OUT, 0, 0, 0, 64, 1};
        case 8:  return Step{K_UP, 0, 0, 0, 64, 1};
        case 9:  return Step{K_FIX, 0, 0, 0, 0, 1};
        case 10: return Step{K_DOWN, 0, 0, 0, 64, 1};
        case 11: return Step{K_IN, 1, 0, 0, 64, 1};
        case 12: return Step{K_MIX, 1, 0, 0, 0, 1};
        case 13: return Step{K_OUT, 1, 1, 64, 5, 2};
        case 14: return Step{K_UP, 1, 1, 64, 5, 2};
        case 15: return Step{K_DOWN, 1, 1, 64, 5, 2};
        case 16: return Step{K_OUT, 1, 0, 0, 64, 1};
        case 17: return Step{K_UP, 1, 0, 0, 64, 1};
        case 18: return Step{K_FIX, 1, 0, 0, 0, 1};
        case 19: return Step{K_DOWN, 1, 0, 0, 64, 1};
        default: return Step{K_FINAL, 0, 0, 0, 0, 1};
    }
}

__global__ void __launch_bounds__(NWAVES * 64, 2) fwd_kernel(Args args) {
    extern __shared__ __attribute__((aligned(16))) unsigned char lds_raw[];
    cg::grid_group grid = cg::this_grid();
    Frame F;
    F.lds = (LAS unsigned char*)lds_raw;
#define REFRESH() do { int t_ = threadIdx.x; asm volatile("" : "+v"(t_)); F.tid = t_; F.lane = t_ & 63; F.wave = __builtin_amdgcn_readfirstlane(t_ >> 6); F.gw = blockIdx.x * NWAVES + F.wave; } while (0)
    F.G = gridDim.x; F.NGW = F.G * NWAVES; REFRESH();
    F.in = args.in; F.out = args.out; F.ws = args.ws;
    volatile LAS unsigned* MISC = (volatile LAS unsigned*)(F.lds + LDSCTL_OFF);
    if (threadIdx.x < 16) MISC[threadIdx.x] = 0u;
    __syncthreads();
    const bool side_wg = blockIdx.x >= 64;
    (void)xcd_barrier_post((unsigned*)(args.ws + WS_CTL), MISC + 8, F.G);
    if (side_wg) (void)xcd_barrier_post((unsigned*)(args.ws + WS_CTL) + 4096, MISC + 10, F.G - 64);
#ifndef KMASK
#define KMASK 0x1ff
#endif
#define INK(kind) ((((KMASK) >> (kind)) & 1) != 0)
#ifndef PROBE_MULT
#define PROBE_MULT 1
#endif
#ifdef PROBE_BLOCK
    volatile LAS unsigned long long* STMP = (volatile LAS unsigned long long*)(F.lds + LDSCTL_OFF + 128);
    if (threadIdx.x < 64) STMP[threadIdx.x] = 0ull;
    __syncthreads();
#define STAMP(id) do { if (blockIdx.x == PROBE_BLOCK && threadIdx.x == 0) STMP[(id)] = __builtin_amdgcn_s_memrealtime(); } while (0)
#else
#define STAMP(id) do { } while (0)
#endif
#pragma unroll 1
    for (int pc = 0; pc < NSTEP; ++pc) {
        const Step st = get_step(pc);
        if (st.pre == 1) { if (pc == 1) grid.sync(); else { XcdBarrier bar_; bar_.gsz = F.G; bar_.bar = (unsigned*)(args.ws + WS_CTL); bar_.x = xb_xcc_id(); bar_.st = (volatile LAS unsigned*)(F.lds + LDSCTL_OFF) + 8; xcd_barrier(bar_); } }
        if (st.side && !side_wg) continue;
        if (st.pre == 2) { XcdBarrier bar_; bar_.gsz = F.G - 64; bar_.bar = (unsigned*)(args.ws + WS_CTL) + 4096; bar_.x = xb_xcc_id(); bar_.st = (volatile LAS unsigned*)(F.lds + LDSCTL_OFF) + 10; xcd_barrier(bar_); }
        const int layer = st.layer;
        STAMP(2 * pc);
        const int Gs = st.side ? F.G - 64 : F.G, cs = st.side ? (int)blockIdx.x - 64 : (int)blockIdx.x;
        if (st.kind == K_P0) { if (INK(0)) { REFRESH(); p0_weights(F); __syncthreads(); REFRESH(); p0_rows(F); REFRESH(); p0_rotary(F, (float*)(args.ws + WS_ROT)); } }
        else if (st.kind == K_IN) { if (INK(1)) {
            pg8::Gemm g{F_XG(F), (const bf16*)(args.ws + (layer == 0 ? WS_WAB : WS_WC)), MPAD, 4096, 1024}; pg8::StaticOrder S; S.init(st.nt, 4096, Gs, cs, st.tile0);
            pg8::EpiBf16 E{F_Z(F), F_ZS1(F, layer), 64, 4096, layer == 0 ? (const float*)nullptr : (const float*)F_SSQ(F)};
            pg8::gemm_phase<pg8::EpiBf16, pg8::StaticOrder, false>(F.lds, g, S, E); } }
        else if (st.kind == K_MIX) { if (INK(2)) { REFRESH(); if (layer == 0) mixer_layer0(F); else mixer_layer1(F); } }
        else if (st.kind == K_OUT) { if (INK(3)) {
            pg8::Gemm g{F_XN(F), (const bf16*)(args.ws + (layer == 0 ? WS_WOAB : WS_WOC)), MPAD, 1024, 1024}; pg8::StaticOrder S; S.init(st.nt, 1024, Gs, cs, st.tile0);
            pg8::EpiResid E{F_X0(F), F_X1(F), PM_META, DM, F_XG(F), F.in[20] + (size_t)layer * DM, F_SSQ(F)};
            pg8::gemm_phase<pg8::EpiResid, pg8::StaticOrder, false>(F.lds, g, S, E); } }
        else if (st.kind == K_UP) { if (INK(5)) {
            pg8::Gemm g{F_XG(F), (const bf16*)(args.ws + WS_WF1) + (size_t)layer * NFF * 1024, MPAD, NFF, 1024}; pg8::StaticOrder S; S.init(st.nt, NFF, Gs, cs, st.tile0);
            EpiFfn E{F_Z(F), F_HS1(F), F.in[22] + (size_t)layer * 3 * DFF, F.in[23] + (size_t)layer * DFF, F.in[7] + (size_t)layer * 128 * 2 * DFF, F.out + O_FS + (size_t)layer * 128 * 2 * DFF, F_SBL(F), F_SBF(F), F_SSQ(F)};
            pg8::gemm_phase<EpiFfn, pg8::StaticOrder, true>(F.lds, g, S, E); } }
        else if (st.kind == K_FIX) { if (INK(6)) { REFRESH(); ffn_fixup(F, layer); } }
        else if (st.kind == K_DOWN) { if (INK(7)) {
            pg8::Gemm g{st.side ? F_HS1(F) : F_Z(F), (const bf16*)(args.ws + WS_WF2) + (size_t)layer * 1024 * DFF, MPAD, 1024, DFF}; pg8::StaticOrder S; S.init(st.nt, 1024, Gs, cs, st.tile0);
            pg8::EpiResid E{F_X0(F), F_X1(F), PM_META, DM, layer == 0 ? F_XG(F) : (bf16*)nullptr, F.in[9] + DM, F_SSQ(F)};
            pg8::gemm_phase<pg8::EpiResid, pg8::StaticOrder, false>(F.lds, g, S, E); } }
        else { if (INK(8)) { REFRESH(); rms_final(F, F.in[25]); } }
        STAMP(2 * pc + 1);
    }
#ifdef PROBE_BLOCK
    if (blockIdx.x == PROBE_BLOCK && threadIdx.x == 0) { const unsigned long long d = (STMP[PROBE_B] - STMP[PROBE_A]) * PROBE_MULT, t0 = __builtin_amdgcn_s_memrealtime(); while (__builtin_amdgcn_s_memrealtime() - t0 < d) __builtin_amdgcn_s_sleep(8); }
#endif
#undef INK
#undef REFRESH
}

extern "C" void kernel_launch(void* const* d_in, const int* in_sizes, int n_in, void* d_out, int out_size, void* d_ws, size_t ws_size, hipStream_t stream) {
    static int grid = 0;
    if (grid == 0) {
        if (n_in != 26 || (size_t)out_size != O_END || ws_size < WS_END) { fprintf(stderr, "kernel_launch: unexpected shapes: n_in %d out %d ws %zu\n", n_in, out_size, ws_size); grid = -1; return; }
        int dev = 0, cus = 0, per_cu = 0;
        if (hipGetDevice(&dev) != hipSuccess || hipDeviceGetAttribute(&cus, hipDeviceAttributeMultiprocessorCount, dev) != hipSuccess) { grid = -1; return; }
        if (hipFuncSetAttribute((const void*)fwd_kernel, hipFuncAttributeMaxDynamicSharedMemorySize, LDS_BYTES) != hipSuccess) { fprintf(stderr, "kernel_launch: hipFuncSetAttribute failed\n"); grid = -1; return; }
        if (hipOccupancyMaxActiveBlocksPerMultiprocessor(&per_cu, (const void*)fwd_kernel, NWAVES * 64, LDS_BYTES) != hipSuccess || per_cu < 1) { fprintf(stderr, "kernel_launch: occupancy query says %d\n", per_cu); per_cu = 1; }
        (void)hipGetLastError();
        grid = cus;
        if (grid < 128) { fprintf(stderr, "kernel_launch: this kernel's static work split needs >= 128 CUs (got %d)\n", grid); grid = -1; return; }
    }
    if (grid < 0) return;
    if (hipMemsetAsync((char*)d_ws + WS_CTL, 0, 32768, stream) != hipSuccess) { fprintf(stderr, "kernel_launch: hipMemsetAsync failed\n"); return; }
    Args a{};
    for (int i = 0; i < 26; ++i) a.in[i] = (const float*)d_in[i];
    a.out = (float*)d_out; a.ws = (unsigned char*)d_ws;
    a.ph_lo = 0; a.ph_hi = NSTEP;
    void* kargs[] = {&a};
    hipError_t e = hipLaunchCooperativeKernel((const void*)fwd_kernel, dim3(grid), dim3(NWAVES * 64), kargs, LDS_BYTES, stream);
    if (e != hipSuccess) fprintf(stderr, "kernel_launch: cooperative launch failed: %s (grid %d)\n", hipGetErrorString(e), grid);
}
```

```cpp
#include <hip/hip_runtime.h>
#include <hip/hip_cooperative_groups.h>
#include <cstdio>
#include <cstdint>
namespace cg = cooperative_groups;

namespace pg8 {
#define PG8_LAS __attribute__((address_space(3)))
typedef unsigned short bf16_t;
typedef short bf16x8 __attribute__((ext_vector_type(8)));
typedef float f32x4 __attribute__((ext_vector_type(4)));
typedef unsigned u32x4 __attribute__((ext_vector_type(4)));
typedef unsigned u32x2 __attribute__((ext_vector_type(2)));
constexpr int BM = 256, BK = 64, HALF = 128, HTB = HALF * BK * 2  , STAGE_BYTES = 8 * HTB, NXCD = 8, WGM = 8;

__host__ __device__ __forceinline__ int lds_byte(int r, int c) { const int st = (r >> 4) * 2 + (c >> 5), rr = r & 15, cc = c & 31, ob = rr * 64 + cc * 2; return st * 1024 + (ob ^ (((ob >> 9) & 1) << 5)); }
__host__ __device__ __forceinline__ void stage_rc(int b, int& R, int& C) { const int st = b / 1024, sb = b % 1024, swz = sb ^ (((sb >> 9) & 1) << 5); R = (st >> 1) * 16 + swz / 64; C = (st & 1) * 32 + (swz % 64) / 2; }
__host__ __device__ __forceinline__ int perm32(int rho) { const int n = rho >> 4, i = rho & 15; return 8 * (i >> 2) + 4 * n + (i & 3); }

struct Unit { int pm, pn; };
struct Gemm { const bf16_t* A; const bf16_t* Bt; int M, N, K; };

struct StaticOrder {
    int nM, nN, nwg, G, c, pm0;
    __host__ __device__ void init(int nMt, int N, int G_, int c_, int pm0_) { nM = nMt; nN = N / BM; nwg = nM * nN; G = G_; c = c_; pm0 = pm0_; }
    __host__ __device__ bool next(int i, Unit& u) const {
        const long L = (long)i * G + c; if (L >= nwg) return false;
        int wgid = (int)L; { const int q = nwg / NXCD, r = nwg % NXCD, xcd = wgid % NXCD, off = wgid / NXCD; wgid = (xcd < r ? xcd * (q + 1) : r * (q + 1) + (xcd - r) * q) + off; }
        const int nig = WGM * nN, gid = wgid / nig, fm = gid * WGM, gsz = (nM - fm) < WGM ? (nM - fm) : WGM;
        u.pm = pm0 + fm + ((wgid % nig) % gsz); u.pn = (wgid % nig) / gsz; return true;
    }
    __device__ __forceinline__ void a_ready(const Unit&) const {}
    __device__ __forceinline__ void done(const Unit&) const {}
};

__device__ __forceinline__ unsigned cvt_pk_bf16(float lo, float hi) { unsigned r; asm volatile("v_cvt_pk_bf16_f32 %0, %1, %2" : "=v"(r) : "v"(lo), "v"(hi)); return r; }

__device__ __forceinline__ float row_rs(const float* ssq, int row, int fq) {
    const f32x4 a = *(const f32x4*)(ssq + (size_t)row * 16 + 4 * fq);
    float s = (a[0] + a[1]) + (a[2] + a[3]); s += __shfl_xor(s, 16); s += __shfl_xor(s, 32);
    return __builtin_amdgcn_rsqf(s * (1.0f / 1024.0f) + 1e-6f);
}
struct EpiBf16 {
    static constexpr bool PERM = true, AFTER_DRAIN = false;
    bf16_t* O0; bf16_t* O1; int pm_split; int ldc; const float* ssq;
    __device__ __forceinline__ void operator()(f32x4 (&acc)[2][2][4][2], const Unit& u, int wr, int wc, int fr, int fq) const {
        bf16_t* O = (u.pm < pm_split) ? O0 : O1;
        const int row0 = u.pm * BM + wr * 64 + fr; const int col0 = u.pn * BM + wc * 32 + 8 * fq;
        float rsv[2][4];
#pragma unroll
        for (int ai = 0; ai < 2; ++ai)
#pragma unroll
            for (int m = 0; m < 4; ++m) rsv[ai][m] = ssq ? row_rs(ssq, row0 + ai * HALF + m * 16, fq) : 1.0f;
#pragma unroll
        for (int ai = 0; ai < 2; ++ai)
#pragma unroll
            for (int m = 0; m < 4; ++m) { const int row = row0 + ai * HALF + m * 16; bf16_t* rowp = O + (size_t)row * ldc + col0;
                const float rs = rsv[ai][m];
#pragma unroll
                for (int bj = 0; bj < 2; ++bj) { const f32x4 v0 = acc[ai][bj][m][0] * rs, v1 = acc[ai][bj][m][1] * rs;
                    u32x4 w; w.x = cvt_pk_bf16(v0[0], v0[1]); w.y = cvt_pk_bf16(v0[2], v0[3]); w.z = cvt_pk_bf16(v1[0], v1[1]); w.w = cvt_pk_bf16(v1[2], v1[3]);
                    *(u32x4*)(rowp + bj * HALF) = w; } }
    }
};

struct EpiResid {
    static constexpr bool PERM = true, AFTER_DRAIN = false;
    float* X0; float* X1; int pm_split; int ldc; bf16_t* XG; const float* gain; float* ssq;
    const float* R0; const float* R1; const float* R2; int nreal;
    __device__ __forceinline__ void operator()(f32x4 (&acc)[2][2][4][2], const Unit& u, int wr, int wc, int fr, int fq) const {
        float* C = (u.pm < pm_split) ? X0 : X1;
        const float* Rsrc = R0 ? (u.pm < 64 ? R0 : u.pm < pm_split ? R1 : R2) : (const float*)C;
        const int row0 = u.pm * BM + wr * 64 + fr, col0 = u.pn * BM + wc * 32 + 8 * fq;
        f32x4 gv[2][2];
#pragma unroll
        for (int bj = 0; bj < 2; ++bj)
#pragma unroll
            for (int n = 0; n < 2; ++n) gv[bj][n] = XG ? *(const f32x4*)(gain + col0 + bj * HALF + 4 * n) : (f32x4){0.f, 0.f, 0.f, 0.f};
#pragma unroll
        for (int ai = 0; ai < 2; ++ai)
#pragma unroll
            for (int mp = 0; mp < 2; ++mp) {
                f32x4 t[2][2][2];
#pragma unroll
                for (int mm = 0; mm < 2; ++mm) { const int rr_ = row0 + ai * HALF + (2 * mp + mm) * 16; const float* rowp = Rsrc + (size_t)rr_ * ldc + col0; const bool have = rr_ < nreal;
#pragma unroll
                    for (int bj = 0; bj < 2; ++bj)
#pragma unroll
                        for (int n = 0; n < 2; ++n) t[mm][bj][n] = have ? *(const f32x4*)(rowp + bj * HALF + 4 * n) : (f32x4){0.f, 0.f, 0.f, 0.f}; }
#pragma unroll
                for (int mm = 0; mm < 2; ++mm) { const int m = 2 * mp + mm; const int row = row0 + ai * HALF + m * 16; float* rowp = C + (size_t)row * ldc + col0; float sq = 0.f;
#pragma unroll
                    for (int bj = 0; bj < 2; ++bj) { f32x4 v[2];
#pragma unroll
                        for (int n = 0; n < 2; ++n) { v[n] = t[mm][bj][n] + acc[ai][bj][m][n]; *(f32x4*)(rowp + bj * HALF + 4 * n) = v[n];
                            sq += (v[n][0] * v[n][0] + v[n][1] * v[n][1]) + (v[n][2] * v[n][2] + v[n][3] * v[n][3]); }
                        if (XG) { const f32x4 y0 = v[0] * gv[bj][0], y1 = v[1] * gv[bj][1]; u32x4 w; w.x = cvt_pk_bf16(y0[0], y0[1]); w.y = cvt_pk_bf16(y0[2], y0[3]); w.z = cvt_pk_bf16(y1[0], y1[1]); w.w = cvt_pk_bf16(y1[2], y1[3]);
                            *(u32x4*)(XG + (size_t)row * ldc + col0 + bj * HALF) = w; } }
                    if (XG) { sq += __shfl_xor(sq, 16); sq += __shfl_xor(sq, 32); if (fq == 0) ssq[(size_t)row * 16 + u.pn * 4 + wc] = sq; } }
                asm volatile("" ::: "memory"); }
    }
};

template <class Epi, class Sched, bool APERM>
__device__ __forceinline__ void gemm_phase(PG8_LAS unsigned char* lds, const Gemm g, const Sched& S, const Epi& E) {
    int tid_ = threadIdx.x; asm volatile("" : "+v"(tid_));
    const int tid = tid_, wid = __builtin_amdgcn_readfirstlane(tid >> 6), lane = tid & 63, wr = wid >> 2, wc = wid & 3, fr = lane & 15, fq = lane >> 4;
    const int K = g.K, nt = K / BK;
    unsigned voffA[2], voffB[2];
#pragma unroll
    for (int i = 0; i < 2; ++i) { int R, C; stage_rc(tid * 16 + i * 8192, R, C); const int Rb = Epi::PERM ? ((R & ~31) + perm32(R & 31)) : R;
        const int Ra = APERM ? (128 * (R >> 6) + 8 * (R & 15) + ((R >> 4) & 3)) : R;
        voffA[i] = (unsigned)(Ra * K + C) * 2u; voffB[i] = (unsigned)(Rb * K + C) * 2u; }
    const size_t kstep = (size_t)(BK * 2);
    const size_t hstep = (size_t)HALF * K * 2;
    const size_t hstepA = APERM ? (size_t)4 * K * 2 : hstep;
    const size_t tstep = 2 * hstep;
    const unsigned ldsw = (unsigned)wid * 1024u;
    const int aoff = lds_byte(wr * 64 + fr, fq * 8), boff = lds_byte(wc * 32 + fr, fq * 8);
#define PG8_SA(b, h) (((b) * 2 + (h)) * HTB)
#define PG8_SB(b, h) ((4 + (b) * 2 + (h)) * HTB)
#define PG8_STAGE(bufoff, gbase, voff) do { _Pragma("unroll") for (int _i = 0; _i < 2; ++_i) \
        __builtin_amdgcn_global_load_lds((const unsigned*)((const char*)(gbase) + (voff)[_i]), (PG8_LAS unsigned*)(lds + (bufoff) + ldsw + _i * 8192), 16, 0, 0); } while (0)
#define PG8_LDA(dst, b, h) do { _Pragma("unroll") for (int m = 0; m < 4; ++m) _Pragma("unroll") for (int k = 0; k < 2; ++k) dst[m][k] = *(const PG8_LAS bf16x8*)(lds + PG8_SA(b, h) + aoff + m * 2048 + k * 1024); } while (0)
#define PG8_LDB(dst, b, h) do { _Pragma("unroll") for (int n = 0; n < 2; ++n) _Pragma("unroll") for (int k = 0; k < 2; ++k) dst[n][k] = *(const PG8_LAS bf16x8*)(lds + PG8_SB(b, h) + boff + n * 2048 + k * 1024); } while (0)
#define PG8_MMA(ai, bj, At, Bt) do { __builtin_amdgcn_s_setprio(1); _Pragma("unroll") for (int m = 0; m < 4; ++m) _Pragma("unroll") for (int n = 0; n < 2; ++n) _Pragma("unroll") for (int k = 0; k < 2; ++k) \
        acc[ai][bj][m][n] = __builtin_amdgcn_mfma_f32_16x16x32_bf16(Bt[n][k], At[m][k], acc[ai][bj][m][n], 0, 0, 0); __builtin_amdgcn_s_setprio(0); } while (0)
#define PG8_WAIT_V(n) asm volatile("s_waitcnt vmcnt(" #n ")" ::: "memory")
#define PG8_WAIT_L(n) asm volatile("s_waitcnt lgkmcnt(" #n ")" ::: "memory")
#define PG8_BAR __builtin_amdgcn_s_barrier()
#define PG8_SCHED __builtin_amdgcn_sched_barrier(0)
    Unit cur, nxt; int ui = 0;
    if (!S.next(0, cur)) return;
    f32x4 acc[2][2][4][2];
#pragma unroll
    for (int a = 0; a < 2; ++a)
#pragma unroll
        for (int b = 0; b < 2; ++b)
#pragma unroll
            for (int m = 0; m < 4; ++m)
#pragma unroll
                for (int n = 0; n < 2; ++n) acc[a][b][m][n] = (f32x4){0.f, 0.f, 0.f, 0.f};
    bf16x8 At[4][2], B0[2][2], B1[2][2];
    const char* cA = (const char*)g.A + (size_t)cur.pm * tstep; const char* cB = (const char*)g.Bt + (size_t)cur.pn * tstep;
    S.a_ready(cur);
    PG8_STAGE(PG8_SB(0, 0), cB, voffB); PG8_STAGE(PG8_SB(0, 1), cB + hstep, voffB); PG8_STAGE(PG8_SA(0, 0), cA, voffA); PG8_STAGE(PG8_SA(0, 1), cA + hstepA, voffA);
    if (wr == 1) PG8_BAR;
    PG8_WAIT_V(2); PG8_BAR;
    PG8_STAGE(PG8_SB(1, 0), cB + kstep, voffB); PG8_STAGE(PG8_SA(1, 0), cA + kstep, voffA); PG8_STAGE(PG8_SB(1, 1), cB + hstep + kstep, voffB);
    PG8_WAIT_V(6); PG8_BAR;
    for (;;) {
        const bool has_next = S.next(ui + 1, nxt);
        const char* nA = has_next ? (const char*)g.A + (size_t)nxt.pm * tstep : cA; const char* nB = has_next ? (const char*)g.Bt + (size_t)nxt.pn * tstep : cB;
        for (int t = 0; t < nt; t += 2) {
            const bool last = (t == nt - 2);
            const char* a1 = cA + (size_t)(t + 1) * kstep;
            const char* a2 = last ? nA : cA + (size_t)(t + 2) * kstep; const char* b2 = last ? nB : cB + (size_t)(t + 2) * kstep;
            const char* a3 = a2 + kstep; const char* b3 = b2 + kstep;
            if (last && has_next) S.a_ready(nxt);
            PG8_LDB(B0, 0, 0); PG8_LDB(B1, 0, 1); PG8_SCHED; PG8_LDA(At, 0, 0); PG8_STAGE(PG8_SA(1, 1), a1 + hstepA, voffA);
            PG8_WAIT_V(8); PG8_WAIT_L(0); PG8_BAR; PG8_MMA(0, 0, At, B0); PG8_MMA(0, 1, At, B1); PG8_BAR; PG8_SCHED;
            PG8_LDA(At, 0, 1); PG8_STAGE(PG8_SB(0, 0), b2, voffB); PG8_STAGE(PG8_SB(0, 1), b2 + hstep, voffB); PG8_STAGE(PG8_SA(0, 0), a2, voffA);
            PG8_WAIT_V(8); PG8_WAIT_L(0); PG8_BAR; PG8_MMA(1, 0, At, B0); PG8_MMA(1, 1, At, B1); PG8_BAR; PG8_SCHED;
            PG8_LDB(B0, 1, 0); PG8_LDB(B1, 1, 1); PG8_SCHED; PG8_LDA(At, 1, 0); PG8_STAGE(PG8_SA(0, 1), a2 + hstepA, voffA);
            PG8_WAIT_V(8); PG8_WAIT_L(0); PG8_BAR; PG8_MMA(0, 0, At, B0); PG8_MMA(0, 1, At, B1); PG8_BAR; PG8_SCHED;
            PG8_LDA(At, 1, 1); PG8_STAGE(PG8_SB(1, 0), b3, voffB); PG8_STAGE(PG8_SB(1, 1), b3 + hstep, voffB); PG8_STAGE(PG8_SA(1, 0), a3, voffA);
            PG8_WAIT_V(8); PG8_WAIT_L(0); PG8_BAR; PG8_MMA(1, 0, At, B0); PG8_MMA(1, 1, At, B1); PG8_BAR; PG8_SCHED;
        }
        if (wr == 0) PG8_BAR;
        E(acc, cur, wr, wc, fr, fq); S.done(cur);
        if (!has_next) break;
#pragma unroll
        for (int a = 0; a < 2; ++a)
#pragma unroll
            for (int b = 0; b < 2; ++b)
#pragma unroll
                for (int m = 0; m < 4; ++m)
#pragma unroll
                    for (int n = 0; n < 2; ++n) acc[a][b][m][n] = (f32x4){0.f, 0.f, 0.f, 0.f};
        cur = nxt; cA = nA; cB = nB; ++ui;
        if (wr == 1) PG8_BAR;
    }
    PG8_WAIT_V(0);
    PG8_BAR;
#undef PG8_SA
#undef PG8_SB
#undef PG8_STAGE
#undef PG8_LDA
#undef PG8_LDB
#undef PG8_MMA
#undef PG8_WAIT_V
#undef PG8_WAIT_L
#undef PG8_BAR
#undef PG8_SCHED
}
}
constexpr int DM = 1024;
constexpr int ROW_S = 16384;
constexpr int ROW_M = 17408;
constexpr int NREAL = 17424;
constexpr int MPAD = 17664;
constexpr int PM_META = 68;
constexpr int NAB = 4096, NCC = 4096, DFF = 2816, NFF = 5632, ABW = 4104;
constexpr int NGRP = 138, GRP_META = 136;
constexpr float EPS = 1e-6f;
constexpr float KSCALE = 0.08838834764831845f;

constexpr size_t O_YP = 0, O_YS = 16777216, O_CP = 17825792, O_CS = 18350080, O_NP = 26738688, O_NS = 26742784, O_MP = 26808320, O_MS = 26808352,
                 O_RP = 26808864, O_RS = 27333152, O_HP = 35721760, O_HS = 36770336, O_FP = 53547552, O_FS = 53637664, O_END = 55079456;

constexpr size_t MiB = 1u << 20;
constexpr size_t WS_CTL = 0, CTL_ZERO_BYTES = 1 * MiB;
constexpr size_t WS_WAB = 1 * MiB, WS_WOAB = 9 * MiB, WS_WC = 11 * MiB, WS_WOC = 19 * MiB, WS_WF1 = 21 * MiB  , WS_WF2 = 43 * MiB  ;
constexpr size_t WS_XN = 54 * MiB;
constexpr size_t WS_Z = 89 * MiB;
constexpr size_t WS_XM = 227 * MiB;
constexpr size_t WS_G = 228 * MiB;
constexpr size_t WS_SBL = 229 * MiB;
constexpr size_t WS_SBF = 233 * MiB;
constexpr size_t WS_ROT = 240 * MiB;
constexpr size_t WS_XG = 242 * MiB;
constexpr size_t WS_SSQ = 277 * MiB;
constexpr size_t WS_ZS = 279 * MiB;
constexpr size_t WS_ZS2 = 290 * MiB;
constexpr size_t WS_HS = 301 * MiB;
constexpr size_t WS_END = 309 * MiB;
static_assert(WS_XN + (size_t)MPAD * DM * 2 <= WS_Z && WS_Z + (size_t)MPAD * 4096 * 2 <= WS_XM && WS_SBL + (size_t)NGRP * 2 * DFF * 4 <= WS_SBF && WS_SBF + (size_t)NGRP * 4 * DFF * 4 <= WS_END, "ws map");

constexpr int P0_ITEMS_AB = 16 * 128;
constexpr int LDS_BYTES = 147456;
constexpr int NWAVES = 8;

#define GAS __attribute__((address_space(1)))
#define LAS __attribute__((address_space(3)))
typedef unsigned short bf16;
typedef float f32x4 __attribute__((ext_vector_type(4)));
typedef unsigned u32x2 __attribute__((ext_vector_type(2)));
typedef unsigned u32x4 __attribute__((ext_vector_type(4)));
#define LDS_WAIT() asm volatile("s_waitcnt lgkmcnt(0)" ::: "memory")

__device__ __forceinline__ unsigned f2bf(float f) { unsigned u = __builtin_bit_cast(unsigned, f); return (u + 0x7fffu + ((u >> 16) & 1u)) >> 16; }
__device__ __forceinline__ unsigned pk2(float lo, float hi) { return f2bf(lo) | (f2bf(hi) << 16); }
__device__ __forceinline__ float bf2f(unsigned short b) { return __builtin_bit_cast(float, ((unsigned)b) << 16); }
__device__ __forceinline__ float bflo(unsigned w) { return __builtin_bit_cast(float, w << 16); }
__device__ __forceinline__ float bfhi(unsigned w) { return __builtin_bit_cast(float, w & 0xffff0000u); }
__device__ __forceinline__ f32x4 ld_bf4(const bf16* p) { const u32x2 w = *(const u32x2*)p; return (f32x4){bflo(w.x), bfhi(w.x), bflo(w.y), bfhi(w.y)}; }
__device__ __forceinline__ float wave_sum(float v) {
#pragma unroll
    for (int o = 1; o < 64; o <<= 1) v += __shfl_xor(v, o);
    return v;
}
__device__ __forceinline__ float half_sum(float v) {
#pragma unroll
    for (int o = 1; o < 32; o <<= 1) v += __shfl_xor(v, o);
    return v;
}
__device__ __forceinline__ float sigmoidf_(float x) { return 1.f / (1.f + __expf(-x)); }
__device__ __forceinline__ float siluf_(float x) { return x / (1.f + __expf(-x)); }
__device__ __forceinline__ float logsigmoidf_(float x) { return fminf(x, 0.f) - __logf(1.f + __expf(-fabsf(x))); }

struct Args { const float* in[26]; float* out; unsigned char* ws; int ph_lo, ph_hi; };

struct Frame {
    LAS unsigned char* lds;
    int tid, lane, wave, G, gw, NGW;
    const float* const* in; float* out; unsigned char* ws;
};
#define F_X0(F) ((F).out)
#define F_X1(F) ((float*)((F).ws + WS_XM) - (size_t)ROW_M * DM)
#define F_XN(F) ((bf16*)((F).ws + WS_XN))
#define F_XG(F) ((bf16*)((F).ws + WS_XG))
#define F_SSQ(F) ((float*)((F).ws + WS_SSQ))
#define F_Z(F) ((bf16*)((F).ws + WS_Z))
#define F_ZS1(F, layer) ((bf16*)((F).ws + ((layer) == 0 ? WS_ZS : WS_ZS2)) - (size_t)ROW_S * 4096)
#define F_HS1(F) ((bf16*)((F).ws + WS_HS) - (size_t)ROW_S * DFF)
#define ZROW(F, row, layer) (((row) < ROW_S ? F_Z(F) : F_ZS1(F, layer)) + (size_t)(row) * 4096)
#define F_GT(F) ((float*)((F).ws + WS_G))
#define F_SBL(F) ((float*)((F).ws + WS_SBL))
#define F_SBF(F) ((float*)((F).ws + WS_SBF))
__device__ __forceinline__ float* xrow(const Frame& F, int r) { return (r < ROW_M ? F_X0(F) : F_X1(F)) + (size_t)r * DM; }

__device__ __forceinline__ void p0_transpose_item(const float* W, int K, int Nsrc, int n0src, bf16* WT, int dstrow0, LAS float* scr, int kb, int lane) {
    const int k0 = 64 * kb;
    f32x4 v[8];
#pragma unroll
    for (int i = 0; i < 8; ++i) v[i] = *(const f32x4*)(W + (size_t)(k0 + 8 * i + (lane >> 3)) * Nsrc + n0src + 4 * (lane & 7));
#pragma unroll
    for (int i = 0; i < 8; ++i) { LAS float* d = scr + (8 * i + (lane >> 3)) * 33 + 4 * (lane & 7); d[0] = v[i][0]; d[1] = v[i][1]; d[2] = v[i][2]; d[3] = v[i][3]; }
    LDS_WAIT(); asm volatile("" ::: "memory");
    const int c = lane & 7;
#pragma unroll
    for (int j = 0; j < 4; ++j) { const int n = (lane >> 3) + 8 * j; const LAS float* s = scr + (8 * c) * 33 + n;
        u32x4 o; o.x = pk2(s[0 * 33], s[1 * 33]); o.y = pk2(s[2 * 33], s[3 * 33]); o.z = pk2(s[4 * 33], s[5 * 33]); o.w = pk2(s[6 * 33], s[7 * 33]);
        *(u32x4*)(WT + (size_t)(dstrow0 + n) * K + k0 + 8 * c) = o; }
    LDS_WAIT(); asm volatile("" ::: "memory");
}

__device__ __forceinline__ void p0_weights(Frame& F, int it0, int it1, int gw, int ngw) {
    LAS float* scr = (LAS float*)(F.lds + F.wave * 16384);
    constexpr int I_AB = 16 * 128, I_O = 16 * 32, I_C = 16 * 128, I_F1 = 16 * 176, I_F2 = 44 * 32;
    constexpr int NIT = I_AB + I_O + I_C + I_O + 2 * I_F1 + 2 * I_F2;
    if (it1 < 0) it1 = NIT;
    for (int it = it0 + gw; it < it1; it += ngw) {
        int r = it;
        if (r < I_AB) { const int kb = r / 128, nb = r % 128; p0_transpose_item(F.in[10], 1024, ABW, nb < 64 ? 32 * nb : 32 * nb + 8, (bf16*)(F.ws + WS_WAB), 32 * nb, scr, kb, F.lane); continue; } r -= I_AB;
        if (r < I_O) { const int kb = r / 32, nb = r % 32; p0_transpose_item(F.in[15], 1024, 1024, 32 * nb, (bf16*)(F.ws + WS_WOAB), 32 * nb, scr, kb, F.lane); continue; } r -= I_O;
        if (r < I_C) { const int kb = r / 128, nb = r % 128; p0_transpose_item(F.in[17], 1024, 4096, 32 * nb, (bf16*)(F.ws + WS_WC), 32 * nb, scr, kb, F.lane); continue; } r -= I_C;
        if (r < I_O) { const int kb = r / 32, nb = r % 32; p0_transpose_item(F.in[19], 1024, 1024, 32 * nb, (bf16*)(F.ws + WS_WOC), 32 * nb, scr, kb, F.lane); continue; } r -= I_O;
        if (r < 2 * I_F1) { const int l = r / I_F1; r -= l * I_F1; const int kb = r / 176, nb = r % 176; const int c = 32 * nb;
            const int ch = c < DFF ? c : c - DFF; const int dst = 256 * (ch / 128) + (c < DFF ? 0 : 128) + (ch % 128);
            p0_transpose_item(F.in[21] + (size_t)l * 1024 * NFF, 1024, NFF, c, (bf16*)(F.ws + WS_WF1) + (size_t)l * NFF * 1024, dst, scr, kb, F.lane); continue; } r -= 2 * I_F1;
        { const int l = r / I_F2; r -= l * I_F2; const int kb = r / 32, nb = r % 32;
            p0_transpose_item(F.in[24] + (size_t)l * DFF * 1024, DFF, 1024, 32 * nb, (bf16*)(F.ws + WS_WF2) + (size_t)l * 1024 * DFF, 32 * nb, scr, kb, F.lane); }
    }
}

__device__ __forceinline__ void p0_rows(Frame& F) {
    LAS float* wg = (LAS float*)F.lds;
    for (int i = F.tid; i < 8192; i += NWAVES * 64) { const int k = i >> 3, c = i & 7; wg[c * 1024 + k] = F.in[10][(size_t)k * ABW + 2048 + c]; }
    __syncthreads();
    const float* gain = F.in[9];
    f32x4 gn[4];
#pragma unroll
    for (int j = 0; j < 4; ++j) gn[j] = *(const f32x4*)(gain + 4 * F.lane + 256 * j);
#define P0_ROWSRC(r) ((r) < ROW_S ? F.in[0] + (size_t)(r) * DM : (r) < ROW_M ? F.in[1] + (size_t)((r) - ROW_S) * DM : (r) < NREAL ? F.in[8] + (size_t)((r) - ROW_M) * DM : (const float*)nullptr)
    f32x4 v[4], vn[4];
    { const float* src = F.gw < MPAD ? P0_ROWSRC(F.gw) : nullptr;
#pragma unroll
      for (int j = 0; j < 4; ++j) vn[j] = src ? *(const f32x4*)(src + 4 * F.lane + 256 * j) : (f32x4){0.f, 0.f, 0.f, 0.f}; }
#pragma unroll 1
    for (int r = F.gw; r < MPAD; r += F.NGW) {
#pragma unroll
        for (int j = 0; j < 4; ++j) v[j] = vn[j];
        { const int rn = r + F.NGW; const float* src = rn < MPAD ? P0_ROWSRC(rn) : nullptr;
#pragma unroll
          for (int j = 0; j < 4; ++j) vn[j] = src ? *(const f32x4*)(src + 4 * F.lane + 256 * j) : (f32x4){0.f, 0.f, 0.f, 0.f}; }
        float ss = 0.f;
#pragma unroll
        for (int j = 0; j < 4; ++j) ss += (v[j].x * v[j].x + v[j].y * v[j].y) + (v[j].z * v[j].z + v[j].w * v[j].w);
        const float rs = rsqrtf(wave_sum(ss) * (1.f / DM) + EPS);
        bf16* xn = F_XG(F) + (size_t)r * DM;
        float ga[8];
#pragma unroll
        for (int c = 0; c < 8; ++c) ga[c] = 0.f;
#pragma unroll
        for (int j = 0; j < 4; ++j) {
            const f32x4 y = v[j] * rs * gn[j];
            u32x2 w; w.x = pk2(y.x, y.y); w.y = pk2(y.z, y.w);
            *(u32x2*)(xn + 4 * F.lane + 256 * j) = w;
#pragma unroll
            for (int c = 0; c < 8; ++c) { const f32x4 wv = *(const LAS f32x4*)(wg + c * 1024 + 4 * F.lane + 256 * j); ga[c] += (y.x * wv.x + y.y * wv.y) + (y.z * wv.z + y.w * wv.w); }
        }
        float g4[4], g2[2], g1;
        { const bool hi = (F.lane & 32) != 0;
#pragma unroll
          for (int c = 0; c < 4; ++c) { const float keep = hi ? ga[4 + c] : ga[c], send = hi ? ga[c] : ga[4 + c]; g4[c] = keep + __shfl_xor(send, 32); } }
        { const bool hi = (F.lane & 16) != 0;
#pragma unroll
          for (int c = 0; c < 2; ++c) { const float keep = hi ? g4[2 + c] : g4[c], send = hi ? g4[c] : g4[2 + c]; g2[c] = keep + __shfl_xor(send, 16); } }
        { const bool hi = (F.lane & 8) != 0; const float keep = hi ? g2[1] : g2[0], send = hi ? g2[0] : g2[1]; g1 = keep + __shfl_xor(send, 8); }
        g1 += __shfl_xor(g1, 4); g1 += __shfl_xor(g1, 2); g1 += __shfl_xor(g1, 1);
        if ((F.lane & 7) == 0) F_GT(F)[(size_t)r * 8 + ((F.lane >> 5) & 1) * 4 + ((F.lane >> 4) & 1) * 2 + ((F.lane >> 3) & 1)] = g1;
    }
#undef P0_ROWSRC
}

__device__ __forceinline__ void rms_final(Frame& F, const float* gain) {
    for (int r = F.gw; r < ROW_M; r += F.NGW) {
        float* xr = F_X0(F) + (size_t)r * DM; f32x4 v[4]; float ss = 0.f;
#pragma unroll
        for (int j = 0; j < 4; ++j) { v[j] = *(const f32x4*)(xr + 4 * F.lane + 256 * j); ss += (v[j].x * v[j].x + v[j].y * v[j].y) + (v[j].z * v[j].z + v[j].w * v[j].w); }
        const float rs = rsqrtf(wave_sum(ss) * (1.f / DM) + EPS);
#pragma unroll
        for (int j = 0; j < 4; ++j) { const f32x4 gn = *(const f32x4*)(gain + 4 * F.lane + 256 * j); *(f32x4*)(xr + 4 * F.lane + 256 * j) = v[j] * rs * gn; }
    }
}

struct EpiFfn {
    static constexpr bool PERM = true, AFTER_DRAIN = false;
    bf16* H0; bf16* H1; const float* cw; const float* cb; const float* cst; float* cso; float* sbl; float* sbf; const float* ssq;
    __device__ __forceinline__ void operator()(f32x4 (&acc)[2][2][4][2], const pg8::Unit& u, int wr, int wc, int fr, int fq) const {
        bf16* H = (u.pm < 64) ? H0 : H1;
        const int ch0 = 128 * u.pn + 32 * wc + 8 * fq;
        const int tok0 = 256 * u.pm + 128 * wr + 8 * fr;
        const int grp = 2 * u.pm + wr;
        const bool samp = (u.pm >= 64 && u.pm < PM_META), meta = (u.pm == PM_META);
        const int sb = 32 * (u.pm - 64) + 16 * wr + fr;
        const bool defer = (!samp && !meta && fr == 0);
        const bool lastlane = meta ? (wr == 0 && fr == 1) : (!samp && fr == 15);
#pragma unroll
        for (int k = 0; k < 8; ++k) { const float rs = pg8::row_rs(ssq, tok0 + k, fq);
#pragma unroll
            for (int bj = 0; bj < 2; ++bj)
#pragma unroll
                for (int n = 0; n < 2; ++n) acc[k >> 2][bj][k & 3][n] = acc[k >> 2][bj][k & 3][n] * rs; }
#pragma unroll
        for (int n = 0; n < 2; ++n) {
            const int c4 = ch0 + 4 * n;
            const f32x4 w0 = *(const f32x4*)(cw + c4), w1 = *(const f32x4*)(cw + DFF + c4), w2 = *(const f32x4*)(cw + 2 * DFF + c4), bb = *(const f32x4*)(cb + c4);
            f32x4 p6, p7;
#pragma unroll
            for (int e = 0; e < 4; ++e) { p6[e] = __shfl_up(acc[1][0][2][n][e], 1, 16); p7[e] = __shfl_up(acc[1][0][3][n][e], 1, 16); }
            if (samp) { p6 = *(const f32x4*)(cst + (size_t)(sb * 2 + 0) * DFF + c4); p7 = *(const f32x4*)(cst + (size_t)(sb * 2 + 1) * DFF + c4); }
            if (meta && wr == 0 && fr == 0) { p6 = (f32x4){0.f, 0.f, 0.f, 0.f}; p7 = p6; }
#pragma unroll
            for (int k = 0; k < 8; ++k) {
                const f32x4 uk = acc[k >> 2][0][k & 3][n], gk = acc[k >> 2][1][k & 3][n];
                const f32x4 um1 = (k >= 1) ? acc[(k - 1 < 0 ? 0 : k - 1) >> 2][0][(k - 1 < 0 ? 0 : k - 1) & 3][n] : p7;
                const f32x4 um2 = (k >= 2) ? acc[(k - 2 < 0 ? 0 : k - 2) >> 2][0][(k - 2 < 0 ? 0 : k - 2) & 3][n] : (k == 1 ? p7 : p6);
                const f32x4 cv = bb + w0 * um2 + w1 * um1 + w2 * uk;
                f32x4 hv;
#pragma unroll
                for (int e = 0; e < 4; ++e) hv[e] = siluf_(cv[e]) * gk[e];
                if (defer && k < 2) {
                    *(f32x4*)(sbf + (size_t)((grp * 2 + k) * 2 + 0) * DFF + c4) = uk;
                    *(f32x4*)(sbf + (size_t)((grp * 2 + k) * 2 + 1) * DFF + c4) = gk;
                } else {
                    u32x2 w; w.x = pg8::cvt_pk_bf16(hv[0], hv[1]); w.y = pg8::cvt_pk_bf16(hv[2], hv[3]);
                    *(u32x2*)(H + (size_t)(tok0 + k) * DFF + c4) = w;
                }
            }
            if (lastlane) { *(f32x4*)(sbl + (size_t)(grp * 2 + 0) * DFF + c4) = acc[1][0][2][n]; *(f32x4*)(sbl + (size_t)(grp * 2 + 1) * DFF + c4) = acc[1][0][3][n]; }
            if (samp) { *(f32x4*)(cso + (size_t)(sb * 2 + 0) * DFF + c4) = acc[1][0][2][n]; *(f32x4*)(cso + (size_t)(sb * 2 + 1) * DFF + c4) = acc[1][0][3][n]; }
        }
    }
};

__device__ __forceinline__ void ffn_fixup(Frame& F, int layer) {
    const float* cw = F.in[22] + (size_t)layer * 3 * DFF; const float* cb = F.in[23] + (size_t)layer * DFF;
    bf16* H = F_Z(F);
    const int gt = blockIdx.x * (NWAVES * 64) + F.tid, NT = F.G * NWAVES * 64;
    for (int i = gt; i < 128 * DFF; i += NT) {
        const int grp = i / DFF, ch = i - grp * DFF;
        const int r0 = 128 * grp;
        const int pg = (r0 % 2048 == 0) ? GRP_META : grp - 1;
        const float um2 = F_SBL(F)[(size_t)(pg * 2 + 0) * DFF + ch], um1 = F_SBL(F)[(size_t)(pg * 2 + 1) * DFF + ch];
        const float u0 = F_SBF(F)[(size_t)((grp * 2 + 0) * 2 + 0) * DFF + ch], g0 = F_SBF(F)[(size_t)((grp * 2 + 0) * 2 + 1) * DFF + ch];
        const float u1 = F_SBF(F)[(size_t)((grp * 2 + 1) * 2 + 0) * DFF + ch], g1 = F_SBF(F)[(size_t)((grp * 2 + 1) * 2 + 1) * DFF + ch];
        const float w0 = cw[ch], w1 = cw[DFF + ch], w2 = cw[2 * DFF + ch], bb = cb[ch];
        const float c0 = bb + w0 * um2 + w1 * um1 + w2 * u0, c1 = bb + w0 * um1 + w1 * u0 + w2 * u1;
        H[(size_t)r0 * DFF + ch] = (bf16)f2bf(siluf_(c0) * g0);
        H[(size_t)(r0 + 1) * DFF + ch] = (bf16)f2bf(siluf_(c1) * g1);
    }
    float* fo = F.out + O_FP + (size_t)layer * 8 * 2 * DFF;
    for (int i = gt; i < 8 * 2 * DFF; i += NT) {
        const int b = i / (2 * DFF), rem = i - b * 2 * DFF, j = rem / DFF, ch = rem - j * DFF;
        const int grp = 2 * (8 * b + 7) + 1;
        fo[i] = F_SBL(F)[(size_t)(grp * 2 + j) * DFF + ch];
    }
}
typedef short bf16x8 __attribute__((ext_vector_type(8)));
typedef short v4i16_t __attribute__((ext_vector_type(4)));
constexpr int MX_PITCH = 272;
constexpr int MX_Q = 0, MX_K = 17408, MX_KH = 34816, MX_V = 52224, MX_GD = 69632  , MX_SC = 71680  , MX_OB = 74752  , MX_RP = 108544  , MX_DI = 110592  , MX_GN = 110848  , MX_LB = 111360  , MX_END = 111872;
constexpr int MX_OP = 132;
constexpr float LNKS = -2.4260151319598084f;
static_assert(MX_END <= 139264, "mixer LDS map");

__device__ __forceinline__ bf16x8 mk8(unsigned a, unsigned b, unsigned c, unsigned d) { const u32x4 v = {a, b, c, d}; return __builtin_bit_cast(bf16x8, v); }
__device__ __forceinline__ u32x2 tr16(const LAS unsigned char* p) { return __builtin_bit_cast(u32x2, __builtin_amdgcn_ds_read_tr16_b64_v4i16((LAS v4i16_t*)p)); }
typedef float f32x2_t __attribute__((ext_vector_type(2))); typedef __bf16 bf16x2_t __attribute__((ext_vector_type(2)));
__device__ __forceinline__ unsigned pkbf(float lo, float hi) { const f32x2_t v = {lo, hi}; const bf16x2_t b = __builtin_convertvector(v, bf16x2_t); return __builtin_bit_cast(unsigned, b); }
#define MFMA16(a, b, c) __builtin_amdgcn_mfma_f32_16x16x32_bf16((a), (b), (c), 0, 0, 0)
typedef short s16x4 __attribute__((ext_vector_type(4)));
__device__ __forceinline__ f32x4 mfma16k16(u32x2 a, u32x2 b, f32x4 c) { const u32x4 a4 = {a.x, a.y, 0u, 0u}, b4 = {b.x, b.y, 0u, 0u}; return __builtin_amdgcn_mfma_f32_16x16x32_bf16(__builtin_bit_cast(bf16x8, a4), __builtin_bit_cast(bf16x8, b4), c, 0, 0, 0); }
__device__ __forceinline__ bf16x8 ld8(const LAS unsigned char* p) { return __builtin_bit_cast(bf16x8, *(const LAS u32x4*)p); }
#define MX_POS4(d) (((d) & ~31) + 8 * ((((d) & 15)) >> 2) + 4 * (((d) >> 4) & 1))
template <int CTRL> __device__ __forceinline__ float dppf(float ident, float x) { return __builtin_bit_cast(float, __builtin_amdgcn_update_dpp(__builtin_bit_cast(int, ident), __builtin_bit_cast(int, x), CTRL, 0xf, 0xf, false)); }
__device__ __forceinline__ float row_prefix_sum(float x) { x += dppf<0x111>(0.f, x); x += dppf<0x112>(0.f, x); x += dppf<0x114>(0.f, x); x += dppf<0x118>(0.f, x); return x; }
__device__ __forceinline__ float row_prefix_max(float x) { x = fmaxf(x, dppf<0x111>(-3e38f, x)); x = fmaxf(x, dppf<0x112>(-3e38f, x)); x = fmaxf(x, dppf<0x114>(-3e38f, x)); x = fmaxf(x, dppf<0x118>(-3e38f, x)); return x; }
__device__ __forceinline__ float row_prefix_prod(float x) { x *= dppf<0x111>(1.f, x); x *= dppf<0x112>(1.f, x); x *= dppf<0x114>(1.f, x); x *= dppf<0x118>(1.f, x); return x; }
__device__ __forceinline__ float row_suffix_prod(float x) { x *= dppf<0x101>(1.f, x); x *= dppf<0x102>(1.f, x); x *= dppf<0x104>(1.f, x); x *= dppf<0x108>(1.f, x); return x; }
__device__ __forceinline__ float rdlane(float x, int l) { return __builtin_bit_cast(float, __builtin_amdgcn_readlane(__builtin_bit_cast(int, x), l)); }

constexpr int ROT_N = 2072;
__device__ __forceinline__ void p0_rotary(Frame& F, float* tab) {
    const int gt = blockIdx.x * (NWAVES * 64) + F.tid, NT = F.G * NWAVES * 64;
    for (int i = gt; i < ROT_N * 64; i += NT) {
        const int pi = i >> 6, fi = i & 63;
        const float pos = pi < 2064 ? (float)pi : (float)(16384 + pi - 2064);
        const float inv = exp2f((float)fi * (-13.287712379549449f / 63.0f));
        float sn, cs; sincosf(pos * inv, &sn, &cs);
        tab[2 * i] = cs; tab[2 * i + 1] = sn;
    }
}

#ifdef PROBE_BLOCK
#define MSTAMP_DECL unsigned long long t_last_ = __builtin_amdgcn_s_memrealtime();
#define MSTAMP(id) do { if (blockIdx.x == PROBE_BLOCK && tid == 0) { const unsigned long long t_now_ = __builtin_amdgcn_s_memrealtime(); volatile LAS unsigned long long* a_ = (volatile LAS unsigned long long*)(F.lds + 139264 + 128) + 48 + (id); *a_ = *a_ + (t_now_ - t_last_); t_last_ = t_now_; } } while (0)
#else
#define MSTAMP_DECL
#define MSTAMP(id) do { } while (0)
#endif
#define MX_SC_PARAMS(scv, row0, ntok, nmc, pos0) do { if (mode != 1) { if ((scv) == 0) { row0 = ROW_M; ntok = 16; nmc = 1; pos0 = 0; } else { row0 = b * 2048 + ((scv) - 1) * 64; ntok = 64; nmc = 4; pos0 = 16 + ((scv) - 1) * 64; } } \
        else { row0 = ROW_S + 8 * b; ntok = 8; nmc = 1; pos0 = 2064; } } while (0)

template <int TYPE, int NMC>
__device__ __forceinline__ void sg_chain(LAS unsigned char* L, LAS float* SC, f32x4 (&S)[8], f32x4& nacc, int w, int r16, int q) {
    LAS float* OB = (LAS float*)(L + MX_OB); LAS float* RP = (LAS float*)(L + MX_RP); LAS float* DI = (LAS float*)(L + MX_DI);
    f32x4 oo[4];
#pragma unroll
    for (int mc = 0; mc < NMC; ++mc) {
        oo[mc] = (f32x4){0.f, 0.f, 0.f, 0.f};
        {
            const LAS unsigned char* Qb = L + MX_Q + 16 * mc * MX_PITCH; const LAS unsigned char* Kb = L + MX_K + 16 * mc * MX_PITCH; const LAS unsigned char* Vb = L + MX_V + 16 * mc * MX_PITCH;
            f32x4 g0 = {0.f, 0.f, 0.f, 0.f}, g1 = {0.f, 0.f, 0.f, 0.f};
#pragma unroll
            for (int ks = 0; ks < 4; ++ks) {
                const bf16x8 kf = ld8(Kb + r16 * MX_PITCH + (32 * ks + 8 * q) * 2), qf = ld8(Qb + r16 * MX_PITCH + (32 * ks + 8 * q) * 2);
                if (ks & 1) g1 = MFMA16(kf, qf, g1); else g0 = MFMA16(kf, qf, g0);
            }
            const f32x4 g = g0 + g1;
            const float xi = SC[mc * 16 + r16]; const f32x4 y4 = *(const LAS f32x4*)(SC + 64 + mc * 16 + 4 * q);
            f32x4 P;
#pragma unroll
            for (int r = 0; r < 4; ++r) P[r] = (4 * q + r <= r16) ? g[r] * __expf(xi + y4[r]) : 0.f;
            if (TYPE == 0) { float ps = (P[0] + P[1]) + (P[2] + P[3]); ps += __shfl_xor(ps, 16); ps += __shfl_xor(ps, 32); if (w == 0 && q == 0) DI[16 * mc + r16] = ps; }
            const u32x2 vt = tr16(Vb + (4 * q + (r16 >> 2)) * MX_PITCH + (16 * w + 4 * (r16 & 3)) * 2);
            oo[mc] = mfma16k16((u32x2){pkbf(P[0], P[1]), pkbf(P[2], P[3])}, vt, oo[mc]);
        }
        if (mc == 1 || TYPE == 1) __builtin_amdgcn_sched_barrier(0);
    }
#pragma unroll
    for (int mc = 0; mc < NMC; ++mc) {
        {
            const LAS unsigned char* Qb = L + MX_Q + 16 * mc * MX_PITCH; const LAS unsigned char* Kb = L + MX_K + 16 * mc * MX_PITCH;
            const u32x2 vt = tr16(L + MX_V + 16 * mc * MX_PITCH + (4 * q + (r16 >> 2)) * MX_PITCH + (16 * w + 4 * (r16 & 3)) * 2);
            f32x4 o2a = {0.f, 0.f, 0.f, 0.f}, o2b = {0.f, 0.f, 0.f, 0.f};
#pragma unroll
            for (int ks = 0; ks < 4; ++ks) {
                const bf16x8 qf = ld8(Qb + r16 * MX_PITCH + (32 * ks + 8 * q) * 2);
                const bf16x8 SB = mk8(pkbf(S[2 * ks][0], S[2 * ks][1]), pkbf(S[2 * ks][2], S[2 * ks][3]), pkbf(S[2 * ks + 1][0], S[2 * ks + 1][1]), pkbf(S[2 * ks + 1][2], S[2 * ks + 1][3]));
                if (ks & 1) o2b = MFMA16(qf, SB, o2b); else o2a = MFMA16(qf, SB, o2a);
            }
            const f32x4 in4 = *(const LAS f32x4*)(SC + 128 + mc * 16 + 4 * q);
            oo[mc] = oo[mc] + in4 * (o2a + o2b);
            const f32x4 w4 = *(const LAS f32x4*)(SC + 192 + mc * 16 + 4 * q); const float carry = SC[320 + mc];
            if (TYPE == 0) {
                const u32x2 qn = *(const LAS u32x2*)(Qb + r16 * MX_PITCH + MX_POS4(16 * w + 4 * q) * 2);
                f32x4 rr = {0.f, 0.f, 0.f, 0.f}; rr = mfma16k16(qn, (u32x2){pkbf(nacc[0], nacc[1]), pkbf(nacc[2], nacc[3])}, rr);
                if (r16 == 0) {
#pragma unroll
                    for (int r = 0; r < 4; ++r) RP[w * 64 + 16 * mc + 4 * q + r] = rr[r]; }
            }
#pragma unroll
            for (int r = 0; r < 4; ++r) OB[(16 * mc + 4 * q + r) * MX_OP + 16 * w + r16] = oo[mc][r];
            const u32x2 VH = {pkbf(bflo(vt.x) * w4[0], bfhi(vt.x) * w4[1]), pkbf(bflo(vt.y) * w4[2], bfhi(vt.y) * w4[3])};
#pragma unroll
            for (int mt = 0; mt < 8; ++mt) {
                const u32x2 kt = tr16(Kb + (4 * q + (r16 >> 2)) * MX_PITCH + MX_POS4(16 * mt + 4 * (r16 & 3)) * 2);
                S[mt] = S[mt] * carry; S[mt] = mfma16k16(kt, VH, S[mt]);
            }
            if (TYPE == 0) {
                const u32x2 kt = tr16(Kb + (4 * q + (r16 >> 2)) * MX_PITCH + MX_POS4(16 * w + 4 * (r16 & 3)) * 2);
                nacc = nacc * carry; nacc = mfma16k16(kt, (u32x2){pkbf(w4[0], w4[1]), pkbf(w4[2], w4[3])}, nacc);
            }
        }
        if (mc + 1 < NMC) __builtin_amdgcn_sched_barrier(0);
    }
}

template <int TYPE>
__device__ __forceinline__ void mix_sg_unit(Frame& F, int b, int h, int mode  , const float* rot) {
    const bool prompt = (mode != 1);
    const int tid = F.tid, lane = F.lane, w = F.wave, r16 = lane & 15, q = lane >> 4;
    const int tk = tid >> 3, p = tid & 7;
    LAS unsigned char* L = F.lds;
    LAS float* OB = (LAS float*)(L + MX_OB); LAS float* RP = (LAS float*)(L + MX_RP); LAS float* DI = (LAS float*)(L + MX_DI);
    bf16* MIX = F_XN(F);
    const int qcol = (TYPE == 0 ? 0 : 2048) + 128 * h, kcol = (TYPE == 0 ? 512 : 2560) + 128 * h, vcol = (TYPE == 0 ? 1024 : 3072) + 128 * h, gcol = (TYPE == 0 ? 1536 : 3584) + 128 * h, mcol = (TYPE == 0 ? 0 : 512) + 128 * h;
    f32x4 S[8]; f32x4 nacc = {0.f, 0.f, 0.f, 0.f}; float m0 = 0.f;
#pragma unroll
    for (int mt = 0; mt < 8; ++mt) S[mt] = (f32x4){0.f, 0.f, 0.f, 0.f};
    if (!prompt) {
        const float* Sin = (TYPE == 0 ? F.in[2] : F.in[5]) + (size_t)(b * 4 + h) * 16384;
#pragma unroll
        for (int mt = 0; mt < 8; ++mt)
#pragma unroll
            for (int r = 0; r < 4; ++r) S[mt][r] = Sin[(16 * mt + 4 * q + r) * 128 + 16 * w + r16];
        if (TYPE == 0) {
#pragma unroll
            for (int r = 0; r < 4; ++r) nacc[r] = F.in[3][(size_t)(b * 4 + h) * 128 + 16 * w + 4 * q + r];
            m0 = F.in[4][b * 4 + h];
        }
    }
    const float lgam = (TYPE != 1) ? 0.f : h == 0 ? -0.031748698314580298f : h == 1 ? -0.015748356968139168f : h == 2 ? -0.0078431774610258928f : -0.0039138993211363287f;
    const float bias_i = (TYPE == 0) ? F.in[11][h] : 0.f, bias_f = (TYPE == 0) ? F.in[12][h] : 0.f;
    LAS float* GN = (LAS float*)(L + MX_GN);
    if (tid < 128) GN[tid] = (TYPE == 0 ? F.in[13] : F.in[14])[128 * h + tid];
    const int nsc = (mode == 0) ? 33 : 1;
    u32x4 pa[6]; f32x4 pr[4]; float pli = 0.f, plf = 0.f; u32x4 pg[2];
    const u32x4 z4 = {0u, 0u, 0u, 0u};
#define SG_LOAD(scv) do { int row0_, ntok_, nmc_, pos0_; MX_SC_PARAMS(scv, row0_, ntok_, nmc_, pos0_); (void)nmc_; \
        const bool valid_ = tk < ntok_; const bf16* zr_ = ZROW(F, row0_ + (valid_ ? tk : 0), 0); \
        _Pragma("unroll") for (int i_ = 0; i_ < 6; ++i_) pa[i_] = z4; \
        if (valid_) { pa[4] = *(const u32x4*)(zr_ + vcol + 16 * p); pa[5] = *(const u32x4*)(zr_ + vcol + 16 * p + 8); \
            if (TYPE == 0) { pa[0] = *(const u32x4*)(zr_ + qcol + 16 * p); pa[1] = *(const u32x4*)(zr_ + qcol + 16 * p + 8); pa[2] = *(const u32x4*)(zr_ + kcol + 16 * p); pa[3] = *(const u32x4*)(zr_ + kcol + 16 * p + 8); } \
            else { pa[0] = *(const u32x4*)(zr_ + qcol + 8 * p); pa[1] = *(const u32x4*)(zr_ + qcol + 64 + 8 * p); pa[2] = *(const u32x4*)(zr_ + kcol + 8 * p); pa[3] = *(const u32x4*)(zr_ + kcol + 64 + 8 * p); } } \
        if (TYPE == 1) { const float* tb_ = rot + ((size_t)(pos0_ + (valid_ ? tk : 0)) * 64 + 8 * p) * 2; _Pragma("unroll") for (int e_ = 0; e_ < 4; ++e_) pr[e_] = *(const f32x4*)(tb_ + 4 * e_); } \
        if (TYPE == 0 && w == 0) { const bool vt_ = lane < ntok_; const float* gp_ = F_GT(F) + (size_t)(row0_ + (vt_ ? lane : 0)) * 8; pli = gp_[h]; plf = gp_[4 + h]; } } while (0)
    SG_LOAD(0);
    MSTAMP_DECL
#pragma unroll 1
    for (int sc = 0; sc < nsc; ++sc) {
        int row0, ntok, nmc, pos0; MX_SC_PARAMS(sc, row0, ntok, nmc, pos0); (void)pos0;
        LAS float* SC = (LAS float*)(L + MX_SC) + (sc & 1) * 384;
        MSTAMP(0);
        {
            *(LAS u32x4*)(L + MX_V + tk * MX_PITCH + 32 * p) = pa[4]; *(LAS u32x4*)(L + MX_V + tk * MX_PITCH + 32 * p + 16) = pa[5];
            if (TYPE == 0) {
                const int c0 = (MX_POS4(16 * p)) * 2;
#pragma unroll
                for (int g = 0; g < 4; ++g) {
                    *(LAS u32x2*)(L + MX_Q + tk * MX_PITCH + c0 + 16 * g) = (u32x2){pa[g >> 1][2 * (g & 1)], pa[g >> 1][2 * (g & 1) + 1]};
                    *(LAS u32x2*)(L + MX_K + tk * MX_PITCH + c0 + 16 * g) = (u32x2){pa[2 + (g >> 1)][2 * (g & 1)], pa[2 + (g >> 1)][2 * (g & 1) + 1]};
                }
            } else {
                u32x4 q1, q2, k1, k2;
#pragma unroll
                for (int e2 = 0; e2 < 4; ++e2) {
                    const f32x4 cs = pr[e2];
                    { const float x1l = bflo(pa[0][e2]), x1h = bfhi(pa[0][e2]), x2l = bflo(pa[1][e2]), x2h = bfhi(pa[1][e2]);
                      q1[e2] = pkbf(x1l * cs[0] - x2l * cs[1], x1h * cs[2] - x2h * cs[3]); q2[e2] = pkbf(x2l * cs[0] + x1l * cs[1], x2h * cs[2] + x1h * cs[3]); }
                    { const float x1l = bflo(pa[2][e2]), x1h = bfhi(pa[2][e2]), x2l = bflo(pa[3][e2]), x2h = bfhi(pa[3][e2]);
                      k1[e2] = pkbf(x1l * cs[0] - x2l * cs[1], x1h * cs[2] - x2h * cs[3]); k2[e2] = pkbf(x2l * cs[0] + x1l * cs[1], x2h * cs[2] + x1h * cs[3]); }
                }
                const int c0 = (MX_POS4(8 * p)) * 2;
                *(LAS u32x2*)(L + MX_Q + tk * MX_PITCH + c0) = (u32x2){q1[0], q1[1]}; *(LAS u32x2*)(L + MX_Q + tk * MX_PITCH + c0 + 16) = (u32x2){q1[2], q1[3]};
                *(LAS u32x2*)(L + MX_Q + tk * MX_PITCH + c0 + 128) = (u32x2){q2[0], q2[1]}; *(LAS u32x2*)(L + MX_Q + tk * MX_PITCH + c0 + 144) = (u32x2){q2[2], q2[3]};
                *(LAS u32x2*)(L + MX_K + tk * MX_PITCH + c0) = (u32x2){k1[0], k1[1]}; *(LAS u32x2*)(L + MX_K + tk * MX_PITCH + c0 + 16) = (u32x2){k1[2], k1[3]};
                *(LAS u32x2*)(L + MX_K + tk * MX_PITCH + c0 + 128) = (u32x2){k2[0], k2[1]}; *(LAS u32x2*)(L + MX_K + tk * MX_PITCH + c0 + 144) = (u32x2){k2[2], k2[3]};
            }
        }
        if (w == 0) {
            const bool valid = lane < ntok;
            float li = -1e30f, lf = 0.f;
            if (TYPE == 0) { if (valid) { li = pli + bias_i; lf = logsigmoidf_(plf + bias_f); } } else { if (valid) { li = 0.f; lf = lgam; } }
            const float bb = row_prefix_sum(lf);
            const float y = li - bb;
            const float am = row_prefix_max(y);
            const float a = bb + am;
            const float B0 = rdlane(bb, 15), B1 = rdlane(bb, 31), B2 = rdlane(bb, 47), B3 = rdlane(bb, 63);
            float M1 = 0.f, M2 = 0.f, M3 = 0.f, M4 = 0.f;
            if (TYPE == 0) { const float A0 = rdlane(a, 15), A1 = rdlane(a, 31), A2 = rdlane(a, 47), A3 = rdlane(a, 63);
                M1 = fmaxf(B0 + m0, A0); M2 = fmaxf(B1 + M1, A1); M3 = fmaxf(B2 + M2, A2); M4 = fmaxf(B3 + M3, A3); }
            const float m0q = q == 0 ? m0 : q == 1 ? M1 : q == 2 ? M2 : M3;
            const float mnq = q == 0 ? M1 : q == 1 ? M2 : q == 2 ? M3 : M4;
            const float b15 = q == 0 ? B0 : q == 1 ? B1 : q == 2 ? B2 : B3;
            const float m = (TYPE == 0) ? fmaxf(bb + m0q, a) : 0.f;
            SC[lane] = bb - m; SC[64 + lane] = y + LNKS; SC[128 + lane] = __expf(bb + m0q - m);
            SC[192 + lane] = __expf(y + LNKS + b15 - mnq); SC[256 + lane] = __expf(-m);
            if (r16 == 0) SC[320 + q] = __expf(b15 + m0q - mnq);
            m0 = (nmc == 4) ? M4 : M1;
        }
        MSTAMP(1);
        __syncthreads();
        MSTAMP(2);
        if (sc + 1 < nsc) SG_LOAD(sc + 1);
        { const bool valid = tk < ntok; const bf16* zr = ZROW(F, row0 + (valid ? tk : 0), 0) + gcol + 16 * p; pg[0] = *(const u32x4*)zr; pg[1] = *(const u32x4*)(zr + 8); }
        MSTAMP(3);
        if (nmc == 4) sg_chain<TYPE, 4>(L, SC, S, nacc, w, r16, q); else sg_chain<TYPE, 1>(L, SC, S, nacc, w, r16, q);
        MSTAMP(4);
        __syncthreads();
        MSTAMP(6);
        {
            const bool valid = tk < ntok; const int row = row0 + (valid ? tk : 0);
            f32x4 o[4];
#pragma unroll
            for (int c = 0; c < 4; ++c) o[c] = *(const LAS f32x4*)(OB + tk * MX_OP + 16 * p + 4 * c);
            if (tk >= 16 * nmc) {
#pragma unroll
                for (int c = 0; c < 4; ++c) o[c] = (f32x4){0.f, 0.f, 0.f, 0.f}; }
            if (TYPE == 0) {
                float rs = 0.f;
#pragma unroll
                for (int ww = 0; ww < 8; ++ww) rs += RP[ww * 64 + tk];
                const float den = DI[tk] + SC[128 + tk] * rs;
                float dn = fmaxf(fabsf(den), SC[256 + tk]); if (tk >= 16 * nmc) dn = 1.f;
                const float rd = 1.f / dn;
#pragma unroll
                for (int c = 0; c < 4; ++c) o[c] = o[c] * rd;
            }
            float sm = 0.f;
#pragma unroll
            for (int c = 0; c < 4; ++c) sm += (o[c].x + o[c].y) + (o[c].z + o[c].w);
            sm += __shfl_xor(sm, 1); sm += __shfl_xor(sm, 2); sm += __shfl_xor(sm, 4);
            const float mu = sm * (1.f / 128.f); float vs = 0.f;
#pragma unroll
            for (int c = 0; c < 4; ++c) { o[c] = o[c] - mu; vs += (o[c].x * o[c].x + o[c].y * o[c].y) + (o[c].z * o[c].z + o[c].w * o[c].w); }
            vs += __shfl_xor(vs, 1); vs += __shfl_xor(vs, 2); vs += __shfl_xor(vs, 4);
            const float rstd = rsqrtf(vs * (1.f / 128.f) + EPS);
            if (valid && !(mode == 0 && sc == 0)) {
                unsigned ow[8];
#pragma unroll
                for (int c = 0; c < 4; ++c) {
                    const unsigned ga = c < 2 ? pg[0][2 * c] : pg[1][2 * c - 4], gb = c < 2 ? pg[0][2 * c + 1] : pg[1][2 * c - 3];
                    f32x4 gt = {bflo(ga), bfhi(ga), bflo(gb), bfhi(gb)};
#pragma unroll
                    for (int e = 0; e < 4; ++e) gt[e] = (TYPE == 0) ? sigmoidf_(gt[e]) : siluf_(gt[e]);
                    const f32x4 r = o[c] * rstd * *(const LAS f32x4*)(GN + 16 * p + 4 * c) * gt;
                    ow[2 * c] = pkbf(r.x, r.y); ow[2 * c + 1] = pkbf(r.z, r.w);
                }
                bf16* mp = MIX + (size_t)row * DM + mcol + 16 * p;
                *(u32x4*)mp = (u32x4){ow[0], ow[1], ow[2], ow[3]}; *(u32x4*)(mp + 8) = (u32x4){ow[4], ow[5], ow[6], ow[7]};
            }
        }
        MSTAMP(7);
    }
#undef SG_LOAD
    __syncthreads();
    if (mode != 2) {
        int l2 = F.lane; asm volatile("" : "+v"(l2)); const int r16 = l2 & 15, q = l2 >> 4;
        float* So = F.out + (TYPE == 0 ? (prompt ? O_CP : O_CS) : (prompt ? O_RP : O_RS)) + (size_t)(b * 4 + h) * 16384;
#pragma unroll
        for (int mt = 0; mt < 8; ++mt)
#pragma unroll
            for (int r = 0; r < 4; ++r) So[(16 * mt + 4 * q + r) * 128 + 16 * w + r16] = S[mt][r];
        if (TYPE == 0) {
            if (r16 == 0) { float* No = F.out + (prompt ? O_NP : O_NS) + (size_t)(b * 4 + h) * 128;
#pragma unroll
                for (int r = 0; r < 4; ++r) No[16 * w + 4 * q + r] = nacc[r]; }
            if (w == 0 && lane == 0) F.out[(prompt ? O_MP : O_MS) + b * 4 + h] = m0;
        }
    }
}

template <int NMC>
__device__ __forceinline__ void hg_chain(LAS unsigned char* L, f32x4 (&S)[8], int w, int r16, int q) {
    LAS float* GD = (LAS float*)(L + MX_GD); LAS float* OB = (LAS float*)(L + MX_OB);
    f32x4 oo[4];
#pragma unroll
    for (int mc = 0; mc < NMC; ++mc) {
        oo[mc] = (f32x4){0.f, 0.f, 0.f, 0.f};
        {
            const LAS unsigned char* Qb = L + MX_Q + 16 * mc * MX_PITCH; const LAS unsigned char* Kb = L + MX_K + 16 * mc * MX_PITCH; const LAS unsigned char* Vb = L + MX_V + 16 * mc * MX_PITCH;
            f32x4 g0 = {0.f, 0.f, 0.f, 0.f}, g1 = {0.f, 0.f, 0.f, 0.f};
#pragma unroll
            for (int ks = 0; ks < 4; ++ks) {
                const bf16x8 kf = ld8(Kb + r16 * MX_PITCH + (32 * ks + 8 * q) * 2), qf = ld8(Qb + r16 * MX_PITCH + (32 * ks + 8 * q) * 2);
                if (ks & 1) g1 = MFMA16(kf, qf, g1); else g0 = MFMA16(kf, qf, g0);
            }
            const f32x4 g = g0 + g1;
            f32x4 P;
#pragma unroll
            for (int r = 0; r < 4; ++r) P[r] = (4 * q + r <= r16) ? g[r] : 0.f;
            const u32x2 vt = tr16(Vb + (4 * q + (r16 >> 2)) * MX_PITCH + (16 * w + 4 * (r16 & 3)) * 2);
            oo[mc] = mfma16k16((u32x2){pkbf(P[0], P[1]), pkbf(P[2], P[3])}, vt, oo[mc]);
        }
        if (mc == 1) __builtin_amdgcn_sched_barrier(0);
    }
#pragma unroll
    for (int mc = 0; mc < NMC; ++mc) {
        {
            const LAS unsigned char* Qb = L + MX_Q + 16 * mc * MX_PITCH; const LAS unsigned char* Hb = L + MX_KH + 16 * mc * MX_PITCH;
            const u32x2 vt = tr16(L + MX_V + 16 * mc * MX_PITCH + (4 * q + (r16 >> 2)) * MX_PITCH + (16 * w + 4 * (r16 & 3)) * 2);
            f32x4 o2b = {0.f, 0.f, 0.f, 0.f};
#pragma unroll
            for (int ks = 0; ks < 4; ++ks) {
                const bf16x8 qf = ld8(Qb + r16 * MX_PITCH + (32 * ks + 8 * q) * 2);
                const bf16x8 SB = mk8(pkbf(S[2 * ks][0], S[2 * ks][1]), pkbf(S[2 * ks][2], S[2 * ks][3]), pkbf(S[2 * ks + 1][0], S[2 * ks + 1][1]), pkbf(S[2 * ks + 1][2], S[2 * ks + 1][3]));
                if (ks & 1) o2b = MFMA16(qf, SB, o2b); else oo[mc] = MFMA16(qf, SB, oo[mc]);
            }
            oo[mc] = oo[mc] + o2b;
#pragma unroll
            for (int mt = 0; mt < 8; ++mt) {
                const f32x4 gd = *(const LAS f32x4*)(GD + mc * 128 + 16 * mt + 4 * q);
                const u32x2 kt = tr16(Hb + (4 * q + (r16 >> 2)) * MX_PITCH + (16 * mt + 4 * (r16 & 3)) * 2);
                S[mt] = S[mt] * gd; S[mt] = mfma16k16(kt, vt, S[mt]);
            }
        }
        if (mc + 1 < NMC) __builtin_amdgcn_sched_barrier(0);
    }
#pragma unroll
    for (int mc = 0; mc < NMC; ++mc) {
        {
#pragma unroll
            for (int r = 0; r < 4; ++r) OB[(16 * mc + 4 * q + r) * MX_OP + 16 * w + r16] = oo[mc][r];
        }
    }
}

__device__ __forceinline__ void mix_hg_unit(Frame& F, int b, int h, int mode) {
    const bool prompt = (mode != 1);
    const int tid = F.tid, lane = F.lane, w = F.wave, r16 = lane & 15, q = lane >> 4;
    const int tk = tid >> 3, p = tid & 7;
    const int amc = w >> 1, app = q + 4 * (w & 1);
    LAS unsigned char* L = F.lds;
    LAS float* GD = (LAS float*)(L + MX_GD); LAS float* OB = (LAS float*)(L + MX_OB);
    bf16* MIX = F_XN(F);
    f32x4 S[8];
#pragma unroll
    for (int mt = 0; mt < 8; ++mt) S[mt] = (f32x4){0.f, 0.f, 0.f, 0.f};
    if (!prompt) {
        const float* Sin = F.in[6] + (size_t)(b * 8 + h) * 16384;
#pragma unroll
        for (int mt = 0; mt < 8; ++mt)
#pragma unroll
            for (int r = 0; r < 4; ++r) S[mt][r] = Sin[(16 * mt + 4 * q + r) * 128 + 16 * w + r16];
    }
    LAS float* GN = (LAS float*)(L + MX_GN); LAS float* LB = (LAS float*)(L + MX_LB);
    if (tid < 128) { GN[tid] = F.in[18][128 * h + tid]; LB[tid] = sigmoidf_(F.in[16][1024 + 128 * h + tid] - F.in[16][128 * h + tid]); }
    __syncthreads();
    const int nsc = (mode == 0) ? 33 : 1;
    u32x4 pa[6]; u32x4 pg[2];
    const u32x4 z4 = {0u, 0u, 0u, 0u};
#define HG_LOAD(scv) do { int row0_, ntok_, nmc_, pos0_; MX_SC_PARAMS(scv, row0_, ntok_, nmc_, pos0_); (void)pos0_; \
        const int t_ = 16 * amc + r16; const bool valid_ = (amc < nmc_) && (t_ < ntok_); const bf16* zr_ = ZROW(F, row0_ + (valid_ ? t_ : 0), 1) + 128 * h + 16 * app; \
        _Pragma("unroll") for (int i_ = 0; i_ < 6; ++i_) pa[i_] = z4; \
        if (valid_) { pa[0] = *(const u32x4*)zr_; pa[1] = *(const u32x4*)(zr_ + 8); pa[2] = *(const u32x4*)(zr_ + 1024); pa[3] = *(const u32x4*)(zr_ + 1032); pa[4] = *(const u32x4*)(zr_ + 2048); pa[5] = *(const u32x4*)(zr_ + 2056); } } while (0)
    HG_LOAD(0);
    MSTAMP_DECL
#pragma unroll 1
    for (int sc = 0; sc < nsc; ++sc) {
        int row0, ntok, nmc, pos0; MX_SC_PARAMS(sc, row0, ntok, nmc, pos0); (void)pos0;
        MSTAMP(8);
        {
            const bool valid = (amc < nmc) && (16 * amc + r16) < ntok;
            unsigned wq[8], wk[8], wh[8]; float Aend[16]; float lbv[16];
#pragma unroll
            for (int c = 0; c < 4; ++c) { const f32x4 t4 = *(const LAS f32x4*)(LB + 16 * app + 4 * c); lbv[4 * c] = t4[0]; lbv[4 * c + 1] = t4[1]; lbv[4 * c + 2] = t4[2]; lbv[4 * c + 3] = t4[3]; }
#pragma unroll
            for (int e2 = 0; e2 < 8; ++e2) {
                const unsigned qw = e2 < 4 ? pa[0][e2] : pa[1][e2 - 4], fw = e2 < 4 ? pa[2][e2] : pa[3][e2 - 4];
                float qo[2], ko[2], ho[2];
#pragma unroll
                for (int hh = 0; hh < 2; ++hh) {
                    const int e = 2 * e2 + hh;
                    const float qv = hh ? bfhi(qw) : bflo(qw), fv = hh ? bfhi(fw) : bflo(fw);
                    const float sg = sigmoidf_(fv);
                    const float a = valid ? lbv[e] + (1.f - lbv[e]) * sg : 1.f;
                    const float kk = valid ? (1.f - lbv[e]) * (1.f - sg) : 0.f;
                    const float A = row_prefix_prod(a);
                    const float A15 = __builtin_bit_cast(float, __builtin_amdgcn_ds_swizzle(__builtin_bit_cast(int, A), 0x1F0));
                    const float kr = kk * __builtin_amdgcn_rcpf(fmaxf(A, 1e-30f));
                    qo[hh] = qv * A; ko[hh] = kr; ho[hh] = kr * A15;
                    Aend[e] = A;
                }
                wq[e2] = pkbf(qo[0], qo[1]); wk[e2] = pkbf(ko[0], ko[1]); wh[e2] = pkbf(ho[0], ho[1]);
            }
            const int ro = (16 * amc + r16) * MX_PITCH + 32 * app;
            { const int rf = (16 * amc + r16) * MX_PITCH + (MX_POS4(16 * app)) * 2;
#pragma unroll
              for (int g = 0; g < 4; ++g) { *(LAS u32x2*)(L + MX_Q + rf + 16 * g) = (u32x2){wq[2 * g], wq[2 * g + 1]}; *(LAS u32x2*)(L + MX_K + rf + 16 * g) = (u32x2){wk[2 * g], wk[2 * g + 1]}; } }
            *(LAS u32x4*)(L + MX_KH + ro) = (u32x4){wh[0], wh[1], wh[2], wh[3]}; *(LAS u32x4*)(L + MX_KH + ro + 16) = (u32x4){wh[4], wh[5], wh[6], wh[7]};
            *(LAS u32x4*)(L + MX_V + ro) = pa[4]; *(LAS u32x4*)(L + MX_V + ro + 16) = pa[5];
            if (r16 == 15) {
#pragma unroll
                for (int c = 0; c < 4; ++c) *(LAS f32x4*)(GD + amc * 128 + 16 * app + 4 * c) = (f32x4){Aend[4 * c], Aend[4 * c + 1], Aend[4 * c + 2], Aend[4 * c + 3]}; }
        }
        MSTAMP(9);
        __syncthreads();
        MSTAMP(10);
        if (sc + 1 < nsc) HG_LOAD(sc + 1);
        { const bool valid = tk < ntok; const bf16* zr = ZROW(F, row0 + (valid ? tk : 0), 1) + 3072 + 128 * h + 16 * p; pg[0] = *(const u32x4*)zr; pg[1] = *(const u32x4*)(zr + 8); }
        MSTAMP(11);
        if (nmc == 4) hg_chain<4>(L, S, w, r16, q); else hg_chain<1>(L, S, w, r16, q);
        MSTAMP(12);
        __syncthreads();
        MSTAMP(13);
        {
            const bool valid = tk < ntok; const int row = row0 + (valid ? tk : 0);
            f32x4 o[4];
#pragma unroll
            for (int c = 0; c < 4; ++c) o[c] = *(const LAS f32x4*)(OB + tk * MX_OP + 16 * p + 4 * c);
            if (tk >= 16 * nmc) {
#pragma unroll
                for (int c = 0; c < 4; ++c) o[c] = (f32x4){0.f, 0.f, 0.f, 0.f}; }
            float vs = 0.f;
#pragma unroll
            for (int c = 0; c < 4; ++c) vs += (o[c].x * o[c].x + o[c].y * o[c].y) + (o[c].z * o[c].z + o[c].w * o[c].w);
            vs += __shfl_xor(vs, 1); vs += __shfl_xor(vs, 2); vs += __shfl_xor(vs, 4);
            const float rstd = rsqrtf(vs * (1.f / 128.f) + EPS);
            if (valid && !(mode == 0 && sc == 0)) {
                unsigned ow[8];
#pragma unroll
                for (int c = 0; c < 4; ++c) {
                    const unsigned ga = c < 2 ? pg[0][2 * c] : pg[1][2 * c - 4], gb = c < 2 ? pg[0][2 * c + 1] : pg[1][2 * c - 3];
                    f32x4 gt = {bflo(ga), bfhi(ga), bflo(gb), bfhi(gb)};
#pragma unroll
                    for (int e = 0; e < 4; ++e) gt[e] = siluf_(gt[e]);
                    const f32x4 r = o[c] * rstd * *(const LAS f32x4*)(GN + 16 * p + 4 * c) * gt;
                    ow[2 * c] = pkbf(r.x, r.y); ow[2 * c + 1] = pkbf(r.z, r.w);
                }
                bf16* mp = MIX + (size_t)row * DM + 128 * h + 16 * p;
                *(u32x4*)mp = (u32x4){ow[0], ow[1], ow[2], ow[3]}; *(u32x4*)(mp + 8) = (u32x4){ow[4], ow[5], ow[6], ow[7]};
            }
        }
        MSTAMP(14);
    }
#undef HG_LOAD
    __syncthreads();
    if (mode != 2) {
        int l2 = F.lane; asm volatile("" : "+v"(l2)); const int r16 = l2 & 15, q = l2 >> 4;
        float* So = F.out + (prompt ? O_HP : O_HS) + (size_t)(b * 8 + h) * 16384;
#pragma unroll
        for (int mt = 0; mt < 8; ++mt)
#pragma unroll
            for (int r = 0; r < 4; ++r) So[(16 * mt + 4 * q + r) * 128 + 16 * w + r16] = S[mt][r];
    }
}

__device__ __forceinline__ void mixer_layer0(Frame& F) {
    const float* rot = (const float*)(F.ws + WS_ROT);
    int bid = blockIdx.x; asm volatile("" : "+s"(bid));
    if (bid < 64) { const int u = bid, ty = u >> 5, bh = u & 31; if (ty == 0) mix_sg_unit<0>(F, bh >> 2, bh & 3, 0, rot); else mix_sg_unit<1>(F, bh >> 2, bh & 3, 0, rot); return; }
#pragma unroll 1
    for (int u = bid - 64; u < 1024 + 8; u += F.G - 64) {
        int ty, bh, mode;
        if (u < 1024) { ty = u >> 9; bh = u & 511; mode = 1; } else { ty = (u - 1024) >> 2; bh = (u - 1024) & 3; mode = 2; }
        if (ty == 0) mix_sg_unit<0>(F, bh >> 2, bh & 3, mode, rot); else mix_sg_unit<1>(F, bh >> 2, bh & 3, mode, rot);
    }
}
__device__ __forceinline__ void mixer_layer1(Frame& F) {
    int bid = blockIdx.x; asm volatile("" : "+s"(bid));
    if (bid < 64) { mix_hg_unit(F, bid >> 3, bid & 7, 0); return; }
#pragma unroll 1
    for (int u = bid - 64; u < 1024 + 8; u += F.G - 64) {
        if (u < 1024) mix_hg_unit(F, u >> 3, u & 7, 1); else mix_hg_unit(F, 0, u - 1024, 2);
    }
}
constexpr int NSTEP = 21;
#ifndef P0_DEFER
#define P0_DEFER 0
#endif
constexpr int LDSCTL_OFF = 139264;
#define RLX_AGENT __ATOMIC_RELAXED, __HIP_MEMORY_SCOPE_AGENT
#define XB_TMO      128
#define XB_XCNT(j)  (256  + 64 * (j))
#define XB_XSUB(j)  (1280 + 64 * (j))
#define XB_XGEN(j)  (2304 + 64 * (j))
#define XB_TOP      3328
#define XB_TOPGEN   3392
#define XCD_BAR_WORDS 3456
#define XB_SPIN_CAP (1u << 18)

__device__ __forceinline__ unsigned xb_ld(unsigned* p)              { return __hip_atomic_load(p, __ATOMIC_RELAXED, __HIP_MEMORY_SCOPE_AGENT); }
__device__ __forceinline__ unsigned xb_add(unsigned* p, unsigned v) { return __hip_atomic_fetch_add(p, v, __ATOMIC_RELAXED, __HIP_MEMORY_SCOPE_AGENT); }
__device__ __forceinline__ unsigned xb_xcc_id() { return (unsigned)__builtin_amdgcn_s_getreg((3 << 11) | 20) & 0xFu; }
#define XB_SPIN(cond, bar) do { unsigned _sp = 0; while (cond) { __builtin_amdgcn_s_sleep(1); \
    if ((++_sp & 255u) == 0u) { if (xb_ld(&(bar)[XB_TMO])) break; if (_sp > XB_SPIN_CAP) { atomicAdd(&(bar)[XB_TMO], 1u); break; } } } } while (0)

struct XcdBarrier {
    unsigned gsz;
    unsigned* bar; unsigned x;
    volatile LAS unsigned* st;
};

__device__ __forceinline__ XcdBarrier xcd_barrier_post(unsigned* bar, volatile LAS unsigned* st, unsigned gsz) {
    XcdBarrier b; b.gsz = gsz; b.bar = bar; b.x = xb_xcc_id(); b.st = st;
    if (threadIdx.x == 0) (void)xb_add(&bar[XB_XCNT(b.x)], 1u);
    return b;
}
__device__ __forceinline__ void xcd_barrier_complete(unsigned* bar, unsigned x, unsigned G, unsigned& nloc, unsigned& nx) {
    unsigned sum, cnt, mine, sp = 0u;
    for (;;) {
        sum = 0u; cnt = 0u; mine = 0u;
#pragma unroll
        for (unsigned j = 0; j < 16; ++j) { const unsigned c = xb_ld(&bar[XB_XCNT(j)]); sum += c; cnt += (c > 0u) ? 1u : 0u; mine = (j == x) ? c : mine; }
        if (sum == G) break;
        __builtin_amdgcn_s_sleep(1);
        if ((++sp & 255u) == 0u) { if (xb_ld(&bar[XB_TMO])) break; if (sp > XB_SPIN_CAP) { atomicAdd(&bar[XB_TMO], 1u); break; } }
    }
    nloc = mine > 0u ? mine : 1u; nx = cnt > 0u ? cnt : 1u;
}

__device__ __forceinline__ void xcd_barrier(const XcdBarrier& b) {
    asm volatile("s_waitcnt vmcnt(0)" ::: "memory");
    __syncthreads();
    if (threadIdx.x == 0) {
        unsigned* bar = b.bar;
        __builtin_amdgcn_s_waitcnt(0);
        unsigned nloc = b.st[0], nx = b.st[1];
        if (nloc == 0u) { xcd_barrier_complete(bar, b.x, b.gsz, nloc, nx); b.st[0] = nloc; b.st[1] = nx; }
        const unsigned old = xb_add(&bar[XB_XSUB(b.x)], 1u);
        const unsigned gen = old / nloc;
        if (old + 1u == (gen + 1u) * nloc) {
            __builtin_amdgcn_fence(__ATOMIC_RELEASE, "agent");
            asm volatile("s_waitcnt vmcnt(0)" ::: "memory");
            const unsigned og = xb_add(&bar[XB_TOP], 1u);
            const unsigned tg = og / nx;
            if (og + 1u == (tg + 1u) * nx) xb_add(&bar[XB_TOPGEN], 1u);
            else XB_SPIN(xb_ld(&bar[XB_TOPGEN]) == tg, bar);
            __builtin_amdgcn_fence(__ATOMIC_ACQUIRE, "agent");
            xb_add(&bar[XB_XGEN(b.x)], 1u);
            asm volatile("s_waitcnt vmcnt(0)" ::: "memory");
        } else {
            XB_SPIN(xb_ld(&bar[XB_XGEN(b.x)]) == gen, bar);
            __builtin_amdgcn_fence(__ATOMIC_ACQUIRE, "agent");
            asm volatile("s_waitcnt vmcnt(0)" ::: "memory");
        }
    }
    __syncthreads();
}


enum { K_P0 = 0, K_IN = 1, K_MIX = 2, K_OUT = 3, K_UP = 5, K_FIX = 6, K_DOWN = 7, K_FINAL = 8 };
struct Step { int kind, layer, side, tile0, nt, pre; };
__device__ __forceinline__ Step get_step(int pc) {
    switch (pc) {
        case 0:  return Step{K_P0, 0, 0, 0, 0, 0};
        case 1:  return Step{K_IN, 0, 0, 0, 69, 1};
        case 2:  return Step{K_MIX, 0, 0, 0, 0, 1};
        case 3:  return Step{K_OUT, 0, 1, 64, 5, 2};
        case 4:  return Step{K_UP, 0, 1, 64, 5, 2};
        case 5:  return Step{K_DOWN, 0, 1, 64, 5, 2};
        case 6:  return Step{K_IN, 1, 1, 64, 5, 2};
        case 7:  return Step{K_OUT, 0, 0, 0, 64, 1};
        case 8:  return Step{K_UP, 0, 0, 0, 64, 1};
        case 9:  return Step{K_FIX, 0, 0, 0, 0, 1};
        case 10: return Step{K_DOWN, 0, 0, 0, 64, 1};
        case 11: return Step{K_IN, 1, 0, 0, 64, 1};
        case 12: return Step{K_MIX, 1, 0, 0, 0, 1};
        case 13: return Step{K_OUT, 1, 1, 64, 5, 2};
        case 14: return Step{K_UP, 1, 1, 64, 5, 2};
        case 15: return Step{K_DOWN, 1, 1, 64, 5, 2};
        case 16: return Step{K_OUT, 1, 0, 0, 64, 1};
        case 17: return Step{K_UP, 1, 0, 0, 64, 1};
        case 18: return Step{K_FIX, 1, 0, 0, 0, 1};
        case 19: return Step{K_DOWN, 1, 0, 0, 64, 1};
        default: return Step{K_FINAL, 0, 0, 0, 0, 1};
    }
}

__global__ void __launch_bounds__(NWAVES * 64, 2) fwd_kernel(Args args) {
    extern __shared__ __attribute__((aligned(16))) unsigned char lds_raw[];
    cg::grid_group grid = cg::this_grid();
    Frame F;
    F.lds = (LAS unsigned char*)lds_raw;
#define REFRESH() do { int t_ = threadIdx.x; asm volatile("" : "+v"(t_)); F.tid = t_; F.lane = t_ & 63; F.wave = __builtin_amdgcn_readfirstlane(t_ >> 6); F.gw = blockIdx.x * NWAVES + F.wave; } while (0)
    F.G = gridDim.x; F.NGW = F.G * NWAVES; REFRESH();
    F.in = args.in; F.out = args.out; F.ws = args.ws;
    volatile LAS unsigned* MISC = (volatile LAS unsigned*)(F.lds + LDSCTL_OFF);
    if (threadIdx.x < 16) MISC[threadIdx.x] = 0u;
    __syncthreads();
    const bool side_wg = blockIdx.x >= 64;
    (void)xcd_barrier_post((unsigned*)(args.ws + WS_CTL), MISC + 8, F.G);
    if (side_wg) (void)xcd_barrier_post((unsigned*)(args.ws + WS_CTL) + 4096, MISC + 10, F.G - 64);
#ifndef KMASK
#define KMASK 0x1ff
#endif
#define INK(kind) ((((KMASK) >> (kind)) & 1) != 0)
#ifndef PROBE_MULT
#define PROBE_MULT 1
#endif
#ifdef PROBE_BLOCK
    volatile LAS unsigned long long* STMP = (volatile LAS unsigned long long*)(F.lds + LDSCTL_OFF + 128);
    if (threadIdx.x < 64) STMP[threadIdx.x] = 0ull;
    __syncthreads();
#define STAMP(id) do { if (blockIdx.x == PROBE_BLOCK && threadIdx.x == 0) STMP[(id)] = __builtin_amdgcn_s_memrealtime(); } while (0)
#else
#define STAMP(id) do { } while (0)
#endif
#pragma unroll 1
    for (int pc = 0; pc < NSTEP; ++pc) {
        const Step st = get_step(pc);
        if (st.pre == 1) { if (args.ph_hi < 0) grid.sync();
            { XcdBarrier bar_; bar_.gsz = F.G; bar_.bar = (unsigned*)(args.ws + WS_CTL); bar_.x = xb_xcc_id(); bar_.st = (volatile LAS unsigned*)(F.lds + LDSCTL_OFF) + 8; xcd_barrier(bar_); } }
        if (st.side && !side_wg) continue;
        if (st.pre == 2) { XcdBarrier bar_; bar_.gsz = F.G - 64; bar_.bar = (unsigned*)(args.ws + WS_CTL) + 4096; bar_.x = xb_xcc_id(); bar_.st = (volatile LAS unsigned*)(F.lds + LDSCTL_OFF) + 10; xcd_barrier(bar_); }
        const int layer = st.layer;
        STAMP(2 * pc);
        const int Gs = st.side ? F.G - 64 : F.G, cs = st.side ? (int)blockIdx.x - 64 : (int)blockIdx.x;
        if (st.kind == K_P0) { if (INK(0)) { REFRESH(); p0_weights(F, 0, P0_DEFER ? P0_ITEMS_AB : -1, F.gw, F.NGW); STAMP(42); __syncthreads(); REFRESH(); p0_rows(F); STAMP(43); REFRESH(); p0_rotary(F, (float*)(args.ws + WS_ROT)); STAMP(44); } }
        else if (st.kind == K_IN) { if (INK(1)) {
            pg8::Gemm g{F_XG(F), (const bf16*)(args.ws + (layer == 0 ? WS_WAB : WS_WC)), MPAD, 4096, 1024}; pg8::StaticOrder S; S.init(st.nt, 4096, Gs, cs, st.tile0);
            pg8::EpiBf16 E{F_Z(F), F_ZS1(F, layer), 64, 4096, layer == 0 ? (const float*)nullptr : (const float*)F_SSQ(F)};
            pg8::gemm_phase<pg8::EpiBf16, pg8::StaticOrder, false>(F.lds, g, S, E);
            if (P0_DEFER && layer == 0 && !st.side) { const int nfull = (st.nt * 16) % Gs; if (nfull != 0 && cs >= nfull) { REFRESH(); p0_weights(F, P0_ITEMS_AB, -1, (cs - nfull) * NWAVES + F.wave, (Gs - nfull) * NWAVES); } else if (nfull == 0) { REFRESH(); p0_weights(F, P0_ITEMS_AB, -1, F.gw, F.NGW); } } } }
        else if (st.kind == K_MIX) { if (INK(2)) { REFRESH(); if (layer == 0) mixer_layer0(F); else mixer_layer1(F); } }
        else if (st.kind == K_OUT) { if (INK(3)) {
            pg8::Gemm g{F_XN(F), (const bf16*)(args.ws + (layer == 0 ? WS_WOAB : WS_WOC)), MPAD, 1024, 1024}; pg8::StaticOrder S; S.init(st.nt, 1024, Gs, cs, st.tile0);
            pg8::EpiResid E{F_X0(F), F_X1(F), PM_META, DM, F_XG(F), F.in[20] + (size_t)layer * DM, F_SSQ(F),
                layer == 0 ? F.in[0] : (const float*)nullptr, F.in[1] - (size_t)ROW_S * DM, F.in[8] - (size_t)ROW_M * DM, layer == 0 ? NREAL : MPAD};
            pg8::gemm_phase<pg8::EpiResid, pg8::StaticOrder, false>(F.lds, g, S, E); } }
        else if (st.kind == K_UP) { if (INK(5)) {
            pg8::Gemm g{F_XG(F), (const bf16*)(args.ws + WS_WF1) + (size_t)layer * NFF * 1024, MPAD, NFF, 1024}; pg8::StaticOrder S; S.init(st.nt, NFF, Gs, cs, st.tile0);
            EpiFfn E{F_Z(F), F_HS1(F), F.in[22] + (size_t)layer * 3 * DFF, F.in[23] + (size_t)layer * DFF, F.in[7] + (size_t)layer * 128 * 2 * DFF, F.out + O_FS + (size_t)layer * 128 * 2 * DFF, F_SBL(F), F_SBF(F), F_SSQ(F)};
            pg8::gemm_phase<EpiFfn, pg8::StaticOrder, true>(F.lds, g, S, E); } }
        else if (st.kind == K_FIX) { if (INK(6)) { REFRESH(); ffn_fixup(F, layer); } }
        else if (st.kind == K_DOWN) { if (INK(7)) {
            pg8::Gemm g{st.side ? F_HS1(F) : F_Z(F), (const bf16*)(args.ws + WS_WF2) + (size_t)layer * 1024 * DFF, MPAD, 1024, DFF}; pg8::StaticOrder S; S.init(st.nt, 1024, Gs, cs, st.tile0);
            pg8::EpiResid E{F_X0(F), F_X1(F), PM_META, DM, layer == 0 ? F_XG(F) : (bf16*)nullptr, F.in[9] + DM, F_SSQ(F), (const float*)nullptr, (const float*)nullptr, (const float*)nullptr, MPAD};
            pg8::gemm_phase<pg8::EpiResid, pg8::StaticOrder, false>(F.lds, g, S, E); } }
        else { if (INK(8)) { REFRESH(); rms_final(F, F.in[25]); } }
        STAMP(2 * pc + 1);
    }
#ifdef PROBE_BLOCK
    if (blockIdx.x == PROBE_BLOCK && threadIdx.x == 0) { const unsigned long long d = (STMP[PROBE_B] - STMP[PROBE_A]) * PROBE_MULT, t0 = __builtin_amdgcn_s_memrealtime(); while (__builtin_amdgcn_s_memrealtime() - t0 < d) __builtin_amdgcn_s_sleep(8); }
#endif
#undef INK
#undef REFRESH
}

extern "C" void kernel_launch(void* const* d_in, const int* in_sizes, int n_in, void* d_out, int out_size, void* d_ws, size_t ws_size, hipStream_t stream) {
    static int grid = 0;
    if (grid == 0) {
        if (n_in != 26 || (size_t)out_size != O_END || ws_size < WS_END) { fprintf(stderr, "kernel_launch: unexpected shapes: n_in %d out %d ws %zu\n", n_in, out_size, ws_size); grid = -1; return; }
        int dev = 0, cus = 0, per_cu = 0;
        if (hipGetDevice(&dev) != hipSuccess || hipDeviceGetAttribute(&cus, hipDeviceAttributeMultiprocessorCount, dev) != hipSuccess) { grid = -1; return; }
        if (hipFuncSetAttribute((const void*)fwd_kernel, hipFuncAttributeMaxDynamicSharedMemorySize, LDS_BYTES) != hipSuccess) { fprintf(stderr, "kernel_launch: hipFuncSetAttribute failed\n"); grid = -1; return; }
        if (hipOccupancyMaxActiveBlocksPerMultiprocessor(&per_cu, (const void*)fwd_kernel, NWAVES * 64, LDS_BYTES) != hipSuccess || per_cu < 1) { fprintf(stderr, "kernel_launch: occupancy query says %d\n", per_cu); per_cu = 1; }
        (void)hipGetLastError();
        grid = cus;
        if (grid < 128) { fprintf(stderr, "kernel_launch: this kernel's static work split needs >= 128 CUs (got %d)\n", grid); grid = -1; return; }
    }
    if (grid < 0) return;
    if (hipMemsetAsync((char*)d_ws + WS_CTL, 0, 32768, stream) != hipSuccess) { fprintf(stderr, "kernel_launch: hipMemsetAsync failed\n"); return; }
    Args a{};
    for (int i = 0; i < 26; ++i) a.in[i] = (const float*)d_in[i];
    a.out = (float*)d_out; a.ws = (unsigned char*)d_ws;
    a.ph_lo = 0; a.ph_hi = NSTEP;
    void* kargs[] = {&a};
    hipError_t e = hipLaunchCooperativeKernel((const void*)fwd_kernel, dim3(grid), dim3(NWAVES * 64), kargs, LDS_BYTES, stream);
    if (e != hipSuccess) fprintf(stderr, "kernel_launch: cooperative launch failed: %s (grid %d)\n", hipGetErrorString(e), grid);
}
```

```cpp
#include <hip/hip_runtime.h>
#include <hip/hip_cooperative_groups.h>
#include <cstdio>
#include <cstdint>
namespace cg = cooperative_groups;

namespace pg8 {
#define PG8_LAS __attribute__((address_space(3)))
typedef unsigned short bf16_t;
typedef short bf16x8 __attribute__((ext_vector_type(8)));
typedef float f32x4 __attribute__((ext_vector_type(4)));
typedef unsigned u32x4 __attribute__((ext_vector_type(4)));
typedef unsigned u32x2 __attribute__((ext_vector_type(2)));
constexpr int BM = 256, BK = 64, HALF = 128, HTB = HALF * BK * 2  , STAGE_BYTES = 8 * HTB, NXCD = 8, WGM = 8;

__host__ __device__ __forceinline__ int lds_byte(int r, int c) { const int st = (r >> 4) * 2 + (c >> 5), rr = r & 15, cc = c & 31, ob = rr * 64 + cc * 2; return st * 1024 + (ob ^ (((ob >> 9) & 1) << 5)); }
__host__ __device__ __forceinline__ void stage_rc(int b, int& R, int& C) { const int st = b / 1024, sb = b % 1024, swz = sb ^ (((sb >> 9) & 1) << 5); R = (st >> 1) * 16 + swz / 64; C = (st & 1) * 32 + (swz % 64) / 2; }
__host__ __device__ __forceinline__ int perm32(int rho) { const int n = rho >> 4, i = rho & 15; return 8 * (i >> 2) + 4 * n + (i & 3); }

struct Unit { int pm, pn; };
struct Gemm { const bf16_t* A; const bf16_t* Bt; int M, N, K; };

struct StaticOrder {
    int nM, nN, nwg, G, c, pm0;
    __host__ __device__ void init(int nMt, int N, int G_, int c_, int pm0_) { nM = nMt; nN = N / BM; nwg = nM * nN; G = G_; c = c_; pm0 = pm0_; }
    __host__ __device__ bool next(int i, Unit& u) const {
        const long L = (long)i * G + c; if (L >= nwg) return false;
        int wgid = (int)L; { const int q = nwg / NXCD, r = nwg % NXCD, xcd = wgid % NXCD, off = wgid / NXCD; wgid = (xcd < r ? xcd * (q + 1) : r * (q + 1) + (xcd - r) * q) + off; }
        const int nig = WGM * nN, gid = wgid / nig, fm = gid * WGM, gsz = (nM - fm) < WGM ? (nM - fm) : WGM;
        u.pm = pm0 + fm + ((wgid % nig) % gsz); u.pn = (wgid % nig) / gsz; return true;
    }
    __device__ __forceinline__ void a_ready(const Unit&) const {}
    __device__ __forceinline__ void done(const Unit&) const {}
};

__device__ __forceinline__ unsigned cvt_pk_bf16(float lo, float hi) { unsigned r; asm volatile("v_cvt_pk_bf16_f32 %0, %1, %2" : "=v"(r) : "v"(lo), "v"(hi)); return r; }

__device__ __forceinline__ float row_rs(const float* ssq, int row) { return __builtin_amdgcn_rsqf(ssq[row] * (1.0f / 1024.0f) + 1e-6f); }
struct EpiBf16 {
    static constexpr bool PERM = true, AFTER_DRAIN = false;
    bf16_t* O0; bf16_t* O1; int pm_split; int ldc; const float* ssq;
    __device__ __forceinline__ void operator()(f32x4 (&acc)[2][2][4][2], const Unit& u, int wr, int wc, int fr, int fq) const {
        bf16_t* O = (u.pm < pm_split) ? O0 : O1;
        const int row0 = u.pm * BM + wr * 64 + fr; const int col0 = u.pn * BM + wc * 32 + 8 * fq;
        float rsv[2][4];
#pragma unroll
        for (int ai = 0; ai < 2; ++ai)
#pragma unroll
            for (int m = 0; m < 4; ++m) rsv[ai][m] = ssq ? row_rs(ssq, row0 + ai * HALF + m * 16) : 1.0f;
#pragma unroll
        for (int ai = 0; ai < 2; ++ai)
#pragma unroll
            for (int m = 0; m < 4; ++m) { const int row = row0 + ai * HALF + m * 16; bf16_t* rowp = O + (size_t)row * ldc + col0;
                const float rs = rsv[ai][m];
#pragma unroll
                for (int bj = 0; bj < 2; ++bj) { const f32x4 v0 = acc[ai][bj][m][0] * rs, v1 = acc[ai][bj][m][1] * rs;
                    u32x4 w; w.x = cvt_pk_bf16(v0[0], v0[1]); w.y = cvt_pk_bf16(v0[2], v0[3]); w.z = cvt_pk_bf16(v1[0], v1[1]); w.w = cvt_pk_bf16(v1[2], v1[3]);
                    *(u32x4*)(rowp + bj * HALF) = w; } }
    }
};

struct EpiResid {
    static constexpr bool PERM = true, AFTER_DRAIN = false;
    float* X0; float* X1; int pm_split; int ldc; bf16_t* XG; const float* gain; float* ssq;
    const float* R0; const float* R1; const float* R2; int nreal;
    __device__ __forceinline__ void operator()(f32x4 (&acc)[2][2][4][2], const Unit& u, int wr, int wc, int fr, int fq) const {
        float* C = (u.pm < pm_split) ? X0 : X1;
        const float* Rsrc = R0 ? (u.pm < 64 ? R0 : u.pm < pm_split ? R1 : R2) : (const float*)C;
        const int row0 = u.pm * BM + wr * 64 + fr, col0 = u.pn * BM + wc * 32 + 8 * fq;
        f32x4 gv[2][2];
#pragma unroll
        for (int bj = 0; bj < 2; ++bj)
#pragma unroll
            for (int n = 0; n < 2; ++n) gv[bj][n] = XG ? *(const f32x4*)(gain + col0 + bj * HALF + 4 * n) : (f32x4){0.f, 0.f, 0.f, 0.f};
#pragma unroll
        for (int ai = 0; ai < 2; ++ai)
#pragma unroll
            for (int mp = 0; mp < 2; ++mp) {
                f32x4 t[2][2][2];
#pragma unroll
                for (int mm = 0; mm < 2; ++mm) { const int rr_ = row0 + ai * HALF + (2 * mp + mm) * 16; const float* rowp = Rsrc + (size_t)rr_ * ldc + col0; const bool have = rr_ < nreal;
#pragma unroll
                    for (int bj = 0; bj < 2; ++bj)
#pragma unroll
                        for (int n = 0; n < 2; ++n) t[mm][bj][n] = have ? *(const f32x4*)(rowp + bj * HALF + 4 * n) : (f32x4){0.f, 0.f, 0.f, 0.f}; }
#pragma unroll
                for (int mm = 0; mm < 2; ++mm) { const int m = 2 * mp + mm; const int row = row0 + ai * HALF + m * 16; float* rowp = C + (size_t)row * ldc + col0; float sq = 0.f;
#pragma unroll
                    for (int bj = 0; bj < 2; ++bj) { f32x4 v[2];
#pragma unroll
                        for (int n = 0; n < 2; ++n) { v[n] = t[mm][bj][n] + acc[ai][bj][m][n]; *(f32x4*)(rowp + bj * HALF + 4 * n) = v[n];
                            sq += (v[n][0] * v[n][0] + v[n][1] * v[n][1]) + (v[n][2] * v[n][2] + v[n][3] * v[n][3]); }
                        if (XG) { const f32x4 y0 = v[0] * gv[bj][0], y1 = v[1] * gv[bj][1]; u32x4 w; w.x = cvt_pk_bf16(y0[0], y0[1]); w.y = cvt_pk_bf16(y0[2], y0[3]); w.z = cvt_pk_bf16(y1[0], y1[1]); w.w = cvt_pk_bf16(y1[2], y1[3]);
                            *(u32x4*)(XG + (size_t)row * ldc + col0 + bj * HALF) = w; } }
                    if (XG) { sq += __shfl_xor(sq, 16); sq += __shfl_xor(sq, 32); if (fq == 0) atomicAdd(ssq + row, sq); } }
                asm volatile("" ::: "memory"); }
    }
};

template <class Epi, class Sched, bool APERM>
__device__ __forceinline__ void gemm_phase(PG8_LAS unsigned char* lds, const Gemm g, const Sched& S, const Epi& E) {
    int tid_ = threadIdx.x; asm volatile("" : "+v"(tid_));
    const int tid = tid_, wid = __builtin_amdgcn_readfirstlane(tid >> 6), lane = tid & 63, wr = wid >> 2, wc = wid & 3, fr = lane & 15, fq = lane >> 4;
    const int K = g.K, nt = K / BK;
    unsigned voffA[2], voffB[2];
#pragma unroll
    for (int i = 0; i < 2; ++i) { int R, C; stage_rc(tid * 16 + i * 8192, R, C); const int Rb = Epi::PERM ? ((R & ~31) + perm32(R & 31)) : R;
        const int Ra = APERM ? (128 * (R >> 6) + 8 * (R & 15) + ((R >> 4) & 3)) : R;
        voffA[i] = (unsigned)(Ra * K + C) * 2u; voffB[i] = (unsigned)(Rb * K + C) * 2u; }
    const size_t kstep = (size_t)(BK * 2);
    const size_t hstep = (size_t)HALF * K * 2;
    const size_t hstepA = APERM ? (size_t)4 * K * 2 : hstep;
    const size_t tstep = 2 * hstep;
    const unsigned ldsw = (unsigned)wid * 1024u;
    const int aoff = lds_byte(wr * 64 + fr, fq * 8), boff = lds_byte(wc * 32 + fr, fq * 8);
#define PG8_SA(b, h) (((b) * 2 + (h)) * HTB)
#define PG8_SB(b, h) ((4 + (b) * 2 + (h)) * HTB)
#define PG8_STAGE(bufoff, gbase, voff) do { _Pragma("unroll") for (int _i = 0; _i < 2; ++_i) \
        __builtin_amdgcn_global_load_lds((const unsigned*)((const char*)(gbase) + (voff)[_i]), (PG8_LAS unsigned*)(lds + (bufoff) + ldsw + _i * 8192), 16, 0, 0); } while (0)
#define PG8_LDA(dst, b, h) do { _Pragma("unroll") for (int m = 0; m < 4; ++m) _Pragma("unroll") for (int k = 0; k < 2; ++k) dst[m][k] = *(const PG8_LAS bf16x8*)(lds + PG8_SA(b, h) + aoff + m * 2048 + k * 1024); } while (0)
#define PG8_LDB(dst, b, h) do { _Pragma("unroll") for (int n = 0; n < 2; ++n) _Pragma("unroll") for (int k = 0; k < 2; ++k) dst[n][k] = *(const PG8_LAS bf16x8*)(lds + PG8_SB(b, h) + boff + n * 2048 + k * 1024); } while (0)
#define PG8_MMA(ai, bj, At, Bt) do { __builtin_amdgcn_s_setprio(1); _Pragma("unroll") for (int m = 0; m < 4; ++m) _Pragma("unroll") for (int n = 0; n < 2; ++n) _Pragma("unroll") for (int k = 0; k < 2; ++k) \
        acc[ai][bj][m][n] = __builtin_amdgcn_mfma_f32_16x16x32_bf16(Bt[n][k], At[m][k], acc[ai][bj][m][n], 0, 0, 0); __builtin_amdgcn_s_setprio(0); } while (0)
#define PG8_WAIT_V(n) asm volatile("s_waitcnt vmcnt(" #n ")" ::: "memory")
#define PG8_WAIT_L(n) asm volatile("s_waitcnt lgkmcnt(" #n ")" ::: "memory")
#define PG8_BAR __builtin_amdgcn_s_barrier()
#define PG8_SCHED __builtin_amdgcn_sched_barrier(0)
    Unit cur, nxt; int ui = 0;
    if (!S.next(0, cur)) return;
    f32x4 acc[2][2][4][2];
#pragma unroll
    for (int a = 0; a < 2; ++a)
#pragma unroll
        for (int b = 0; b < 2; ++b)
#pragma unroll
            for (int m = 0; m < 4; ++m)
#pragma unroll
                for (int n = 0; n < 2; ++n) acc[a][b][m][n] = (f32x4){0.f, 0.f, 0.f, 0.f};
    bf16x8 At[4][2], B0[2][2], B1[2][2];
    const char* cA = (const char*)g.A + (size_t)cur.pm * tstep; const char* cB = (const char*)g.Bt + (size_t)cur.pn * tstep;
    S.a_ready(cur);
    PG8_STAGE(PG8_SB(0, 0), cB, voffB); PG8_STAGE(PG8_SB(0, 1), cB + hstep, voffB); PG8_STAGE(PG8_SA(0, 0), cA, voffA); PG8_STAGE(PG8_SA(0, 1), cA + hstepA, voffA);
    if (wr == 1) PG8_BAR;
    PG8_WAIT_V(2); PG8_BAR;
    PG8_STAGE(PG8_SB(1, 0), cB + kstep, voffB); PG8_STAGE(PG8_SA(1, 0), cA + kstep, voffA); PG8_STAGE(PG8_SB(1, 1), cB + hstep + kstep, voffB);
    PG8_WAIT_V(6); PG8_BAR;
    for (;;) {
        const bool has_next = S.next(ui + 1, nxt);
        const char* nA = has_next ? (const char*)g.A + (size_t)nxt.pm * tstep : cA; const char* nB = has_next ? (const char*)g.Bt + (size_t)nxt.pn * tstep : cB;
        for (int t = 0; t < nt; t += 2) {
            const bool last = (t == nt - 2);
            const char* a1 = cA + (size_t)(t + 1) * kstep;
            const char* a2 = last ? nA : cA + (size_t)(t + 2) * kstep; const char* b2 = last ? nB : cB + (size_t)(t + 2) * kstep;
            const char* a3 = a2 + kstep; const char* b3 = b2 + kstep;
            if (last && has_next) S.a_ready(nxt);
            PG8_LDB(B0, 0, 0); PG8_LDB(B1, 0, 1); PG8_SCHED; PG8_LDA(At, 0, 0); PG8_STAGE(PG8_SA(1, 1), a1 + hstepA, voffA);
            PG8_WAIT_V(8); PG8_WAIT_L(0); PG8_BAR; PG8_MMA(0, 0, At, B0); PG8_MMA(0, 1, At, B1); PG8_BAR; PG8_SCHED;
            PG8_LDA(At, 0, 1); PG8_STAGE(PG8_SB(0, 0), b2, voffB); PG8_STAGE(PG8_SB(0, 1), b2 + hstep, voffB); PG8_STAGE(PG8_SA(0, 0), a2, voffA);
            PG8_WAIT_V(8); PG8_WAIT_L(0); PG8_BAR; PG8_MMA(1, 0, At, B0); PG8_MMA(1, 1, At, B1); PG8_BAR; PG8_SCHED;
            PG8_LDB(B0, 1, 0); PG8_LDB(B1, 1, 1); PG8_SCHED; PG8_LDA(At, 1, 0); PG8_STAGE(PG8_SA(0, 1), a2 + hstepA, voffA);
            PG8_WAIT_V(8); PG8_WAIT_L(0); PG8_BAR; PG8_MMA(0, 0, At, B0); PG8_MMA(0, 1, At, B1); PG8_BAR; PG8_SCHED;
            PG8_LDA(At, 1, 1); PG8_STAGE(PG8_SB(1, 0), b3, voffB); PG8_STAGE(PG8_SB(1, 1), b3 + hstep, voffB); PG8_STAGE(PG8_SA(1, 0), a3, voffA);
            PG8_WAIT_V(8); PG8_WAIT_L(0); PG8_BAR; PG8_MMA(1, 0, At, B0); PG8_MMA(1, 1, At, B1); PG8_BAR; PG8_SCHED;
        }
        if (wr == 0) PG8_BAR;
        E(acc, cur, wr, wc, fr, fq); S.done(cur);
        if (!has_next) break;
#pragma unroll
        for (int a = 0; a < 2; ++a)
#pragma unroll
            for (int b = 0; b < 2; ++b)
#pragma unroll
                for (int m = 0; m < 4; ++m)
#pragma unroll
                    for (int n = 0; n < 2; ++n) acc[a][b][m][n] = (f32x4){0.f, 0.f, 0.f, 0.f};
        cur = nxt; cA = nA; cB = nB; ++ui;
        if (wr == 1) PG8_BAR;
    }
    PG8_WAIT_V(0);
    PG8_BAR;
#undef PG8_SA
#undef PG8_SB
#undef PG8_STAGE
#undef PG8_LDA
#undef PG8_LDB
#undef PG8_MMA
#undef PG8_WAIT_V
#undef PG8_WAIT_L
#undef PG8_BAR
#undef PG8_SCHED
}
}
constexpr int DM = 1024;
constexpr int ROW_S = 16384;
constexpr int ROW_M = 17408;
constexpr int NREAL = 17424;
constexpr int MPAD = 17664;
constexpr int PM_META = 68;
constexpr int NAB = 4096, NCC = 4096, DFF = 2816, NFF = 5632, ABW = 4104;
constexpr int NGRP = 138, GRP_META = 136;
constexpr float EPS = 1e-6f;
constexpr float KSCALE = 0.08838834764831845f;

constexpr size_t O_YP = 0, O_YS = 16777216, O_CP = 17825792, O_CS = 18350080, O_NP = 26738688, O_NS = 26742784, O_MP = 26808320, O_MS = 26808352,
                 O_RP = 26808864, O_RS = 27333152, O_HP = 35721760, O_HS = 36770336, O_FP = 53547552, O_FS = 53637664, O_END = 55079456;

constexpr size_t MiB = 1u << 20;
constexpr size_t WS_CTL = 0, CTL_ZERO_BYTES = 1 * MiB;
constexpr size_t WS_WAB = 1 * MiB, WS_WOAB = 9 * MiB, WS_WC = 11 * MiB, WS_WOC = 19 * MiB, WS_WF1 = 21 * MiB  , WS_WF2 = 43 * MiB  ;
constexpr size_t WS_XN = 54 * MiB;
constexpr size_t WS_Z = 89 * MiB;
constexpr size_t WS_XM = 227 * MiB;
constexpr size_t WS_G = 228 * MiB;
constexpr size_t WS_SBL = 229 * MiB;
constexpr size_t WS_SBF = 233 * MiB;
constexpr size_t WS_ROT = 240 * MiB;
constexpr size_t WS_XG = 242 * MiB;
constexpr size_t WS_SSQ = 277 * MiB;
constexpr size_t WS_ZS = 279 * MiB;
constexpr size_t WS_ZS2 = 290 * MiB;
constexpr size_t WS_HS = 301 * MiB;
constexpr size_t WS_END = 309 * MiB;
static_assert(WS_XN + (size_t)MPAD * DM * 2 <= WS_Z && WS_Z + (size_t)MPAD * 4096 * 2 <= WS_XM && WS_SBL + (size_t)NGRP * 2 * DFF * 4 <= WS_SBF && WS_SBF + (size_t)NGRP * 4 * DFF * 4 <= WS_END, "ws map");

constexpr int P0_ITEMS_AB = 16 * 128;
constexpr int LDS_BYTES = 147456;
constexpr int NWAVES = 8;

#define GAS __attribute__((address_space(1)))
#define LAS __attribute__((address_space(3)))
typedef unsigned short bf16;
typedef float f32x4 __attribute__((ext_vector_type(4)));
typedef unsigned u32x2 __attribute__((ext_vector_type(2)));
typedef unsigned u32x4 __attribute__((ext_vector_type(4)));
#define LDS_WAIT() asm volatile("s_waitcnt lgkmcnt(0)" ::: "memory")

__device__ __forceinline__ unsigned f2bf(float f) { unsigned u = __builtin_bit_cast(unsigned, f); return (u + 0x7fffu + ((u >> 16) & 1u)) >> 16; }
__device__ __forceinline__ unsigned pk2(float lo, float hi) { return f2bf(lo) | (f2bf(hi) << 16); }
__device__ __forceinline__ float bf2f(unsigned short b) { return __builtin_bit_cast(float, ((unsigned)b) << 16); }
__device__ __forceinline__ float bflo(unsigned w) { return __builtin_bit_cast(float, w << 16); }
__device__ __forceinline__ float bfhi(unsigned w) { return __builtin_bit_cast(float, w & 0xffff0000u); }
__device__ __forceinline__ f32x4 ld_bf4(const bf16* p) { const u32x2 w = *(const u32x2*)p; return (f32x4){bflo(w.x), bfhi(w.x), bflo(w.y), bfhi(w.y)}; }
__device__ __forceinline__ float wave_sum(float v) {
#pragma unroll
    for (int o = 1; o < 64; o <<= 1) v += __shfl_xor(v, o);
    return v;
}
__device__ __forceinline__ float half_sum(float v) {
#pragma unroll
    for (int o = 1; o < 32; o <<= 1) v += __shfl_xor(v, o);
    return v;
}
__device__ __forceinline__ float sigmoidf_(float x) { return 1.f / (1.f + __expf(-x)); }
__device__ __forceinline__ float siluf_(float x) { return x / (1.f + __expf(-x)); }
__device__ __forceinline__ float logsigmoidf_(float x) { return fminf(x, 0.f) - __logf(1.f + __expf(-fabsf(x))); }

struct Args { const float* in[26]; float* out; unsigned char* ws; int ph_lo, ph_hi; };

struct Frame {
    LAS unsigned char* lds;
    int tid, lane, wave, G, gw, NGW;
    const float* const* in; float* out; unsigned char* ws;
};
#define F_X0(F) ((F).out)
#define F_X1(F) ((float*)((F).ws + WS_XM) - (size_t)ROW_M * DM)
#define F_XN(F) ((bf16*)((F).ws + WS_XN))
#define F_XG(F) ((bf16*)((F).ws + WS_XG))
#define F_SSQ(F, i) ((float*)((F).ws + WS_SSQ) + (size_t)(i) * MPAD)
#define F_Z(F) ((bf16*)((F).ws + WS_Z))
#define F_ZS1(F, layer) ((bf16*)((F).ws + ((layer) == 0 ? WS_ZS : WS_ZS2)) - (size_t)ROW_S * 4096)
#define F_HS1(F) ((bf16*)((F).ws + WS_HS) - (size_t)ROW_S * DFF)
#define ZROW(F, row, layer) (((row) < ROW_S ? F_Z(F) : F_ZS1(F, layer)) + (size_t)(row) * 4096)
#define F_GT(F) ((float*)((F).ws + WS_G))
#define F_SBL(F) ((float*)((F).ws + WS_SBL))
#define F_SBF(F) ((float*)((F).ws + WS_SBF))
__device__ __forceinline__ float* xrow(const Frame& F, int r) { return (r < ROW_M ? F_X0(F) : F_X1(F)) + (size_t)r * DM; }

__device__ __forceinline__ void p0_transpose_item(const float* W, int K, int Nsrc, int n0src, bf16* WT, int dstrow0, LAS float* scr, int kb, int lane) {
    const int k0 = 64 * kb;
    f32x4 v[8];
#pragma unroll
    for (int i = 0; i < 8; ++i) v[i] = *(const f32x4*)(W + (size_t)(k0 + 8 * i + (lane >> 3)) * Nsrc + n0src + 4 * (lane & 7));
#pragma unroll
    for (int i = 0; i < 8; ++i) { LAS float* d = scr + (8 * i + (lane >> 3)) * 33 + 4 * (lane & 7); d[0] = v[i][0]; d[1] = v[i][1]; d[2] = v[i][2]; d[3] = v[i][3]; }
    LDS_WAIT(); asm volatile("" ::: "memory");
    const int c = lane & 7;
#pragma unroll
    for (int j = 0; j < 4; ++j) { const int n = (lane >> 3) + 8 * j; const LAS float* s = scr + (8 * c) * 33 + n;
        u32x4 o; o.x = pk2(s[0 * 33], s[1 * 33]); o.y = pk2(s[2 * 33], s[3 * 33]); o.z = pk2(s[4 * 33], s[5 * 33]); o.w = pk2(s[6 * 33], s[7 * 33]);
        *(u32x4*)(WT + (size_t)(dstrow0 + n) * K + k0 + 8 * c) = o; }
    LDS_WAIT(); asm volatile("" ::: "memory");
}

__device__ __forceinline__ void p0_weights(Frame& F, int it0, int it1, int gw, int ngw) {
    LAS float* scr = (LAS float*)(F.lds + F.wave * 16384);
    constexpr int I_AB = 16 * 128, I_O = 16 * 32, I_C = 16 * 128, I_F1 = 16 * 176, I_F2 = 44 * 32;
    constexpr int NIT = I_AB + I_O + I_C + I_O + 2 * I_F1 + 2 * I_F2;
    if (it1 < 0) it1 = NIT;
    for (int it = it0 + gw; it < it1; it += ngw) {
        int r = it;
        if (r < I_AB) { const int kb = r / 128, nb = r % 128; p0_transpose_item(F.in[10], 1024, ABW, nb < 64 ? 32 * nb : 32 * nb + 8, (bf16*)(F.ws + WS_WAB), 32 * nb, scr, kb, F.lane); continue; } r -= I_AB;
        if (r < I_O) { const int kb = r / 32, nb = r % 32; p0_transpose_item(F.in[15], 1024, 1024, 32 * nb, (bf16*)(F.ws + WS_WOAB), 32 * nb, scr, kb, F.lane); continue; } r -= I_O;
        if (r < I_C) { const int kb = r / 128, nb = r % 128; p0_transpose_item(F.in[17], 1024, 4096, 32 * nb, (bf16*)(F.ws + WS_WC), 32 * nb, scr, kb, F.lane); continue; } r -= I_C;
        if (r < I_O) { const int kb = r / 32, nb = r % 32; p0_transpose_item(F.in[19], 1024, 1024, 32 * nb, (bf16*)(F.ws + WS_WOC), 32 * nb, scr, kb, F.lane); continue; } r -= I_O;
        if (r < 2 * I_F1) { const int l = r / I_F1; r -= l * I_F1; const int kb = r / 176, nb = r % 176; const int c = 32 * nb;
            const int ch = c < DFF ? c : c - DFF; const int dst = 256 * (ch / 128) + (c < DFF ? 0 : 128) + (ch % 128);
            p0_transpose_item(F.in[21] + (size_t)l * 1024 * NFF, 1024, NFF, c, (bf16*)(F.ws + WS_WF1) + (size_t)l * NFF * 1024, dst, scr, kb, F.lane); continue; } r -= 2 * I_F1;
        { const int l = r / I_F2; r -= l * I_F2; const int kb = r / 32, nb = r % 32;
            p0_transpose_item(F.in[24] + (size_t)l * DFF * 1024, DFF, 1024, 32 * nb, (bf16*)(F.ws + WS_WF2) + (size_t)l * 1024 * DFF, 32 * nb, scr, kb, F.lane); }
    }
}

__device__ __forceinline__ void p0_rows(Frame& F) {
    LAS float* wg = (LAS float*)F.lds;
    for (int i = F.tid; i < 8192; i += NWAVES * 64) { const int k = i >> 3, c = i & 7; wg[c * 1024 + k] = F.in[10][(size_t)k * ABW + 2048 + c]; }
    __syncthreads();
    const float* gain = F.in[9];
    f32x4 gn[4];
#pragma unroll
    for (int j = 0; j < 4; ++j) gn[j] = *(const f32x4*)(gain + 4 * F.lane + 256 * j);
#define P0_ROWSRC(r) ((r) < ROW_S ? F.in[0] + (size_t)(r) * DM : (r) < ROW_M ? F.in[1] + (size_t)((r) - ROW_S) * DM : (r) < NREAL ? F.in[8] + (size_t)((r) - ROW_M) * DM : (const float*)nullptr)
    f32x4 v[4], vn[4];
    { const float* src = F.gw < MPAD ? P0_ROWSRC(F.gw) : nullptr;
#pragma unroll
      for (int j = 0; j < 4; ++j) vn[j] = src ? *(const f32x4*)(src + 4 * F.lane + 256 * j) : (f32x4){0.f, 0.f, 0.f, 0.f}; }
#pragma unroll 1
    for (int r = F.gw; r < MPAD; r += F.NGW) {
#pragma unroll
        for (int j = 0; j < 4; ++j) v[j] = vn[j];
        { const int rn = r + F.NGW; const float* src = rn < MPAD ? P0_ROWSRC(rn) : nullptr;
#pragma unroll
          for (int j = 0; j < 4; ++j) vn[j] = src ? *(const f32x4*)(src + 4 * F.lane + 256 * j) : (f32x4){0.f, 0.f, 0.f, 0.f}; }
        float ss = 0.f;
#pragma unroll
        for (int j = 0; j < 4; ++j) ss += (v[j].x * v[j].x + v[j].y * v[j].y) + (v[j].z * v[j].z + v[j].w * v[j].w);
        const float rs = rsqrtf(wave_sum(ss) * (1.f / DM) + EPS);
        bf16* xn = F_XG(F) + (size_t)r * DM;
        float ga[8];
#pragma unroll
        for (int c = 0; c < 8; ++c) ga[c] = 0.f;
#pragma unroll
        for (int j = 0; j < 4; ++j) {
            const f32x4 y = v[j] * rs * gn[j];
            u32x2 w; w.x = pk2(y.x, y.y); w.y = pk2(y.z, y.w);
            *(u32x2*)(xn + 4 * F.lane + 256 * j) = w;
#pragma unroll
            for (int c = 0; c < 8; ++c) { const f32x4 wv = *(const LAS f32x4*)(wg + c * 1024 + 4 * F.lane + 256 * j); ga[c] += (y.x * wv.x + y.y * wv.y) + (y.z * wv.z + y.w * wv.w); }
        }
        float g4[4], g2[2], g1;
        { const bool hi = (F.lane & 32) != 0;
#pragma unroll
          for (int c = 0; c < 4; ++c) { const float keep = hi ? ga[4 + c] : ga[c], send = hi ? ga[c] : ga[4 + c]; g4[c] = keep + __shfl_xor(send, 32); } }
        { const bool hi = (F.lane & 16) != 0;
#pragma unroll
          for (int c = 0; c < 2; ++c) { const float keep = hi ? g4[2 + c] : g4[c], send = hi ? g4[c] : g4[2 + c]; g2[c] = keep + __shfl_xor(send, 16); } }
        { const bool hi = (F.lane & 8) != 0; const float keep = hi ? g2[1] : g2[0], send = hi ? g2[0] : g2[1]; g1 = keep + __shfl_xor(send, 8); }
        g1 += __shfl_xor(g1, 4); g1 += __shfl_xor(g1, 2); g1 += __shfl_xor(g1, 1);
        if ((F.lane & 7) == 0) F_GT(F)[(size_t)r * 8 + ((F.lane >> 5) & 1) * 4 + ((F.lane >> 4) & 1) * 2 + ((F.lane >> 3) & 1)] = g1;
    }
#undef P0_ROWSRC
}

__device__ __forceinline__ void p0_zero_ssq(Frame& F) { const int gt = blockIdx.x * (NWAVES * 64) + F.tid, NT = F.G * NWAVES * 64; for (int i = gt; i < 3 * MPAD; i += NT) F_SSQ(F, 0)[i] = 0.f; }
__device__ __forceinline__ void rms_final(Frame& F, const float* gain) {
    for (int r = F.gw; r < ROW_M; r += F.NGW) {
        float* xr = F_X0(F) + (size_t)r * DM; f32x4 v[4]; float ss = 0.f;
#pragma unroll
        for (int j = 0; j < 4; ++j) { v[j] = *(const f32x4*)(xr + 4 * F.lane + 256 * j); ss += (v[j].x * v[j].x + v[j].y * v[j].y) + (v[j].z * v[j].z + v[j].w * v[j].w); }
        const float rs = rsqrtf(wave_sum(ss) * (1.f / DM) + EPS);
#pragma unroll
        for (int j = 0; j < 4; ++j) { const f32x4 gn = *(const f32x4*)(gain + 4 * F.lane + 256 * j); *(f32x4*)(xr + 4 * F.lane + 256 * j) = v[j] * rs * gn; }
    }
}

__device__ __forceinline__ float dpp_row_shr1(float x) { return __builtin_bit_cast(float, __builtin_amdgcn_update_dpp(__builtin_bit_cast(int, x), __builtin_bit_cast(int, x), 0x111, 0xf, 0xf, false)); }
struct EpiFfn {
    static constexpr bool PERM = true, AFTER_DRAIN = false;
    bf16* H0; bf16* H1; const float* cw; const float* cb; const float* cst; float* cso; float* sbl; float* sbf; const float* ssq;
    __device__ __forceinline__ void operator()(f32x4 (&acc)[2][2][4][2], const pg8::Unit& u, int wr, int wc, int fr, int fq) const {
        bf16* H = (u.pm < 64) ? H0 : H1;
        const int ch0 = 128 * u.pn + 32 * wc + 8 * fq;
        const int tok0 = 256 * u.pm + 128 * wr + 8 * fr;
        const int grp = 2 * u.pm + wr;
        const bool samp = (u.pm >= 64 && u.pm < PM_META), meta = (u.pm == PM_META);
        const int sb = 32 * (u.pm - 64) + 16 * wr + fr;
        const bool defer = (!samp && !meta && fr == 0);
        const bool lastlane = meta ? (wr == 0 && fr == 1) : (!samp && fr == 15);
#pragma unroll
        for (int k = 0; k < 8; ++k) { const float rs = pg8::row_rs(ssq, tok0 + k);
#pragma unroll
            for (int bj = 0; bj < 2; ++bj)
#pragma unroll
                for (int n = 0; n < 2; ++n) acc[k >> 2][bj][k & 3][n] = acc[k >> 2][bj][k & 3][n] * rs; }
        f32x4 w0[2], w1[2], w2[2], bb[2], p6[2], p7[2];
#pragma unroll
        for (int n = 0; n < 2; ++n) {
            const int c4 = ch0 + 4 * n;
            w0[n] = *(const f32x4*)(cw + c4); w1[n] = *(const f32x4*)(cw + DFF + c4); w2[n] = *(const f32x4*)(cw + 2 * DFF + c4); bb[n] = *(const f32x4*)(cb + c4);
#pragma unroll
            for (int e = 0; e < 4; ++e) { p6[n][e] = dpp_row_shr1(acc[1][0][2][n][e]); p7[n][e] = dpp_row_shr1(acc[1][0][3][n][e]); }
            if (samp) { p6[n] = *(const f32x4*)(cst + (size_t)(sb * 2 + 0) * DFF + c4); p7[n] = *(const f32x4*)(cst + (size_t)(sb * 2 + 1) * DFF + c4); }
            if (meta && wr == 0 && fr == 0) { p6[n] = (f32x4){0.f, 0.f, 0.f, 0.f}; p7[n] = p6[n]; }
            if (lastlane) { *(f32x4*)(sbl + (size_t)(grp * 2 + 0) * DFF + c4) = acc[1][0][2][n]; *(f32x4*)(sbl + (size_t)(grp * 2 + 1) * DFF + c4) = acc[1][0][3][n]; }
            if (samp) { *(f32x4*)(cso + (size_t)(sb * 2 + 0) * DFF + c4) = acc[1][0][2][n]; *(f32x4*)(cso + (size_t)(sb * 2 + 1) * DFF + c4) = acc[1][0][3][n]; }
        }
#pragma unroll
        for (int k = 0; k < 8; ++k) {
            unsigned hw[4];
#pragma unroll
            for (int n = 0; n < 2; ++n) {
                const f32x4 uk = acc[k >> 2][0][k & 3][n], gk = acc[k >> 2][1][k & 3][n];
                const f32x4 um1 = (k >= 1) ? acc[(k - 1 < 0 ? 0 : k - 1) >> 2][0][(k - 1 < 0 ? 0 : k - 1) & 3][n] : p7[n];
                const f32x4 um2 = (k >= 2) ? acc[(k - 2 < 0 ? 0 : k - 2) >> 2][0][(k - 2 < 0 ? 0 : k - 2) & 3][n] : (k == 1 ? p7[n] : p6[n]);
                const f32x4 cv = bb[n] + w0[n] * um2 + w1[n] * um1 + w2[n] * uk;
                f32x4 hv;
#pragma unroll
                for (int e = 0; e < 4; ++e) hv[e] = siluf_(cv[e]) * gk[e];
                hw[2 * n] = pg8::cvt_pk_bf16(hv[0], hv[1]); hw[2 * n + 1] = pg8::cvt_pk_bf16(hv[2], hv[3]);
                if (defer && k < 2) {
                    *(f32x4*)(sbf + (size_t)((grp * 2 + k) * 2 + 0) * DFF + ch0 + 4 * n) = uk;
                    *(f32x4*)(sbf + (size_t)((grp * 2 + k) * 2 + 1) * DFF + ch0 + 4 * n) = gk;
                }
            }
            if (!(defer && k < 2)) *(u32x4*)(H + (size_t)(tok0 + k) * DFF + ch0) = (u32x4){hw[0], hw[1], hw[2], hw[3]};
        }
    }
};

__device__ __forceinline__ void ffn_fixup(Frame& F, int layer) {
    const float* cw = F.in[22] + (size_t)layer * 3 * DFF; const float* cb = F.in[23] + (size_t)layer * DFF;
    bf16* H = F_Z(F);
    const int gt = blockIdx.x * (NWAVES * 64) + F.tid, NT = F.G * NWAVES * 64;
    for (int i = gt; i < 128 * DFF; i += NT) {
        const int grp = i / DFF, ch = i - grp * DFF;
        const int r0 = 128 * grp;
        const int pg = (r0 % 2048 == 0) ? GRP_META : grp - 1;
        const float um2 = F_SBL(F)[(size_t)(pg * 2 + 0) * DFF + ch], um1 = F_SBL(F)[(size_t)(pg * 2 + 1) * DFF + ch];
        const float u0 = F_SBF(F)[(size_t)((grp * 2 + 0) * 2 + 0) * DFF + ch], g0 = F_SBF(F)[(size_t)((grp * 2 + 0) * 2 + 1) * DFF + ch];
        const float u1 = F_SBF(F)[(size_t)((grp * 2 + 1) * 2 + 0) * DFF + ch], g1 = F_SBF(F)[(size_t)((grp * 2 + 1) * 2 + 1) * DFF + ch];
        const float w0 = cw[ch], w1 = cw[DFF + ch], w2 = cw[2 * DFF + ch], bb = cb[ch];
        const float c0 = bb + w0 * um2 + w1 * um1 + w2 * u0, c1 = bb + w0 * um1 + w1 * u0 + w2 * u1;
        H[(size_t)r0 * DFF + ch] = (bf16)f2bf(siluf_(c0) * g0);
        H[(size_t)(r0 + 1) * DFF + ch] = (bf16)f2bf(siluf_(c1) * g1);
    }
    float* fo = F.out + O_FP + (size_t)layer * 8 * 2 * DFF;
    for (int i = gt; i < 8 * 2 * DFF; i += NT) {
        const int b = i / (2 * DFF), rem = i - b * 2 * DFF, j = rem / DFF, ch = rem - j * DFF;
        const int grp = 2 * (8 * b + 7) + 1;
        fo[i] = F_SBL(F)[(size_t)(grp * 2 + j) * DFF + ch];
    }
}
typedef short bf16x8 __attribute__((ext_vector_type(8)));
typedef short v4i16_t __attribute__((ext_vector_type(4)));
constexpr int MX_PITCH = 272;
constexpr int MX_Q = 0, MX_K = 17408, MX_KH = 34816, MX_V = 52224, MX_GD = 69632  , MX_SC = 71680  , MX_OB = 74752  , MX_RP = 108544  , MX_DI = 110592  , MX_GN = 110848  , MX_LB = 111360  , MX_END = 111872;
constexpr int MX_OP = 132;
constexpr float LNKS = -2.4260151319598084f;
static_assert(MX_END <= 139264, "mixer LDS map");

__device__ __forceinline__ bf16x8 mk8(unsigned a, unsigned b, unsigned c, unsigned d) { const u32x4 v = {a, b, c, d}; return __builtin_bit_cast(bf16x8, v); }
__device__ __forceinline__ u32x2 tr16(const LAS unsigned char* p) { return __builtin_bit_cast(u32x2, __builtin_amdgcn_ds_read_tr16_b64_v4i16((LAS v4i16_t*)p)); }
typedef float f32x2_t __attribute__((ext_vector_type(2))); typedef __bf16 bf16x2_t __attribute__((ext_vector_type(2)));
__device__ __forceinline__ unsigned pkbf(float lo, float hi) { const f32x2_t v = {lo, hi}; const bf16x2_t b = __builtin_convertvector(v, bf16x2_t); return __builtin_bit_cast(unsigned, b); }
#define MFMA16(a, b, c) __builtin_amdgcn_mfma_f32_16x16x32_bf16((a), (b), (c), 0, 0, 0)
typedef short s16x4 __attribute__((ext_vector_type(4)));
__device__ __forceinline__ f32x4 mfma16k16(u32x2 a, u32x2 b, f32x4 c) { const u32x4 a4 = {a.x, a.y, 0u, 0u}, b4 = {b.x, b.y, 0u, 0u}; return __builtin_amdgcn_mfma_f32_16x16x32_bf16(__builtin_bit_cast(bf16x8, a4), __builtin_bit_cast(bf16x8, b4), c, 0, 0, 0); }
__device__ __forceinline__ bf16x8 ld8(const LAS unsigned char* p) { return __builtin_bit_cast(bf16x8, *(const LAS u32x4*)p); }
#define MX_POS4(d) (((d) & ~31) + 8 * ((((d) & 15)) >> 2) + 4 * (((d) >> 4) & 1))
template <int CTRL> __device__ __forceinline__ float dppf(float ident, float x) { return __builtin_bit_cast(float, __builtin_amdgcn_update_dpp(__builtin_bit_cast(int, ident), __builtin_bit_cast(int, x), CTRL, 0xf, 0xf, false)); }
__device__ __forceinline__ float row_prefix_sum(float x) { x += dppf<0x111>(0.f, x); x += dppf<0x112>(0.f, x); x += dppf<0x114>(0.f, x); x += dppf<0x118>(0.f, x); return x; }
__device__ __forceinline__ float row_prefix_max(float x) { x = fmaxf(x, dppf<0x111>(-3e38f, x)); x = fmaxf(x, dppf<0x112>(-3e38f, x)); x = fmaxf(x, dppf<0x114>(-3e38f, x)); x = fmaxf(x, dppf<0x118>(-3e38f, x)); return x; }
__device__ __forceinline__ float row_prefix_prod(float x) { x *= dppf<0x111>(1.f, x); x *= dppf<0x112>(1.f, x); x *= dppf<0x114>(1.f, x); x *= dppf<0x118>(1.f, x); return x; }
__device__ __forceinline__ float row_suffix_prod(float x) { x *= dppf<0x101>(1.f, x); x *= dppf<0x102>(1.f, x); x *= dppf<0x104>(1.f, x); x *= dppf<0x108>(1.f, x); return x; }
__device__ __forceinline__ float rdlane(float x, int l) { return __builtin_bit_cast(float, __builtin_amdgcn_readlane(__builtin_bit_cast(int, x), l)); }

constexpr int ROT_N = 2072;
__device__ __forceinline__ void p0_rotary(Frame& F, float* tab) {
    const int gt = blockIdx.x * (NWAVES * 64) + F.tid, NT = F.G * NWAVES * 64;
    for (int i = gt; i < ROT_N * 64; i += NT) {
        const int pi = i >> 6, fi = i & 63;
        const float pos = pi < 2064 ? (float)pi : (float)(16384 + pi - 2064);
        const float inv = exp2f((float)fi * (-13.287712379549449f / 63.0f));
        float sn, cs; sincosf(pos * inv, &sn, &cs);
        tab[2 * i] = cs; tab[2 * i + 1] = sn;
    }
}

#ifdef PROBE_BLOCK
#define MSTAMP_DECL unsigned long long t_last_ = __builtin_amdgcn_s_memrealtime();
#define MSTAMP(id) do { if (blockIdx.x == PROBE_BLOCK && tid == 0) { const unsigned long long t_now_ = __builtin_amdgcn_s_memrealtime(); volatile LAS unsigned long long* a_ = (volatile LAS unsigned long long*)(F.lds + 139264 + 128) + 48 + (id); *a_ = *a_ + (t_now_ - t_last_); t_last_ = t_now_; } } while (0)
#else
#define MSTAMP_DECL
#define MSTAMP(id) do { } while (0)
#endif
#define MX_SC_PARAMS(scv, row0, ntok, nmc, pos0) do { if (mode != 1) { if ((scv) == 0) { row0 = ROW_M; ntok = 16; nmc = 1; pos0 = 0; } else { row0 = b * 2048 + ((scv) - 1) * 64; ntok = 64; nmc = 4; pos0 = 16 + ((scv) - 1) * 64; } } \
        else { row0 = ROW_S + 8 * b; ntok = 8; nmc = 1; pos0 = 2064; } } while (0)

template <int TYPE, int NMC>
__device__ __forceinline__ void sg_chain(LAS unsigned char* L, LAS float* SC, f32x4 (&S)[8], f32x4& nacc, int w, int r16, int q) {
    LAS float* OB = (LAS float*)(L + MX_OB); LAS float* RP = (LAS float*)(L + MX_RP); LAS float* DI = (LAS float*)(L + MX_DI);
    f32x4 oo[4];
#pragma unroll
    for (int mc = 0; mc < NMC; ++mc) {
        oo[mc] = (f32x4){0.f, 0.f, 0.f, 0.f};
        {
            const LAS unsigned char* Qb = L + MX_Q + 16 * mc * MX_PITCH; const LAS unsigned char* Kb = L + MX_K + 16 * mc * MX_PITCH; const LAS unsigned char* Vb = L + MX_V + 16 * mc * MX_PITCH;
            f32x4 g0 = {0.f, 0.f, 0.f, 0.f}, g1 = {0.f, 0.f, 0.f, 0.f};
#pragma unroll
            for (int ks = 0; ks < 4; ++ks) {
                const bf16x8 kf = ld8(Kb + r16 * MX_PITCH + (32 * ks + 8 * q) * 2), qf = ld8(Qb + r16 * MX_PITCH + (32 * ks + 8 * q) * 2);
                if (ks & 1) g1 = MFMA16(kf, qf, g1); else g0 = MFMA16(kf, qf, g0);
            }
            const f32x4 g = g0 + g1;
            const float xi = SC[mc * 16 + r16]; const f32x4 y4 = *(const LAS f32x4*)(SC + 64 + mc * 16 + 4 * q);
            f32x4 P;
#pragma unroll
            for (int r = 0; r < 4; ++r) P[r] = (4 * q + r <= r16) ? g[r] * __expf(xi + y4[r]) : 0.f;
            if (TYPE == 0) { float ps = (P[0] + P[1]) + (P[2] + P[3]); ps += __shfl_xor(ps, 16); ps += __shfl_xor(ps, 32); if (w == 0 && q == 0) DI[16 * mc + r16] = ps; }
            const u32x2 vt = tr16(Vb + (4 * q + (r16 >> 2)) * MX_PITCH + (16 * w + 4 * (r16 & 3)) * 2);
            oo[mc] = mfma16k16((u32x2){pkbf(P[0], P[1]), pkbf(P[2], P[3])}, vt, oo[mc]);
        }
        if (mc == 1 || TYPE == 1) __builtin_amdgcn_sched_barrier(0);
    }
#pragma unroll
    for (int mc = 0; mc < NMC; ++mc) {
        {
            const LAS unsigned char* Qb = L + MX_Q + 16 * mc * MX_PITCH; const LAS unsigned char* Kb = L + MX_K + 16 * mc * MX_PITCH;
            const u32x2 vt = tr16(L + MX_V + 16 * mc * MX_PITCH + (4 * q + (r16 >> 2)) * MX_PITCH + (16 * w + 4 * (r16 & 3)) * 2);
            f32x4 o2a = {0.f, 0.f, 0.f, 0.f}, o2b = {0.f, 0.f, 0.f, 0.f};
#pragma unroll
            for (int ks = 0; ks < 4; ++ks) {
                const bf16x8 qf = ld8(Qb + r16 * MX_PITCH + (32 * ks + 8 * q) * 2);
                const bf16x8 SB = mk8(pkbf(S[2 * ks][0], S[2 * ks][1]), pkbf(S[2 * ks][2], S[2 * ks][3]), pkbf(S[2 * ks + 1][0], S[2 * ks + 1][1]), pkbf(S[2 * ks + 1][2], S[2 * ks + 1][3]));
                if (ks & 1) o2b = MFMA16(qf, SB, o2b); else o2a = MFMA16(qf, SB, o2a);
            }
            const f32x4 in4 = *(const LAS f32x4*)(SC + 128 + mc * 16 + 4 * q);
            oo[mc] = oo[mc] + in4 * (o2a + o2b);
            const f32x4 w4 = *(const LAS f32x4*)(SC + 192 + mc * 16 + 4 * q); const float carry = SC[320 + mc];
            if (TYPE == 0) {
                const u32x2 qn = *(const LAS u32x2*)(Qb + r16 * MX_PITCH + MX_POS4(16 * w + 4 * q) * 2);
                f32x4 rr = {0.f, 0.f, 0.f, 0.f}; rr = mfma16k16(qn, (u32x2){pkbf(nacc[0], nacc[1]), pkbf(nacc[2], nacc[3])}, rr);
                if (r16 == 0) {
#pragma unroll
                    for (int r = 0; r < 4; ++r) RP[w * 64 + 16 * mc + 4 * q + r] = rr[r]; }
            }
#pragma unroll
            for (int r = 0; r < 4; ++r) OB[(16 * mc + 4 * q + r) * MX_OP + 16 * w + r16] = oo[mc][r];
            const u32x2 VH = {pkbf(bflo(vt.x) * w4[0], bfhi(vt.x) * w4[1]), pkbf(bflo(vt.y) * w4[2], bfhi(vt.y) * w4[3])};
#pragma unroll
            for (int mt = 0; mt < 8; ++mt) {
                const u32x2 kt = tr16(Kb + (4 * q + (r16 >> 2)) * MX_PITCH + MX_POS4(16 * mt + 4 * (r16 & 3)) * 2);
                S[mt] = S[mt] * carry; S[mt] = mfma16k16(kt, VH, S[mt]);
            }
            if (TYPE == 0) {
                const u32x2 kt = tr16(Kb + (4 * q + (r16 >> 2)) * MX_PITCH + MX_POS4(16 * w + 4 * (r16 & 3)) * 2);
                nacc = nacc * carry; nacc = mfma16k16(kt, (u32x2){pkbf(w4[0], w4[1]), pkbf(w4[2], w4[3])}, nacc);
            }
        }
        if (mc + 1 < NMC) __builtin_amdgcn_sched_barrier(0);
    }
}

template <int TYPE>
__device__ __forceinline__ void mix_sg_unit(Frame& F, int b, int h, int mode  , const float* rot) {
    const bool prompt = (mode != 1);
    const int tid = F.tid, lane = F.lane, w = F.wave, r16 = lane & 15, q = lane >> 4;
    const int tk = tid >> 3, p = tid & 7;
    LAS unsigned char* L = F.lds;
    LAS float* OB = (LAS float*)(L + MX_OB); LAS float* RP = (LAS float*)(L + MX_RP); LAS float* DI = (LAS float*)(L + MX_DI);
    bf16* MIX = F_XN(F);
    const int qcol = (TYPE == 0 ? 0 : 2048) + 128 * h, kcol = (TYPE == 0 ? 512 : 2560) + 128 * h, vcol = (TYPE == 0 ? 1024 : 3072) + 128 * h, gcol = (TYPE == 0 ? 1536 : 3584) + 128 * h, mcol = (TYPE == 0 ? 0 : 512) + 128 * h;
    f32x4 S[8]; f32x4 nacc = {0.f, 0.f, 0.f, 0.f}; float m0 = 0.f;
#pragma unroll
    for (int mt = 0; mt < 8; ++mt) S[mt] = (f32x4){0.f, 0.f, 0.f, 0.f};
    if (!prompt) {
        const float* Sin = (TYPE == 0 ? F.in[2] : F.in[5]) + (size_t)(b * 4 + h) * 16384;
#pragma unroll
        for (int mt = 0; mt < 8; ++mt)
#pragma unroll
            for (int r = 0; r < 4; ++r) S[mt][r] = Sin[(16 * mt + 4 * q + r) * 128 + 16 * w + r16];
        if (TYPE == 0) {
#pragma unroll
            for (int r = 0; r < 4; ++r) nacc[r] = F.in[3][(size_t)(b * 4 + h) * 128 + 16 * w + 4 * q + r];
            m0 = F.in[4][b * 4 + h];
        }
    }
    const float lgam = (TYPE != 1) ? 0.f : h == 0 ? -0.031748698314580298f : h == 1 ? -0.015748356968139168f : h == 2 ? -0.0078431774610258928f : -0.0039138993211363287f;
    const float bias_i = (TYPE == 0) ? F.in[11][h] : 0.f, bias_f = (TYPE == 0) ? F.in[12][h] : 0.f;
    LAS float* GN = (LAS float*)(L + MX_GN);
    if (tid < 128) GN[tid] = (TYPE == 0 ? F.in[13] : F.in[14])[128 * h + tid];
    const int nsc = (mode == 0) ? 33 : 1;
    u32x4 pa[6]; f32x4 pr[4]; float pli = 0.f, plf = 0.f; u32x4 pg[2];
    const u32x4 z4 = {0u, 0u, 0u, 0u};
#define SG_LOAD(scv) do { int row0_, ntok_, nmc_, pos0_; MX_SC_PARAMS(scv, row0_, ntok_, nmc_, pos0_); (void)nmc_; \
        const bool valid_ = tk < ntok_; const bf16* zr_ = ZROW(F, row0_ + (valid_ ? tk : 0), 0); \
        _Pragma("unroll") for (int i_ = 0; i_ < 6; ++i_) pa[i_] = z4; \
        if (valid_) { pa[4] = *(const u32x4*)(zr_ + vcol + 16 * p); pa[5] = *(const u32x4*)(zr_ + vcol + 16 * p + 8); \
            if (TYPE == 0) { pa[0] = *(const u32x4*)(zr_ + qcol + 16 * p); pa[1] = *(const u32x4*)(zr_ + qcol + 16 * p + 8); pa[2] = *(const u32x4*)(zr_ + kcol + 16 * p); pa[3] = *(const u32x4*)(zr_ + kcol + 16 * p + 8); } \
            else { pa[0] = *(const u32x4*)(zr_ + qcol + 8 * p); pa[1] = *(const u32x4*)(zr_ + qcol + 64 + 8 * p); pa[2] = *(const u32x4*)(zr_ + kcol + 8 * p); pa[3] = *(const u32x4*)(zr_ + kcol + 64 + 8 * p); } } \
        if (TYPE == 1) { const float* tb_ = rot + ((size_t)(pos0_ + (valid_ ? tk : 0)) * 64 + 8 * p) * 2; _Pragma("unroll") for (int e_ = 0; e_ < 4; ++e_) pr[e_] = *(const f32x4*)(tb_ + 4 * e_); } \
        if (TYPE == 0 && w == 0) { const bool vt_ = lane < ntok_; const float* gp_ = F_GT(F) + (size_t)(row0_ + (vt_ ? lane : 0)) * 8; pli = gp_[h]; plf = gp_[4 + h]; } } while (0)
    SG_LOAD(0);
    MSTAMP_DECL
#pragma unroll 1
    for (int sc = 0; sc < nsc; ++sc) {
        int row0, ntok, nmc, pos0; MX_SC_PARAMS(sc, row0, ntok, nmc, pos0); (void)pos0;
        LAS float* SC = (LAS float*)(L + MX_SC) + (sc & 1) * 384;
        MSTAMP(0);
        {
            *(LAS u32x4*)(L + MX_V + tk * MX_PITCH + 32 * p) = pa[4]; *(LAS u32x4*)(L + MX_V + tk * MX_PITCH + 32 * p + 16) = pa[5];
            if (TYPE == 0) {
                const int c0 = (MX_POS4(16 * p)) * 2;
#pragma unroll
                for (int g = 0; g < 4; ++g) {
                    *(LAS u32x2*)(L + MX_Q + tk * MX_PITCH + c0 + 16 * g) = (u32x2){pa[g >> 1][2 * (g & 1)], pa[g >> 1][2 * (g & 1) + 1]};
                    *(LAS u32x2*)(L + MX_K + tk * MX_PITCH + c0 + 16 * g) = (u32x2){pa[2 + (g >> 1)][2 * (g & 1)], pa[2 + (g >> 1)][2 * (g & 1) + 1]};
                }
            } else {
                u32x4 q1, q2, k1, k2;
#pragma unroll
                for (int e2 = 0; e2 < 4; ++e2) {
                    const f32x4 cs = pr[e2];
                    { const float x1l = bflo(pa[0][e2]), x1h = bfhi(pa[0][e2]), x2l = bflo(pa[1][e2]), x2h = bfhi(pa[1][e2]);
                      q1[e2] = pkbf(x1l * cs[0] - x2l * cs[1], x1h * cs[2] - x2h * cs[3]); q2[e2] = pkbf(x2l * cs[0] + x1l * cs[1], x2h * cs[2] + x1h * cs[3]); }
                    { const float x1l = bflo(pa[2][e2]), x1h = bfhi(pa[2][e2]), x2l = bflo(pa[3][e2]), x2h = bfhi(pa[3][e2]);
                      k1[e2] = pkbf(x1l * cs[0] - x2l * cs[1], x1h * cs[2] - x2h * cs[3]); k2[e2] = pkbf(x2l * cs[0] + x1l * cs[1], x2h * cs[2] + x1h * cs[3]); }
                }
                const int c0 = (MX_POS4(8 * p)) * 2;
                *(LAS u32x2*)(L + MX_Q + tk * MX_PITCH + c0) = (u32x2){q1[0], q1[1]}; *(LAS u32x2*)(L + MX_Q + tk * MX_PITCH + c0 + 16) = (u32x2){q1[2], q1[3]};
                *(LAS u32x2*)(L + MX_Q + tk * MX_PITCH + c0 + 128) = (u32x2){q2[0], q2[1]}; *(LAS u32x2*)(L + MX_Q + tk * MX_PITCH + c0 + 144) = (u32x2){q2[2], q2[3]};
                *(LAS u32x2*)(L + MX_K + tk * MX_PITCH + c0) = (u32x2){k1[0], k1[1]}; *(LAS u32x2*)(L + MX_K + tk * MX_PITCH + c0 + 16) = (u32x2){k1[2], k1[3]};
                *(LAS u32x2*)(L + MX_K + tk * MX_PITCH + c0 + 128) = (u32x2){k2[0], k2[1]}; *(LAS u32x2*)(L + MX_K + tk * MX_PITCH + c0 + 144) = (u32x2){k2[2], k2[3]};
            }
        }
        if (w == 0) {
            const bool valid = lane < ntok;
            float li = -1e30f, lf = 0.f;
            if (TYPE == 0) { if (valid) { li = pli + bias_i; lf = logsigmoidf_(plf + bias_f); } } else { if (valid) { li = 0.f; lf = lgam; } }
            const float bb = row_prefix_sum(lf);
            const float y = li - bb;
            const float am = row_prefix_max(y);
            const float a = bb + am;
            const float B0 = rdlane(bb, 15), B1 = rdlane(bb, 31), B2 = rdlane(bb, 47), B3 = rdlane(bb, 63);
            float M1 = 0.f, M2 = 0.f, M3 = 0.f, M4 = 0.f;
            if (TYPE == 0) { const float A0 = rdlane(a, 15), A1 = rdlane(a, 31), A2 = rdlane(a, 47), A3 = rdlane(a, 63);
                M1 = fmaxf(B0 + m0, A0); M2 = fmaxf(B1 + M1, A1); M3 = fmaxf(B2 + M2, A2); M4 = fmaxf(B3 + M3, A3); }
            const float m0q = q == 0 ? m0 : q == 1 ? M1 : q == 2 ? M2 : M3;
            const float mnq = q == 0 ? M1 : q == 1 ? M2 : q == 2 ? M3 : M4;
            const float b15 = q == 0 ? B0 : q == 1 ? B1 : q == 2 ? B2 : B3;
            const float m = (TYPE == 0) ? fmaxf(bb + m0q, a) : 0.f;
            SC[lane] = bb - m; SC[64 + lane] = y + LNKS; SC[128 + lane] = __expf(bb + m0q - m);
            SC[192 + lane] = __expf(y + LNKS + b15 - mnq); SC[256 + lane] = __expf(-m);
            if (r16 == 0) SC[320 + q] = __expf(b15 + m0q - mnq);
            m0 = (nmc == 4) ? M4 : M1;
        }
        MSTAMP(1);
        __syncthreads();
        MSTAMP(2);
        if (sc + 1 < nsc) SG_LOAD(sc + 1);
        { const bool valid = tk < ntok; const bf16* zr = ZROW(F, row0 + (valid ? tk : 0), 0) + gcol + 16 * p; pg[0] = *(const u32x4*)zr; pg[1] = *(const u32x4*)(zr + 8); }
        MSTAMP(3);
        if (nmc == 4) sg_chain<TYPE, 4>(L, SC, S, nacc, w, r16, q); else sg_chain<TYPE, 1>(L, SC, S, nacc, w, r16, q);
        MSTAMP(4);
        __syncthreads();
        MSTAMP(6);
        {
            const bool valid = tk < ntok; const int row = row0 + (valid ? tk : 0);
            f32x4 o[4];
#pragma unroll
            for (int c = 0; c < 4; ++c) o[c] = *(const LAS f32x4*)(OB + tk * MX_OP + 16 * p + 4 * c);
            if (tk >= 16 * nmc) {
#pragma unroll
                for (int c = 0; c < 4; ++c) o[c] = (f32x4){0.f, 0.f, 0.f, 0.f}; }
            if (TYPE == 0) {
                float rs = 0.f;
#pragma unroll
                for (int ww = 0; ww < 8; ++ww) rs += RP[ww * 64 + tk];
                const float den = DI[tk] + SC[128 + tk] * rs;
                float dn = fmaxf(fabsf(den), SC[256 + tk]); if (tk >= 16 * nmc) dn = 1.f;
                const float rd = 1.f / dn;
#pragma unroll
                for (int c = 0; c < 4; ++c) o[c] = o[c] * rd;
            }
            float sm = 0.f;
#pragma unroll
            for (int c = 0; c < 4; ++c) sm += (o[c].x + o[c].y) + (o[c].z + o[c].w);
            sm += __shfl_xor(sm, 1); sm += __shfl_xor(sm, 2); sm += __shfl_xor(sm, 4);
            const float mu = sm * (1.f / 128.f); float vs = 0.f;
#pragma unroll
            for (int c = 0; c < 4; ++c) { o[c] = o[c] - mu; vs += (o[c].x * o[c].x + o[c].y * o[c].y) + (o[c].z * o[c].z + o[c].w * o[c].w); }
            vs += __shfl_xor(vs, 1); vs += __shfl_xor(vs, 2); vs += __shfl_xor(vs, 4);
            const float rstd = rsqrtf(vs * (1.f / 128.f) + EPS);
            if (valid && !(mode == 0 && sc == 0)) {
                unsigned ow[8];
#pragma unroll
                for (int c = 0; c < 4; ++c) {
                    const unsigned ga = c < 2 ? pg[0][2 * c] : pg[1][2 * c - 4], gb = c < 2 ? pg[0][2 * c + 1] : pg[1][2 * c - 3];
                    f32x4 gt = {bflo(ga), bfhi(ga), bflo(gb), bfhi(gb)};
#pragma unroll
                    for (int e = 0; e < 4; ++e) gt[e] = (TYPE == 0) ? sigmoidf_(gt[e]) : siluf_(gt[e]);
                    const f32x4 r = o[c] * rstd * *(const LAS f32x4*)(GN + 16 * p + 4 * c) * gt;
                    ow[2 * c] = pkbf(r.x, r.y); ow[2 * c + 1] = pkbf(r.z, r.w);
                }
                bf16* mp = MIX + (size_t)row * DM + mcol + 16 * p;
                *(u32x4*)mp = (u32x4){ow[0], ow[1], ow[2], ow[3]}; *(u32x4*)(mp + 8) = (u32x4){ow[4], ow[5], ow[6], ow[7]};
            }
        }
        MSTAMP(7);
    }
#undef SG_LOAD
    __syncthreads();
    if (mode != 2) {
        int l2 = F.lane; asm volatile("" : "+v"(l2)); const int r16 = l2 & 15, q = l2 >> 4;
        float* So = F.out + (TYPE == 0 ? (prompt ? O_CP : O_CS) : (prompt ? O_RP : O_RS)) + (size_t)(b * 4 + h) * 16384;
#pragma unroll
        for (int mt = 0; mt < 8; ++mt)
#pragma unroll
            for (int r = 0; r < 4; ++r) So[(16 * mt + 4 * q + r) * 128 + 16 * w + r16] = S[mt][r];
        if (TYPE == 0) {
            if (r16 == 0) { float* No = F.out + (prompt ? O_NP : O_NS) + (size_t)(b * 4 + h) * 128;
#pragma unroll
                for (int r = 0; r < 4; ++r) No[16 * w + 4 * q + r] = nacc[r]; }
            if (w == 0 && lane == 0) F.out[(prompt ? O_MP : O_MS) + b * 4 + h] = m0;
        }
    }
}

template <int NMC>
__device__ __forceinline__ void hg_chain(LAS unsigned char* L, f32x4 (&S)[8], int w, int r16, int q) {
    LAS float* GD = (LAS float*)(L + MX_GD); LAS float* OB = (LAS float*)(L + MX_OB);
    f32x4 oo[4];
#pragma unroll
    for (int mc = 0; mc < NMC; ++mc) {
        oo[mc] = (f32x4){0.f, 0.f, 0.f, 0.f};
        {
            const LAS unsigned char* Qb = L + MX_Q + 16 * mc * MX_PITCH; const LAS unsigned char* Kb = L + MX_K + 16 * mc * MX_PITCH; const LAS unsigned char* Vb = L + MX_V + 16 * mc * MX_PITCH;
            f32x4 g0 = {0.f, 0.f, 0.f, 0.f}, g1 = {0.f, 0.f, 0.f, 0.f};
#pragma unroll
            for (int ks = 0; ks < 4; ++ks) {
                const bf16x8 kf = ld8(Kb + r16 * MX_PITCH + (32 * ks + 8 * q) * 2), qf = ld8(Qb + r16 * MX_PITCH + (32 * ks + 8 * q) * 2);
                if (ks & 1) g1 = MFMA16(kf, qf, g1); else g0 = MFMA16(kf, qf, g0);
            }
            const f32x4 g = g0 + g1;
            f32x4 P;
#pragma unroll
            for (int r = 0; r < 4; ++r) P[r] = (4 * q + r <= r16) ? g[r] : 0.f;
            const u32x2 vt = tr16(Vb + (4 * q + (r16 >> 2)) * MX_PITCH + (16 * w + 4 * (r16 & 3)) * 2);
            oo[mc] = mfma16k16((u32x2){pkbf(P[0], P[1]), pkbf(P[2], P[3])}, vt, oo[mc]);
        }
        if (mc == 1) __builtin_amdgcn_sched_barrier(0);
    }
#pragma unroll
    for (int mc = 0; mc < NMC; ++mc) {
        {
            const LAS unsigned char* Qb = L + MX_Q + 16 * mc * MX_PITCH; const LAS unsigned char* Hb = L + MX_KH + 16 * mc * MX_PITCH;
            const u32x2 vt = tr16(L + MX_V + 16 * mc * MX_PITCH + (4 * q + (r16 >> 2)) * MX_PITCH + (16 * w + 4 * (r16 & 3)) * 2);
            f32x4 o2b = {0.f, 0.f, 0.f, 0.f};
#pragma unroll
            for (int ks = 0; ks < 4; ++ks) {
                const bf16x8 qf = ld8(Qb + r16 * MX_PITCH + (32 * ks + 8 * q) * 2);
                const bf16x8 SB = mk8(pkbf(S[2 * ks][0], S[2 * ks][1]), pkbf(S[2 * ks][2], S[2 * ks][3]), pkbf(S[2 * ks + 1][0], S[2 * ks + 1][1]), pkbf(S[2 * ks + 1][2], S[2 * ks + 1][3]));
                if (ks & 1) o2b = MFMA16(qf, SB, o2b); else oo[mc] = MFMA16(qf, SB, oo[mc]);
            }
            oo[mc] = oo[mc] + o2b;
#pragma unroll
            for (int mt = 0; mt < 8; ++mt) {
                const f32x4 gd = *(const LAS f32x4*)(GD + mc * 128 + 16 * mt + 4 * q);
                const u32x2 kt = tr16(Hb + (4 * q + (r16 >> 2)) * MX_PITCH + (16 * mt + 4 * (r16 & 3)) * 2);
                S[mt] = S[mt] * gd; S[mt] = mfma16k16(kt, vt, S[mt]);
            }
        }
        if (mc + 1 < NMC) __builtin_amdgcn_sched_barrier(0);
    }
#pragma unroll
    for (int mc = 0; mc < NMC; ++mc) {
        {
#pragma unroll
            for (int r = 0; r < 4; ++r) OB[(16 * mc + 4 * q + r) * MX_OP + 16 * w + r16] = oo[mc][r];
        }
    }
}

__device__ __forceinline__ void mix_hg_unit(Frame& F, int b, int h, int mode) {
    const bool prompt = (mode != 1);
    const int tid = F.tid, lane = F.lane, w = F.wave, r16 = lane & 15, q = lane >> 4;
    const int tk = tid >> 3, p = tid & 7;
    const int amc = w >> 1, app = q + 4 * (w & 1);
    LAS unsigned char* L = F.lds;
    LAS float* GD = (LAS float*)(L + MX_GD); LAS float* OB = (LAS float*)(L + MX_OB);
    bf16* MIX = F_XN(F);
    f32x4 S[8];
#pragma unroll
    for (int mt = 0; mt < 8; ++mt) S[mt] = (f32x4){0.f, 0.f, 0.f, 0.f};
    if (!prompt) {
        const float* Sin = F.in[6] + (size_t)(b * 8 + h) * 16384;
#pragma unroll
        for (int mt = 0; mt < 8; ++mt)
#pragma unroll
            for (int r = 0; r < 4; ++r) S[mt][r] = Sin[(16 * mt + 4 * q + r) * 128 + 16 * w + r16];
    }
    LAS float* GN = (LAS float*)(L + MX_GN); LAS float* LB = (LAS float*)(L + MX_LB);
    if (tid < 128) { GN[tid] = F.in[18][128 * h + tid]; LB[tid] = sigmoidf_(F.in[16][1024 + 128 * h + tid] - F.in[16][128 * h + tid]); }
    __syncthreads();
    const int nsc = (mode == 0) ? 33 : 1;
    u32x4 pa[6]; u32x4 pg[2];
    const u32x4 z4 = {0u, 0u, 0u, 0u};
#define HG_LOAD(scv) do { int row0_, ntok_, nmc_, pos0_; MX_SC_PARAMS(scv, row0_, ntok_, nmc_, pos0_); (void)pos0_; \
        const int t_ = 16 * amc + r16; const bool valid_ = (amc < nmc_) && (t_ < ntok_); const bf16* zr_ = ZROW(F, row0_ + (valid_ ? t_ : 0), 1) + 128 * h + 16 * app; \
        _Pragma("unroll") for (int i_ = 0; i_ < 6; ++i_) pa[i_] = z4; \
        if (valid_) { pa[0] = *(const u32x4*)zr_; pa[1] = *(const u32x4*)(zr_ + 8); pa[2] = *(const u32x4*)(zr_ + 1024); pa[3] = *(const u32x4*)(zr_ + 1032); pa[4] = *(const u32x4*)(zr_ + 2048); pa[5] = *(const u32x4*)(zr_ + 2056); } } while (0)
    HG_LOAD(0);
    MSTAMP_DECL
#pragma unroll 1
    for (int sc = 0; sc < nsc; ++sc) {
        int row0, ntok, nmc, pos0; MX_SC_PARAMS(sc, row0, ntok, nmc, pos0); (void)pos0;
        MSTAMP(8);
        {
            const bool valid = (amc < nmc) && (16 * amc + r16) < ntok;
            unsigned wq[8], wk[8], wh[8]; float Aend[16]; float lbv[16];
#pragma unroll
            for (int c = 0; c < 4; ++c) { const f32x4 t4 = *(const LAS f32x4*)(LB + 16 * app + 4 * c); lbv[4 * c] = t4[0]; lbv[4 * c + 1] = t4[1]; lbv[4 * c + 2] = t4[2]; lbv[4 * c + 3] = t4[3]; }
#pragma unroll
            for (int e2 = 0; e2 < 8; ++e2) {
                const unsigned qw = e2 < 4 ? pa[0][e2] : pa[1][e2 - 4], fw = e2 < 4 ? pa[2][e2] : pa[3][e2 - 4];
                float qo[2], ko[2], ho[2];
#pragma unroll
                for (int hh = 0; hh < 2; ++hh) {
                    const int e = 2 * e2 + hh;
                    const float qv = hh ? bfhi(qw) : bflo(qw), fv = hh ? bfhi(fw) : bflo(fw);
                    const float sg = sigmoidf_(fv);
                    const float a = valid ? lbv[e] + (1.f - lbv[e]) * sg : 1.f;
                    const float kk = valid ? (1.f - lbv[e]) * (1.f - sg) : 0.f;
                    const float A = row_prefix_prod(a);
                    const float A15 = __builtin_bit_cast(float, __builtin_amdgcn_ds_swizzle(__builtin_bit_cast(int, A), 0x1F0));
                    const float kr = kk * __builtin_amdgcn_rcpf(fmaxf(A, 1e-30f));
                    qo[hh] = qv * A; ko[hh] = kr; ho[hh] = kr * A15;
                    Aend[e] = A;
                }
                wq[e2] = pkbf(qo[0], qo[1]); wk[e2] = pkbf(ko[0], ko[1]); wh[e2] = pkbf(ho[0], ho[1]);
            }
            const int ro = (16 * amc + r16) * MX_PITCH + 32 * app;
            { const int rf = (16 * amc + r16) * MX_PITCH + (MX_POS4(16 * app)) * 2;
#pragma unroll
              for (int g = 0; g < 4; ++g) { *(LAS u32x2*)(L + MX_Q + rf + 16 * g) = (u32x2){wq[2 * g], wq[2 * g + 1]}; *(LAS u32x2*)(L + MX_K + rf + 16 * g) = (u32x2){wk[2 * g], wk[2 * g + 1]}; } }
            *(LAS u32x4*)(L + MX_KH + ro) = (u32x4){wh[0], wh[1], wh[2], wh[3]}; *(LAS u32x4*)(L + MX_KH + ro + 16) = (u32x4){wh[4], wh[5], wh[6], wh[7]};
            *(LAS u32x4*)(L + MX_V + ro) = pa[4]; *(LAS u32x4*)(L + MX_V + ro + 16) = pa[5];
            if (r16 == 15) {
#pragma unroll
                for (int c = 0; c < 4; ++c) *(LAS f32x4*)(GD + amc * 128 + 16 * app + 4 * c) = (f32x4){Aend[4 * c], Aend[4 * c + 1], Aend[4 * c + 2], Aend[4 * c + 3]}; }
        }
        MSTAMP(9);
        __syncthreads();
        MSTAMP(10);
        if (sc + 1 < nsc) HG_LOAD(sc + 1);
        { const bool valid = tk < ntok; const bf16* zr = ZROW(F, row0 + (valid ? tk : 0), 1) + 3072 + 128 * h + 16 * p; pg[0] = *(const u32x4*)zr; pg[1] = *(const u32x4*)(zr + 8); }
        MSTAMP(11);
        if (nmc == 4) hg_chain<4>(L, S, w, r16, q); else hg_chain<1>(L, S, w, r16, q);
        MSTAMP(12);
        __syncthreads();
        MSTAMP(13);
        {
            const bool valid = tk < ntok; const int row = row0 + (valid ? tk : 0);
            f32x4 o[4];
#pragma unroll
            for (int c = 0; c < 4; ++c) o[c] = *(const LAS f32x4*)(OB + tk * MX_OP + 16 * p + 4 * c);
            if (tk >= 16 * nmc) {
#pragma unroll
                for (int c = 0; c < 4; ++c) o[c] = (f32x4){0.f, 0.f, 0.f, 0.f}; }
            float vs = 0.f;
#pragma unroll
            for (int c = 0; c < 4; ++c) vs += (o[c].x * o[c].x + o[c].y * o[c].y) + (o[c].z * o[c].z + o[c].w * o[c].w);
            vs += __shfl_xor(vs, 1); vs += __shfl_xor(vs, 2); vs += __shfl_xor(vs, 4);
            const float rstd = rsqrtf(vs * (1.f / 128.f) + EPS);
            if (valid && !(mode == 0 && sc == 0)) {
                unsigned ow[8];
#pragma unroll
                for (int c = 0; c < 4; ++c) {
                    const unsigned ga = c < 2 ? pg[0][2 * c] : pg[1][2 * c - 4], gb = c < 2 ? pg[0][2 * c + 1] : pg[1][2 * c - 3];
                    f32x4 gt = {bflo(ga), bfhi(ga), bflo(gb), bfhi(gb)};
#pragma unroll
                    for (int e = 0; e < 4; ++e) gt[e] = siluf_(gt[e]);
                    const f32x4 r = o[c] * rstd * *(const LAS f32x4*)(GN + 16 * p + 4 * c) * gt;
                    ow[2 * c] = pkbf(r.x, r.y); ow[2 * c + 1] = pkbf(r.z, r.w);
                }
                bf16* mp = MIX + (size_t)row * DM + 128 * h + 16 * p;
                *(u32x4*)mp = (u32x4){ow[0], ow[1], ow[2], ow[3]}; *(u32x4*)(mp + 8) = (u32x4){ow[4], ow[5], ow[6], ow[7]};
            }
        }
        MSTAMP(14);
    }
#undef HG_LOAD
    __syncthreads();
    if (mode != 2) {
        int l2 = F.lane; asm volatile("" : "+v"(l2)); const int r16 = l2 & 15, q = l2 >> 4;
        float* So = F.out + (prompt ? O_HP : O_HS) + (size_t)(b * 8 + h) * 16384;
#pragma unroll
        for (int mt = 0; mt < 8; ++mt)
#pragma unroll
            for (int r = 0; r < 4; ++r) So[(16 * mt + 4 * q + r) * 128 + 16 * w + r16] = S[mt][r];
    }
}

__device__ __forceinline__ void mixer_layer0(Frame& F) {
    const float* rot = (const float*)(F.ws + WS_ROT);
    int bid = blockIdx.x; asm volatile("" : "+s"(bid));
    if (bid < 64) { const int u = bid, ty = u >> 5, bh = u & 31; if (ty == 0) mix_sg_unit<0>(F, bh >> 2, bh & 3, 0, rot); else mix_sg_unit<1>(F, bh >> 2, bh & 3, 0, rot); return; }
#pragma unroll 1
    for (int u = bid - 64; u < 1024 + 8; u += F.G - 64) {
        int ty, bh, mode;
        if (u < 1024) { ty = u >> 9; bh = u & 511; mode = 1; } else { ty = (u - 1024) >> 2; bh = (u - 1024) & 3; mode = 2; }
        if (ty == 0) mix_sg_unit<0>(F, bh >> 2, bh & 3, mode, rot); else mix_sg_unit<1>(F, bh >> 2, bh & 3, mode, rot);
    }
}
__device__ __forceinline__ void mixer_layer1(Frame& F) {
    int bid = blockIdx.x; asm volatile("" : "+s"(bid));
    if (bid < 64) { mix_hg_unit(F, bid >> 3, bid & 7, 0); return; }
#pragma unroll 1
    for (int u = bid - 64; u < 1024 + 8; u += F.G - 64) {
        if (u < 1024) mix_hg_unit(F, u >> 3, u & 7, 1); else mix_hg_unit(F, 0, u - 1024, 2);
    }
}
constexpr int NSTEP = 21;
#ifndef P0_DEFER
#define P0_DEFER 0
#endif
constexpr int LDSCTL_OFF = 139264;
#define RLX_AGENT __ATOMIC_RELAXED, __HIP_MEMORY_SCOPE_AGENT
#define XB_TMO      128
#define XB_XCNT(j)  (256  + 64 * (j))
#define XB_XSUB(j)  (1280 + 64 * (j))
#define XB_XGEN(j)  (2304 + 64 * (j))
#define XB_TOP      3328
#define XB_TOPGEN   3392
#define XCD_BAR_WORDS 3456
#define XB_SPIN_CAP (1u << 18)

__device__ __forceinline__ unsigned xb_ld(unsigned* p)              { return __hip_atomic_load(p, __ATOMIC_RELAXED, __HIP_MEMORY_SCOPE_AGENT); }
__device__ __forceinline__ unsigned xb_add(unsigned* p, unsigned v) { return __hip_atomic_fetch_add(p, v, __ATOMIC_RELAXED, __HIP_MEMORY_SCOPE_AGENT); }
__device__ __forceinline__ unsigned xb_xcc_id() { return (unsigned)__builtin_amdgcn_s_getreg((3 << 11) | 20) & 0xFu; }
#define XB_SPIN(cond, bar) do { unsigned _sp = 0; while (cond) { __builtin_amdgcn_s_sleep(1); \
    if ((++_sp & 255u) == 0u) { if (xb_ld(&(bar)[XB_TMO])) break; if (_sp > XB_SPIN_CAP) { atomicAdd(&(bar)[XB_TMO], 1u); break; } } } } while (0)

struct XcdBarrier {
    unsigned gsz;
    unsigned* bar; unsigned x;
    volatile LAS unsigned* st;
};

__device__ __forceinline__ XcdBarrier xcd_barrier_post(unsigned* bar, volatile LAS unsigned* st, unsigned gsz) {
    XcdBarrier b; b.gsz = gsz; b.bar = bar; b.x = xb_xcc_id(); b.st = st;
    if (threadIdx.x == 0) (void)xb_add(&bar[XB_XCNT(b.x)], 1u);
    return b;
}
__device__ __forceinline__ void xcd_barrier_complete(unsigned* bar, unsigned x, unsigned G, unsigned& nloc, unsigned& nx) {
    unsigned sum, cnt, mine, sp = 0u;
    for (;;) {
        sum = 0u; cnt = 0u; mine = 0u;
#pragma unroll
        for (unsigned j = 0; j < 16; ++j) { const unsigned c = xb_ld(&bar[XB_XCNT(j)]); sum += c; cnt += (c > 0u) ? 1u : 0u; mine = (j == x) ? c : mine; }
        if (sum == G) break;
        __builtin_amdgcn_s_sleep(1);
        if ((++sp & 255u) == 0u) { if (xb_ld(&bar[XB_TMO])) break; if (sp > XB_SPIN_CAP) { atomicAdd(&bar[XB_TMO], 1u); break; } }
    }
    nloc = mine > 0u ? mine : 1u; nx = cnt > 0u ? cnt : 1u;
}

__device__ __forceinline__ void xcd_barrier(const XcdBarrier& b) {
    asm volatile("s_waitcnt vmcnt(0)" ::: "memory");
    __syncthreads();
    if (threadIdx.x == 0) {
        unsigned* bar = b.bar;
        __builtin_amdgcn_s_waitcnt(0);
        unsigned nloc = b.st[0], nx = b.st[1];
        if (nloc == 0u) { xcd_barrier_complete(bar, b.x, b.gsz, nloc, nx); b.st[0] = nloc; b.st[1] = nx; }
        const unsigned old = xb_add(&bar[XB_XSUB(b.x)], 1u);
        const unsigned gen = old / nloc;
        if (old + 1u == (gen + 1u) * nloc) {
            __builtin_amdgcn_fence(__ATOMIC_RELEASE, "agent");
            asm volatile("s_waitcnt vmcnt(0)" ::: "memory");
            const unsigned og = xb_add(&bar[XB_TOP], 1u);
            const unsigned tg = og / nx;
            if (og + 1u == (tg + 1u) * nx) xb_add(&bar[XB_TOPGEN], 1u);
            else XB_SPIN(xb_ld(&bar[XB_TOPGEN]) == tg, bar);
            __builtin_amdgcn_fence(__ATOMIC_ACQUIRE, "agent");
            xb_add(&bar[XB_XGEN(b.x)], 1u);
            asm volatile("s_waitcnt vmcnt(0)" ::: "memory");
        } else {
            XB_SPIN(xb_ld(&bar[XB_XGEN(b.x)]) == gen, bar);
            __builtin_amdgcn_fence(__ATOMIC_ACQUIRE, "agent");
            asm volatile("s_waitcnt vmcnt(0)" ::: "memory");
        }
    }
    __syncthreads();
}


enum { K_P0 = 0, K_IN = 1, K_MIX = 2, K_OUT = 3, K_UP = 5, K_FIX = 6, K_DOWN = 7, K_FINAL = 8 };
struct Step { int kind, layer, side, tile0, nt, pre; };
__device__ __forceinline__ Step get_step(int pc) {
    switch (pc) {
        case 0:  return Step{K_P0, 0, 0, 0, 0, 0};
        case 1:  return Step{K_IN, 0, 0, 0, 69, 1};
        case 2:  return Step{K_MIX, 0, 0, 0, 0, 1};
        case 3:  return Step{K_OUT, 0, 1, 64, 5, 2};
        case 4:  return Step{K_UP, 0, 1, 64, 5, 2};
        case 5:  return Step{K_DOWN, 0, 1, 64, 5, 2};
        case 6:  return Step{K_IN, 1, 1, 64, 5, 2};
        case 7:  return Step{K_OUT, 0, 0, 0, 64, 1};
        case 8:  return Step{K_UP, 0, 0, 0, 64, 1};
        case 9:  return Step{K_FIX, 0, 0, 0, 0, 1};
        case 10: return Step{K_DOWN, 0, 0, 0, 64, 1};
        case 11: return Step{K_IN, 1, 0, 0, 64, 1};
        case 12: return Step{K_MIX, 1, 0, 0, 0, 1};
        case 13: return Step{K_OUT, 1, 1, 64, 5, 2};
        case 14: return Step{K_UP, 1, 1, 64, 5, 2};
        case 15: return Step{K_DOWN, 1, 1, 64, 5, 2};
        case 16: return Step{K_OUT, 1, 0, 0, 64, 1};
        case 17: return Step{K_UP, 1, 0, 0, 64, 1};
        case 18: return Step{K_FIX, 1, 0, 0, 0, 1};
        case 19: return Step{K_DOWN, 1, 0, 0, 64, 1};
        default: return Step{K_FINAL, 0, 0, 0, 0, 1};
    }
}

__global__ void __launch_bounds__(NWAVES * 64, 2) fwd_kernel(Args args) {
    extern __shared__ __attribute__((aligned(16))) unsigned char lds_raw[];
    cg::grid_group grid = cg::this_grid();
    Frame F;
    F.lds = (LAS unsigned char*)lds_raw;
#define REFRESH() do { int t_ = threadIdx.x; asm volatile("" : "+v"(t_)); F.tid = t_; F.lane = t_ & 63; F.wave = __builtin_amdgcn_readfirstlane(t_ >> 6); F.gw = blockIdx.x * NWAVES + F.wave; } while (0)
    F.G = gridDim.x; F.NGW = F.G * NWAVES; REFRESH();
    F.in = args.in; F.out = args.out; F.ws = args.ws;
    volatile LAS unsigned* MISC = (volatile LAS unsigned*)(F.lds + LDSCTL_OFF);
    if (threadIdx.x < 16) MISC[threadIdx.x] = 0u;
    __syncthreads();
    const bool side_wg = blockIdx.x >= 64;
    (void)xcd_barrier_post((unsigned*)(args.ws + WS_CTL), MISC + 8, F.G);
    if (side_wg) (void)xcd_barrier_post((unsigned*)(args.ws + WS_CTL) + 4096, MISC + 10, F.G - 64);
#ifndef KMASK
#define KMASK 0x1ff
#endif
#define INK(kind) ((((KMASK) >> (kind)) & 1) != 0)
#ifndef PROBE_MULT
#define PROBE_MULT 1
#endif
#ifdef PROBE_BLOCK
    volatile LAS unsigned long long* STMP = (volatile LAS unsigned long long*)(F.lds + LDSCTL_OFF + 128);
    if (threadIdx.x < 64) STMP[threadIdx.x] = 0ull;
    __syncthreads();
#define STAMP(id) do { if (blockIdx.x == PROBE_BLOCK && threadIdx.x == 0) STMP[(id)] = __builtin_amdgcn_s_memrealtime(); } while (0)
#else
#define STAMP(id) do { } while (0)
#endif
#pragma unroll 1
    for (int pc = 0; pc < NSTEP; ++pc) {
        const Step st = get_step(pc);
        if (st.pre == 1) { if (args.ph_hi < 0) grid.sync();
            { XcdBarrier bar_; bar_.gsz = F.G; bar_.bar = (unsigned*)(args.ws + WS_CTL); bar_.x = xb_xcc_id(); bar_.st = (volatile LAS unsigned*)(F.lds + LDSCTL_OFF) + 8; xcd_barrier(bar_); } }
        if (st.side && !side_wg) continue;
        if (st.pre == 2) { XcdBarrier bar_; bar_.gsz = F.G - 64; bar_.bar = (unsigned*)(args.ws + WS_CTL) + 4096; bar_.x = xb_xcc_id(); bar_.st = (volatile LAS unsigned*)(F.lds + LDSCTL_OFF) + 10; xcd_barrier(bar_); }
        const int layer = st.layer;
        STAMP(2 * pc);
        const int Gs = st.side ? F.G - 64 : F.G, cs = st.side ? (int)blockIdx.x - 64 : (int)blockIdx.x;
        if (st.kind == K_P0) { if (INK(0)) { REFRESH(); p0_weights(F, 0, P0_DEFER ? P0_ITEMS_AB : -1, F.gw, F.NGW); STAMP(42); __syncthreads(); REFRESH(); p0_rows(F); STAMP(43); REFRESH(); p0_rotary(F, (float*)(args.ws + WS_ROT)); p0_zero_ssq(F); STAMP(44); } }
        else if (st.kind == K_IN) { if (INK(1)) {
            pg8::Gemm g{F_XG(F), (const bf16*)(args.ws + (layer == 0 ? WS_WAB : WS_WC)), MPAD, 4096, 1024}; pg8::StaticOrder S; S.init(st.nt, 4096, Gs, cs, st.tile0);
            pg8::EpiBf16 E{F_Z(F), F_ZS1(F, layer), 64, 4096, layer == 0 ? (const float*)nullptr : (const float*)F_SSQ(F, 1)};
            pg8::gemm_phase<pg8::EpiBf16, pg8::StaticOrder, false>(F.lds, g, S, E);
            if (P0_DEFER && layer == 0 && !st.side) { const int nfull = (st.nt * 16) % Gs; if (nfull != 0 && cs >= nfull) { REFRESH(); p0_weights(F, P0_ITEMS_AB, -1, (cs - nfull) * NWAVES + F.wave, (Gs - nfull) * NWAVES); } else if (nfull == 0) { REFRESH(); p0_weights(F, P0_ITEMS_AB, -1, F.gw, F.NGW); } } } }
        else if (st.kind == K_MIX) { if (INK(2)) { REFRESH(); if (layer == 0) mixer_layer0(F); else mixer_layer1(F); } }
        else if (st.kind == K_OUT) { if (INK(3)) {
            pg8::Gemm g{F_XN(F), (const bf16*)(args.ws + (layer == 0 ? WS_WOAB : WS_WOC)), MPAD, 1024, 1024}; pg8::StaticOrder S; S.init(st.nt, 1024, Gs, cs, st.tile0);
            pg8::EpiResid E{F_X0(F), F_X1(F), PM_META, DM, F_XG(F), F.in[20] + (size_t)layer * DM, F_SSQ(F, layer == 0 ? 0 : 2),
                layer == 0 ? F.in[0] : (const float*)nullptr, F.in[1] - (size_t)ROW_S * DM, F.in[8] - (size_t)ROW_M * DM, layer == 0 ? NREAL : MPAD};
            pg8::gemm_phase<pg8::EpiResid, pg8::StaticOrder, false>(F.lds, g, S, E); } }
        else if (st.kind == K_UP) { if (INK(5)) {
            pg8::Gemm g{F_XG(F), (const bf16*)(args.ws + WS_WF1) + (size_t)layer * NFF * 1024, MPAD, NFF, 1024}; pg8::StaticOrder S; S.init(st.nt, NFF, Gs, cs, st.tile0);
            EpiFfn E{F_Z(F), F_HS1(F), F.in[22] + (size_t)layer * 3 * DFF, F.in[23] + (size_t)layer * DFF, F.in[7] + (size_t)layer * 128 * 2 * DFF, F.out + O_FS + (size_t)layer * 128 * 2 * DFF, F_SBL(F), F_SBF(F), F_SSQ(F, layer == 0 ? 0 : 2)};
            pg8::gemm_phase<EpiFfn, pg8::StaticOrder, true>(F.lds, g, S, E); } }
        else if (st.kind == K_FIX) { if (INK(6)) { REFRESH(); ffn_fixup(F, layer); } }
        else if (st.kind == K_DOWN) { if (INK(7)) {
            pg8::Gemm g{st.side ? F_HS1(F) : F_Z(F), (const bf16*)(args.ws + WS_WF2) + (size_t)layer * 1024 * DFF, MPAD, 1024, DFF}; pg8::StaticOrder S; S.init(st.nt, 1024, Gs, cs, st.tile0);
            pg8::EpiResid E{F_X0(F), F_X1(F), PM_META, DM, layer == 0 ? F_XG(F) : (bf16*)nullptr, F.in[9] + DM, F_SSQ(F, 1), (const float*)nullptr, (const float*)nullptr, (const float*)nullptr, MPAD};
            pg8::gemm_phase<pg8::EpiResid, pg8::StaticOrder, false>(F.lds, g, S, E); } }
        else { if (INK(8)) { REFRESH(); rms_final(F, F.in[25]); } }
        STAMP(2 * pc + 1);
    }
#ifdef PROBE_BLOCK
    if (blockIdx.x == PROBE_BLOCK && threadIdx.x == 0) { const unsigned long long d = (STMP[PROBE_B] - STMP[PROBE_A]) * PROBE_MULT, t0 = __builtin_amdgcn_s_memrealtime(); while (__builtin_amdgcn_s_memrealtime() - t0 < d) __builtin_amdgcn_s_sleep(8); }
#endif
#undef INK
#undef REFRESH
}

extern "C" void kernel_launch(void* const* d_in, const int* in_sizes, int n_in, void* d_out, int out_size, void* d_ws, size_t ws_size, hipStream_t stream) {
    static int grid = 0;
    if (grid == 0) {
        if (n_in != 26 || (size_t)out_size != O_END || ws_size < WS_END) { fprintf(stderr, "kernel_launch: unexpected shapes: n_in %d out %d ws %zu\n", n_in, out_size, ws_size); grid = -1; return; }
        int dev = 0, cus = 0, per_cu = 0;
        if (hipGetDevice(&dev) != hipSuccess || hipDeviceGetAttribute(&cus, hipDeviceAttributeMultiprocessorCount, dev) != hipSuccess) { grid = -1; return; }
        if (hipFuncSetAttribute((const void*)fwd_kernel, hipFuncAttributeMaxDynamicSharedMemorySize, LDS_BYTES) != hipSuccess) { fprintf(stderr, "kernel_launch: hipFuncSetAttribute failed\n"); grid = -1; return; }
        if (hipOccupancyMaxActiveBlocksPerMultiprocessor(&per_cu, (const void*)fwd_kernel, NWAVES * 64, LDS_BYTES) != hipSuccess || per_cu < 1) { fprintf(stderr, "kernel_launch: occupancy query says %d\n", per_cu); per_cu = 1; }
        (void)hipGetLastError();
        grid = cus;
        if (grid < 128) { fprintf(stderr, "kernel_launch: this kernel's static work split needs >= 128 CUs (got %d)\n", grid); grid = -1; return; }
    }
    if (grid < 0) return;
    if (hipMemsetAsync((char*)d_ws + WS_CTL, 0, 32768, stream) != hipSuccess) { fprintf(stderr, "kernel_launch: hipMemsetAsync failed\n"); return; }
    Args a{};
    for (int i = 0; i < 26; ++i) a.in[i] = (const float*)d_in[i];
    a.out = (float*)d_out; a.ws = (unsigned char*)d_ws;
    a.ph_lo = 0; a.ph_hi = NSTEP;
    void* kargs[] = {&a};
    hipError_t e = hipLaunchCooperativeKernel((const void*)fwd_kernel, dim3(grid), dim3(NWAVES * 64), kargs, LDS_BYTES, stream);
    if (e != hipSuccess) fprintf(stderr, "kernel_launch: cooperative launch failed: %s (grid %d)\n", hipGetErrorString(e), grid);
}
```

```cpp
#include <hip/hip_runtime.h>
#include <hip/hip_cooperative_groups.h>
#include <cstdio>
#include <cstdint>
namespace cg = cooperative_groups;

namespace pg8 {
#define PG8_LAS __attribute__((address_space(3)))
typedef unsigned short bf16_t;
typedef short bf16x8 __attribute__((ext_vector_type(8)));
typedef float f32x4 __attribute__((ext_vector_type(4)));
typedef unsigned u32x4 __attribute__((ext_vector_type(4)));
typedef unsigned u32x2 __attribute__((ext_vector_type(2)));
constexpr int BM = 256, BK = 64, HALF = 128, HTB = HALF * BK * 2  , STAGE_BYTES = 8 * HTB, NXCD = 8, WGM = 8;

__host__ __device__ __forceinline__ int lds_byte(int r, int c) { const int st = (r >> 4) * 2 + (c >> 5), rr = r & 15, cc = c & 31, ob = rr * 64 + cc * 2; return st * 1024 + (ob ^ (((ob >> 9) & 1) << 5)); }
__host__ __device__ __forceinline__ void stage_rc(int b, int& R, int& C) { const int st = b / 1024, sb = b % 1024, swz = sb ^ (((sb >> 9) & 1) << 5); R = (st >> 1) * 16 + swz / 64; C = (st & 1) * 32 + (swz % 64) / 2; }
__host__ __device__ __forceinline__ int perm32(int rho) { const int n = rho >> 4, i = rho & 15; return 8 * (i >> 2) + 4 * n + (i & 3); }

struct Unit { int pm, pn; };
struct Gemm { const bf16_t* A; const bf16_t* Bt; int M, N, K; };

struct StaticOrder {
    int nM, nN, nwg, G, c, pm0;
    __host__ __device__ __forceinline__ void init(int nMt, int N, int G_, int c_, int pm0_) { nM = nMt; nN = N / BM; nwg = nM * nN; G = G_; c = c_; pm0 = pm0_; }
    __host__ __device__ __forceinline__ bool next(int i, Unit& u) const {
        const long L = (long)i * G + c; if (L >= nwg) return false;
        int wgid = (int)L; { const int q = nwg / NXCD, r = nwg % NXCD, xcd = wgid % NXCD, off = wgid / NXCD; wgid = (xcd < r ? xcd * (q + 1) : r * (q + 1) + (xcd - r) * q) + off; }
        const int nig = WGM * nN, gid = wgid / nig, fm = gid * WGM, gsz = (nM - fm) < WGM ? (nM - fm) : WGM;
        u.pm = pm0 + fm + ((wgid % nig) % gsz); u.pn = (wgid % nig) / gsz; return true;
    }
    __device__ __forceinline__ void a_ready(const Unit&) const {}
    __device__ __forceinline__ void done(const Unit&) const {}
};

__device__ __forceinline__ unsigned cvt_pk_bf16(float lo, float hi) { unsigned r; asm volatile("v_cvt_pk_bf16_f32 %0, %1, %2" : "=v"(r) : "v"(lo), "v"(hi)); return r; }

struct EpiBf16 {
    static constexpr bool PERM = true, AFTER_DRAIN = false;
    bf16_t* O0; bf16_t* O1; int pm_split; int ldc;
    __device__ __forceinline__ void operator()(f32x4 (&acc)[2][2][4][2], const Unit& u, int wr, int wc, int fr, int fq) const {
        bf16_t* O = (u.pm < pm_split) ? O0 : O1;
        const int row0 = u.pm * BM + wr * 64 + fr; const int col0 = u.pn * BM + wc * 32 + 8 * fq;
#pragma unroll
        for (int ai = 0; ai < 2; ++ai)
#pragma unroll
            for (int m = 0; m < 4; ++m) { bf16_t* rowp = O + (size_t)(row0 + ai * HALF + m * 16) * ldc + col0;
#pragma unroll
                for (int bj = 0; bj < 2; ++bj) { const f32x4 v0 = acc[ai][bj][m][0], v1 = acc[ai][bj][m][1];
                    u32x4 w; w.x = cvt_pk_bf16(v0[0], v0[1]); w.y = cvt_pk_bf16(v0[2], v0[3]); w.z = cvt_pk_bf16(v1[0], v1[1]); w.w = cvt_pk_bf16(v1[2], v1[3]);
                    *(u32x4*)(rowp + bj * HALF) = w; } }
    }
};

struct EpiResid {
    static constexpr bool PERM = true, AFTER_DRAIN = false;
    float* X0; float* X1; int pm_split; int ldc; bf16_t* XG; float* Y; int yrows; const float* gain; float* ssq; unsigned* cnt;
    const float* R0; const float* R1; const float* R2; int nreal;
    __device__ __forceinline__ void operator()(f32x4 (&acc)[2][2][4][2], const Unit& u, int wr, int wc, int fr, int fq) const {
        float* C = (u.pm < pm_split) ? X0 : X1;
        const float* Rsrc = R0 ? (u.pm < 64 ? R0 : u.pm < pm_split ? R1 : R2) : (const float*)C;
        const int row0 = u.pm * BM + wr * 64 + fr, col0 = u.pn * BM + wc * 32 + 8 * fq;
#pragma unroll
        for (int ai = 0; ai < 2; ++ai)
#pragma unroll
            for (int mp = 0; mp < 2; ++mp) {
                f32x4 t[2][2][2];
#pragma unroll
                for (int mm = 0; mm < 2; ++mm) { const int rr_ = row0 + ai * HALF + (2 * mp + mm) * 16; const float* rowp = Rsrc + (size_t)rr_ * ldc + col0; const bool have = rr_ < nreal;
#pragma unroll
                    for (int bj = 0; bj < 2; ++bj)
#pragma unroll
                        for (int n = 0; n < 2; ++n) t[mm][bj][n] = have ? *(const f32x4*)(rowp + bj * HALF + 4 * n) : (f32x4){0.f, 0.f, 0.f, 0.f}; }
#pragma unroll
                for (int mm = 0; mm < 2; ++mm) { const int m = 2 * mp + mm; const int row = row0 + ai * HALF + m * 16; float* rowp = C + (size_t)row * ldc + col0; float sq = 0.f;
#pragma unroll
                    for (int bj = 0; bj < 2; ++bj)
#pragma unroll
                        for (int n = 0; n < 2; ++n) { const f32x4 v = t[mm][bj][n] + acc[ai][bj][m][n]; acc[ai][bj][m][n] = v; if (!Y) *(f32x4*)(rowp + bj * HALF + 4 * n) = v;
                            sq += (v[0] * v[0] + v[1] * v[1]) + (v[2] * v[2] + v[3] * v[3]); }
                    sq += __shfl_xor(sq, 16); sq += __shfl_xor(sq, 32); if (fq == 0) atomicAdd(ssq + row, sq); }
                asm volatile("" ::: "memory"); }
        asm volatile("s_waitcnt vmcnt(0)" ::: "memory");
        unsigned* pc = cnt + u.pm * 16;
        if (fr == 0 && fq == 0) {
            __hip_atomic_fetch_add(pc, 1u, __ATOMIC_RELAXED, __HIP_MEMORY_SCOPE_AGENT);
            unsigned sp = 0u;
            while (__hip_atomic_load(pc, __ATOMIC_RELAXED, __HIP_MEMORY_SCOPE_AGENT) < 32u) { __builtin_amdgcn_s_sleep(1); if (++sp > (1u << 22)) break; }
        }
        asm volatile("" ::: "memory");
        f32x4 gv[2][2];
#pragma unroll
        for (int bj = 0; bj < 2; ++bj)
#pragma unroll
            for (int n = 0; n < 2; ++n) gv[bj][n] = *(const f32x4*)(gain + col0 + bj * HALF + 4 * n);
#pragma unroll
        for (int ai = 0; ai < 2; ++ai)
#pragma unroll
            for (int m = 0; m < 4; ++m) { const int row = row0 + ai * HALF + m * 16;
                const float rs = __builtin_amdgcn_rsqf(__hip_atomic_load(ssq + row, __ATOMIC_RELAXED, __HIP_MEMORY_SCOPE_AGENT) * (1.0f / 1024.0f) + 1e-6f);
#pragma unroll
                for (int bj = 0; bj < 2; ++bj) { const f32x4 y0 = acc[ai][bj][m][0] * rs * gv[bj][0], y1 = acc[ai][bj][m][1] * rs * gv[bj][1];
                    if (Y) { if (row < yrows) { *(f32x4*)(Y + (size_t)row * ldc + col0 + bj * HALF) = y0; *(f32x4*)(Y + (size_t)row * ldc + col0 + bj * HALF + 4) = y1; } }
                    else { u32x4 w; w.x = cvt_pk_bf16(y0[0], y0[1]); w.y = cvt_pk_bf16(y0[2], y0[3]); w.z = cvt_pk_bf16(y1[0], y1[1]); w.w = cvt_pk_bf16(y1[2], y1[3]);
                        *(u32x4*)(XG + (size_t)row * ldc + col0 + bj * HALF) = w; } } }
    }
};

template <class Epi, class Sched, bool APERM>
__device__ __forceinline__ void gemm_phase(PG8_LAS unsigned char* lds, const Gemm g, const Sched& S, const Epi& E) {
    int tid_ = threadIdx.x; asm volatile("" : "+v"(tid_));
    const int tid = tid_, wid = __builtin_amdgcn_readfirstlane(tid >> 6), lane = tid & 63, wr = wid >> 2, wc = wid & 3, fr = lane & 15, fq = lane >> 4;
    const int K = g.K, nt = K / BK;
    unsigned voffA[2], voffB[2];
#pragma unroll
    for (int i = 0; i < 2; ++i) { int R, C; stage_rc(tid * 16 + i * 8192, R, C); const int Rb = Epi::PERM ? ((R & ~31) + perm32(R & 31)) : R;
        const int Ra = APERM ? (128 * (R >> 6) + 8 * (R & 15) + ((R >> 4) & 3)) : R;
        voffA[i] = (unsigned)(Ra * K + C) * 2u; voffB[i] = (unsigned)(Rb * K + C) * 2u; }
    const size_t kstep = (size_t)(BK * 2);
    const size_t hstep = (size_t)HALF * K * 2;
    const size_t hstepA = APERM ? (size_t)4 * K * 2 : hstep;
    const size_t tstep = 2 * hstep;
    const unsigned ldsw = (unsigned)wid * 1024u;
    const int aoff = lds_byte(wr * 64 + fr, fq * 8), boff = lds_byte(wc * 32 + fr, fq * 8);
#define PG8_SA(b, h) (((b) * 2 + (h)) * HTB)
#define PG8_SB(b, h) ((4 + (b) * 2 + (h)) * HTB)
#define PG8_STAGE(bufoff, gbase, voff) do { _Pragma("unroll") for (int _i = 0; _i < 2; ++_i) \
        __builtin_amdgcn_global_load_lds((const unsigned*)((const char*)(gbase) + (voff)[_i]), (PG8_LAS unsigned*)(lds + (bufoff) + ldsw + _i * 8192), 16, 0, 0); } while (0)
#define PG8_LDA(dst, b, h) do { _Pragma("unroll") for (int m = 0; m < 4; ++m) _Pragma("unroll") for (int k = 0; k < 2; ++k) dst[m][k] = *(const PG8_LAS bf16x8*)(lds + PG8_SA(b, h) + aoff + m * 2048 + k * 1024); } while (0)
#define PG8_LDB(dst, b, h) do { _Pragma("unroll") for (int n = 0; n < 2; ++n) _Pragma("unroll") for (int k = 0; k < 2; ++k) dst[n][k] = *(const PG8_LAS bf16x8*)(lds + PG8_SB(b, h) + boff + n * 2048 + k * 1024); } while (0)
#define PG8_MMA(ai, bj, At, Bt) do { __builtin_amdgcn_s_setprio(1); _Pragma("unroll") for (int m = 0; m < 4; ++m) _Pragma("unroll") for (int n = 0; n < 2; ++n) _Pragma("unroll") for (int k = 0; k < 2; ++k) \
        acc[ai][bj][m][n] = __builtin_amdgcn_mfma_f32_16x16x32_bf16(Bt[n][k], At[m][k], acc[ai][bj][m][n], 0, 0, 0); __builtin_amdgcn_s_setprio(0); } while (0)
#define PG8_WAIT_V(n) asm volatile("s_waitcnt vmcnt(" #n ")" ::: "memory")
#define PG8_WAIT_L(n) asm volatile("s_waitcnt lgkmcnt(" #n ")" ::: "memory")
#define PG8_BAR __builtin_amdgcn_s_barrier()
#define PG8_SCHED __builtin_amdgcn_sched_barrier(0)
    Unit cur, nxt; int ui = 0;
    if (!S.next(0, cur)) return;
    f32x4 acc[2][2][4][2];
#pragma unroll
    for (int a = 0; a < 2; ++a)
#pragma unroll
        for (int b = 0; b < 2; ++b)
#pragma unroll
            for (int m = 0; m < 4; ++m)
#pragma unroll
                for (int n = 0; n < 2; ++n) acc[a][b][m][n] = (f32x4){0.f, 0.f, 0.f, 0.f};
    bf16x8 At[4][2], B0[2][2], B1[2][2];
    const char* cA = (const char*)g.A + (size_t)cur.pm * tstep; const char* cB = (const char*)g.Bt + (size_t)cur.pn * tstep;
    S.a_ready(cur);
    PG8_STAGE(PG8_SB(0, 0), cB, voffB); PG8_STAGE(PG8_SB(0, 1), cB + hstep, voffB); PG8_STAGE(PG8_SA(0, 0), cA, voffA); PG8_STAGE(PG8_SA(0, 1), cA + hstepA, voffA);
    if (wr == 1) PG8_BAR;
    PG8_WAIT_V(2); PG8_BAR;
    PG8_STAGE(PG8_SB(1, 0), cB + kstep, voffB); PG8_STAGE(PG8_SA(1, 0), cA + kstep, voffA); PG8_STAGE(PG8_SB(1, 1), cB + hstep + kstep, voffB);
    PG8_WAIT_V(6); PG8_BAR;
    for (;;) {
        const bool has_next = S.next(ui + 1, nxt);
        const char* nA = has_next ? (const char*)g.A + (size_t)nxt.pm * tstep : cA; const char* nB = has_next ? (const char*)g.Bt + (size_t)nxt.pn * tstep : cB;
        for (int t = 0; t < nt; t += 2) {
            const bool last = (t == nt - 2);
            const char* a1 = cA + (size_t)(t + 1) * kstep;
            const char* a2 = last ? nA : cA + (size_t)(t + 2) * kstep; const char* b2 = last ? nB : cB + (size_t)(t + 2) * kstep;
            const char* a3 = a2 + kstep; const char* b3 = b2 + kstep;
            if (last && has_next) S.a_ready(nxt);
            PG8_LDB(B0, 0, 0); PG8_LDB(B1, 0, 1); PG8_SCHED; PG8_LDA(At, 0, 0); PG8_STAGE(PG8_SA(1, 1), a1 + hstepA, voffA);
            PG8_WAIT_V(8); PG8_WAIT_L(0); PG8_BAR; PG8_MMA(0, 0, At, B0); PG8_MMA(0, 1, At, B1); PG8_BAR; PG8_SCHED;
            PG8_LDA(At, 0, 1); PG8_STAGE(PG8_SB(0, 0), b2, voffB); PG8_STAGE(PG8_SB(0, 1), b2 + hstep, voffB); PG8_STAGE(PG8_SA(0, 0), a2, voffA);
            PG8_WAIT_V(8); PG8_WAIT_L(0); PG8_BAR; PG8_MMA(1, 0, At, B0); PG8_MMA(1, 1, At, B1); PG8_BAR; PG8_SCHED;
            PG8_LDB(B0, 1, 0); PG8_LDB(B1, 1, 1); PG8_SCHED; PG8_LDA(At, 1, 0); PG8_STAGE(PG8_SA(0, 1), a2 + hstepA, voffA);
            PG8_WAIT_V(8); PG8_WAIT_L(0); PG8_BAR; PG8_MMA(0, 0, At, B0); PG8_MMA(0, 1, At, B1); PG8_BAR; PG8_SCHED;
            PG8_LDA(At, 1, 1); PG8_STAGE(PG8_SB(1, 0), b3, voffB); PG8_STAGE(PG8_SB(1, 1), b3 + hstep, voffB); PG8_STAGE(PG8_SA(1, 0), a3, voffA);
            PG8_WAIT_V(8); PG8_WAIT_L(0); PG8_BAR; PG8_MMA(1, 0, At, B0); PG8_MMA(1, 1, At, B1); PG8_BAR; PG8_SCHED;
        }
        if (wr == 0) PG8_BAR;
        E(acc, cur, wr, wc, fr, fq); S.done(cur);
        if (!has_next) break;
#pragma unroll
        for (int a = 0; a < 2; ++a)
#pragma unroll
            for (int b = 0; b < 2; ++b)
#pragma unroll
                for (int m = 0; m < 4; ++m)
#pragma unroll
                    for (int n = 0; n < 2; ++n) acc[a][b][m][n] = (f32x4){0.f, 0.f, 0.f, 0.f};
        cur = nxt; cA = nA; cB = nB; ++ui;
        if (wr == 1) PG8_BAR;
    }
    PG8_WAIT_V(0);
    PG8_BAR;
#undef PG8_SA
#undef PG8_SB
#undef PG8_STAGE
#undef PG8_LDA
#undef PG8_LDB
#undef PG8_MMA
#undef PG8_WAIT_V
#undef PG8_WAIT_L
#undef PG8_BAR
#undef PG8_SCHED
}
}
constexpr int DM = 1024;
constexpr int ROW_S = 16384;
constexpr int ROW_M = 17408;
constexpr int NREAL = 17424;
constexpr int MPAD = 17664;
constexpr int PM_META = 68;
constexpr int NAB = 4096, NCC = 4096, DFF = 2816, NFF = 5632, ABW = 4104;
constexpr int NGRP = 138, GRP_META = 136;
constexpr float EPS = 1e-6f;
constexpr float KSCALE = 0.08838834764831845f;

constexpr size_t O_YP = 0, O_YS = 16777216, O_CP = 17825792, O_CS = 18350080, O_NP = 26738688, O_NS = 26742784, O_MP = 26808320, O_MS = 26808352,
                 O_RP = 26808864, O_RS = 27333152, O_HP = 35721760, O_HS = 36770336, O_FP = 53547552, O_FS = 53637664, O_END = 55079456;

constexpr size_t MiB = 1u << 20;
constexpr size_t WS_CTL = 0, CTL_ZERO_BYTES = 128 * 1024;
constexpr size_t WS_PCNT = 64 * 1024;
constexpr size_t WS_WAB = 1 * MiB, WS_WOAB = 9 * MiB, WS_WC = 11 * MiB, WS_WOC = 19 * MiB, WS_WF1 = 21 * MiB  , WS_WF2 = 43 * MiB  ;
constexpr size_t WS_XN = 54 * MiB;
constexpr size_t WS_Z = 89 * MiB;
constexpr size_t WS_GD = 217 * MiB;
constexpr size_t WS_GDS = 222 * MiB;
constexpr size_t WS_LB = 223 * MiB;
constexpr size_t WS_XM = 227 * MiB;
constexpr size_t WS_G = 228 * MiB;
constexpr size_t WS_SBL = 229 * MiB;
constexpr size_t WS_SBF = 233 * MiB;
constexpr size_t WS_ROT = 240 * MiB;
constexpr size_t WS_XG = 242 * MiB;
constexpr size_t WS_SSQ = 277 * MiB;
constexpr size_t WS_ZS = 279 * MiB;
constexpr size_t WS_ZS2 = 290 * MiB;
constexpr size_t WS_HS = 301 * MiB;
constexpr size_t WS_END = 309 * MiB;
static_assert(WS_XN + (size_t)MPAD * DM * 2 <= WS_Z && WS_Z + (size_t)MPAD * 4096 * 2 <= WS_XM && WS_SBL + (size_t)NGRP * 2 * DFF * 4 <= WS_SBF && WS_SBF + (size_t)NGRP * 4 * DFF * 4 <= WS_END, "ws map");

constexpr int P0_ITEMS_AB = 16 * 128;
constexpr int LDS_BYTES = 147456;
constexpr int NWAVES = 8;

#define GAS __attribute__((address_space(1)))
#define LAS __attribute__((address_space(3)))
typedef unsigned short bf16;
typedef float f32x4 __attribute__((ext_vector_type(4)));
typedef unsigned u32x2 __attribute__((ext_vector_type(2)));
typedef unsigned u32x4 __attribute__((ext_vector_type(4)));
#define LDS_WAIT() asm volatile("s_waitcnt lgkmcnt(0)" ::: "memory")

__device__ __forceinline__ unsigned f2bf(float f) { unsigned u = __builtin_bit_cast(unsigned, f); return (u + 0x7fffu + ((u >> 16) & 1u)) >> 16; }
__device__ __forceinline__ unsigned pk2(float lo, float hi) { return f2bf(lo) | (f2bf(hi) << 16); }
__device__ __forceinline__ float bf2f(unsigned short b) { return __builtin_bit_cast(float, ((unsigned)b) << 16); }
__device__ __forceinline__ float bflo(unsigned w) { return __builtin_bit_cast(float, w << 16); }
__device__ __forceinline__ float bfhi(unsigned w) { return __builtin_bit_cast(float, w & 0xffff0000u); }
__device__ __forceinline__ f32x4 ld_bf4(const bf16* p) { const u32x2 w = *(const u32x2*)p; return (f32x4){bflo(w.x), bfhi(w.x), bflo(w.y), bfhi(w.y)}; }
__device__ __forceinline__ float wave_sum(float v) {
#pragma unroll
    for (int o = 1; o < 64; o <<= 1) v += __shfl_xor(v, o);
    return v;
}
__device__ __forceinline__ float half_sum(float v) {
#pragma unroll
    for (int o = 1; o < 32; o <<= 1) v += __shfl_xor(v, o);
    return v;
}
__device__ __forceinline__ float sigmoidf_(float x) { return 1.f / (1.f + __expf(-x)); }
__device__ __forceinline__ float siluf_(float x) { return x / (1.f + __expf(-x)); }
__device__ __forceinline__ float logsigmoidf_(float x) { return fminf(x, 0.f) - __logf(1.f + __expf(-fabsf(x))); }

struct Args { const float* in[26]; float* out; unsigned char* ws; int ph_lo, ph_hi; };

struct Frame {
    LAS unsigned char* lds;
    int tid, lane, wave, G, gw, NGW;
    const float* const* in; float* out; unsigned char* ws;
};
#define F_X0(F) ((F).out)
#define F_X1(F) ((float*)((F).ws + WS_XM) - (size_t)ROW_M * DM)
#define F_XN(F) ((bf16*)((F).ws + WS_XN))
#define F_XG(F) ((bf16*)((F).ws + WS_XG))
#define F_SSQ(F, i) ((float*)((F).ws + WS_SSQ) + (size_t)(i) * MPAD)
#define F_Z(F) ((bf16*)((F).ws + WS_Z))
#define F_ZS1(F, layer) ((bf16*)((F).ws + ((layer) == 0 ? WS_ZS : WS_ZS2)) - (size_t)ROW_S * 4096)
#define F_HS1(F) ((bf16*)((F).ws + WS_HS) - (size_t)ROW_S * DFF)
#define ZROW(F, row, layer) (((row) < ROW_S ? F_Z(F) : F_ZS1(F, layer)) + (size_t)(row) * 4096)
#define F_GT(F) ((float*)((F).ws + WS_G))
#define F_SBL(F) ((float*)((F).ws + WS_SBL))
#define F_SBF(F) ((float*)((F).ws + WS_SBF))
__device__ __forceinline__ float* xrow(const Frame& F, int r) { return (r < ROW_M ? F_X0(F) : F_X1(F)) + (size_t)r * DM; }

__device__ __forceinline__ void p0_transpose_item(const float* W, int K, int Nsrc, int n0src, bf16* WT, int dstrow0, LAS float* scr, int kb, int lane) {
    const int k0 = 64 * kb;
    f32x4 v[8];
#pragma unroll
    for (int i = 0; i < 8; ++i) v[i] = *(const f32x4*)(W + (size_t)(k0 + 8 * i + (lane >> 3)) * Nsrc + n0src + 4 * (lane & 7));
#pragma unroll
    for (int i = 0; i < 8; ++i) { LAS float* d = scr + (8 * i + (lane >> 3)) * 33 + 4 * (lane & 7); d[0] = v[i][0]; d[1] = v[i][1]; d[2] = v[i][2]; d[3] = v[i][3]; }
    LDS_WAIT(); asm volatile("" ::: "memory");
    const int c = lane & 7;
#pragma unroll
    for (int j = 0; j < 4; ++j) { const int n = (lane >> 3) + 8 * j; const LAS float* s = scr + (8 * c) * 33 + n;
        u32x4 o; o.x = pk2(s[0 * 33], s[1 * 33]); o.y = pk2(s[2 * 33], s[3 * 33]); o.z = pk2(s[4 * 33], s[5 * 33]); o.w = pk2(s[6 * 33], s[7 * 33]);
        *(u32x4*)(WT + (size_t)(dstrow0 + n) * K + k0 + 8 * c) = o; }
    LDS_WAIT(); asm volatile("" ::: "memory");
}

__device__ __forceinline__ void p0_weights(Frame& F, int it0, int it1, int gw, int ngw) {
    LAS float* scr = (LAS float*)(F.lds + F.wave * 16384);
    constexpr int I_AB = 16 * 128, I_O = 16 * 32, I_C = 16 * 128, I_F1 = 16 * 176, I_F2 = 44 * 32;
    constexpr int NIT = I_AB + I_O + I_C + I_O + 2 * I_F1 + 2 * I_F2;
    if (it1 < 0) it1 = NIT;
    for (int it = it0 + gw; it < it1; it += ngw) {
        int r = it;
        if (r < I_AB) { const int kb = r / 128, nb = r % 128; p0_transpose_item(F.in[10], 1024, ABW, nb < 64 ? 32 * nb : 32 * nb + 8, (bf16*)(F.ws + WS_WAB), 32 * nb, scr, kb, F.lane); continue; } r -= I_AB;
        if (r < I_O) { const int kb = r / 32, nb = r % 32; p0_transpose_item(F.in[15], 1024, 1024, 32 * nb, (bf16*)(F.ws + WS_WOAB), 32 * nb, scr, kb, F.lane); continue; } r -= I_O;
        if (r < I_C) { const int kb = r / 128, nb = r % 128; const int c = 32 * nb;
            const int dst = c < 1024 ? 256 * (c / 128) + (c % 128) : c < 2048 ? 256 * ((c - 1024) / 128) + 128 + (c % 128) : c;
            p0_transpose_item(F.in[17], 1024, 4096, c, (bf16*)(F.ws + WS_WC), dst, scr, kb, F.lane); continue; } r -= I_C;
        if (r < I_O) { const int kb = r / 32, nb = r % 32; p0_transpose_item(F.in[19], 1024, 1024, 32 * nb, (bf16*)(F.ws + WS_WOC), 32 * nb, scr, kb, F.lane); continue; } r -= I_O;
        if (r < 2 * I_F1) { const int l = r / I_F1; r -= l * I_F1; const int kb = r / 176, nb = r % 176; const int c = 32 * nb;
            const int ch = c < DFF ? c : c - DFF; const int dst = 256 * (ch / 128) + (c < DFF ? 0 : 128) + (ch % 128);
            p0_transpose_item(F.in[21] + (size_t)l * 1024 * NFF, 1024, NFF, c, (bf16*)(F.ws + WS_WF1) + (size_t)l * NFF * 1024, dst, scr, kb, F.lane); continue; } r -= 2 * I_F1;
        { const int l = r / I_F2; r -= l * I_F2; const int kb = r / 32, nb = r % 32;
            p0_transpose_item(F.in[24] + (size_t)l * DFF * 1024, DFF, 1024, 32 * nb, (bf16*)(F.ws + WS_WF2) + (size_t)l * 1024 * DFF, 32 * nb, scr, kb, F.lane); }
    }
}

__device__ __forceinline__ void p0_rows(Frame& F) {
    LAS float* wg = (LAS float*)F.lds;
    for (int i = F.tid; i < 8192; i += NWAVES * 64) { const int k = i >> 3, c = i & 7; wg[c * 1024 + k] = F.in[10][(size_t)k * ABW + 2048 + c]; }
    __syncthreads();
    const float* gain = F.in[9];
    f32x4 gn[4];
#pragma unroll
    for (int j = 0; j < 4; ++j) gn[j] = *(const f32x4*)(gain + 4 * F.lane + 256 * j);
#define P0_ROWSRC(r) ((r) < ROW_S ? F.in[0] + (size_t)(r) * DM : (r) < ROW_M ? F.in[1] + (size_t)((r) - ROW_S) * DM : (r) < NREAL ? F.in[8] + (size_t)((r) - ROW_M) * DM : (const float*)nullptr)
    f32x4 v[4], vn[4];
    { const float* src = F.gw < MPAD ? P0_ROWSRC(F.gw) : nullptr;
#pragma unroll
      for (int j = 0; j < 4; ++j) vn[j] = src ? *(const f32x4*)(src + 4 * F.lane + 256 * j) : (f32x4){0.f, 0.f, 0.f, 0.f}; }
#pragma unroll 1
    for (int r = F.gw; r < MPAD; r += F.NGW) {
#pragma unroll
        for (int j = 0; j < 4; ++j) v[j] = vn[j];
        { const int rn = r + F.NGW; const float* src = rn < MPAD ? P0_ROWSRC(rn) : nullptr;
#pragma unroll
          for (int j = 0; j < 4; ++j) vn[j] = src ? *(const f32x4*)(src + 4 * F.lane + 256 * j) : (f32x4){0.f, 0.f, 0.f, 0.f}; }
        float ss = 0.f;
#pragma unroll
        for (int j = 0; j < 4; ++j) ss += (v[j].x * v[j].x + v[j].y * v[j].y) + (v[j].z * v[j].z + v[j].w * v[j].w);
        const float rs = rsqrtf(wave_sum(ss) * (1.f / DM) + EPS);
        bf16* xn = F_XG(F) + (size_t)r * DM;
        float ga[8];
#pragma unroll
        for (int c = 0; c < 8; ++c) ga[c] = 0.f;
#pragma unroll
        for (int j = 0; j < 4; ++j) {
            const f32x4 y = v[j] * rs * gn[j];
            u32x2 w; w.x = pk2(y.x, y.y); w.y = pk2(y.z, y.w);
            *(u32x2*)(xn + 4 * F.lane + 256 * j) = w;
#pragma unroll
            for (int c = 0; c < 8; ++c) { const f32x4 wv = *(const LAS f32x4*)(wg + c * 1024 + 4 * F.lane + 256 * j); ga[c] += (y.x * wv.x + y.y * wv.y) + (y.z * wv.z + y.w * wv.w); }
        }
        float g4[4], g2[2], g1;
        { const bool hi = (F.lane & 32) != 0;
#pragma unroll
          for (int c = 0; c < 4; ++c) { const float keep = hi ? ga[4 + c] : ga[c], send = hi ? ga[c] : ga[4 + c]; g4[c] = keep + __shfl_xor(send, 32); } }
        { const bool hi = (F.lane & 16) != 0;
#pragma unroll
          for (int c = 0; c < 2; ++c) { const float keep = hi ? g4[2 + c] : g4[c], send = hi ? g4[c] : g4[2 + c]; g2[c] = keep + __shfl_xor(send, 16); } }
        { const bool hi = (F.lane & 8) != 0; const float keep = hi ? g2[1] : g2[0], send = hi ? g2[0] : g2[1]; g1 = keep + __shfl_xor(send, 8); }
        g1 += __shfl_xor(g1, 4); g1 += __shfl_xor(g1, 2); g1 += __shfl_xor(g1, 1);
        if ((F.lane & 7) == 0) F_GT(F)[(size_t)r * 8 + ((F.lane >> 5) & 1) * 4 + ((F.lane >> 4) & 1) * 2 + ((F.lane >> 3) & 1)] = g1;
    }
#undef P0_ROWSRC
}

__device__ __forceinline__ void p0_zero_ssq(Frame& F) { const int gt = blockIdx.x * (NWAVES * 64) + F.tid, NT = F.G * NWAVES * 64; for (int i = gt; i < 4 * MPAD; i += NT) F_SSQ(F, 0)[i] = 0.f;
    if (gt < 1024) ((float*)(F.ws + WS_LB))[gt] = sigmoidf_(F.in[16][1024 + gt] - F.in[16][gt]); }
__device__ __forceinline__ float dpp_row_shr1(float x) { return __builtin_bit_cast(float, __builtin_amdgcn_update_dpp(__builtin_bit_cast(int, x), __builtin_bit_cast(int, x), 0x111, 0xf, 0xf, false)); }
struct EpiFfn {
    static constexpr bool PERM = true, AFTER_DRAIN = false;
    bf16* H0; bf16* H1; const float* cw; const float* cb; const float* cst; float* cso; float* sbl; float* sbf;
    __device__ __forceinline__ void operator()(f32x4 (&acc)[2][2][4][2], const pg8::Unit& u, int wr, int wc, int fr, int fq) const {
        bf16* H = (u.pm < 64) ? H0 : H1;
        const int ch0 = 128 * u.pn + 32 * wc + 8 * fq;
        const int tok0 = 256 * u.pm + 128 * wr + 8 * fr;
        const int grp = 2 * u.pm + wr;
        const bool samp = (u.pm >= 64 && u.pm < PM_META), meta = (u.pm == PM_META);
        const int sb = 32 * (u.pm - 64) + 16 * wr + fr;
        const bool defer = (!samp && !meta && fr == 0);
        const bool lastlane = meta ? (wr == 0 && fr == 1) : (!samp && fr == 15);
        f32x4 w0[2], w1[2], w2[2], bb[2], p6[2], p7[2];
#pragma unroll
        for (int n = 0; n < 2; ++n) {
            const int c4 = ch0 + 4 * n;
            w0[n] = *(const f32x4*)(cw + c4); w1[n] = *(const f32x4*)(cw + DFF + c4); w2[n] = *(const f32x4*)(cw + 2 * DFF + c4); bb[n] = *(const f32x4*)(cb + c4);
#pragma unroll
            for (int e = 0; e < 4; ++e) { p6[n][e] = dpp_row_shr1(acc[1][0][2][n][e]); p7[n][e] = dpp_row_shr1(acc[1][0][3][n][e]); }
            if (samp) { p6[n] = *(const f32x4*)(cst + (size_t)(sb * 2 + 0) * DFF + c4); p7[n] = *(const f32x4*)(cst + (size_t)(sb * 2 + 1) * DFF + c4); }
            if (meta && wr == 0 && fr == 0) { p6[n] = (f32x4){0.f, 0.f, 0.f, 0.f}; p7[n] = p6[n]; }
            if (lastlane) { *(f32x4*)(sbl + (size_t)(grp * 2 + 0) * DFF + c4) = acc[1][0][2][n]; *(f32x4*)(sbl + (size_t)(grp * 2 + 1) * DFF + c4) = acc[1][0][3][n]; }
            if (samp) { *(f32x4*)(cso + (size_t)(sb * 2 + 0) * DFF + c4) = acc[1][0][2][n]; *(f32x4*)(cso + (size_t)(sb * 2 + 1) * DFF + c4) = acc[1][0][3][n]; }
        }
#pragma unroll
        for (int k = 0; k < 8; ++k) {
            unsigned hw[4];
#pragma unroll
            for (int n = 0; n < 2; ++n) {
                const f32x4 uk = acc[k >> 2][0][k & 3][n], gk = acc[k >> 2][1][k & 3][n];
                const f32x4 um1 = (k >= 1) ? acc[(k - 1 < 0 ? 0 : k - 1) >> 2][0][(k - 1 < 0 ? 0 : k - 1) & 3][n] : p7[n];
                const f32x4 um2 = (k >= 2) ? acc[(k - 2 < 0 ? 0 : k - 2) >> 2][0][(k - 2 < 0 ? 0 : k - 2) & 3][n] : (k == 1 ? p7[n] : p6[n]);
                const f32x4 cv = bb[n] + w0[n] * um2 + w1[n] * um1 + w2[n] * uk;
                f32x4 hv;
#pragma unroll
                for (int e = 0; e < 4; ++e) hv[e] = siluf_(cv[e]) * gk[e];
                hw[2 * n] = pg8::cvt_pk_bf16(hv[0], hv[1]); hw[2 * n + 1] = pg8::cvt_pk_bf16(hv[2], hv[3]);
                if (defer && k < 2) {
                    *(f32x4*)(sbf + (size_t)((grp * 2 + k) * 2 + 0) * DFF + ch0 + 4 * n) = uk;
                    *(f32x4*)(sbf + (size_t)((grp * 2 + k) * 2 + 1) * DFF + ch0 + 4 * n) = gk;
                }
            }
            if (!(defer && k < 2)) *(u32x4*)(H + (size_t)(tok0 + k) * DFF + ch0) = (u32x4){hw[0], hw[1], hw[2], hw[3]};
        }
    }
};

__device__ __forceinline__ void ffn_fixup_tile(Frame& F, int layer, int pm, bool conv_out) {
    const float* cw = F.in[22] + (size_t)layer * 3 * DFF; const float* cb = F.in[23] + (size_t)layer * DFF;
    bf16* H = F_Z(F);
    for (int i = F.tid; i < 2 * DFF; i += NWAVES * 64) {
        const int wr = i / DFF, ch = i - wr * DFF, grp = 2 * pm + wr;
        const int r0 = 128 * grp;
        const int pg = (r0 % 2048 == 0) ? GRP_META : grp - 1;
        const float um2 = F_SBL(F)[(size_t)(pg * 2 + 0) * DFF + ch], um1 = F_SBL(F)[(size_t)(pg * 2 + 1) * DFF + ch];
        const float u0 = F_SBF(F)[(size_t)((grp * 2 + 0) * 2 + 0) * DFF + ch], g0 = F_SBF(F)[(size_t)((grp * 2 + 0) * 2 + 1) * DFF + ch];
        const float u1 = F_SBF(F)[(size_t)((grp * 2 + 1) * 2 + 0) * DFF + ch], g1 = F_SBF(F)[(size_t)((grp * 2 + 1) * 2 + 1) * DFF + ch];
        const float w0 = cw[ch], w1 = cw[DFF + ch], w2 = cw[2 * DFF + ch], bb = cb[ch];
        const float c0 = bb + w0 * um2 + w1 * um1 + w2 * u0, c1 = bb + w0 * um1 + w1 * u0 + w2 * u1;
        H[(size_t)r0 * DFF + ch] = (bf16)f2bf(siluf_(c0) * g0);
        H[(size_t)(r0 + 1) * DFF + ch] = (bf16)f2bf(siluf_(c1) * g1);
        if (conv_out && (pm & 7) == 7 && wr == 1) {
            float* fo = F.out + O_FP + ((size_t)layer * 8 + (pm >> 3)) * 2 * DFF;
            fo[ch] = F_SBL(F)[(size_t)(grp * 2 + 0) * DFF + ch]; fo[DFF + ch] = F_SBL(F)[(size_t)(grp * 2 + 1) * DFF + ch];
        }
    }
}
typedef short bf16x8 __attribute__((ext_vector_type(8)));
typedef short v4i16_t __attribute__((ext_vector_type(4)));
constexpr int MX_PITCH = 272;
constexpr int MX_Q = 0, MX_K = 17408, MX_KH = 34816, MX_V = 52224, MX_GD = 69632  , MX_SC = 71680  , MX_OB = 74752  , MX_RP = 108544  , MX_DI = 110592  , MX_GN = 110848  , MX_LB = 111360  , MX_END = 111872;
constexpr int MX_OP = 132;
constexpr float LNKS = -2.4260151319598084f;
static_assert(MX_END <= 139264, "mixer LDS map");

__device__ __forceinline__ bf16x8 mk8(unsigned a, unsigned b, unsigned c, unsigned d) { const u32x4 v = {a, b, c, d}; return __builtin_bit_cast(bf16x8, v); }
__device__ __forceinline__ u32x2 tr16(const LAS unsigned char* p) { return __builtin_bit_cast(u32x2, __builtin_amdgcn_ds_read_tr16_b64_v4i16((LAS v4i16_t*)p)); }
typedef float f32x2_t __attribute__((ext_vector_type(2))); typedef __bf16 bf16x2_t __attribute__((ext_vector_type(2)));
__device__ __forceinline__ unsigned pkbf(float lo, float hi) { const f32x2_t v = {lo, hi}; const bf16x2_t b = __builtin_convertvector(v, bf16x2_t); return __builtin_bit_cast(unsigned, b); }
#define MFMA16(a, b, c) __builtin_amdgcn_mfma_f32_16x16x32_bf16((a), (b), (c), 0, 0, 0)
typedef short s16x4 __attribute__((ext_vector_type(4)));
__device__ __forceinline__ f32x4 mfma16k16(u32x2 a, u32x2 b, f32x4 c) { const u32x4 a4 = {a.x, a.y, 0u, 0u}, b4 = {b.x, b.y, 0u, 0u}; return __builtin_amdgcn_mfma_f32_16x16x32_bf16(__builtin_bit_cast(bf16x8, a4), __builtin_bit_cast(bf16x8, b4), c, 0, 0, 0); }
__device__ __forceinline__ bf16x8 ld8(const LAS unsigned char* p) { return __builtin_bit_cast(bf16x8, *(const LAS u32x4*)p); }
#define MX_POS4(d) (((d) & ~31) + 8 * ((((d) & 15)) >> 2) + 4 * (((d) >> 4) & 1))
template <int CTRL> __device__ __forceinline__ float dppf(float ident, float x) { return __builtin_bit_cast(float, __builtin_amdgcn_update_dpp(__builtin_bit_cast(int, ident), __builtin_bit_cast(int, x), CTRL, 0xf, 0xf, false)); }
__device__ __forceinline__ float row_prefix_sum(float x) { x += dppf<0x111>(0.f, x); x += dppf<0x112>(0.f, x); x += dppf<0x114>(0.f, x); x += dppf<0x118>(0.f, x); return x; }
__device__ __forceinline__ float row_prefix_max(float x) { x = fmaxf(x, dppf<0x111>(-3e38f, x)); x = fmaxf(x, dppf<0x112>(-3e38f, x)); x = fmaxf(x, dppf<0x114>(-3e38f, x)); x = fmaxf(x, dppf<0x118>(-3e38f, x)); return x; }
__device__ __forceinline__ float row_prefix_prod(float x) { x *= dppf<0x111>(1.f, x); x *= dppf<0x112>(1.f, x); x *= dppf<0x114>(1.f, x); x *= dppf<0x118>(1.f, x); return x; }
__device__ __forceinline__ float row_suffix_prod(float x) { x *= dppf<0x101>(1.f, x); x *= dppf<0x102>(1.f, x); x *= dppf<0x104>(1.f, x); x *= dppf<0x108>(1.f, x); return x; }
__device__ __forceinline__ float rdlane(float x, int l) { return __builtin_bit_cast(float, __builtin_amdgcn_readlane(__builtin_bit_cast(int, x), l)); }

struct EpiHg {
    static constexpr bool PERM = true, AFTER_DRAIN = false;
    bf16* O0; bf16* O1; int pm_split; int ldc; const float* LB; float* GD; float* GDS;
    __device__ __forceinline__ void operator()(f32x4 (&acc)[2][2][4][2], const pg8::Unit& u, int wr, int wc, int fr, int fq) const {
        bf16* O = (u.pm < pm_split) ? O0 : O1;
        const int row0 = u.pm * 256 + wr * 64 + fr;
        if (u.pn >= 8) {
            const int col0 = u.pn * 256 + wc * 32 + 8 * fq;
#pragma unroll
            for (int ai = 0; ai < 2; ++ai)
#pragma unroll
                for (int m = 0; m < 4; ++m) { bf16* rowp = O + (size_t)(row0 + ai * 128 + m * 16) * ldc + col0;
#pragma unroll
                    for (int bj = 0; bj < 2; ++bj) { const f32x4 v0 = acc[ai][bj][m][0], v1 = acc[ai][bj][m][1];
                        u32x4 w; w.x = pg8::cvt_pk_bf16(v0[0], v0[1]); w.y = pg8::cvt_pk_bf16(v0[2], v0[3]); w.z = pg8::cvt_pk_bf16(v1[0], v1[1]); w.w = pg8::cvt_pk_bf16(v1[2], v1[3]);
                        *(u32x4*)(rowp + bj * 128) = w; } }
            return;
        }
        const int c0 = 128 * u.pn + 32 * wc + 8 * fq;
        const bool samp = (u.pm >= 64 && u.pm < PM_META);
        const f32x4 lb0 = *(const f32x4*)(LB + c0), lb1 = *(const f32x4*)(LB + c0 + 4);
#pragma unroll
        for (int ai = 0; ai < 2; ++ai)
#pragma unroll
            for (int m = 0; m < 4; ++m) {
                const int row = row0 + ai * 128 + m * 16;
                f32x4 qt[2], kt[2], Ae[2];
#pragma unroll
                for (int n = 0; n < 2; ++n)
#pragma unroll
                    for (int e = 0; e < 4; ++e) {
                        const float lb = n ? lb1[e] : lb0[e];
                        const float sg = sigmoidf_(acc[ai][1][m][n][e]);
                        const float a = lb + (1.f - lb) * sg, kk = (1.f - lb) * (1.f - sg);
                        float A = a;
                        if (samp) { float t;
                            t = dppf<0x111>(1.f, A); A *= ((fr & 7) >= 1) ? t : 1.f; t = dppf<0x112>(1.f, A); A *= ((fr & 7) >= 2) ? t : 1.f; t = dppf<0x114>(1.f, A); A *= ((fr & 7) >= 4) ? t : 1.f; }
                        else A = row_prefix_prod(a);
                        qt[n][e] = acc[ai][0][m][n][e] * A; kt[n][e] = kk * __builtin_amdgcn_rcpf(fmaxf(A, 1e-30f)); Ae[n][e] = A;
                    }
                bf16* rowp = O + (size_t)row * ldc + c0;
                u32x4 w; w.x = pg8::cvt_pk_bf16(qt[0][0], qt[0][1]); w.y = pg8::cvt_pk_bf16(qt[0][2], qt[0][3]); w.z = pg8::cvt_pk_bf16(qt[1][0], qt[1][1]); w.w = pg8::cvt_pk_bf16(qt[1][2], qt[1][3]);
                *(u32x4*)rowp = w;
                w.x = pg8::cvt_pk_bf16(kt[0][0], kt[0][1]); w.y = pg8::cvt_pk_bf16(kt[0][2], kt[0][3]); w.z = pg8::cvt_pk_bf16(kt[1][0], kt[1][1]); w.w = pg8::cvt_pk_bf16(kt[1][2], kt[1][3]);
                *(u32x4*)(rowp + 1024) = w;
                if (!samp && fr == 15) { float* gp = GD + (size_t)(row >> 4) * 1024 + c0; *(f32x4*)gp = Ae[0]; *(f32x4*)(gp + 4) = Ae[1]; }
                if (samp && (fr & 7) == 7) { float* gp = GDS + (size_t)((row - ROW_S) >> 3) * 1024 + c0; *(f32x4*)gp = Ae[0]; *(f32x4*)(gp + 4) = Ae[1]; }
            }
    }
};

constexpr int ROT_N = 2072;
__device__ __forceinline__ void p0_rotary(Frame& F, float* tab) {
    const int gt = blockIdx.x * (NWAVES * 64) + F.tid, NT = F.G * NWAVES * 64;
    for (int i = gt; i < ROT_N * 64; i += NT) {
        const int pi = i >> 6, fi = i & 63;
        const float pos = pi < 2064 ? (float)pi : (float)(16384 + pi - 2064);
        const float inv = exp2f((float)fi * (-13.287712379549449f / 63.0f));
        float sn, cs; sincosf(pos * inv, &sn, &cs);
        tab[2 * i] = cs; tab[2 * i + 1] = sn;
    }
}

#ifdef PROBE_BLOCK
#define MSTAMP_DECL unsigned long long t_last_ = __builtin_amdgcn_s_memrealtime();
#define MSTAMP(id) do { if (blockIdx.x == PROBE_BLOCK && tid == 0) { const unsigned long long t_now_ = __builtin_amdgcn_s_memrealtime(); volatile LAS unsigned long long* a_ = (volatile LAS unsigned long long*)(F.lds + 139264 + 128) + 48 + (id); *a_ = *a_ + (t_now_ - t_last_); t_last_ = t_now_; } } while (0)
#else
#define MSTAMP_DECL
#define MSTAMP(id) do { } while (0)
#endif
#define MX_SC_PARAMS(scv, row0, ntok, nmc, pos0) do { if (mode != 1) { if ((scv) == 0) { row0 = ROW_M; ntok = 16; nmc = 1; pos0 = 0; } else { row0 = b * 2048 + ((scv) - 1) * 64; ntok = 64; nmc = 4; pos0 = 16 + ((scv) - 1) * 64; } } \
        else { row0 = ROW_S + 8 * b; ntok = 8; nmc = 1; pos0 = 2064; } } while (0)

template <int TYPE, int NMC>
__device__ __forceinline__ void sg_chain(LAS unsigned char* L, LAS float* SC, f32x4 (&S)[8], f32x4& nacc, int w, int r16, int q) {
    LAS float* OB = (LAS float*)(L + MX_OB); LAS float* RP = (LAS float*)(L + MX_RP); LAS float* DI = (LAS float*)(L + MX_DI);
    f32x4 oo[4];
#pragma unroll
    for (int mc = 0; mc < NMC; ++mc) {
        oo[mc] = (f32x4){0.f, 0.f, 0.f, 0.f};
        {
            const LAS unsigned char* Qb = L + MX_Q + 16 * mc * MX_PITCH; const LAS unsigned char* Kb = L + MX_K + 16 * mc * MX_PITCH; const LAS unsigned char* Vb = L + MX_V + 16 * mc * MX_PITCH;
            f32x4 g0 = {0.f, 0.f, 0.f, 0.f}, g1 = {0.f, 0.f, 0.f, 0.f};
#pragma unroll
            for (int ks = 0; ks < 4; ++ks) {
                const bf16x8 kf = ld8(Kb + r16 * MX_PITCH + (32 * ks + 8 * q) * 2), qf = ld8(Qb + r16 * MX_PITCH + (32 * ks + 8 * q) * 2);
                if (ks & 1) g1 = MFMA16(kf, qf, g1); else g0 = MFMA16(kf, qf, g0);
            }
            const f32x4 g = g0 + g1;
            const float xi = SC[mc * 16 + r16]; const f32x4 y4 = *(const LAS f32x4*)(SC + 64 + mc * 16 + 4 * q);
            f32x4 P;
#pragma unroll
            for (int r = 0; r < 4; ++r) P[r] = (4 * q + r <= r16) ? g[r] * __expf(xi + y4[r]) : 0.f;
            if (TYPE == 0) { float ps = (P[0] + P[1]) + (P[2] + P[3]); ps += __shfl_xor(ps, 16); ps += __shfl_xor(ps, 32); if (w == 0 && q == 0) DI[16 * mc + r16] = ps; }
            const u32x2 vt = tr16(Vb + (4 * q + (r16 >> 2)) * MX_PITCH + (16 * w + 4 * (r16 & 3)) * 2);
            oo[mc] = mfma16k16((u32x2){pkbf(P[0], P[1]), pkbf(P[2], P[3])}, vt, oo[mc]);
        }
        if (mc == 1 || TYPE == 1) __builtin_amdgcn_sched_barrier(0);
    }
#pragma unroll
    for (int mc = 0; mc < NMC; ++mc) {
        {
            const LAS unsigned char* Qb = L + MX_Q + 16 * mc * MX_PITCH; const LAS unsigned char* Kb = L + MX_K + 16 * mc * MX_PITCH;
            const u32x2 vt = tr16(L + MX_V + 16 * mc * MX_PITCH + (4 * q + (r16 >> 2)) * MX_PITCH + (16 * w + 4 * (r16 & 3)) * 2);
            f32x4 o2a = {0.f, 0.f, 0.f, 0.f}, o2b = {0.f, 0.f, 0.f, 0.f};
#pragma unroll
            for (int ks = 0; ks < 4; ++ks) {
                const bf16x8 qf = ld8(Qb + r16 * MX_PITCH + (32 * ks + 8 * q) * 2);
                const bf16x8 SB = mk8(pkbf(S[2 * ks][0], S[2 * ks][1]), pkbf(S[2 * ks][2], S[2 * ks][3]), pkbf(S[2 * ks + 1][0], S[2 * ks + 1][1]), pkbf(S[2 * ks + 1][2], S[2 * ks + 1][3]));
                if (ks & 1) o2b = MFMA16(qf, SB, o2b); else o2a = MFMA16(qf, SB, o2a);
            }
            const f32x4 in4 = *(const LAS f32x4*)(SC + 128 + mc * 16 + 4 * q);
            oo[mc] = oo[mc] + in4 * (o2a + o2b);
            const f32x4 w4 = *(const LAS f32x4*)(SC + 192 + mc * 16 + 4 * q); const float carry = SC[320 + mc];
            if (TYPE == 0) {
                const u32x2 qn = *(const LAS u32x2*)(Qb + r16 * MX_PITCH + MX_POS4(16 * w + 4 * q) * 2);
                f32x4 rr = {0.f, 0.f, 0.f, 0.f}; rr = mfma16k16(qn, (u32x2){pkbf(nacc[0], nacc[1]), pkbf(nacc[2], nacc[3])}, rr);
                if (r16 == 0) {
#pragma unroll
                    for (int r = 0; r < 4; ++r) RP[w * 64 + 16 * mc + 4 * q + r] = rr[r]; }
            }
#pragma unroll
            for (int r = 0; r < 4; ++r) OB[(16 * mc + 4 * q + r) * MX_OP + 16 * w + r16] = oo[mc][r];
            const u32x2 VH = {pkbf(bflo(vt.x) * w4[0], bfhi(vt.x) * w4[1]), pkbf(bflo(vt.y) * w4[2], bfhi(vt.y) * w4[3])};
#pragma unroll
            for (int mt = 0; mt < 8; ++mt) {
                const u32x2 kt = tr16(Kb + (4 * q + (r16 >> 2)) * MX_PITCH + MX_POS4(16 * mt + 4 * (r16 & 3)) * 2);
                S[mt] = S[mt] * carry; S[mt] = mfma16k16(kt, VH, S[mt]);
            }
            if (TYPE == 0) {
                const u32x2 kt = tr16(Kb + (4 * q + (r16 >> 2)) * MX_PITCH + MX_POS4(16 * w + 4 * (r16 & 3)) * 2);
                nacc = nacc * carry; nacc = mfma16k16(kt, (u32x2){pkbf(w4[0], w4[1]), pkbf(w4[2], w4[3])}, nacc);
            }
        }
        if (mc + 1 < NMC) __builtin_amdgcn_sched_barrier(0);
    }
}

template <int TYPE>
__device__ __forceinline__ void mix_sg_unit(Frame& F, int b, int h, int mode  , const float* rot) {
    const bool prompt = (mode != 1);
    const int tid = F.tid, lane = F.lane, w = F.wave, r16 = lane & 15, q = lane >> 4;
    const int tk = tid >> 3, p = tid & 7;
    LAS unsigned char* L = F.lds;
    LAS float* OB = (LAS float*)(L + MX_OB); LAS float* RP = (LAS float*)(L + MX_RP); LAS float* DI = (LAS float*)(L + MX_DI);
    bf16* MIX = F_XN(F);
    const int qcol = (TYPE == 0 ? 0 : 2048) + 128 * h, kcol = (TYPE == 0 ? 512 : 2560) + 128 * h, vcol = (TYPE == 0 ? 1024 : 3072) + 128 * h, gcol = (TYPE == 0 ? 1536 : 3584) + 128 * h, mcol = (TYPE == 0 ? 0 : 512) + 128 * h;
    f32x4 S[8]; f32x4 nacc = {0.f, 0.f, 0.f, 0.f}; float m0 = 0.f;
#pragma unroll
    for (int mt = 0; mt < 8; ++mt) S[mt] = (f32x4){0.f, 0.f, 0.f, 0.f};
    if (!prompt) {
        const float* Sin = (TYPE == 0 ? F.in[2] : F.in[5]) + (size_t)(b * 4 + h) * 16384;
#pragma unroll
        for (int mt = 0; mt < 8; ++mt)
#pragma unroll
            for (int r = 0; r < 4; ++r) S[mt][r] = Sin[(16 * mt + 4 * q + r) * 128 + 16 * w + r16];
        if (TYPE == 0) {
#pragma unroll
            for (int r = 0; r < 4; ++r) nacc[r] = F.in[3][(size_t)(b * 4 + h) * 128 + 16 * w + 4 * q + r];
            m0 = F.in[4][b * 4 + h];
        }
    }
    const float lgam = (TYPE != 1) ? 0.f : h == 0 ? -0.031748698314580298f : h == 1 ? -0.015748356968139168f : h == 2 ? -0.0078431774610258928f : -0.0039138993211363287f;
    const float bias_i = (TYPE == 0) ? F.in[11][h] : 0.f, bias_f = (TYPE == 0) ? F.in[12][h] : 0.f;
    LAS float* GN = (LAS float*)(L + MX_GN);
    if (tid < 128) GN[tid] = (TYPE == 0 ? F.in[13] : F.in[14])[128 * h + tid];
    const int nsc = (mode == 0) ? 33 : 1;
    u32x4 pa[6]; f32x4 pr[4]; float pli = 0.f, plf = 0.f; u32x4 pg[2];
    const u32x4 z4 = {0u, 0u, 0u, 0u};
#define SG_LOAD(scv) do { int row0_, ntok_, nmc_, pos0_; MX_SC_PARAMS(scv, row0_, ntok_, nmc_, pos0_); (void)nmc_; \
        const bool valid_ = tk < ntok_; const bf16* zr_ = ZROW(F, row0_ + (valid_ ? tk : 0), 0); \
        _Pragma("unroll") for (int i_ = 0; i_ < 6; ++i_) pa[i_] = z4; \
        if (valid_) { pa[4] = *(const u32x4*)(zr_ + vcol + 16 * p); pa[5] = *(const u32x4*)(zr_ + vcol + 16 * p + 8); \
            if (TYPE == 0) { pa[0] = *(const u32x4*)(zr_ + qcol + 16 * p); pa[1] = *(const u32x4*)(zr_ + qcol + 16 * p + 8); pa[2] = *(const u32x4*)(zr_ + kcol + 16 * p); pa[3] = *(const u32x4*)(zr_ + kcol + 16 * p + 8); } \
            else { pa[0] = *(const u32x4*)(zr_ + qcol + 8 * p); pa[1] = *(const u32x4*)(zr_ + qcol + 64 + 8 * p); pa[2] = *(const u32x4*)(zr_ + kcol + 8 * p); pa[3] = *(const u32x4*)(zr_ + kcol + 64 + 8 * p); } } \
        if (TYPE == 1) { const float* tb_ = rot + ((size_t)(pos0_ + (valid_ ? tk : 0)) * 64 + 8 * p) * 2; _Pragma("unroll") for (int e_ = 0; e_ < 4; ++e_) pr[e_] = *(const f32x4*)(tb_ + 4 * e_); } \
        if (TYPE == 0 && w == 0) { const bool vt_ = lane < ntok_; const float* gp_ = F_GT(F) + (size_t)(row0_ + (vt_ ? lane : 0)) * 8; pli = gp_[h]; plf = gp_[4 + h]; } } while (0)
    SG_LOAD(0);
    MSTAMP_DECL
#pragma unroll 1
    for (int sc = 0; sc < nsc; ++sc) {
        int row0, ntok, nmc, pos0; MX_SC_PARAMS(sc, row0, ntok, nmc, pos0); (void)pos0;
        LAS float* SC = (LAS float*)(L + MX_SC) + (sc & 1) * 384;
        MSTAMP(0);
        {
            *(LAS u32x4*)(L + MX_V + tk * MX_PITCH + 32 * p) = pa[4]; *(LAS u32x4*)(L + MX_V + tk * MX_PITCH + 32 * p + 16) = pa[5];
            if (TYPE == 0) {
                const int c0 = (MX_POS4(16 * p)) * 2;
#pragma unroll
                for (int g = 0; g < 4; ++g) {
                    *(LAS u32x2*)(L + MX_Q + tk * MX_PITCH + c0 + 16 * g) = (u32x2){pa[g >> 1][2 * (g & 1)], pa[g >> 1][2 * (g & 1) + 1]};
                    *(LAS u32x2*)(L + MX_K + tk * MX_PITCH + c0 + 16 * g) = (u32x2){pa[2 + (g >> 1)][2 * (g & 1)], pa[2 + (g >> 1)][2 * (g & 1) + 1]};
                }
            } else {
                u32x4 q1, q2, k1, k2;
#pragma unroll
                for (int e2 = 0; e2 < 4; ++e2) {
                    const f32x4 cs = pr[e2];
                    { const float x1l = bflo(pa[0][e2]), x1h = bfhi(pa[0][e2]), x2l = bflo(pa[1][e2]), x2h = bfhi(pa[1][e2]);
                      q1[e2] = pkbf(x1l * cs[0] - x2l * cs[1], x1h * cs[2] - x2h * cs[3]); q2[e2] = pkbf(x2l * cs[0] + x1l * cs[1], x2h * cs[2] + x1h * cs[3]); }
                    { const float x1l = bflo(pa[2][e2]), x1h = bfhi(pa[2][e2]), x2l = bflo(pa[3][e2]), x2h = bfhi(pa[3][e2]);
                      k1[e2] = pkbf(x1l * cs[0] - x2l * cs[1], x1h * cs[2] - x2h * cs[3]); k2[e2] = pkbf(x2l * cs[0] + x1l * cs[1], x2h * cs[2] + x1h * cs[3]); }
                }
                const int c0 = (MX_POS4(8 * p)) * 2;
                *(LAS u32x2*)(L + MX_Q + tk * MX_PITCH + c0) = (u32x2){q1[0], q1[1]}; *(LAS u32x2*)(L + MX_Q + tk * MX_PITCH + c0 + 16) = (u32x2){q1[2], q1[3]};
                *(LAS u32x2*)(L + MX_Q + tk * MX_PITCH + c0 + 128) = (u32x2){q2[0], q2[1]}; *(LAS u32x2*)(L + MX_Q + tk * MX_PITCH + c0 + 144) = (u32x2){q2[2], q2[3]};
                *(LAS u32x2*)(L + MX_K + tk * MX_PITCH + c0) = (u32x2){k1[0], k1[1]}; *(LAS u32x2*)(L + MX_K + tk * MX_PITCH + c0 + 16) = (u32x2){k1[2], k1[3]};
                *(LAS u32x2*)(L + MX_K + tk * MX_PITCH + c0 + 128) = (u32x2){k2[0], k2[1]}; *(LAS u32x2*)(L + MX_K + tk * MX_PITCH + c0 + 144) = (u32x2){k2[2], k2[3]};
            }
        }
        if (w == 0) {
            const bool valid = lane < ntok;
            float li = -1e30f, lf = 0.f;
            if (TYPE == 0) { if (valid) { li = pli + bias_i; lf = logsigmoidf_(plf + bias_f); } } else { if (valid) { li = 0.f; lf = lgam; } }
            const float bb = row_prefix_sum(lf);
            const float y = li - bb;
            const float am = row_prefix_max(y);
            const float a = bb + am;
            const float B0 = rdlane(bb, 15), B1 = rdlane(bb, 31), B2 = rdlane(bb, 47), B3 = rdlane(bb, 63);
            float M1 = 0.f, M2 = 0.f, M3 = 0.f, M4 = 0.f;
            if (TYPE == 0) { const float A0 = rdlane(a, 15), A1 = rdlane(a, 31), A2 = rdlane(a, 47), A3 = rdlane(a, 63);
                M1 = fmaxf(B0 + m0, A0); M2 = fmaxf(B1 + M1, A1); M3 = fmaxf(B2 + M2, A2); M4 = fmaxf(B3 + M3, A3); }
            const float m0q = q == 0 ? m0 : q == 1 ? M1 : q == 2 ? M2 : M3;
            const float mnq = q == 0 ? M1 : q == 1 ? M2 : q == 2 ? M3 : M4;
            const float b15 = q == 0 ? B0 : q == 1 ? B1 : q == 2 ? B2 : B3;
            const float m = (TYPE == 0) ? fmaxf(bb + m0q, a) : 0.f;
            SC[lane] = bb - m; SC[64 + lane] = y + LNKS; SC[128 + lane] = __expf(bb + m0q - m);
            SC[192 + lane] = __expf(y + LNKS + b15 - mnq); SC[256 + lane] = __expf(-m);
            if (r16 == 0) SC[320 + q] = __expf(b15 + m0q - mnq);
            m0 = (nmc == 4) ? M4 : M1;
        }
        MSTAMP(1);
        __syncthreads();
        MSTAMP(2);
        if (sc + 1 < nsc) SG_LOAD(sc + 1);
        { const bool valid = tk < ntok; const bf16* zr = ZROW(F, row0 + (valid ? tk : 0), 0) + gcol + 16 * p; pg[0] = *(const u32x4*)zr; pg[1] = *(const u32x4*)(zr + 8); }
        MSTAMP(3);
        if (nmc == 4) sg_chain<TYPE, 4>(L, SC, S, nacc, w, r16, q); else sg_chain<TYPE, 1>(L, SC, S, nacc, w, r16, q);
        MSTAMP(4);
        __syncthreads();
        MSTAMP(6);
        {
            const bool valid = tk < ntok; const int row = row0 + (valid ? tk : 0);
            f32x4 o[4];
#pragma unroll
            for (int c = 0; c < 4; ++c) o[c] = *(const LAS f32x4*)(OB + tk * MX_OP + 16 * p + 4 * c);
            if (tk >= 16 * nmc) {
#pragma unroll
                for (int c = 0; c < 4; ++c) o[c] = (f32x4){0.f, 0.f, 0.f, 0.f}; }
            if (TYPE == 0) {
                float rs = 0.f;
#pragma unroll
                for (int ww = 0; ww < 8; ++ww) rs += RP[ww * 64 + tk];
                const float den = DI[tk] + SC[128 + tk] * rs;
                float dn = fmaxf(fabsf(den), SC[256 + tk]); if (tk >= 16 * nmc) dn = 1.f;
                const float rd = 1.f / dn;
#pragma unroll
                for (int c = 0; c < 4; ++c) o[c] = o[c] * rd;
            }
            float sm = 0.f;
#pragma unroll
            for (int c = 0; c < 4; ++c) sm += (o[c].x + o[c].y) + (o[c].z + o[c].w);
            sm += __shfl_xor(sm, 1); sm += __shfl_xor(sm, 2); sm += __shfl_xor(sm, 4);
            const float mu = sm * (1.f / 128.f); float vs = 0.f;
#pragma unroll
            for (int c = 0; c < 4; ++c) { o[c] = o[c] - mu; vs += (o[c].x * o[c].x + o[c].y * o[c].y) + (o[c].z * o[c].z + o[c].w * o[c].w); }
            vs += __shfl_xor(vs, 1); vs += __shfl_xor(vs, 2); vs += __shfl_xor(vs, 4);
            const float rstd = rsqrtf(vs * (1.f / 128.f) + EPS);
            if (valid && !(mode == 0 && sc == 0)) {
                unsigned ow[8];
#pragma unroll
                for (int c = 0; c < 4; ++c) {
                    const unsigned ga = c < 2 ? pg[0][2 * c] : pg[1][2 * c - 4], gb = c < 2 ? pg[0][2 * c + 1] : pg[1][2 * c - 3];
                    f32x4 gt = {bflo(ga), bfhi(ga), bflo(gb), bfhi(gb)};
#pragma unroll
                    for (int e = 0; e < 4; ++e) gt[e] = (TYPE == 0) ? sigmoidf_(gt[e]) : siluf_(gt[e]);
                    const f32x4 r = o[c] * rstd * *(const LAS f32x4*)(GN + 16 * p + 4 * c) * gt;
                    ow[2 * c] = pkbf(r.x, r.y); ow[2 * c + 1] = pkbf(r.z, r.w);
                }
                bf16* mp = MIX + (size_t)row * DM + mcol + 16 * p;
                *(u32x4*)mp = (u32x4){ow[0], ow[1], ow[2], ow[3]}; *(u32x4*)(mp + 8) = (u32x4){ow[4], ow[5], ow[6], ow[7]};
            }
        }
        MSTAMP(7);
    }
#undef SG_LOAD
    __syncthreads();
    if (mode != 2) {
        int l2 = F.lane; asm volatile("" : "+v"(l2)); const int r16 = l2 & 15, q = l2 >> 4;
        float* So = F.out + (TYPE == 0 ? (prompt ? O_CP : O_CS) : (prompt ? O_RP : O_RS)) + (size_t)(b * 4 + h) * 16384;
#pragma unroll
        for (int mt = 0; mt < 8; ++mt)
#pragma unroll
            for (int r = 0; r < 4; ++r) So[(16 * mt + 4 * q + r) * 128 + 16 * w + r16] = S[mt][r];
        if (TYPE == 0) {
            if (r16 == 0) { float* No = F.out + (prompt ? O_NP : O_NS) + (size_t)(b * 4 + h) * 128;
#pragma unroll
                for (int r = 0; r < 4; ++r) No[16 * w + 4 * q + r] = nacc[r]; }
            if (w == 0 && lane == 0) F.out[(prompt ? O_MP : O_MS) + b * 4 + h] = m0;
        }
    }
}

template <int NMC>
__device__ __forceinline__ void hg_chain(LAS unsigned char* L, f32x4 (&S)[8], int w, int r16, int q) {
    LAS float* GD = (LAS float*)(L + MX_GD); LAS float* OB = (LAS float*)(L + MX_OB);
    f32x4 oo[4];
#pragma unroll
    for (int mc = 0; mc < NMC; ++mc) {
        oo[mc] = (f32x4){0.f, 0.f, 0.f, 0.f};
        {
            const LAS unsigned char* Qb = L + MX_Q + 16 * mc * MX_PITCH; const LAS unsigned char* Kb = L + MX_K + 16 * mc * MX_PITCH; const LAS unsigned char* Vb = L + MX_V + 16 * mc * MX_PITCH;
            f32x4 g0 = {0.f, 0.f, 0.f, 0.f}, g1 = {0.f, 0.f, 0.f, 0.f};
#pragma unroll
            for (int ks = 0; ks < 4; ++ks) {
                const bf16x8 kf = ld8(Kb + r16 * MX_PITCH + (32 * ks + 8 * q) * 2), qf = ld8(Qb + r16 * MX_PITCH + (32 * ks + 8 * q) * 2);
                if (ks & 1) g1 = MFMA16(kf, qf, g1); else g0 = MFMA16(kf, qf, g0);
            }
            const f32x4 g = g0 + g1;
            f32x4 P;
#pragma unroll
            for (int r = 0; r < 4; ++r) P[r] = (4 * q + r <= r16) ? g[r] : 0.f;
            const u32x2 vt = tr16(Vb + (4 * q + (r16 >> 2)) * MX_PITCH + (16 * w + 4 * (r16 & 3)) * 2);
            oo[mc] = mfma16k16((u32x2){pkbf(P[0], P[1]), pkbf(P[2], P[3])}, vt, oo[mc]);
        }
        if (mc == 1) __builtin_amdgcn_sched_barrier(0);
    }
#pragma unroll
    for (int mc = 0; mc < NMC; ++mc) {
        {
            const LAS unsigned char* Qb = L + MX_Q + 16 * mc * MX_PITCH; const LAS unsigned char* Kb = L + MX_K + 16 * mc * MX_PITCH;
            const u32x2 vt = tr16(L + MX_V + 16 * mc * MX_PITCH + (4 * q + (r16 >> 2)) * MX_PITCH + (16 * w + 4 * (r16 & 3)) * 2);
            f32x4 o2b = {0.f, 0.f, 0.f, 0.f};
#pragma unroll
            for (int ks = 0; ks < 4; ++ks) {
                const bf16x8 qf = ld8(Qb + r16 * MX_PITCH + (32 * ks + 8 * q) * 2);
                const bf16x8 SB = mk8(pkbf(S[2 * ks][0], S[2 * ks][1]), pkbf(S[2 * ks][2], S[2 * ks][3]), pkbf(S[2 * ks + 1][0], S[2 * ks + 1][1]), pkbf(S[2 * ks + 1][2], S[2 * ks + 1][3]));
                if (ks & 1) o2b = MFMA16(qf, SB, o2b); else oo[mc] = MFMA16(qf, SB, oo[mc]);
            }
            oo[mc] = oo[mc] + o2b;
#pragma unroll
            for (int mt = 0; mt < 8; ++mt) {
                const f32x4 gd = *(const LAS f32x4*)(GD + mc * 128 + 16 * mt + 4 * q);
                const u32x2 kt = tr16(Kb + (4 * q + (r16 >> 2)) * MX_PITCH + MX_POS4(16 * mt + 4 * (r16 & 3)) * 2);
                S[mt] = mfma16k16(kt, vt, S[mt]); S[mt] = S[mt] * gd;
            }
        }
        if (mc + 1 < NMC) __builtin_amdgcn_sched_barrier(0);
    }
#pragma unroll
    for (int mc = 0; mc < NMC; ++mc) {
        {
#pragma unroll
            for (int r = 0; r < 4; ++r) OB[(16 * mc + 4 * q + r) * MX_OP + 16 * w + r16] = oo[mc][r];
        }
    }
}

__device__ __forceinline__ void mix_hg_unit(Frame& F, int b, int h, int mode) {
    const bool prompt = (mode != 1);
    const int tid = F.tid, lane = F.lane, w = F.wave, r16 = lane & 15, q = lane >> 4;
    const int tk = tid >> 3, p = tid & 7;
    LAS unsigned char* L = F.lds;
    LAS float* GD = (LAS float*)(L + MX_GD); LAS float* OB = (LAS float*)(L + MX_OB);
    bf16* MIX = F_XN(F);
    f32x4 S[8];
#pragma unroll
    for (int mt = 0; mt < 8; ++mt) S[mt] = (f32x4){0.f, 0.f, 0.f, 0.f};
    if (!prompt) {
        const float* Sin = F.in[6] + (size_t)(b * 8 + h) * 16384;
#pragma unroll
        for (int mt = 0; mt < 8; ++mt)
#pragma unroll
            for (int r = 0; r < 4; ++r) S[mt][r] = Sin[(16 * mt + 4 * q + r) * 128 + 16 * w + r16];
    }
    LAS float* GN = (LAS float*)(L + MX_GN);
    if (tid < 128) GN[tid] = F.in[18][128 * h + tid];
    const int nsc = (mode == 0) ? 33 : 1;
    u32x4 pa[6]; u32x4 pg[2]; float pgd = 1.f;
    const u32x4 z4 = {0u, 0u, 0u, 0u};
#define HG_LOAD(scv) do { int row0_, ntok_, nmc_, pos0_; MX_SC_PARAMS(scv, row0_, ntok_, nmc_, pos0_); (void)pos0_; \
        const bool valid_ = tk < ntok_; const bf16* zr_ = ZROW(F, row0_ + (valid_ ? tk : 0), 1) + 128 * h + 16 * p; \
        _Pragma("unroll") for (int i_ = 0; i_ < 6; ++i_) pa[i_] = z4; \
        if (valid_) { pa[0] = *(const u32x4*)zr_; pa[1] = *(const u32x4*)(zr_ + 8); pa[2] = *(const u32x4*)(zr_ + 1024); pa[3] = *(const u32x4*)(zr_ + 1032); pa[4] = *(const u32x4*)(zr_ + 2048); pa[5] = *(const u32x4*)(zr_ + 2056); } \
        pgd = 1.f; if ((tid >> 7) < nmc_) pgd = (mode == 1) ? ((const float*)(F.ws + WS_GDS))[(size_t)b * 1024 + 128 * h + (tid & 127)] : ((const float*)(F.ws + WS_GD))[(size_t)((row0_ >> 4) + (tid >> 7)) * 1024 + 128 * h + (tid & 127)]; } while (0)
    HG_LOAD(0);
    MSTAMP_DECL
#pragma unroll 1
    for (int sc = 0; sc < nsc; ++sc) {
        int row0, ntok, nmc, pos0; MX_SC_PARAMS(sc, row0, ntok, nmc, pos0); (void)pos0;
        MSTAMP(8);
        {
            const int c0 = (MX_POS4(16 * p)) * 2;
#pragma unroll
            for (int g = 0; g < 4; ++g) {
                *(LAS u32x2*)(L + MX_Q + tk * MX_PITCH + c0 + 16 * g) = (u32x2){pa[g >> 1][2 * (g & 1)], pa[g >> 1][2 * (g & 1) + 1]};
                *(LAS u32x2*)(L + MX_K + tk * MX_PITCH + c0 + 16 * g) = (u32x2){pa[2 + (g >> 1)][2 * (g & 1)], pa[2 + (g >> 1)][2 * (g & 1) + 1]};
            }
            *(LAS u32x4*)(L + MX_V + tk * MX_PITCH + 32 * p) = pa[4]; *(LAS u32x4*)(L + MX_V + tk * MX_PITCH + 32 * p + 16) = pa[5];
            GD[tid] = pgd;
        }
        MSTAMP(9);
        __syncthreads();
        MSTAMP(10);
        if (sc + 1 < nsc) HG_LOAD(sc + 1);
        { const bool valid = tk < ntok; const bf16* zr = ZROW(F, row0 + (valid ? tk : 0), 1) + 3072 + 128 * h + 16 * p; pg[0] = *(const u32x4*)zr; pg[1] = *(const u32x4*)(zr + 8); }
        MSTAMP(11);
        if (nmc == 4) hg_chain<4>(L, S, w, r16, q); else hg_chain<1>(L, S, w, r16, q);
        MSTAMP(12);
        __syncthreads();
        MSTAMP(13);
        {
            const bool valid = tk < ntok; const int row = row0 + (valid ? tk : 0);
            f32x4 o[4];
#pragma unroll
            for (int c = 0; c < 4; ++c) o[c] = *(const LAS f32x4*)(OB + tk * MX_OP + 16 * p + 4 * c);
            if (tk >= 16 * nmc) {
#pragma unroll
                for (int c = 0; c < 4; ++c) o[c] = (f32x4){0.f, 0.f, 0.f, 0.f}; }
            float vs = 0.f;
#pragma unroll
            for (int c = 0; c < 4; ++c) vs += (o[c].x * o[c].x + o[c].y * o[c].y) + (o[c].z * o[c].z + o[c].w * o[c].w);
            vs += __shfl_xor(vs, 1); vs += __shfl_xor(vs, 2); vs += __shfl_xor(vs, 4);
            const float rstd = rsqrtf(vs * (1.f / 128.f) + EPS);
            if (valid && !(mode == 0 && sc == 0)) {
                unsigned ow[8];
#pragma unroll
                for (int c = 0; c < 4; ++c) {
                    const unsigned ga = c < 2 ? pg[0][2 * c] : pg[1][2 * c - 4], gb = c < 2 ? pg[0][2 * c + 1] : pg[1][2 * c - 3];
                    f32x4 gt = {bflo(ga), bfhi(ga), bflo(gb), bfhi(gb)};
#pragma unroll
                    for (int e = 0; e < 4; ++e) gt[e] = siluf_(gt[e]);
                    const f32x4 r = o[c] * rstd * *(const LAS f32x4*)(GN + 16 * p + 4 * c) * gt;
                    ow[2 * c] = pkbf(r.x, r.y); ow[2 * c + 1] = pkbf(r.z, r.w);
                }
                bf16* mp = MIX + (size_t)row * DM + 128 * h + 16 * p;
                *(u32x4*)mp = (u32x4){ow[0], ow[1], ow[2], ow[3]}; *(u32x4*)(mp + 8) = (u32x4){ow[4], ow[5], ow[6], ow[7]};
            }
        }
        MSTAMP(14);
    }
#undef HG_LOAD
    __syncthreads();
    if (mode != 2) {
        int l2 = F.lane; asm volatile("" : "+v"(l2)); const int r16 = l2 & 15, q = l2 >> 4;
        float* So = F.out + (prompt ? O_HP : O_HS) + (size_t)(b * 8 + h) * 16384;
#pragma unroll
        for (int mt = 0; mt < 8; ++mt)
#pragma unroll
            for (int r = 0; r < 4; ++r) So[(16 * mt + 4 * q + r) * 128 + 16 * w + r16] = S[mt][r];
    }
}

__device__ __forceinline__ void mixer_layer0(Frame& F) {
    const float* rot = (const float*)(F.ws + WS_ROT);
    int bid = blockIdx.x; asm volatile("" : "+s"(bid));
    if (bid < 64) { const int u = bid, ty = u >> 5, bh = u & 31; if (ty == 0) mix_sg_unit<0>(F, bh >> 2, bh & 3, 0, rot); else mix_sg_unit<1>(F, bh >> 2, bh & 3, 0, rot); return; }
#pragma unroll 1
    for (int u = bid - 64; u < 1024 + 8; u += F.G - 64) {
        int ty, bh, mode;
        if (u < 1024) { ty = u >> 9; bh = u & 511; mode = 1; } else { ty = (u - 1024) >> 2; bh = (u - 1024) & 3; mode = 2; }
        if (ty == 0) mix_sg_unit<0>(F, bh >> 2, bh & 3, mode, rot); else mix_sg_unit<1>(F, bh >> 2, bh & 3, mode, rot);
    }
}
__device__ __forceinline__ void mixer_layer1(Frame& F) {
    int bid = blockIdx.x; asm volatile("" : "+s"(bid));
    if (bid < 64) { mix_hg_unit(F, bid >> 3, bid & 7, 0); return; }
#pragma unroll 1
    for (int u = bid - 64; u < 1024 + 8; u += F.G - 64) {
        if (u < 1024) mix_hg_unit(F, u >> 3, u & 7, 1); else mix_hg_unit(F, 0, u - 1024, 2);
    }
}
constexpr int NSTEP = 18;
#ifndef P0_DEFER
#define P0_DEFER 0
#endif
constexpr int LDSCTL_OFF = 139264;
#define RLX_AGENT __ATOMIC_RELAXED, __HIP_MEMORY_SCOPE_AGENT
#define XB_TMO      128
#define XB_XCNT(j)  (256  + 64 * (j))
#define XB_XSUB(j)  (1280 + 64 * (j))
#define XB_XGEN(j)  (2304 + 64 * (j))
#define XB_TOP      3328
#define XB_TOPGEN   3392
#define XCD_BAR_WORDS 3456
#define XB_SPIN_CAP (1u << 18)

__device__ __forceinline__ unsigned xb_ld(unsigned* p)              { return __hip_atomic_load(p, __ATOMIC_RELAXED, __HIP_MEMORY_SCOPE_AGENT); }
__device__ __forceinline__ unsigned xb_add(unsigned* p, unsigned v) { return __hip_atomic_fetch_add(p, v, __ATOMIC_RELAXED, __HIP_MEMORY_SCOPE_AGENT); }
__device__ __forceinline__ unsigned xb_xcc_id() { return (unsigned)__builtin_amdgcn_s_getreg((3 << 11) | 20) & 0xFu; }
#define XB_SPIN(cond, bar) do { unsigned _sp = 0; while (cond) { __builtin_amdgcn_s_sleep(1); \
    if ((++_sp & 255u) == 0u) { if (xb_ld(&(bar)[XB_TMO])) break; if (_sp > XB_SPIN_CAP) { atomicAdd(&(bar)[XB_TMO], 1u); break; } } } } while (0)

struct XcdBarrier {
    unsigned gsz;
    unsigned* bar; unsigned x;
    volatile LAS unsigned* st;
};

__device__ __forceinline__ XcdBarrier xcd_barrier_post(unsigned* bar, volatile LAS unsigned* st, unsigned gsz) {
    XcdBarrier b; b.gsz = gsz; b.bar = bar; b.x = xb_xcc_id(); b.st = st;
    if (threadIdx.x == 0) (void)xb_add(&bar[XB_XCNT(b.x)], 1u);
    return b;
}
__device__ __forceinline__ void xcd_barrier_complete(unsigned* bar, unsigned x, unsigned G, unsigned& nloc, unsigned& nx) {
    unsigned sum, cnt, mine, sp = 0u;
    for (;;) {
        sum = 0u; cnt = 0u; mine = 0u;
#pragma unroll
        for (unsigned j = 0; j < 16; ++j) { const unsigned c = xb_ld(&bar[XB_XCNT(j)]); sum += c; cnt += (c > 0u) ? 1u : 0u; mine = (j == x) ? c : mine; }
        if (sum == G) break;
        __builtin_amdgcn_s_sleep(1);
        if ((++sp & 255u) == 0u) { if (xb_ld(&bar[XB_TMO])) break; if (sp > XB_SPIN_CAP) { atomicAdd(&bar[XB_TMO], 1u); break; } }
    }
    nloc = mine > 0u ? mine : 1u; nx = cnt > 0u ? cnt : 1u;
}

__device__ __forceinline__ void xcd_barrier(const XcdBarrier& b) {
    asm volatile("s_waitcnt vmcnt(0)" ::: "memory");
    __syncthreads();
    if (threadIdx.x == 0) {
        unsigned* bar = b.bar;
        __builtin_amdgcn_s_waitcnt(0);
        unsigned nloc = b.st[0], nx = b.st[1];
        if (nloc == 0u) { xcd_barrier_complete(bar, b.x, b.gsz, nloc, nx); b.st[0] = nloc; b.st[1] = nx; }
        const unsigned old = xb_add(&bar[XB_XSUB(b.x)], 1u);
        const unsigned gen = old / nloc;
        if (old + 1u == (gen + 1u) * nloc) {
            __builtin_amdgcn_fence(__ATOMIC_RELEASE, "agent");
            asm volatile("s_waitcnt vmcnt(0)" ::: "memory");
            const unsigned og = xb_add(&bar[XB_TOP], 1u);
            const unsigned tg = og / nx;
            if (og + 1u == (tg + 1u) * nx) xb_add(&bar[XB_TOPGEN], 1u);
            else XB_SPIN(xb_ld(&bar[XB_TOPGEN]) == tg, bar);
            __builtin_amdgcn_fence(__ATOMIC_ACQUIRE, "agent");
            xb_add(&bar[XB_XGEN(b.x)], 1u);
            asm volatile("s_waitcnt vmcnt(0)" ::: "memory");
        } else {
            XB_SPIN(xb_ld(&bar[XB_XGEN(b.x)]) == gen, bar);
            __builtin_amdgcn_fence(__ATOMIC_ACQUIRE, "agent");
            asm volatile("s_waitcnt vmcnt(0)" ::: "memory");
        }
    }
    __syncthreads();
}


enum { K_P0 = 0, K_IN = 1, K_MIX = 2, K_OUT = 3, K_UP = 5, K_FIX = 6, K_DOWN = 7, K_FINAL = 8 };
struct Step { int kind, layer, side, tile0, nt, pre; };
__device__ __forceinline__ Step get_step(int pc) {
    switch (pc) {
        case 0:  return Step{K_P0, 0, 0, 0, 0, 0};
        case 1:  return Step{K_IN, 0, 0, 0, 69, 1};
        case 2:  return Step{K_MIX, 0, 0, 0, 0, 1};
        case 3:  return Step{K_OUT, 0, 1, 64, 5, 2};
        case 4:  return Step{K_UP, 0, 1, 64, 5, 2};
        case 5:  return Step{K_DOWN, 0, 1, 64, 5, 2};
        case 6:  return Step{K_IN, 1, 1, 64, 5, 2};
        case 7:  return Step{K_OUT, 0, 0, 0, 64, 1};
        case 8:  return Step{K_UP, 0, 0, 0, 64, 1};
        case 9:  return Step{K_DOWN, 0, 0, 0, 64, 1};
        case 10: return Step{K_IN, 1, 0, 0, 64, 1};
        case 11: return Step{K_MIX, 1, 0, 0, 0, 1};
        case 12: return Step{K_OUT, 1, 1, 64, 5, 2};
        case 13: return Step{K_UP, 1, 1, 64, 5, 2};
        case 14: return Step{K_DOWN, 1, 1, 64, 5, 2};
        case 15: return Step{K_OUT, 1, 0, 0, 64, 1};
        case 16: return Step{K_UP, 1, 0, 0, 64, 1};
        default: return Step{K_DOWN, 1, 0, 0, 64, 1};
    }
}

__global__ void __launch_bounds__(NWAVES * 64, 2) fwd_kernel(Args args) {
    extern __shared__ __attribute__((aligned(16))) unsigned char lds_raw[];
    cg::grid_group grid = cg::this_grid();
    Frame F;
    F.lds = (LAS unsigned char*)lds_raw;
#define REFRESH() do { int t_ = threadIdx.x; asm volatile("" : "+v"(t_)); F.tid = t_; F.lane = t_ & 63; F.wave = __builtin_amdgcn_readfirstlane(t_ >> 6); F.gw = blockIdx.x * NWAVES + F.wave; } while (0)
    F.G = gridDim.x; F.NGW = F.G * NWAVES; REFRESH();
    F.in = args.in; F.out = args.out; F.ws = args.ws;
    volatile LAS unsigned* MISC = (volatile LAS unsigned*)(F.lds + LDSCTL_OFF);
    if (threadIdx.x < 16) MISC[threadIdx.x] = 0u;
    __syncthreads();
    const bool side_wg = blockIdx.x >= 64;
    (void)xcd_barrier_post((unsigned*)(args.ws + WS_CTL), MISC + 8, F.G);
    if (side_wg) (void)xcd_barrier_post((unsigned*)(args.ws + WS_CTL) + 4096, MISC + 10, F.G - 64);
#ifndef KMASK
#define KMASK 0x1ff
#endif
#define INK(kind) ((((KMASK) >> (kind)) & 1) != 0)
#ifndef PROBE_MULT
#define PROBE_MULT 1
#endif
#ifdef PROBE_BLOCK
    volatile LAS unsigned long long* STMP = (volatile LAS unsigned long long*)(F.lds + LDSCTL_OFF + 128);
    if (threadIdx.x < 64) STMP[threadIdx.x] = 0ull;
    __syncthreads();
#define STAMP(id) do { if (blockIdx.x == PROBE_BLOCK && threadIdx.x == 0) STMP[(id)] = __builtin_amdgcn_s_memrealtime(); } while (0)
#else
#define STAMP(id) do { } while (0)
#endif
#pragma unroll 1
    for (int pc = 0; pc < NSTEP; ++pc) {
        const Step st = get_step(pc);
        if (st.pre == 1) { if (args.ph_hi < 0) grid.sync();
            { XcdBarrier bar_; bar_.gsz = F.G; bar_.bar = (unsigned*)(args.ws + WS_CTL); bar_.x = xb_xcc_id(); bar_.st = (volatile LAS unsigned*)(F.lds + LDSCTL_OFF) + 8; xcd_barrier(bar_); } }
        if (st.side && !side_wg) continue;
        if (st.pre == 2) { XcdBarrier bar_; bar_.gsz = F.G - 64; bar_.bar = (unsigned*)(args.ws + WS_CTL) + 4096; bar_.x = xb_xcc_id(); bar_.st = (volatile LAS unsigned*)(F.lds + LDSCTL_OFF) + 10; xcd_barrier(bar_); }
        const int layer = st.layer;
        STAMP(2 * pc);
        const int Gs = st.side ? F.G - 64 : F.G, cs = st.side ? (int)blockIdx.x - 64 : (int)blockIdx.x;
        if (st.kind == K_P0) { if (INK(0)) { REFRESH(); p0_weights(F, 0, P0_DEFER ? P0_ITEMS_AB : -1, F.gw, F.NGW); STAMP(42); __syncthreads(); REFRESH(); p0_rows(F); STAMP(43); REFRESH(); p0_rotary(F, (float*)(args.ws + WS_ROT)); p0_zero_ssq(F); STAMP(44); } }
        else if (st.kind == K_IN) { if (INK(1)) {
            pg8::Gemm g{F_XG(F), (const bf16*)(args.ws + (layer == 0 ? WS_WAB : WS_WC)), MPAD, 4096, 1024}; pg8::StaticOrder S; S.init(st.nt, 4096, Gs, cs, st.tile0);
            if (layer == 0) { pg8::EpiBf16 E{F_Z(F), F_ZS1(F, layer), 64, 4096}; pg8::gemm_phase<pg8::EpiBf16, pg8::StaticOrder, false>(F.lds, g, S, E); }
            else { EpiHg E{F_Z(F), F_ZS1(F, layer), 64, 4096, (const float*)(args.ws + WS_LB), (float*)(args.ws + WS_GD), (float*)(args.ws + WS_GDS)}; pg8::gemm_phase<EpiHg, pg8::StaticOrder, false>(F.lds, g, S, E); }
            if (P0_DEFER && layer == 0 && !st.side) { const int nfull = (st.nt * 16) % Gs; if (nfull != 0 && cs >= nfull) { REFRESH(); p0_weights(F, P0_ITEMS_AB, -1, (cs - nfull) * NWAVES + F.wave, (Gs - nfull) * NWAVES); } else if (nfull == 0) { REFRESH(); p0_weights(F, P0_ITEMS_AB, -1, F.gw, F.NGW); } } } }
        else if (st.kind == K_MIX) { if (INK(2)) { REFRESH(); if (layer == 0) mixer_layer0(F); else mixer_layer1(F); } }
        else if (st.kind == K_OUT) { if (INK(3)) {
            pg8::Gemm g{F_XN(F), (const bf16*)(args.ws + (layer == 0 ? WS_WOAB : WS_WOC)), MPAD, 1024, 1024}; pg8::StaticOrder S; S.init(st.nt, 1024, Gs, cs, st.tile0);
            pg8::EpiResid E{F_X0(F), F_X1(F), PM_META, DM, F_XG(F), (float*)nullptr, 0, F.in[20] + (size_t)layer * DM, F_SSQ(F, 2 * layer), (unsigned*)(args.ws + WS_PCNT) + (2 * layer) * 69 * 16,
                layer == 0 ? F.in[0] : (const float*)nullptr, F.in[1] - (size_t)ROW_S * DM, F.in[8] - (size_t)ROW_M * DM, layer == 0 ? NREAL : MPAD};
            pg8::gemm_phase<pg8::EpiResid, pg8::StaticOrder, false>(F.lds, g, S, E); } }
        else if (st.kind == K_UP) { if (INK(5)) {
            pg8::Gemm g{F_XG(F), (const bf16*)(args.ws + WS_WF1) + (size_t)layer * NFF * 1024, MPAD, NFF, 1024}; pg8::StaticOrder S; S.init(st.nt, NFF, Gs, cs, st.tile0);
            EpiFfn E{F_Z(F), F_HS1(F), F.in[22] + (size_t)layer * 3 * DFF, F.in[23] + (size_t)layer * DFF, F.in[7] + (size_t)layer * 128 * 2 * DFF, F.out + O_FS + (size_t)layer * 128 * 2 * DFF, F_SBL(F), F_SBF(F)};
            pg8::gemm_phase<EpiFfn, pg8::StaticOrder, true>(F.lds, g, S, E); } }
        else if (st.kind == K_DOWN) { if (INK(7)) {
            pg8::Gemm g{st.side ? F_HS1(F) : F_Z(F), (const bf16*)(args.ws + WS_WF2) + (size_t)layer * 1024 * DFF, MPAD, 1024, DFF}; pg8::StaticOrder S; S.init(st.nt, 1024, Gs, cs, st.tile0);
            if (!st.side) {
                REFRESH(); pg8::StaticOrder S2; S2.init(st.nt, 1024, Gs, cs, st.tile0); pg8::Unit fu; for (int i = 0; S2.next(i, fu); ++i) ffn_fixup_tile(F, layer, fu.pm, fu.pn == 0);
                asm volatile("s_waitcnt vmcnt(0)" ::: "memory"); __syncthreads(); }
            pg8::EpiResid E{F_X0(F), F_X1(F), PM_META, DM, F_XG(F), layer == 0 ? (float*)nullptr : F.out, ROW_M, layer == 0 ? F.in[9] + DM : F.in[25], F_SSQ(F, 2 * layer + 1), (unsigned*)(args.ws + WS_PCNT) + (2 * layer + 1) * 69 * 16,
                (const float*)nullptr, (const float*)nullptr, (const float*)nullptr, MPAD};
            pg8::gemm_phase<pg8::EpiResid, pg8::StaticOrder, false>(F.lds, g, S, E); } }
        STAMP(2 * pc + 1);
    }
#ifdef PROBE_BLOCK
    if (blockIdx.x == PROBE_BLOCK && threadIdx.x == 0) { const unsigned long long d = (STMP[PROBE_B] - STMP[PROBE_A]) * PROBE_MULT, t0 = __builtin_amdgcn_s_memrealtime(); while (__builtin_amdgcn_s_memrealtime() - t0 < d) __builtin_amdgcn_s_sleep(8); }
#endif
#undef INK
#undef REFRESH
}

extern "C" void kernel_launch(void* const* d_in, const int* in_sizes, int n_in, void* d_out, int out_size, void* d_ws, size_t ws_size, hipStream_t stream) {
    static int grid = 0;
    if (grid == 0) {
        if (n_in != 26 || (size_t)out_size != O_END || ws_size < WS_END) { fprintf(stderr, "kernel_launch: unexpected shapes: n_in %d out %d ws %zu\n", n_in, out_size, ws_size); grid = -1; return; }
        int dev = 0, cus = 0, per_cu = 0;
        if (hipGetDevice(&dev) != hipSuccess || hipDeviceGetAttribute(&cus, hipDeviceAttributeMultiprocessorCount, dev) != hipSuccess) { grid = -1; return; }
        if (hipFuncSetAttribute((const void*)fwd_kernel, hipFuncAttributeMaxDynamicSharedMemorySize, LDS_BYTES) != hipSuccess) { fprintf(stderr, "kernel_launch: hipFuncSetAttribute failed\n"); grid = -1; return; }
        if (hipOccupancyMaxActiveBlocksPerMultiprocessor(&per_cu, (const void*)fwd_kernel, NWAVES * 64, LDS_BYTES) != hipSuccess || per_cu < 1) { fprintf(stderr, "kernel_launch: occupancy query says %d\n", per_cu); per_cu = 1; }
        (void)hipGetLastError();
        grid = cus;
        if (grid != 256) { fprintf(stderr, "kernel_launch: the fused row-norm exchange needs one unit per workgroup in the N = 1024 GEMM steps: exactly 256 CUs (got %d)\n", grid); grid = -1; return; }
        if (grid < 128) { fprintf(stderr, "kernel_launch: this kernel's static work split needs >= 128 CUs (got %d)\n", grid); grid = -1; return; }
    }
    if (grid < 0) return;
    if (hipMemsetAsync((char*)d_ws + WS_CTL, 0, CTL_ZERO_BYTES, stream) != hipSuccess) { fprintf(stderr, "kernel_launch: hipMemsetAsync failed\n"); return; }
    Args a{};
    for (int i = 0; i < 26; ++i) a.in[i] = (const float*)d_in[i];
    a.out = (float*)d_out; a.ws = (unsigned char*)d_ws;
    a.ph_lo = 0; a.ph_hi = NSTEP;
    void* kargs[] = {&a};
    hipError_t e = hipLaunchCooperativeKernel((const void*)fwd_kernel, dim3(grid), dim3(NWAVES * 64), kargs, LDS_BYTES, stream);
    if (e != hipSuccess) fprintf(stderr, "kernel_launch: cooperative launch failed: %s (grid %d)\n", hipGetErrorString(e), grid);
}
```

```cpp
#include <hip/hip_runtime.h>
#include <hip/hip_cooperative_groups.h>
#include <cstdio>
#include <cstdint>
namespace cg = cooperative_groups;

namespace pg8 {
#define PG8_LAS __attribute__((address_space(3)))
typedef unsigned short bf16_t;
typedef short bf16x8 __attribute__((ext_vector_type(8)));
typedef float f32x4 __attribute__((ext_vector_type(4)));
typedef unsigned u32x4 __attribute__((ext_vector_type(4)));
typedef unsigned u32x2 __attribute__((ext_vector_type(2)));
constexpr int BM = 256, BK = 64, HALF = 128, HTB = HALF * BK * 2  , STAGE_BYTES = 8 * HTB, NXCD = 8, WGM = 8;

__host__ __device__ __forceinline__ int lds_byte(int r, int c) { const int st = (r >> 4) * 2 + (c >> 5), rr = r & 15, cc = c & 31, ob = rr * 64 + cc * 2; return st * 1024 + (ob ^ (((ob >> 9) & 1) << 5)); }
__host__ __device__ __forceinline__ void stage_rc(int b, int& R, int& C) { const int st = b / 1024, sb = b % 1024, swz = sb ^ (((sb >> 9) & 1) << 5); R = (st >> 1) * 16 + swz / 64; C = (st & 1) * 32 + (swz % 64) / 2; }
__host__ __device__ __forceinline__ int perm32(int rho) { const int n = rho >> 4, i = rho & 15; return 8 * (i >> 2) + 4 * n + (i & 3); }

struct Unit { int pm, pn; };
struct Gemm { const bf16_t* A; const bf16_t* Bt; int M, N, K; };

struct StaticOrder {
    int nM, nN, nwg, G, c, pm0;
    __host__ __device__ __forceinline__ void init(int nMt, int N, int G_, int c_, int pm0_) { nM = nMt; nN = N / BM; nwg = nM * nN; G = G_; c = c_; pm0 = pm0_; }
    __host__ __device__ __forceinline__ bool next(int i, Unit& u) const {
        const long L = (long)i * G + c; if (L >= nwg) return false;
        int wgid = (int)L; { const int q = nwg / NXCD, r = nwg % NXCD, xcd = wgid % NXCD, off = wgid / NXCD; wgid = (xcd < r ? xcd * (q + 1) : r * (q + 1) + (xcd - r) * q) + off; }
        const int nig = WGM * nN, gid = wgid / nig, fm = gid * WGM, gsz = (nM - fm) < WGM ? (nM - fm) : WGM;
        u.pm = pm0 + fm + ((wgid % nig) % gsz); u.pn = (wgid % nig) / gsz; return true;
    }
    __device__ __forceinline__ void a_ready(const Unit&) const {}
    __device__ __forceinline__ void done(const Unit&) const {}
};

__device__ __forceinline__ unsigned cvt_pk_bf16(float lo, float hi) { unsigned r; asm volatile("v_cvt_pk_bf16_f32 %0, %1, %2" : "=v"(r) : "v"(lo), "v"(hi)); return r; }

struct EpiBf16 {
    static constexpr bool PERM = true, AFTER_DRAIN = false;
    bf16_t* O0; bf16_t* O1; int pm_split; int ldc;
    __device__ __forceinline__ void operator()(f32x4 (&acc)[2][2][4][2], const Unit& u, int wr, int wc, int fr, int fq) const {
        bf16_t* O = (u.pm < pm_split) ? O0 : O1;
        const int row0 = u.pm * BM + wr * 64 + fr; const int col0 = u.pn * BM + wc * 32 + 8 * fq;
#pragma unroll
        for (int ai = 0; ai < 2; ++ai)
#pragma unroll
            for (int m = 0; m < 4; ++m) { bf16_t* rowp = O + (size_t)(row0 + ai * HALF + m * 16) * ldc + col0;
#pragma unroll
                for (int bj = 0; bj < 2; ++bj) { const f32x4 v0 = acc[ai][bj][m][0], v1 = acc[ai][bj][m][1];
                    u32x4 w; w.x = cvt_pk_bf16(v0[0], v0[1]); w.y = cvt_pk_bf16(v0[2], v0[3]); w.z = cvt_pk_bf16(v1[0], v1[1]); w.w = cvt_pk_bf16(v1[2], v1[3]);
                    *(u32x4*)(rowp + bj * HALF) = w; } }
    }
};

struct EpiResid {
    static constexpr bool PERM = true, AFTER_DRAIN = false;
    float* X0; float* X1; int pm_split; int ldc; bf16_t* XG; float* Y; int yrows; const float* gain; float* ssq; unsigned* cnt;
    const float* R0; const float* R1; const float* R2; int nreal;
    __device__ __forceinline__ void operator()(f32x4 (&acc)[2][2][4][2], const Unit& u, int wr, int wc, int fr, int fq) const {
        float* C = (u.pm < pm_split) ? X0 : X1;
        const float* Rsrc = R0 ? (u.pm < 64 ? R0 : u.pm < pm_split ? R1 : R2) : (const float*)C;
        const int row0 = u.pm * BM + wr * 64 + fr, col0 = u.pn * BM + wc * 32 + 8 * fq;
#pragma unroll
        for (int ai = 0; ai < 2; ++ai)
#pragma unroll
            for (int mp = 0; mp < 2; ++mp) {
                f32x4 t[2][2][2];
#pragma unroll
                for (int mm = 0; mm < 2; ++mm) { const int rr_ = row0 + ai * HALF + (2 * mp + mm) * 16; const float* rowp = Rsrc + (size_t)rr_ * ldc + col0; const bool have = rr_ < nreal;
#pragma unroll
                    for (int bj = 0; bj < 2; ++bj)
#pragma unroll
                        for (int n = 0; n < 2; ++n) t[mm][bj][n] = have ? *(const f32x4*)(rowp + bj * HALF + 4 * n) : (f32x4){0.f, 0.f, 0.f, 0.f}; }
#pragma unroll
                for (int mm = 0; mm < 2; ++mm) { const int m = 2 * mp + mm; const int row = row0 + ai * HALF + m * 16; float* rowp = C + (size_t)row * ldc + col0; float sq = 0.f;
#pragma unroll
                    for (int bj = 0; bj < 2; ++bj)
#pragma unroll
                        for (int n = 0; n < 2; ++n) { const f32x4 v = t[mm][bj][n] + acc[ai][bj][m][n]; acc[ai][bj][m][n] = v; if (!Y) *(f32x4*)(rowp + bj * HALF + 4 * n) = v;
                            sq += (v[0] * v[0] + v[1] * v[1]) + (v[2] * v[2] + v[3] * v[3]); }
                    sq += __shfl_xor(sq, 16); sq += __shfl_xor(sq, 32); if (fq == 0) atomicAdd(ssq + row, sq); }
                asm volatile("" ::: "memory"); }
        asm volatile("s_waitcnt vmcnt(0)" ::: "memory");
        unsigned* pc = cnt + u.pm * 16;
        if (fr == 0 && fq == 0) {
            __hip_atomic_fetch_add(pc, 1u, __ATOMIC_RELAXED, __HIP_MEMORY_SCOPE_AGENT);
            unsigned sp = 0u;
            while (__hip_atomic_load(pc, __ATOMIC_RELAXED, __HIP_MEMORY_SCOPE_AGENT) < 32u) { __builtin_amdgcn_s_sleep(1); if (++sp > (1u << 22)) break; }
        }
        asm volatile("" ::: "memory");
        f32x4 gv[2][2];
#pragma unroll
        for (int bj = 0; bj < 2; ++bj)
#pragma unroll
            for (int n = 0; n < 2; ++n) gv[bj][n] = *(const f32x4*)(gain + col0 + bj * HALF + 4 * n);
#pragma unroll
        for (int ai = 0; ai < 2; ++ai)
#pragma unroll
            for (int m = 0; m < 4; ++m) { const int row = row0 + ai * HALF + m * 16;
                const float rs = __builtin_amdgcn_rsqf(__hip_atomic_load(ssq + row, __ATOMIC_RELAXED, __HIP_MEMORY_SCOPE_AGENT) * (1.0f / 1024.0f) + 1e-6f);
#pragma unroll
                for (int bj = 0; bj < 2; ++bj) { const f32x4 y0 = acc[ai][bj][m][0] * rs * gv[bj][0], y1 = acc[ai][bj][m][1] * rs * gv[bj][1];
                    if (Y) { if (row < yrows) { *(f32x4*)(Y + (size_t)row * ldc + col0 + bj * HALF) = y0; *(f32x4*)(Y + (size_t)row * ldc + col0 + bj * HALF + 4) = y1; } }
                    else { u32x4 w; w.x = cvt_pk_bf16(y0[0], y0[1]); w.y = cvt_pk_bf16(y0[2], y0[3]); w.z = cvt_pk_bf16(y1[0], y1[1]); w.w = cvt_pk_bf16(y1[2], y1[3]);
                        *(u32x4*)(XG + (size_t)row * ldc + col0 + bj * HALF) = w; } } }
    }
};

template <class Epi, class Sched, bool APERM>
__device__ __forceinline__ void gemm_phase(PG8_LAS unsigned char* lds, const Gemm g, const Sched& S, const Epi& E) {
    int tid_ = threadIdx.x; asm volatile("" : "+v"(tid_));
    const int tid = tid_, wid = __builtin_amdgcn_readfirstlane(tid >> 6), lane = tid & 63, wr = wid >> 2, wc = wid & 3, fr = lane & 15, fq = lane >> 4;
    const int K = g.K, nt = K / BK;
    unsigned voffA[2], voffB[2];
#pragma unroll
    for (int i = 0; i < 2; ++i) { int R, C; stage_rc(tid * 16 + i * 8192, R, C); const int Rb = Epi::PERM ? ((R & ~31) + perm32(R & 31)) : R;
        const int Ra = APERM ? (128 * (R >> 6) + 8 * (R & 15) + ((R >> 4) & 3)) : R;
        voffA[i] = (unsigned)(Ra * K + C) * 2u; voffB[i] = (unsigned)(Rb * K + C) * 2u; }
    const size_t kstep = (size_t)(BK * 2);
    const size_t hstep = (size_t)HALF * K * 2;
    const size_t hstepA = APERM ? (size_t)4 * K * 2 : hstep;
    const size_t tstep = 2 * hstep;
    const unsigned ldsw = (unsigned)wid * 1024u;
    const int aoff = lds_byte(wr * 64 + fr, fq * 8), boff = lds_byte(wc * 32 + fr, fq * 8);
#define PG8_SA(b, h) (((b) * 2 + (h)) * HTB)
#define PG8_SB(b, h) ((4 + (b) * 2 + (h)) * HTB)
#define PG8_STAGE(bufoff, gbase, voff) do { _Pragma("unroll") for (int _i = 0; _i < 2; ++_i) \
        __builtin_amdgcn_global_load_lds((const unsigned*)((const char*)(gbase) + (voff)[_i]), (PG8_LAS unsigned*)(lds + (bufoff) + ldsw + _i * 8192), 16, 0, 0); } while (0)
#define PG8_LDA(dst, b, h) do { _Pragma("unroll") for (int m = 0; m < 4; ++m) _Pragma("unroll") for (int k = 0; k < 2; ++k) dst[m][k] = *(const PG8_LAS bf16x8*)(lds + PG8_SA(b, h) + aoff + m * 2048 + k * 1024); } while (0)
#define PG8_LDB(dst, b, h) do { _Pragma("unroll") for (int n = 0; n < 2; ++n) _Pragma("unroll") for (int k = 0; k < 2; ++k) dst[n][k] = *(const PG8_LAS bf16x8*)(lds + PG8_SB(b, h) + boff + n * 2048 + k * 1024); } while (0)
#define PG8_MMA(ai, bj, At, Bt) do { __builtin_amdgcn_s_setprio(1); _Pragma("unroll") for (int m = 0; m < 4; ++m) _Pragma("unroll") for (int n = 0; n < 2; ++n) _Pragma("unroll") for (int k = 0; k < 2; ++k) \
        acc[ai][bj][m][n] = __builtin_amdgcn_mfma_f32_16x16x32_bf16(Bt[n][k], At[m][k], acc[ai][bj][m][n], 0, 0, 0); __builtin_amdgcn_s_setprio(0); } while (0)
#define PG8_WAIT_V(n) asm volatile("s_waitcnt vmcnt(" #n ")" ::: "memory")
#define PG8_WAIT_L(n) asm volatile("s_waitcnt lgkmcnt(" #n ")" ::: "memory")
#define PG8_BAR __builtin_amdgcn_s_barrier()
#define PG8_SCHED __builtin_amdgcn_sched_barrier(0)
    Unit cur, nxt; int ui = 0;
    if (!S.next(0, cur)) return;
    f32x4 acc[2][2][4][2];
#pragma unroll
    for (int a = 0; a < 2; ++a)
#pragma unroll
        for (int b = 0; b < 2; ++b)
#pragma unroll
            for (int m = 0; m < 4; ++m)
#pragma unroll
                for (int n = 0; n < 2; ++n) acc[a][b][m][n] = (f32x4){0.f, 0.f, 0.f, 0.f};
    bf16x8 At[4][2], B0[2][2], B1[2][2];
    const char* cA = (const char*)g.A + (size_t)cur.pm * tstep; const char* cB = (const char*)g.Bt + (size_t)cur.pn * tstep;
    S.a_ready(cur);
    PG8_STAGE(PG8_SB(0, 0), cB, voffB); PG8_STAGE(PG8_SB(0, 1), cB + hstep, voffB); PG8_STAGE(PG8_SA(0, 0), cA, voffA); PG8_STAGE(PG8_SA(0, 1), cA + hstepA, voffA);
    if (wr == 1) PG8_BAR;
    PG8_WAIT_V(2); PG8_BAR;
    PG8_STAGE(PG8_SB(1, 0), cB + kstep, voffB); PG8_STAGE(PG8_SA(1, 0), cA + kstep, voffA); PG8_STAGE(PG8_SB(1, 1), cB + hstep + kstep, voffB);
    PG8_WAIT_V(6); PG8_BAR;
    for (;;) {
        const bool has_next = S.next(ui + 1, nxt);
        const char* nA = has_next ? (const char*)g.A + (size_t)nxt.pm * tstep : cA; const char* nB = has_next ? (const char*)g.Bt + (size_t)nxt.pn * tstep : cB;
        for (int t = 0; t < nt; t += 2) {
            const bool last = (t == nt - 2);
            const char* a1 = cA + (size_t)(t + 1) * kstep;
            const char* a2 = last ? nA : cA + (size_t)(t + 2) * kstep; const char* b2 = last ? nB : cB + (size_t)(t + 2) * kstep;
            const char* a3 = a2 + kstep; const char* b3 = b2 + kstep;
            if (last && has_next) S.a_ready(nxt);
            PG8_LDB(B0, 0, 0); PG8_LDB(B1, 0, 1); PG8_SCHED; PG8_LDA(At, 0, 0); PG8_STAGE(PG8_SA(1, 1), a1 + hstepA, voffA);
            PG8_WAIT_V(8); PG8_WAIT_L(0); PG8_BAR; PG8_MMA(0, 0, At, B0); PG8_MMA(0, 1, At, B1); PG8_BAR; PG8_SCHED;
            PG8_LDA(At, 0, 1); PG8_STAGE(PG8_SB(0, 0), b2, voffB); PG8_STAGE(PG8_SB(0, 1), b2 + hstep, voffB); PG8_STAGE(PG8_SA(0, 0), a2, voffA);
            PG8_WAIT_V(8); PG8_WAIT_L(0); PG8_BAR; PG8_MMA(1, 0, At, B0); PG8_MMA(1, 1, At, B1); PG8_BAR; PG8_SCHED;
            PG8_LDB(B0, 1, 0); PG8_LDB(B1, 1, 1); PG8_SCHED; PG8_LDA(At, 1, 0); PG8_STAGE(PG8_SA(0, 1), a2 + hstepA, voffA);
            PG8_WAIT_V(8); PG8_WAIT_L(0); PG8_BAR; PG8_MMA(0, 0, At, B0); PG8_MMA(0, 1, At, B1); PG8_BAR; PG8_SCHED;
            PG8_LDA(At, 1, 1); PG8_STAGE(PG8_SB(1, 0), b3, voffB); PG8_STAGE(PG8_SB(1, 1), b3 + hstep, voffB); PG8_STAGE(PG8_SA(1, 0), a3, voffA);
            PG8_WAIT_V(8); PG8_WAIT_L(0); PG8_BAR; PG8_MMA(1, 0, At, B0); PG8_MMA(1, 1, At, B1); PG8_BAR; PG8_SCHED;
        }
        if (wr == 0) PG8_BAR;
        E(acc, cur, wr, wc, fr, fq); S.done(cur);
        if (!has_next) break;
#pragma unroll
        for (int a = 0; a < 2; ++a)
#pragma unroll
            for (int b = 0; b < 2; ++b)
#pragma unroll
                for (int m = 0; m < 4; ++m)
#pragma unroll
                    for (int n = 0; n < 2; ++n) acc[a][b][m][n] = (f32x4){0.f, 0.f, 0.f, 0.f};
        cur = nxt; cA = nA; cB = nB; ++ui;
        if (wr == 1) PG8_BAR;
    }
    PG8_WAIT_V(0);
    PG8_BAR;
#undef PG8_SA
#undef PG8_SB
#undef PG8_STAGE
#undef PG8_LDA
#undef PG8_LDB
#undef PG8_MMA
#undef PG8_WAIT_V
#undef PG8_WAIT_L
#undef PG8_BAR
#undef PG8_SCHED
}
}
constexpr int DM = 1024;
constexpr int ROW_S = 16384;
constexpr int ROW_M = 17408;
constexpr int NREAL = 17424;
constexpr int MPAD = 17664;
constexpr int PM_META = 68;
constexpr int NAB = 4096, NCC = 4096, DFF = 2816, NFF = 5632, ABW = 4104;
constexpr int NGRP = 138, GRP_META = 136;
constexpr float EPS = 1e-6f;
constexpr float KSCALE = 0.08838834764831845f;

constexpr size_t O_YP = 0, O_YS = 16777216, O_CP = 17825792, O_CS = 18350080, O_NP = 26738688, O_NS = 26742784, O_MP = 26808320, O_MS = 26808352,
                 O_RP = 26808864, O_RS = 27333152, O_HP = 35721760, O_HS = 36770336, O_FP = 53547552, O_FS = 53637664, O_END = 55079456;

constexpr size_t MiB = 1u << 20;
constexpr size_t WS_CTL = 0, CTL_ZERO_BYTES = 128 * 1024;
constexpr size_t WS_PCNT = 64 * 1024;
constexpr size_t WS_WAB = 1 * MiB, WS_WOAB = 9 * MiB, WS_WC = 11 * MiB, WS_WOC = 19 * MiB, WS_WF1 = 21 * MiB  , WS_WF2 = 43 * MiB  ;
constexpr size_t WS_XN = 54 * MiB;
constexpr size_t WS_Z = 89 * MiB;
constexpr size_t WS_GD = 217 * MiB;
constexpr size_t WS_GDS = 222 * MiB;
constexpr size_t WS_LB = 223 * MiB;
constexpr size_t WS_XM = 227 * MiB;
constexpr size_t WS_G = 228 * MiB;
constexpr size_t WS_SBL = 229 * MiB;
constexpr size_t WS_SBF = 233 * MiB;
constexpr size_t WS_ROT = 240 * MiB;
constexpr size_t WS_XG = 242 * MiB;
constexpr size_t WS_SSQ = 277 * MiB;
constexpr size_t WS_ZS = 279 * MiB;
constexpr size_t WS_ZS2 = 290 * MiB;
constexpr size_t WS_HS = 301 * MiB;
constexpr size_t WS_END = 309 * MiB;
static_assert(WS_XN + (size_t)MPAD * DM * 2 <= WS_Z && WS_Z + (size_t)MPAD * 4096 * 2 <= WS_XM && WS_SBL + (size_t)NGRP * 2 * DFF * 4 <= WS_SBF && WS_SBF + (size_t)NGRP * 4 * DFF * 4 <= WS_END, "ws map");

constexpr int P0_ITEMS_L0 = 16 * 128 + 16 * 32 + 16 * 128 + 16 * 176 + 44 * 32, P0_ITEMS_ALL = P0_ITEMS_L0 + 16 * 32 + 16 * 176 + 44 * 32;
constexpr int P0_ITEMS_AB = 16 * 128;
constexpr int LDS_BYTES = 147456;
constexpr int NWAVES = 8;

#define GAS __attribute__((address_space(1)))
#define LAS __attribute__((address_space(3)))
typedef unsigned short bf16;
typedef float f32x4 __attribute__((ext_vector_type(4)));
typedef unsigned u32x2 __attribute__((ext_vector_type(2)));
typedef unsigned u32x4 __attribute__((ext_vector_type(4)));
#define LDS_WAIT() asm volatile("s_waitcnt lgkmcnt(0)" ::: "memory")

__device__ __forceinline__ unsigned f2bf(float f) { unsigned u = __builtin_bit_cast(unsigned, f); return (u + 0x7fffu + ((u >> 16) & 1u)) >> 16; }
__device__ __forceinline__ unsigned pk2(float lo, float hi) { return f2bf(lo) | (f2bf(hi) << 16); }
__device__ __forceinline__ float bf2f(unsigned short b) { return __builtin_bit_cast(float, ((unsigned)b) << 16); }
__device__ __forceinline__ float bflo(unsigned w) { return __builtin_bit_cast(float, w << 16); }
__device__ __forceinline__ float bfhi(unsigned w) { return __builtin_bit_cast(float, w & 0xffff0000u); }
__device__ __forceinline__ f32x4 ld_bf4(const bf16* p) { const u32x2 w = *(const u32x2*)p; return (f32x4){bflo(w.x), bfhi(w.x), bflo(w.y), bfhi(w.y)}; }
__device__ __forceinline__ float wave_sum(float v) {
#pragma unroll
    for (int o = 1; o < 64; o <<= 1) v += __shfl_xor(v, o);
    return v;
}
__device__ __forceinline__ float half_sum(float v) {
#pragma unroll
    for (int o = 1; o < 32; o <<= 1) v += __shfl_xor(v, o);
    return v;
}
__device__ __forceinline__ float sigmoidf_(float x) { return 1.f / (1.f + __expf(-x)); }
__device__ __forceinline__ float siluf_(float x) { return x / (1.f + __expf(-x)); }
__device__ __forceinline__ float logsigmoidf_(float x) { return fminf(x, 0.f) - __logf(1.f + __expf(-fabsf(x))); }

struct Args { const float* in[26]; float* out; unsigned char* ws; int ph_lo, ph_hi; };

struct Frame {
    LAS unsigned char* lds;
    int tid, lane, wave, G, gw, NGW;
    const float* const* in; float* out; unsigned char* ws;
};
#define F_X0(F) ((F).out)
#define F_X1(F) ((float*)((F).ws + WS_XM) - (size_t)ROW_M * DM)
#define F_XN(F) ((bf16*)((F).ws + WS_XN))
#define F_XG(F) ((bf16*)((F).ws + WS_XG))
#define F_SSQ(F, i) ((float*)((F).ws + WS_SSQ) + (size_t)(i) * MPAD)
#define F_Z(F) ((bf16*)((F).ws + WS_Z))
#define F_ZS1(F, layer) ((bf16*)((F).ws + ((layer) == 0 ? WS_ZS : WS_ZS2)) - (size_t)ROW_S * 4096)
#define F_HS1(F) ((bf16*)((F).ws + WS_HS) - (size_t)ROW_S * DFF)
#define ZROW(F, row, layer) (((row) < ROW_S ? F_Z(F) : F_ZS1(F, layer)) + (size_t)(row) * 4096)
#define F_GT(F) ((float*)((F).ws + WS_G))
#define F_SBL(F) ((float*)((F).ws + WS_SBL))
#define F_SBF(F) ((float*)((F).ws + WS_SBF))
__device__ __forceinline__ float* xrow(const Frame& F, int r) { return (r < ROW_M ? F_X0(F) : F_X1(F)) + (size_t)r * DM; }

__device__ __forceinline__ void p0_transpose_item(const float* W, int K, int Nsrc, int n0src, bf16* WT, int dstrow0, LAS float* scr, int kb, int lane) {
    const int k0 = 64 * kb;
    f32x4 v[8];
#pragma unroll
    for (int i = 0; i < 8; ++i) v[i] = *(const f32x4*)(W + (size_t)(k0 + 8 * i + (lane >> 3)) * Nsrc + n0src + 4 * (lane & 7));
#pragma unroll
    for (int i = 0; i < 8; ++i) { LAS float* d = scr + (8 * i + (lane >> 3)) * 33 + 4 * (lane & 7); d[0] = v[i][0]; d[1] = v[i][1]; d[2] = v[i][2]; d[3] = v[i][3]; }
    LDS_WAIT(); asm volatile("" ::: "memory");
    const int c = lane & 7;
#pragma unroll
    for (int j = 0; j < 4; ++j) { const int n = (lane >> 3) + 8 * j; const LAS float* s = scr + (8 * c) * 33 + n;
        u32x4 o; o.x = pk2(s[0 * 33], s[1 * 33]); o.y = pk2(s[2 * 33], s[3 * 33]); o.z = pk2(s[4 * 33], s[5 * 33]); o.w = pk2(s[6 * 33], s[7 * 33]);
        *(u32x4*)(WT + (size_t)(dstrow0 + n) * K + k0 + 8 * c) = o; }
    LDS_WAIT(); asm volatile("" ::: "memory");
}

__device__ __forceinline__ void p0_weights(Frame& F, int it0, int it1, int gw, int ngw) {
    LAS float* scr = (LAS float*)(F.lds + F.wave * 16384);
    constexpr int I_AB = 16 * 128, I_O = 16 * 32, I_C = 16 * 128, I_F1 = 16 * 176, I_F2 = 44 * 32;
    for (int it = it0 + gw; it < it1; it += ngw) {
        int r = it;
        if (r < I_AB) { const int kb = r / 128, nb = r % 128; p0_transpose_item(F.in[10], 1024, ABW, nb < 64 ? 32 * nb : 32 * nb + 8, (bf16*)(F.ws + WS_WAB), 32 * nb, scr, kb, F.lane); continue; } r -= I_AB;
        if (r < I_O) { const int kb = r / 32, nb = r % 32; p0_transpose_item(F.in[15], 1024, 1024, 32 * nb, (bf16*)(F.ws + WS_WOAB), 32 * nb, scr, kb, F.lane); continue; } r -= I_O;
        if (r < I_C) { const int kb = r / 128, nb = r % 128; const int c = 32 * nb;
            const int dst = c < 1024 ? 256 * (c / 128) + (c % 128) : c < 2048 ? 256 * ((c - 1024) / 128) + 128 + (c % 128) : c;
            p0_transpose_item(F.in[17], 1024, 4096, c, (bf16*)(F.ws + WS_WC), dst, scr, kb, F.lane); continue; } r -= I_C;
        int l = 0;
        if (r >= I_F1 + I_F2) { r -= I_F1 + I_F2; l = 1;
            if (r < I_O) { const int kb = r / 32, nb = r % 32; p0_transpose_item(F.in[19], 1024, 1024, 32 * nb, (bf16*)(F.ws + WS_WOC), 32 * nb, scr, kb, F.lane); continue; } r -= I_O; }
        if (r < I_F1) { const int kb = r / 176, nb = r % 176; const int c = 32 * nb;
            const int ch = c < DFF ? c : c - DFF; const int dst = 256 * (ch / 128) + (c < DFF ? 0 : 128) + (ch % 128);
            p0_transpose_item(F.in[21] + (size_t)l * 1024 * NFF, 1024, NFF, c, (bf16*)(F.ws + WS_WF1) + (size_t)l * NFF * 1024, dst, scr, kb, F.lane); continue; } r -= I_F1;
        { const int kb = r / 32, nb = r % 32;
            p0_transpose_item(F.in[24] + (size_t)l * DFF * 1024, DFF, 1024, 32 * nb, (bf16*)(F.ws + WS_WF2) + (size_t)l * 1024 * DFF, 32 * nb, scr, kb, F.lane); }
    }
}

__device__ __forceinline__ void p0_rows(Frame& F) {
    LAS float* wg = (LAS float*)F.lds;
    for (int i = F.tid; i < 8192; i += NWAVES * 64) { const int k = i >> 3, c = i & 7; wg[c * 1024 + k] = F.in[10][(size_t)k * ABW + 2048 + c]; }
    __syncthreads();
    const float* gain = F.in[9];
    f32x4 gn[4];
#pragma unroll
    for (int j = 0; j < 4; ++j) gn[j] = *(const f32x4*)(gain + 4 * F.lane + 256 * j);
#define P0_ROWSRC(r) ((r) < ROW_S ? F.in[0] + (size_t)(r) * DM : (r) < ROW_M ? F.in[1] + (size_t)((r) - ROW_S) * DM : (r) < NREAL ? F.in[8] + (size_t)((r) - ROW_M) * DM : (const float*)nullptr)
    f32x4 v[4], vn[4];
    { const float* src = F.gw < MPAD ? P0_ROWSRC(F.gw) : nullptr;
#pragma unroll
      for (int j = 0; j < 4; ++j) vn[j] = src ? *(const f32x4*)(src + 4 * F.lane + 256 * j) : (f32x4){0.f, 0.f, 0.f, 0.f}; }
#pragma unroll 1
    for (int r = F.gw; r < MPAD; r += F.NGW) {
#pragma unroll
        for (int j = 0; j < 4; ++j) v[j] = vn[j];
        { const int rn = r + F.NGW; const float* src = rn < MPAD ? P0_ROWSRC(rn) : nullptr;
#pragma unroll
          for (int j = 0; j < 4; ++j) vn[j] = src ? *(const f32x4*)(src + 4 * F.lane + 256 * j) : (f32x4){0.f, 0.f, 0.f, 0.f}; }
        float ss = 0.f;
#pragma unroll
        for (int j = 0; j < 4; ++j) ss += (v[j].x * v[j].x + v[j].y * v[j].y) + (v[j].z * v[j].z + v[j].w * v[j].w);
        const float rs = rsqrtf(wave_sum(ss) * (1.f / DM) + EPS);
        bf16* xn = F_XG(F) + (size_t)r * DM;
        float ga[8];
#pragma unroll
        for (int c = 0; c < 8; ++c) ga[c] = 0.f;
#pragma unroll
        for (int j = 0; j < 4; ++j) {
            const f32x4 y = v[j] * rs * gn[j];
            u32x2 w; w.x = pk2(y.x, y.y); w.y = pk2(y.z, y.w);
            *(u32x2*)(xn + 4 * F.lane + 256 * j) = w;
#pragma unroll
            for (int c = 0; c < 8; ++c) { const f32x4 wv = *(const LAS f32x4*)(wg + c * 1024 + 4 * F.lane + 256 * j); ga[c] += (y.x * wv.x + y.y * wv.y) + (y.z * wv.z + y.w * wv.w); }
        }
        float g4[4], g2[2], g1;
        { const bool hi = (F.lane & 32) != 0;
#pragma unroll
          for (int c = 0; c < 4; ++c) { const float keep = hi ? ga[4 + c] : ga[c], send = hi ? ga[c] : ga[4 + c]; g4[c] = keep + __shfl_xor(send, 32); } }
        { const bool hi = (F.lane & 16) != 0;
#pragma unroll
          for (int c = 0; c < 2; ++c) { const float keep = hi ? g4[2 + c] : g4[c], send = hi ? g4[c] : g4[2 + c]; g2[c] = keep + __shfl_xor(send, 16); } }
        { const bool hi = (F.lane & 8) != 0; const float keep = hi ? g2[1] : g2[0], send = hi ? g2[0] : g2[1]; g1 = keep + __shfl_xor(send, 8); }
        g1 += __shfl_xor(g1, 4); g1 += __shfl_xor(g1, 2); g1 += __shfl_xor(g1, 1);
        if ((F.lane & 7) == 0) F_GT(F)[(size_t)r * 8 + ((F.lane >> 5) & 1) * 4 + ((F.lane >> 4) & 1) * 2 + ((F.lane >> 3) & 1)] = g1;
    }
#undef P0_ROWSRC
}

__device__ __forceinline__ void p0_zero_ssq(Frame& F) { const int gt = blockIdx.x * (NWAVES * 64) + F.tid, NT = F.G * NWAVES * 64; for (int i = gt; i < 4 * MPAD; i += NT) F_SSQ(F, 0)[i] = 0.f;
    if (gt < 1024) ((float*)(F.ws + WS_LB))[gt] = sigmoidf_(F.in[16][1024 + gt] - F.in[16][gt]); }
__device__ __forceinline__ float dpp_row_shr1(float x) { return __builtin_bit_cast(float, __builtin_amdgcn_update_dpp(__builtin_bit_cast(int, x), __builtin_bit_cast(int, x), 0x111, 0xf, 0xf, false)); }
struct EpiFfn {
    static constexpr bool PERM = true, AFTER_DRAIN = false;
    bf16* H0; bf16* H1; const float* cw; const float* cb; const float* cst; float* cso; float* sbl; float* sbf;
    __device__ __forceinline__ void operator()(f32x4 (&acc)[2][2][4][2], const pg8::Unit& u, int wr, int wc, int fr, int fq) const {
        bf16* H = (u.pm < 64) ? H0 : H1;
        const int ch0 = 128 * u.pn + 32 * wc + 8 * fq;
        const int tok0 = 256 * u.pm + 128 * wr + 8 * fr;
        const int grp = 2 * u.pm + wr;
        const bool samp = (u.pm >= 64 && u.pm < PM_META), meta = (u.pm == PM_META);
        const int sb = 32 * (u.pm - 64) + 16 * wr + fr;
        const bool defer = (!samp && !meta && fr == 0);
        const bool lastlane = meta ? (wr == 0 && fr == 1) : (!samp && fr == 15);
        f32x4 w0[2], w1[2], w2[2], bb[2], p6[2], p7[2];
#pragma unroll
        for (int n = 0; n < 2; ++n) {
            const int c4 = ch0 + 4 * n;
            w0[n] = *(const f32x4*)(cw + c4); w1[n] = *(const f32x4*)(cw + DFF + c4); w2[n] = *(const f32x4*)(cw + 2 * DFF + c4); bb[n] = *(const f32x4*)(cb + c4);
#pragma unroll
            for (int e = 0; e < 4; ++e) { p6[n][e] = dpp_row_shr1(acc[1][0][2][n][e]); p7[n][e] = dpp_row_shr1(acc[1][0][3][n][e]); }
            if (samp) { p6[n] = *(const f32x4*)(cst + (size_t)(sb * 2 + 0) * DFF + c4); p7[n] = *(const f32x4*)(cst + (size_t)(sb * 2 + 1) * DFF + c4); }
            if (meta && wr == 0 && fr == 0) { p6[n] = (f32x4){0.f, 0.f, 0.f, 0.f}; p7[n] = p6[n]; }
            if (lastlane) { *(f32x4*)(sbl + (size_t)(grp * 2 + 0) * DFF + c4) = acc[1][0][2][n]; *(f32x4*)(sbl + (size_t)(grp * 2 + 1) * DFF + c4) = acc[1][0][3][n]; }
            if (samp) { *(f32x4*)(cso + (size_t)(sb * 2 + 0) * DFF + c4) = acc[1][0][2][n]; *(f32x4*)(cso + (size_t)(sb * 2 + 1) * DFF + c4) = acc[1][0][3][n]; }
        }
#pragma unroll
        for (int k = 0; k < 8; ++k) {
            unsigned hw[4];
#pragma unroll
            for (int n = 0; n < 2; ++n) {
                const f32x4 uk = acc[k >> 2][0][k & 3][n], gk = acc[k >> 2][1][k & 3][n];
                const f32x4 um1 = (k >= 1) ? acc[(k - 1 < 0 ? 0 : k - 1) >> 2][0][(k - 1 < 0 ? 0 : k - 1) & 3][n] : p7[n];
                const f32x4 um2 = (k >= 2) ? acc[(k - 2 < 0 ? 0 : k - 2) >> 2][0][(k - 2 < 0 ? 0 : k - 2) & 3][n] : (k == 1 ? p7[n] : p6[n]);
                const f32x4 cv = bb[n] + w0[n] * um2 + w1[n] * um1 + w2[n] * uk;
                f32x4 hv;
#pragma unroll
                for (int e = 0; e < 4; ++e) hv[e] = siluf_(cv[e]) * gk[e];
                hw[2 * n] = pg8::cvt_pk_bf16(hv[0], hv[1]); hw[2 * n + 1] = pg8::cvt_pk_bf16(hv[2], hv[3]);
                if (defer && k < 2) {
                    *(f32x4*)(sbf + (size_t)((grp * 2 + k) * 2 + 0) * DFF + ch0 + 4 * n) = uk;
                    *(f32x4*)(sbf + (size_t)((grp * 2 + k) * 2 + 1) * DFF + ch0 + 4 * n) = gk;
                }
            }
            if (!(defer && k < 2)) *(u32x4*)(H + (size_t)(tok0 + k) * DFF + ch0) = (u32x4){hw[0], hw[1], hw[2], hw[3]};
        }
    }
};

__device__ __forceinline__ void ffn_fixup_tile(Frame& F, int layer, int pm, bool conv_out) {
    const float* cw = F.in[22] + (size_t)layer * 3 * DFF; const float* cb = F.in[23] + (size_t)layer * DFF;
    bf16* H = F_Z(F);
    for (int i = F.tid; i < 2 * DFF; i += NWAVES * 64) {
        const int wr = i / DFF, ch = i - wr * DFF, grp = 2 * pm + wr;
        const int r0 = 128 * grp;
        const int pg = (r0 % 2048 == 0) ? GRP_META : grp - 1;
        const float um2 = F_SBL(F)[(size_t)(pg * 2 + 0) * DFF + ch], um1 = F_SBL(F)[(size_t)(pg * 2 + 1) * DFF + ch];
        const float u0 = F_SBF(F)[(size_t)((grp * 2 + 0) * 2 + 0) * DFF + ch], g0 = F_SBF(F)[(size_t)((grp * 2 + 0) * 2 + 1) * DFF + ch];
        const float u1 = F_SBF(F)[(size_t)((grp * 2 + 1) * 2 + 0) * DFF + ch], g1 = F_SBF(F)[(size_t)((grp * 2 + 1) * 2 + 1) * DFF + ch];
        const float w0 = cw[ch], w1 = cw[DFF + ch], w2 = cw[2 * DFF + ch], bb = cb[ch];
        const float c0 = bb + w0 * um2 + w1 * um1 + w2 * u0, c1 = bb + w0 * um1 + w1 * u0 + w2 * u1;
        H[(size_t)r0 * DFF + ch] = (bf16)f2bf(siluf_(c0) * g0);
        H[(size_t)(r0 + 1) * DFF + ch] = (bf16)f2bf(siluf_(c1) * g1);
        if (conv_out && (pm & 7) == 7 && wr == 1) {
            float* fo = F.out + O_FP + ((size_t)layer * 8 + (pm >> 3)) * 2 * DFF;
            fo[ch] = F_SBL(F)[(size_t)(grp * 2 + 0) * DFF + ch]; fo[DFF + ch] = F_SBL(F)[(size_t)(grp * 2 + 1) * DFF + ch];
        }
    }
}
typedef short bf16x8 __attribute__((ext_vector_type(8)));
typedef short v4i16_t __attribute__((ext_vector_type(4)));
constexpr int MX_PITCH = 272;
constexpr int MX_Q = 0, MX_K = 17408, MX_KH = 34816, MX_V = 52224, MX_GD = 69632  , MX_SC = 71680  , MX_OB = 74752  , MX_RP = 108544  , MX_DI = 110592  , MX_GN = 110848  , MX_LB = 111360  , MX_END = 111872;
constexpr int MX_OP = 132;
constexpr float LNKS = -2.4260151319598084f;
static_assert(MX_END <= 139264, "mixer LDS map");

__device__ __forceinline__ bf16x8 mk8(unsigned a, unsigned b, unsigned c, unsigned d) { const u32x4 v = {a, b, c, d}; return __builtin_bit_cast(bf16x8, v); }
__device__ __forceinline__ u32x2 tr16(const LAS unsigned char* p) { return __builtin_bit_cast(u32x2, __builtin_amdgcn_ds_read_tr16_b64_v4i16((LAS v4i16_t*)p)); }
typedef float f32x2_t __attribute__((ext_vector_type(2))); typedef __bf16 bf16x2_t __attribute__((ext_vector_type(2)));
__device__ __forceinline__ unsigned pkbf(float lo, float hi) { const f32x2_t v = {lo, hi}; const bf16x2_t b = __builtin_convertvector(v, bf16x2_t); return __builtin_bit_cast(unsigned, b); }
#define MFMA16(a, b, c) __builtin_amdgcn_mfma_f32_16x16x32_bf16((a), (b), (c), 0, 0, 0)
typedef short s16x4 __attribute__((ext_vector_type(4)));
__device__ __forceinline__ f32x4 mfma16k16(u32x2 a, u32x2 b, f32x4 c) { const u32x4 a4 = {a.x, a.y, 0u, 0u}, b4 = {b.x, b.y, 0u, 0u}; return __builtin_amdgcn_mfma_f32_16x16x32_bf16(__builtin_bit_cast(bf16x8, a4), __builtin_bit_cast(bf16x8, b4), c, 0, 0, 0); }
__device__ __forceinline__ bf16x8 ld8(const LAS unsigned char* p) { return __builtin_bit_cast(bf16x8, *(const LAS u32x4*)p); }
#define MX_POS4(d) (((d) & ~31) + 8 * ((((d) & 15)) >> 2) + 4 * (((d) >> 4) & 1))
template <int CTRL> __device__ __forceinline__ float dppf(float ident, float x) { return __builtin_bit_cast(float, __builtin_amdgcn_update_dpp(__builtin_bit_cast(int, ident), __builtin_bit_cast(int, x), CTRL, 0xf, 0xf, false)); }
__device__ __forceinline__ float row_prefix_sum(float x) { x += dppf<0x111>(0.f, x); x += dppf<0x112>(0.f, x); x += dppf<0x114>(0.f, x); x += dppf<0x118>(0.f, x); return x; }
__device__ __forceinline__ float row_prefix_max(float x) { x = fmaxf(x, dppf<0x111>(-3e38f, x)); x = fmaxf(x, dppf<0x112>(-3e38f, x)); x = fmaxf(x, dppf<0x114>(-3e38f, x)); x = fmaxf(x, dppf<0x118>(-3e38f, x)); return x; }
__device__ __forceinline__ float row_prefix_prod(float x) { x *= dppf<0x111>(1.f, x); x *= dppf<0x112>(1.f, x); x *= dppf<0x114>(1.f, x); x *= dppf<0x118>(1.f, x); return x; }
__device__ __forceinline__ float row_suffix_prod(float x) { x *= dppf<0x101>(1.f, x); x *= dppf<0x102>(1.f, x); x *= dppf<0x104>(1.f, x); x *= dppf<0x108>(1.f, x); return x; }
__device__ __forceinline__ float rdlane(float x, int l) { return __builtin_bit_cast(float, __builtin_amdgcn_readlane(__builtin_bit_cast(int, x), l)); }

struct EpiHg {
    static constexpr bool PERM = true, AFTER_DRAIN = false;
    bf16* O0; bf16* O1; int pm_split; int ldc; const float* LB; float* GD; float* GDS;
    __device__ __forceinline__ void operator()(f32x4 (&acc)[2][2][4][2], const pg8::Unit& u, int wr, int wc, int fr, int fq) const {
        bf16* O = (u.pm < pm_split) ? O0 : O1;
        const int row0 = u.pm * 256 + wr * 64 + fr;
        if (u.pn >= 8) {
            const int col0 = u.pn * 256 + wc * 32 + 8 * fq;
#pragma unroll
            for (int ai = 0; ai < 2; ++ai)
#pragma unroll
                for (int m = 0; m < 4; ++m) { bf16* rowp = O + (size_t)(row0 + ai * 128 + m * 16) * ldc + col0;
#pragma unroll
                    for (int bj = 0; bj < 2; ++bj) { const f32x4 v0 = acc[ai][bj][m][0], v1 = acc[ai][bj][m][1];
                        u32x4 w; w.x = pg8::cvt_pk_bf16(v0[0], v0[1]); w.y = pg8::cvt_pk_bf16(v0[2], v0[3]); w.z = pg8::cvt_pk_bf16(v1[0], v1[1]); w.w = pg8::cvt_pk_bf16(v1[2], v1[3]);
                        *(u32x4*)(rowp + bj * 128) = w; } }
            return;
        }
        const int c0 = 128 * u.pn + 32 * wc + 8 * fq;
        const bool samp = (u.pm >= 64 && u.pm < PM_META);
        const f32x4 lb0 = *(const f32x4*)(LB + c0), lb1 = *(const f32x4*)(LB + c0 + 4);
#pragma unroll
        for (int ai = 0; ai < 2; ++ai)
#pragma unroll
            for (int m = 0; m < 4; ++m) {
                const int row = row0 + ai * 128 + m * 16;
                f32x4 qt[2], kt[2], Ae[2];
#pragma unroll
                for (int n = 0; n < 2; ++n)
#pragma unroll
                    for (int e = 0; e < 4; ++e) {
                        const float lb = n ? lb1[e] : lb0[e];
                        const float sg = sigmoidf_(acc[ai][1][m][n][e]);
                        const float a = lb + (1.f - lb) * sg, kk = (1.f - lb) * (1.f - sg);
                        float A = a;
                        if (samp) { float t;
                            t = dppf<0x111>(1.f, A); A *= ((fr & 7) >= 1) ? t : 1.f; t = dppf<0x112>(1.f, A); A *= ((fr & 7) >= 2) ? t : 1.f; t = dppf<0x114>(1.f, A); A *= ((fr & 7) >= 4) ? t : 1.f; }
                        else A = row_prefix_prod(a);
                        qt[n][e] = acc[ai][0][m][n][e] * A; kt[n][e] = kk * __builtin_amdgcn_rcpf(fmaxf(A, 1e-30f)); Ae[n][e] = A;
                    }
                bf16* rowp = O + (size_t)row * ldc + c0;
                u32x4 w; w.x = pg8::cvt_pk_bf16(qt[0][0], qt[0][1]); w.y = pg8::cvt_pk_bf16(qt[0][2], qt[0][3]); w.z = pg8::cvt_pk_bf16(qt[1][0], qt[1][1]); w.w = pg8::cvt_pk_bf16(qt[1][2], qt[1][3]);
                *(u32x4*)rowp = w;
                w.x = pg8::cvt_pk_bf16(kt[0][0], kt[0][1]); w.y = pg8::cvt_pk_bf16(kt[0][2], kt[0][3]); w.z = pg8::cvt_pk_bf16(kt[1][0], kt[1][1]); w.w = pg8::cvt_pk_bf16(kt[1][2], kt[1][3]);
                *(u32x4*)(rowp + 1024) = w;
                if (!samp && fr == 15) { float* gp = GD + (size_t)(row >> 4) * 1024 + c0; *(f32x4*)gp = Ae[0]; *(f32x4*)(gp + 4) = Ae[1]; }
                if (samp && (fr & 7) == 7) { float* gp = GDS + (size_t)((row - ROW_S) >> 3) * 1024 + c0; *(f32x4*)gp = Ae[0]; *(f32x4*)(gp + 4) = Ae[1]; }
            }
    }
};

constexpr int ROT_N = 2072;
__device__ __forceinline__ void p0_rotary(Frame& F, float* tab) {
    const int gt = blockIdx.x * (NWAVES * 64) + F.tid, NT = F.G * NWAVES * 64;
    for (int i = gt; i < ROT_N * 64; i += NT) {
        const int pi = i >> 6, fi = i & 63;
        const float pos = pi < 2064 ? (float)pi : (float)(16384 + pi - 2064);
        const float inv = exp2f((float)fi * (-13.287712379549449f / 63.0f));
        float sn, cs; sincosf(pos * inv, &sn, &cs);
        tab[2 * i] = cs; tab[2 * i + 1] = sn;
    }
}

#ifdef PROBE_BLOCK
#define MSTAMP_DECL unsigned long long t_last_ = __builtin_amdgcn_s_memrealtime();
#define MSTAMP(id) do { if (blockIdx.x == PROBE_BLOCK && tid == 0) { const unsigned long long t_now_ = __builtin_amdgcn_s_memrealtime(); volatile LAS unsigned long long* a_ = (volatile LAS unsigned long long*)(F.lds + 139264 + 128) + 48 + (id); *a_ = *a_ + (t_now_ - t_last_); t_last_ = t_now_; } } while (0)
#else
#define MSTAMP_DECL
#define MSTAMP(id) do { } while (0)
#endif
#define MX_SC_PARAMS(scv, row0, ntok, nmc, pos0) do { if (mode != 1) { if ((scv) == 0) { row0 = ROW_M; ntok = 16; nmc = 1; pos0 = 0; } else { row0 = b * 2048 + ((scv) - 1) * 64; ntok = 64; nmc = 4; pos0 = 16 + ((scv) - 1) * 64; } } \
        else { row0 = ROW_S + 8 * b; ntok = 8; nmc = 1; pos0 = 2064; } } while (0)

template <int TYPE, int NMC>
__device__ __forceinline__ void sg_chain(LAS unsigned char* L, LAS float* SC, f32x4 (&S)[8], f32x4& nacc, int w, int r16, int q) {
    LAS float* OB = (LAS float*)(L + MX_OB); LAS float* RP = (LAS float*)(L + MX_RP); LAS float* DI = (LAS float*)(L + MX_DI);
    f32x4 oo[4];
#pragma unroll
    for (int mc = 0; mc < NMC; ++mc) {
        oo[mc] = (f32x4){0.f, 0.f, 0.f, 0.f};
        {
            const LAS unsigned char* Qb = L + MX_Q + 16 * mc * MX_PITCH; const LAS unsigned char* Kb = L + MX_K + 16 * mc * MX_PITCH; const LAS unsigned char* Vb = L + MX_V + 16 * mc * MX_PITCH;
            f32x4 g0 = {0.f, 0.f, 0.f, 0.f}, g1 = {0.f, 0.f, 0.f, 0.f};
#pragma unroll
            for (int ks = 0; ks < 4; ++ks) {
                const bf16x8 kf = ld8(Kb + r16 * MX_PITCH + (32 * ks + 8 * q) * 2), qf = ld8(Qb + r16 * MX_PITCH + (32 * ks + 8 * q) * 2);
                if (ks & 1) g1 = MFMA16(kf, qf, g1); else g0 = MFMA16(kf, qf, g0);
            }
            const f32x4 g = g0 + g1;
            const float xi = SC[mc * 16 + r16]; const f32x4 y4 = *(const LAS f32x4*)(SC + 64 + mc * 16 + 4 * q);
            f32x4 P;
#pragma unroll
            for (int r = 0; r < 4; ++r) P[r] = (4 * q + r <= r16) ? g[r] * __expf(xi + y4[r]) : 0.f;
            if (TYPE == 0) { float ps = (P[0] + P[1]) + (P[2] + P[3]); ps += __shfl_xor(ps, 16); ps += __shfl_xor(ps, 32); if (w == 0 && q == 0) DI[16 * mc + r16] = ps; }
            const u32x2 vt = tr16(Vb + (4 * q + (r16 >> 2)) * MX_PITCH + (16 * w + 4 * (r16 & 3)) * 2);
            oo[mc] = mfma16k16((u32x2){pkbf(P[0], P[1]), pkbf(P[2], P[3])}, vt, oo[mc]);
        }
        if (mc == 1 || TYPE == 1) __builtin_amdgcn_sched_barrier(0);
    }
#pragma unroll
    for (int mc = 0; mc < NMC; ++mc) {
        {
            const LAS unsigned char* Qb = L + MX_Q + 16 * mc * MX_PITCH; const LAS unsigned char* Kb = L + MX_K + 16 * mc * MX_PITCH;
            const u32x2 vt = tr16(L + MX_V + 16 * mc * MX_PITCH + (4 * q + (r16 >> 2)) * MX_PITCH + (16 * w + 4 * (r16 & 3)) * 2);
            f32x4 o2a = {0.f, 0.f, 0.f, 0.f}, o2b = {0.f, 0.f, 0.f, 0.f};
#pragma unroll
            for (int ks = 0; ks < 4; ++ks) {
                const bf16x8 qf = ld8(Qb + r16 * MX_PITCH + (32 * ks + 8 * q) * 2);
                const bf16x8 SB = mk8(pkbf(S[2 * ks][0], S[2 * ks][1]), pkbf(S[2 * ks][2], S[2 * ks][3]), pkbf(S[2 * ks + 1][0], S[2 * ks + 1][1]), pkbf(S[2 * ks + 1][2], S[2 * ks + 1][3]));
                if (ks & 1) o2b = MFMA16(qf, SB, o2b); else o2a = MFMA16(qf, SB, o2a);
            }
            const f32x4 in4 = *(const LAS f32x4*)(SC + 128 + mc * 16 + 4 * q);
            oo[mc] = oo[mc] + in4 * (o2a + o2b);
            const f32x4 w4 = *(const LAS f32x4*)(SC + 192 + mc * 16 + 4 * q); const float carry = SC[320 + mc];
            if (TYPE == 0) {
                const u32x2 qn = *(const LAS u32x2*)(Qb + r16 * MX_PITCH + MX_POS4(16 * w + 4 * q) * 2);
                f32x4 rr = {0.f, 0.f, 0.f, 0.f}; rr = mfma16k16(qn, (u32x2){pkbf(nacc[0], nacc[1]), pkbf(nacc[2], nacc[3])}, rr);
                if (r16 == 0) {
#pragma unroll
                    for (int r = 0; r < 4; ++r) RP[w * 64 + 16 * mc + 4 * q + r] = rr[r]; }
            }
#pragma unroll
            for (int r = 0; r < 4; ++r) OB[(16 * mc + 4 * q + r) * MX_OP + 16 * w + r16] = oo[mc][r];
            const u32x2 VH = {pkbf(bflo(vt.x) * w4[0], bfhi(vt.x) * w4[1]), pkbf(bflo(vt.y) * w4[2], bfhi(vt.y) * w4[3])};
#pragma unroll
            for (int mt = 0; mt < 8; ++mt) {
                const u32x2 kt = tr16(Kb + (4 * q + (r16 >> 2)) * MX_PITCH + MX_POS4(16 * mt + 4 * (r16 & 3)) * 2);
                S[mt] = S[mt] * carry; S[mt] = mfma16k16(kt, VH, S[mt]);
            }
            if (TYPE == 0) {
                const u32x2 kt = tr16(Kb + (4 * q + (r16 >> 2)) * MX_PITCH + MX_POS4(16 * w + 4 * (r16 & 3)) * 2);
                nacc = nacc * carry; nacc = mfma16k16(kt, (u32x2){pkbf(w4[0], w4[1]), pkbf(w4[2], w4[3])}, nacc);
            }
        }
        if (mc + 1 < NMC) __builtin_amdgcn_sched_barrier(0);
    }
}

template <int TYPE>
__device__ __forceinline__ void mix_sg_unit(Frame& F, int b, int h, int mode  , const float* rot) {
    const bool prompt = (mode != 1);
    const int tid = F.tid, lane = F.lane, w = F.wave, r16 = lane & 15, q = lane >> 4;
    const int tk = tid >> 3, p = tid & 7;
    LAS unsigned char* L = F.lds;
    LAS float* OB = (LAS float*)(L + MX_OB); LAS float* RP = (LAS float*)(L + MX_RP); LAS float* DI = (LAS float*)(L + MX_DI);
    bf16* MIX = F_XN(F);
    const int qcol = (TYPE == 0 ? 0 : 2048) + 128 * h, kcol = (TYPE == 0 ? 512 : 2560) + 128 * h, vcol = (TYPE == 0 ? 1024 : 3072) + 128 * h, gcol = (TYPE == 0 ? 1536 : 3584) + 128 * h, mcol = (TYPE == 0 ? 0 : 512) + 128 * h;
    f32x4 S[8]; f32x4 nacc = {0.f, 0.f, 0.f, 0.f}; float m0 = 0.f;
#pragma unroll
    for (int mt = 0; mt < 8; ++mt) S[mt] = (f32x4){0.f, 0.f, 0.f, 0.f};
    if (!prompt) {
        const float* Sin = (TYPE == 0 ? F.in[2] : F.in[5]) + (size_t)(b * 4 + h) * 16384;
#pragma unroll
        for (int mt = 0; mt < 8; ++mt)
#pragma unroll
            for (int r = 0; r < 4; ++r) S[mt][r] = Sin[(16 * mt + 4 * q + r) * 128 + 16 * w + r16];
        if (TYPE == 0) {
#pragma unroll
            for (int r = 0; r < 4; ++r) nacc[r] = F.in[3][(size_t)(b * 4 + h) * 128 + 16 * w + 4 * q + r];
            m0 = F.in[4][b * 4 + h];
        }
    }
    const float lgam = (TYPE != 1) ? 0.f : h == 0 ? -0.031748698314580298f : h == 1 ? -0.015748356968139168f : h == 2 ? -0.0078431774610258928f : -0.0039138993211363287f;
    const float bias_i = (TYPE == 0) ? F.in[11][h] : 0.f, bias_f = (TYPE == 0) ? F.in[12][h] : 0.f;
    LAS float* GN = (LAS float*)(L + MX_GN);
    if (tid < 128) GN[tid] = (TYPE == 0 ? F.in[13] : F.in[14])[128 * h + tid];
    const int nsc = (mode == 0) ? 33 : 1;
    u32x4 pa[6]; f32x4 pr[4]; float pli = 0.f, plf = 0.f; u32x4 pg[2];
    const u32x4 z4 = {0u, 0u, 0u, 0u};
#define SG_LOAD(scv) do { int row0_, ntok_, nmc_, pos0_; MX_SC_PARAMS(scv, row0_, ntok_, nmc_, pos0_); (void)nmc_; \
        const bool valid_ = tk < ntok_; const bf16* zr_ = ZROW(F, row0_ + (valid_ ? tk : 0), 0); \
        _Pragma("unroll") for (int i_ = 0; i_ < 6; ++i_) pa[i_] = z4; \
        if (valid_) { pa[4] = *(const u32x4*)(zr_ + vcol + 16 * p); pa[5] = *(const u32x4*)(zr_ + vcol + 16 * p + 8); \
            if (TYPE == 0) { pa[0] = *(const u32x4*)(zr_ + qcol + 16 * p); pa[1] = *(const u32x4*)(zr_ + qcol + 16 * p + 8); pa[2] = *(const u32x4*)(zr_ + kcol + 16 * p); pa[3] = *(const u32x4*)(zr_ + kcol + 16 * p + 8); } \
            else { pa[0] = *(const u32x4*)(zr_ + qcol + 8 * p); pa[1] = *(const u32x4*)(zr_ + qcol + 64 + 8 * p); pa[2] = *(const u32x4*)(zr_ + kcol + 8 * p); pa[3] = *(const u32x4*)(zr_ + kcol + 64 + 8 * p); } } \
        if (TYPE == 1) { const float* tb_ = rot + ((size_t)(pos0_ + (valid_ ? tk : 0)) * 64 + 8 * p) * 2; _Pragma("unroll") for (int e_ = 0; e_ < 4; ++e_) pr[e_] = *(const f32x4*)(tb_ + 4 * e_); } \
        if (TYPE == 0 && w == 0) { const bool vt_ = lane < ntok_; const float* gp_ = F_GT(F) + (size_t)(row0_ + (vt_ ? lane : 0)) * 8; pli = gp_[h]; plf = gp_[4 + h]; } } while (0)
    SG_LOAD(0);
    MSTAMP_DECL
#pragma unroll 1
    for (int sc = 0; sc < nsc; ++sc) {
        int row0, ntok, nmc, pos0; MX_SC_PARAMS(sc, row0, ntok, nmc, pos0); (void)pos0;
        LAS float* SC = (LAS float*)(L + MX_SC) + (sc & 1) * 384;
        MSTAMP(0);
        {
            *(LAS u32x4*)(L + MX_V + tk * MX_PITCH + 32 * p) = pa[4]; *(LAS u32x4*)(L + MX_V + tk * MX_PITCH + 32 * p + 16) = pa[5];
            if (TYPE == 0) {
                const int c0 = (MX_POS4(16 * p)) * 2;
#pragma unroll
                for (int g = 0; g < 4; ++g) {
                    *(LAS u32x2*)(L + MX_Q + tk * MX_PITCH + c0 + 16 * g) = (u32x2){pa[g >> 1][2 * (g & 1)], pa[g >> 1][2 * (g & 1) + 1]};
                    *(LAS u32x2*)(L + MX_K + tk * MX_PITCH + c0 + 16 * g) = (u32x2){pa[2 + (g >> 1)][2 * (g & 1)], pa[2 + (g >> 1)][2 * (g & 1) + 1]};
                }
            } else {
                u32x4 q1, q2, k1, k2;
#pragma unroll
                for (int e2 = 0; e2 < 4; ++e2) {
                    const f32x4 cs = pr[e2];
                    { const float x1l = bflo(pa[0][e2]), x1h = bfhi(pa[0][e2]), x2l = bflo(pa[1][e2]), x2h = bfhi(pa[1][e2]);
                      q1[e2] = pkbf(x1l * cs[0] - x2l * cs[1], x1h * cs[2] - x2h * cs[3]); q2[e2] = pkbf(x2l * cs[0] + x1l * cs[1], x2h * cs[2] + x1h * cs[3]); }
                    { const float x1l = bflo(pa[2][e2]), x1h = bfhi(pa[2][e2]), x2l = bflo(pa[3][e2]), x2h = bfhi(pa[3][e2]);
                      k1[e2] = pkbf(x1l * cs[0] - x2l * cs[1], x1h * cs[2] - x2h * cs[3]); k2[e2] = pkbf(x2l * cs[0] + x1l * cs[1], x2h * cs[2] + x1h * cs[3]); }
                }
                const int c0 = (MX_POS4(8 * p)) * 2;
                *(LAS u32x2*)(L + MX_Q + tk * MX_PITCH + c0) = (u32x2){q1[0], q1[1]}; *(LAS u32x2*)(L + MX_Q + tk * MX_PITCH + c0 + 16) = (u32x2){q1[2], q1[3]};
                *(LAS u32x2*)(L + MX_Q + tk * MX_PITCH + c0 + 128) = (u32x2){q2[0], q2[1]}; *(LAS u32x2*)(L + MX_Q + tk * MX_PITCH + c0 + 144) = (u32x2){q2[2], q2[3]};
                *(LAS u32x2*)(L + MX_K + tk * MX_PITCH + c0) = (u32x2){k1[0], k1[1]}; *(LAS u32x2*)(L + MX_K + tk * MX_PITCH + c0 + 16) = (u32x2){k1[2], k1[3]};
                *(LAS u32x2*)(L + MX_K + tk * MX_PITCH + c0 + 128) = (u32x2){k2[0], k2[1]}; *(LAS u32x2*)(L + MX_K + tk * MX_PITCH + c0 + 144) = (u32x2){k2[2], k2[3]};
            }
        }
        if (w == 0) {
            const bool valid = lane < ntok;
            float li = -1e30f, lf = 0.f;
            if (TYPE == 0) { if (valid) { li = pli + bias_i; lf = logsigmoidf_(plf + bias_f); } } else { if (valid) { li = 0.f; lf = lgam; } }
            const float bb = row_prefix_sum(lf);
            const float y = li - bb;
            const float am = row_prefix_max(y);
            const float a = bb + am;
            const float B0 = rdlane(bb, 15), B1 = rdlane(bb, 31), B2 = rdlane(bb, 47), B3 = rdlane(bb, 63);
            float M1 = 0.f, M2 = 0.f, M3 = 0.f, M4 = 0.f;
            if (TYPE == 0) { const float A0 = rdlane(a, 15), A1 = rdlane(a, 31), A2 = rdlane(a, 47), A3 = rdlane(a, 63);
                M1 = fmaxf(B0 + m0, A0); M2 = fmaxf(B1 + M1, A1); M3 = fmaxf(B2 + M2, A2); M4 = fmaxf(B3 + M3, A3); }
            const float m0q = q == 0 ? m0 : q == 1 ? M1 : q == 2 ? M2 : M3;
            const float mnq = q == 0 ? M1 : q == 1 ? M2 : q == 2 ? M3 : M4;
            const float b15 = q == 0 ? B0 : q == 1 ? B1 : q == 2 ? B2 : B3;
            const float m = (TYPE == 0) ? fmaxf(bb + m0q, a) : 0.f;
            SC[lane] = bb - m; SC[64 + lane] = y + LNKS; SC[128 + lane] = __expf(bb + m0q - m);
            SC[192 + lane] = __expf(y + LNKS + b15 - mnq); SC[256 + lane] = __expf(-m);
            if (r16 == 0) SC[320 + q] = __expf(b15 + m0q - mnq);
            m0 = (nmc == 4) ? M4 : M1;
        }
        MSTAMP(1);
        __syncthreads();
        MSTAMP(2);
        if (sc + 1 < nsc) SG_LOAD(sc + 1);
        { const bool valid = tk < ntok; const bf16* zr = ZROW(F, row0 + (valid ? tk : 0), 0) + gcol + 16 * p; pg[0] = *(const u32x4*)zr; pg[1] = *(const u32x4*)(zr + 8); }
        MSTAMP(3);
        if (nmc == 4) sg_chain<TYPE, 4>(L, SC, S, nacc, w, r16, q); else sg_chain<TYPE, 1>(L, SC, S, nacc, w, r16, q);
        MSTAMP(4);
        __syncthreads();
        MSTAMP(6);
        {
            const bool valid = tk < ntok; const int row = row0 + (valid ? tk : 0);
            f32x4 o[4];
#pragma unroll
            for (int c = 0; c < 4; ++c) o[c] = *(const LAS f32x4*)(OB + tk * MX_OP + 16 * p + 4 * c);
            if (tk >= 16 * nmc) {
#pragma unroll
                for (int c = 0; c < 4; ++c) o[c] = (f32x4){0.f, 0.f, 0.f, 0.f}; }
            if (TYPE == 0) {
                float rs = 0.f;
#pragma unroll
                for (int ww = 0; ww < 8; ++ww) rs += RP[ww * 64 + tk];
                const float den = DI[tk] + SC[128 + tk] * rs;
                float dn = fmaxf(fabsf(den), SC[256 + tk]); if (tk >= 16 * nmc) dn = 1.f;
                const float rd = 1.f / dn;
#pragma unroll
                for (int c = 0; c < 4; ++c) o[c] = o[c] * rd;
            }
            float sm = 0.f;
#pragma unroll
            for (int c = 0; c < 4; ++c) sm += (o[c].x + o[c].y) + (o[c].z + o[c].w);
            sm += __shfl_xor(sm, 1); sm += __shfl_xor(sm, 2); sm += __shfl_xor(sm, 4);
            const float mu = sm * (1.f / 128.f); float vs = 0.f;
#pragma unroll
            for (int c = 0; c < 4; ++c) { o[c] = o[c] - mu; vs += (o[c].x * o[c].x + o[c].y * o[c].y) + (o[c].z * o[c].z + o[c].w * o[c].w); }
            vs += __shfl_xor(vs, 1); vs += __shfl_xor(vs, 2); vs += __shfl_xor(vs, 4);
            const float rstd = rsqrtf(vs * (1.f / 128.f) + EPS);
            if (valid && !(mode == 0 && sc == 0)) {
                unsigned ow[8];
#pragma unroll
                for (int c = 0; c < 4; ++c) {
                    const unsigned ga = c < 2 ? pg[0][2 * c] : pg[1][2 * c - 4], gb = c < 2 ? pg[0][2 * c + 1] : pg[1][2 * c - 3];
                    f32x4 gt = {bflo(ga), bfhi(ga), bflo(gb), bfhi(gb)};
#pragma unroll
                    for (int e = 0; e < 4; ++e) gt[e] = (TYPE == 0) ? sigmoidf_(gt[e]) : siluf_(gt[e]);
                    const f32x4 r = o[c] * rstd * *(const LAS f32x4*)(GN + 16 * p + 4 * c) * gt;
                    ow[2 * c] = pkbf(r.x, r.y); ow[2 * c + 1] = pkbf(r.z, r.w);
                }
                bf16* mp = MIX + (size_t)row * DM + mcol + 16 * p;
                *(u32x4*)mp = (u32x4){ow[0], ow[1], ow[2], ow[3]}; *(u32x4*)(mp + 8) = (u32x4){ow[4], ow[5], ow[6], ow[7]};
            }
        }
        MSTAMP(7);
    }
#undef SG_LOAD
    __syncthreads();
    if (mode != 2) {
        int l2 = F.lane; asm volatile("" : "+v"(l2)); const int r16 = l2 & 15, q = l2 >> 4;
        float* So = F.out + (TYPE == 0 ? (prompt ? O_CP : O_CS) : (prompt ? O_RP : O_RS)) + (size_t)(b * 4 + h) * 16384;
#pragma unroll
        for (int mt = 0; mt < 8; ++mt)
#pragma unroll
            for (int r = 0; r < 4; ++r) So[(16 * mt + 4 * q + r) * 128 + 16 * w + r16] = S[mt][r];
        if (TYPE == 0) {
            if (r16 == 0) { float* No = F.out + (prompt ? O_NP : O_NS) + (size_t)(b * 4 + h) * 128;
#pragma unroll
                for (int r = 0; r < 4; ++r) No[16 * w + 4 * q + r] = nacc[r]; }
            if (w == 0 && lane == 0) F.out[(prompt ? O_MP : O_MS) + b * 4 + h] = m0;
        }
    }
}

template <int NMC>
__device__ __forceinline__ void hg_chain(LAS unsigned char* L, f32x4 (&S)[8], int w, int r16, int q) {
    LAS float* GD = (LAS float*)(L + MX_GD); LAS float* OB = (LAS float*)(L + MX_OB);
    f32x4 oo[4];
#pragma unroll
    for (int mc = 0; mc < NMC; ++mc) {
        oo[mc] = (f32x4){0.f, 0.f, 0.f, 0.f};
        {
            const LAS unsigned char* Qb = L + MX_Q + 16 * mc * MX_PITCH; const LAS unsigned char* Kb = L + MX_K + 16 * mc * MX_PITCH; const LAS unsigned char* Vb = L + MX_V + 16 * mc * MX_PITCH;
            f32x4 g0 = {0.f, 0.f, 0.f, 0.f}, g1 = {0.f, 0.f, 0.f, 0.f};
#pragma unroll
            for (int ks = 0; ks < 4; ++ks) {
                const bf16x8 kf = ld8(Kb + r16 * MX_PITCH + (32 * ks + 8 * q) * 2), qf = ld8(Qb + r16 * MX_PITCH + (32 * ks + 8 * q) * 2);
                if (ks & 1) g1 = MFMA16(kf, qf, g1); else g0 = MFMA16(kf, qf, g0);
            }
            const f32x4 g = g0 + g1;
            f32x4 P;
#pragma unroll
            for (int r = 0; r < 4; ++r) P[r] = (4 * q + r <= r16) ? g[r] : 0.f;
            const u32x2 vt = tr16(Vb + (4 * q + (r16 >> 2)) * MX_PITCH + (16 * w + 4 * (r16 & 3)) * 2);
            oo[mc] = mfma16k16((u32x2){pkbf(P[0], P[1]), pkbf(P[2], P[3])}, vt, oo[mc]);
        }
        if (mc == 1) __builtin_amdgcn_sched_barrier(0);
    }
#pragma unroll
    for (int mc = 0; mc < NMC; ++mc) {
        {
            const LAS unsigned char* Qb = L + MX_Q + 16 * mc * MX_PITCH; const LAS unsigned char* Kb = L + MX_K + 16 * mc * MX_PITCH;
            const u32x2 vt = tr16(L + MX_V + 16 * mc * MX_PITCH + (4 * q + (r16 >> 2)) * MX_PITCH + (16 * w + 4 * (r16 & 3)) * 2);
            f32x4 o2b = {0.f, 0.f, 0.f, 0.f};
#pragma unroll
            for (int ks = 0; ks < 4; ++ks) {
                const bf16x8 qf = ld8(Qb + r16 * MX_PITCH + (32 * ks + 8 * q) * 2);
                const bf16x8 SB = mk8(pkbf(S[2 * ks][0], S[2 * ks][1]), pkbf(S[2 * ks][2], S[2 * ks][3]), pkbf(S[2 * ks + 1][0], S[2 * ks + 1][1]), pkbf(S[2 * ks + 1][2], S[2 * ks + 1][3]));
                if (ks & 1) o2b = MFMA16(qf, SB, o2b); else oo[mc] = MFMA16(qf, SB, oo[mc]);
            }
            oo[mc] = oo[mc] + o2b;
#pragma unroll
            for (int mt = 0; mt < 8; ++mt) {
                const f32x4 gd = *(const LAS f32x4*)(GD + mc * 128 + 16 * mt + 4 * q);
                const u32x2 kt = tr16(Kb + (4 * q + (r16 >> 2)) * MX_PITCH + MX_POS4(16 * mt + 4 * (r16 & 3)) * 2);
                S[mt] = mfma16k16(kt, vt, S[mt]); S[mt] = S[mt] * gd;
            }
        }
        if (mc + 1 < NMC) __builtin_amdgcn_sched_barrier(0);
    }
#pragma unroll
    for (int mc = 0; mc < NMC; ++mc) {
        {
#pragma unroll
            for (int r = 0; r < 4; ++r) OB[(16 * mc + 4 * q + r) * MX_OP + 16 * w + r16] = oo[mc][r];
        }
    }
}

__device__ __forceinline__ void mix_hg_unit(Frame& F, int b, int h, int mode) {
    const bool prompt = (mode != 1);
    const int tid = F.tid, lane = F.lane, w = F.wave, r16 = lane & 15, q = lane >> 4;
    const int tk = tid >> 3, p = tid & 7;
    LAS unsigned char* L = F.lds;
    LAS float* GD = (LAS float*)(L + MX_GD); LAS float* OB = (LAS float*)(L + MX_OB);
    bf16* MIX = F_XN(F);
    f32x4 S[8];
#pragma unroll
    for (int mt = 0; mt < 8; ++mt) S[mt] = (f32x4){0.f, 0.f, 0.f, 0.f};
    if (!prompt) {
        const float* Sin = F.in[6] + (size_t)(b * 8 + h) * 16384;
#pragma unroll
        for (int mt = 0; mt < 8; ++mt)
#pragma unroll
            for (int r = 0; r < 4; ++r) S[mt][r] = Sin[(16 * mt + 4 * q + r) * 128 + 16 * w + r16];
    }
    LAS float* GN = (LAS float*)(L + MX_GN);
    if (tid < 128) GN[tid] = F.in[18][128 * h + tid];
    const int nsc = (mode == 0) ? 33 : 1;
    u32x4 pa[6]; u32x4 pg[2]; float pgd = 1.f;
    const u32x4 z4 = {0u, 0u, 0u, 0u};
#define HG_LOAD(scv) do { int row0_, ntok_, nmc_, pos0_; MX_SC_PARAMS(scv, row0_, ntok_, nmc_, pos0_); (void)pos0_; \
        const bool valid_ = tk < ntok_; const bf16* zr_ = ZROW(F, row0_ + (valid_ ? tk : 0), 1) + 128 * h + 16 * p; \
        _Pragma("unroll") for (int i_ = 0; i_ < 6; ++i_) pa[i_] = z4; \
        if (valid_) { pa[0] = *(const u32x4*)zr_; pa[1] = *(const u32x4*)(zr_ + 8); pa[2] = *(const u32x4*)(zr_ + 1024); pa[3] = *(const u32x4*)(zr_ + 1032); pa[4] = *(const u32x4*)(zr_ + 2048); pa[5] = *(const u32x4*)(zr_ + 2056); } \
        pgd = 1.f; if ((tid >> 7) < nmc_) pgd = (mode == 1) ? ((const float*)(F.ws + WS_GDS))[(size_t)b * 1024 + 128 * h + (tid & 127)] : ((const float*)(F.ws + WS_GD))[(size_t)((row0_ >> 4) + (tid >> 7)) * 1024 + 128 * h + (tid & 127)]; } while (0)
    HG_LOAD(0);
    MSTAMP_DECL
#pragma unroll 1
    for (int sc = 0; sc < nsc; ++sc) {
        int row0, ntok, nmc, pos0; MX_SC_PARAMS(sc, row0, ntok, nmc, pos0); (void)pos0;
        MSTAMP(8);
        {
            const int c0 = (MX_POS4(16 * p)) * 2;
#pragma unroll
            for (int g = 0; g < 4; ++g) {
                *(LAS u32x2*)(L + MX_Q + tk * MX_PITCH + c0 + 16 * g) = (u32x2){pa[g >> 1][2 * (g & 1)], pa[g >> 1][2 * (g & 1) + 1]};
                *(LAS u32x2*)(L + MX_K + tk * MX_PITCH + c0 + 16 * g) = (u32x2){pa[2 + (g >> 1)][2 * (g & 1)], pa[2 + (g >> 1)][2 * (g & 1) + 1]};
            }
            *(LAS u32x4*)(L + MX_V + tk * MX_PITCH + 32 * p) = pa[4]; *(LAS u32x4*)(L + MX_V + tk * MX_PITCH + 32 * p + 16) = pa[5];
            GD[tid] = pgd;
        }
        MSTAMP(9);
        __syncthreads();
        MSTAMP(10);
        if (sc + 1 < nsc) HG_LOAD(sc + 1);
        { const bool valid = tk < ntok; const bf16* zr = ZROW(F, row0 + (valid ? tk : 0), 1) + 3072 + 128 * h + 16 * p; pg[0] = *(const u32x4*)zr; pg[1] = *(const u32x4*)(zr + 8); }
        MSTAMP(11);
        if (nmc == 4) hg_chain<4>(L, S, w, r16, q); else hg_chain<1>(L, S, w, r16, q);
        MSTAMP(12);
        __syncthreads();
        MSTAMP(13);
        {
            const bool valid = tk < ntok; const int row = row0 + (valid ? tk : 0);
            f32x4 o[4];
#pragma unroll
            for (int c = 0; c < 4; ++c) o[c] = *(const LAS f32x4*)(OB + tk * MX_OP + 16 * p + 4 * c);
            if (tk >= 16 * nmc) {
#pragma unroll
                for (int c = 0; c < 4; ++c) o[c] = (f32x4){0.f, 0.f, 0.f, 0.f}; }
            float vs = 0.f;
#pragma unroll
            for (int c = 0; c < 4; ++c) vs += (o[c].x * o[c].x + o[c].y * o[c].y) + (o[c].z * o[c].z + o[c].w * o[c].w);
            vs += __shfl_xor(vs, 1); vs += __shfl_xor(vs, 2); vs += __shfl_xor(vs, 4);
            const float rstd = rsqrtf(vs * (1.f / 128.f) + EPS);
            if (valid && !(mode == 0 && sc == 0)) {
                unsigned ow[8];
#pragma unroll
                for (int c = 0; c < 4; ++c) {
                    const unsigned ga = c < 2 ? pg[0][2 * c] : pg[1][2 * c - 4], gb = c < 2 ? pg[0][2 * c + 1] : pg[1][2 * c - 3];
                    f32x4 gt = {bflo(ga), bfhi(ga), bflo(gb), bfhi(gb)};
#pragma unroll
                    for (int e = 0; e < 4; ++e) gt[e] = siluf_(gt[e]);
                    const f32x4 r = o[c] * rstd * *(const LAS f32x4*)(GN + 16 * p + 4 * c) * gt;
                    ow[2 * c] = pkbf(r.x, r.y); ow[2 * c + 1] = pkbf(r.z, r.w);
                }
                bf16* mp = MIX + (size_t)row * DM + 128 * h + 16 * p;
                *(u32x4*)mp = (u32x4){ow[0], ow[1], ow[2], ow[3]}; *(u32x4*)(mp + 8) = (u32x4){ow[4], ow[5], ow[6], ow[7]};
            }
        }
        MSTAMP(14);
    }
#undef HG_LOAD
    __syncthreads();
    if (mode != 2) {
        int l2 = F.lane; asm volatile("" : "+v"(l2)); const int r16 = l2 & 15, q = l2 >> 4;
        float* So = F.out + (prompt ? O_HP : O_HS) + (size_t)(b * 8 + h) * 16384;
#pragma unroll
        for (int mt = 0; mt < 8; ++mt)
#pragma unroll
            for (int r = 0; r < 4; ++r) So[(16 * mt + 4 * q + r) * 128 + 16 * w + r16] = S[mt][r];
    }
}

__device__ __forceinline__ void mixer_layer0(Frame& F) {
    const float* rot = (const float*)(F.ws + WS_ROT);
    int bid = blockIdx.x; asm volatile("" : "+s"(bid));
    if (bid < 64) { const int u = bid, ty = u >> 5, bh = u & 31; if (ty == 0) mix_sg_unit<0>(F, bh >> 2, bh & 3, 0, rot); else mix_sg_unit<1>(F, bh >> 2, bh & 3, 0, rot); return; }
#pragma unroll 1
    for (int u = bid - 64; u < 1024 + 8; u += F.G - 64) {
        int ty, bh, mode;
        if (u < 1024) { ty = u >> 9; bh = u & 511; mode = 1; } else { ty = (u - 1024) >> 2; bh = (u - 1024) & 3; mode = 2; }
        if (ty == 0) mix_sg_unit<0>(F, bh >> 2, bh & 3, mode, rot); else mix_sg_unit<1>(F, bh >> 2, bh & 3, mode, rot);
    }
}
__device__ __forceinline__ void mixer_layer1(Frame& F) {
    int bid = blockIdx.x; asm volatile("" : "+s"(bid));
    if (bid < 64) { mix_hg_unit(F, bid >> 3, bid & 7, 0); return; }
#pragma unroll 1
    for (int u = bid - 64; u < 1024 + 8; u += F.G - 64) {
        if (u < 1024) mix_hg_unit(F, u >> 3, u & 7, 1); else mix_hg_unit(F, 0, u - 1024, 2);
    }
}
constexpr int NSTEP = 18;
#ifndef P0_DEFER
#define P0_DEFER 0
#endif
constexpr int LDSCTL_OFF = 139264;
#define RLX_AGENT __ATOMIC_RELAXED, __HIP_MEMORY_SCOPE_AGENT
#define XB_TMO      128
#define XB_XCNT(j)  (256  + 64 * (j))
#define XB_XSUB(j)  (1280 + 64 * (j))
#define XB_XGEN(j)  (2304 + 64 * (j))
#define XB_TOP      3328
#define XB_TOPGEN   3392
#define XCD_BAR_WORDS 3456
#define XB_SPIN_CAP (1u << 18)

__device__ __forceinline__ unsigned xb_ld(unsigned* p)              { return __hip_atomic_load(p, __ATOMIC_RELAXED, __HIP_MEMORY_SCOPE_AGENT); }
__device__ __forceinline__ unsigned xb_add(unsigned* p, unsigned v) { return __hip_atomic_fetch_add(p, v, __ATOMIC_RELAXED, __HIP_MEMORY_SCOPE_AGENT); }
__device__ __forceinline__ unsigned xb_xcc_id() { return (unsigned)__builtin_amdgcn_s_getreg((3 << 11) | 20) & 0xFu; }
#define XB_SPIN(cond, bar) do { unsigned _sp = 0; while (cond) { __builtin_amdgcn_s_sleep(1); \
    if ((++_sp & 255u) == 0u) { if (xb_ld(&(bar)[XB_TMO])) break; if (_sp > XB_SPIN_CAP) { atomicAdd(&(bar)[XB_TMO], 1u); break; } } } } while (0)

struct XcdBarrier {
    unsigned gsz;
    unsigned* bar; unsigned x;
    volatile LAS unsigned* st;
};

__device__ __forceinline__ XcdBarrier xcd_barrier_post(unsigned* bar, volatile LAS unsigned* st, unsigned gsz) {
    XcdBarrier b; b.gsz = gsz; b.bar = bar; b.x = xb_xcc_id(); b.st = st;
    if (threadIdx.x == 0) (void)xb_add(&bar[XB_XCNT(b.x)], 1u);
    return b;
}
__device__ __forceinline__ void xcd_barrier_complete(unsigned* bar, unsigned x, unsigned G, unsigned& nloc, unsigned& nx) {
    unsigned sum, cnt, mine, sp = 0u;
    for (;;) {
        sum = 0u; cnt = 0u; mine = 0u;
#pragma unroll
        for (unsigned j = 0; j < 16; ++j) { const unsigned c = xb_ld(&bar[XB_XCNT(j)]); sum += c; cnt += (c > 0u) ? 1u : 0u; mine = (j == x) ? c : mine; }
        if (sum == G) break;
        __builtin_amdgcn_s_sleep(1);
        if ((++sp & 255u) == 0u) { if (xb_ld(&bar[XB_TMO])) break; if (sp > XB_SPIN_CAP) { atomicAdd(&bar[XB_TMO], 1u); break; } }
    }
    nloc = mine > 0u ? mine : 1u; nx = cnt > 0u ? cnt : 1u;
}

__device__ __forceinline__ void xcd_barrier(const XcdBarrier& b) {
    asm volatile("s_waitcnt vmcnt(0)" ::: "memory");
    __syncthreads();
    if (threadIdx.x == 0) {
        unsigned* bar = b.bar;
        __builtin_amdgcn_s_waitcnt(0);
        unsigned nloc = b.st[0], nx = b.st[1];
        if (nloc == 0u) { xcd_barrier_complete(bar, b.x, b.gsz, nloc, nx); b.st[0] = nloc; b.st[1] = nx; }
        const unsigned old = xb_add(&bar[XB_XSUB(b.x)], 1u);
        const unsigned gen = old / nloc;
        if (old + 1u == (gen + 1u) * nloc) {
            __builtin_amdgcn_fence(__ATOMIC_RELEASE, "agent");
            asm volatile("s_waitcnt vmcnt(0)" ::: "memory");
            const unsigned og = xb_add(&bar[XB_TOP], 1u);
            const unsigned tg = og / nx;
            if (og + 1u == (tg + 1u) * nx) xb_add(&bar[XB_TOPGEN], 1u);
            else XB_SPIN(xb_ld(&bar[XB_TOPGEN]) == tg, bar);
            __builtin_amdgcn_fence(__ATOMIC_ACQUIRE, "agent");
            xb_add(&bar[XB_XGEN(b.x)], 1u);
            asm volatile("s_waitcnt vmcnt(0)" ::: "memory");
        } else {
            XB_SPIN(xb_ld(&bar[XB_XGEN(b.x)]) == gen, bar);
            __builtin_amdgcn_fence(__ATOMIC_ACQUIRE, "agent");
            asm volatile("s_waitcnt vmcnt(0)" ::: "memory");
        }
    }
    __syncthreads();
}


enum { K_P0 = 0, K_IN = 1, K_MIX = 2, K_OUT = 3, K_UP = 5, K_FIX = 6, K_DOWN = 7, K_FINAL = 8 };
struct Step { int kind, layer, side, tile0, nt, pre; };
__device__ __forceinline__ Step get_step(int pc) {
    switch (pc) {
        case 0:  return Step{K_P0, 0, 0, 0, 0, 0};
        case 1:  return Step{K_IN, 0, 0, 0, 69, 1};
        case 2:  return Step{K_MIX, 0, 0, 0, 0, 1};
        case 3:  return Step{K_OUT, 0, 1, 64, 5, 2};
        case 4:  return Step{K_UP, 0, 1, 64, 5, 2};
        case 5:  return Step{K_DOWN, 0, 1, 64, 5, 2};
        case 6:  return Step{K_IN, 1, 1, 64, 5, 2};
        case 7:  return Step{K_OUT, 0, 0, 0, 64, 1};
        case 8:  return Step{K_UP, 0, 0, 0, 64, 1};
        case 9:  return Step{K_DOWN, 0, 0, 0, 64, 1};
        case 10: return Step{K_IN, 1, 0, 0, 64, 1};
        case 11: return Step{K_MIX, 1, 0, 0, 0, 1};
        case 12: return Step{K_OUT, 1, 1, 64, 5, 2};
        case 13: return Step{K_UP, 1, 1, 64, 5, 2};
        case 14: return Step{K_DOWN, 1, 1, 64, 5, 2};
        case 15: return Step{K_OUT, 1, 0, 0, 64, 1};
        case 16: return Step{K_UP, 1, 0, 0, 64, 1};
        default: return Step{K_DOWN, 1, 0, 0, 64, 1};
    }
}

__global__ void __launch_bounds__(NWAVES * 64, 2) fwd_kernel(Args args) {
    extern __shared__ __attribute__((aligned(16))) unsigned char lds_raw[];
    cg::grid_group grid = cg::this_grid();
    Frame F;
    F.lds = (LAS unsigned char*)lds_raw;
#define REFRESH() do { int t_ = threadIdx.x; asm volatile("" : "+v"(t_)); F.tid = t_; F.lane = t_ & 63; F.wave = __builtin_amdgcn_readfirstlane(t_ >> 6); F.gw = blockIdx.x * NWAVES + F.wave; } while (0)
    F.G = gridDim.x; F.NGW = F.G * NWAVES; REFRESH();
    F.in = args.in; F.out = args.out; F.ws = args.ws;
    volatile LAS unsigned* MISC = (volatile LAS unsigned*)(F.lds + LDSCTL_OFF);
    if (threadIdx.x < 16) MISC[threadIdx.x] = 0u;
    __syncthreads();
    const bool side_wg = blockIdx.x >= 64;
    (void)xcd_barrier_post((unsigned*)(args.ws + WS_CTL), MISC + 8, F.G);
    if (side_wg) (void)xcd_barrier_post((unsigned*)(args.ws + WS_CTL) + 4096, MISC + 10, F.G - 64);
#ifndef KMASK
#define KMASK 0x1ff
#endif
#define INK(kind) ((((KMASK) >> (kind)) & 1) != 0)
#ifndef PROBE_MULT
#define PROBE_MULT 1
#endif
#ifdef PROBE_BLOCK
    volatile LAS unsigned long long* STMP = (volatile LAS unsigned long long*)(F.lds + LDSCTL_OFF + 128);
    if (threadIdx.x < 64) STMP[threadIdx.x] = 0ull;
    __syncthreads();
#define STAMP(id) do { if (blockIdx.x == PROBE_BLOCK && threadIdx.x == 0) STMP[(id)] = __builtin_amdgcn_s_memrealtime(); } while (0)
#else
#define STAMP(id) do { } while (0)
#endif
#pragma unroll 1
    for (int pc = 0; pc < NSTEP; ++pc) {
        const Step st = get_step(pc);
        if (st.pre == 1) { if (args.ph_hi < 0) grid.sync();
            { XcdBarrier bar_; bar_.gsz = F.G; bar_.bar = (unsigned*)(args.ws + WS_CTL); bar_.x = xb_xcc_id(); bar_.st = (volatile LAS unsigned*)(F.lds + LDSCTL_OFF) + 8; xcd_barrier(bar_); } }
        if (st.side && !side_wg) continue;
        if (st.pre == 2) { XcdBarrier bar_; bar_.gsz = F.G - 64; bar_.bar = (unsigned*)(args.ws + WS_CTL) + 4096; bar_.x = xb_xcc_id(); bar_.st = (volatile LAS unsigned*)(F.lds + LDSCTL_OFF) + 10; xcd_barrier(bar_); }
        const int layer = st.layer;
        STAMP(2 * pc);
        const int Gs = st.side ? F.G - 64 : F.G, cs = st.side ? (int)blockIdx.x - 64 : (int)blockIdx.x;
        if (st.kind == K_P0) { if (INK(0)) { REFRESH(); p0_weights(F, 0, P0_ITEMS_L0, F.gw, F.NGW); STAMP(42); __syncthreads(); REFRESH(); p0_rows(F); STAMP(43); REFRESH(); p0_rotary(F, (float*)(args.ws + WS_ROT)); p0_zero_ssq(F); STAMP(44); } }
        else if (st.kind == K_IN) { if (INK(1)) {
            pg8::Gemm g{F_XG(F), (const bf16*)(args.ws + (layer == 0 ? WS_WAB : WS_WC)), MPAD, 4096, 1024}; pg8::StaticOrder S; S.init(st.nt, 4096, Gs, cs, st.tile0);
            if (layer == 0) { pg8::EpiBf16 E{F_Z(F), F_ZS1(F, layer), 64, 4096}; pg8::gemm_phase<pg8::EpiBf16, pg8::StaticOrder, false>(F.lds, g, S, E); }
            else { EpiHg E{F_Z(F), F_ZS1(F, layer), 64, 4096, (const float*)(args.ws + WS_LB), (float*)(args.ws + WS_GD), (float*)(args.ws + WS_GDS)}; pg8::gemm_phase<EpiHg, pg8::StaticOrder, false>(F.lds, g, S, E); } } }
        else if (st.kind == K_MIX) { if (INK(2)) {
            if (layer == 1 && side_wg) { REFRESH(); p0_weights(F, P0_ITEMS_L0, P0_ITEMS_ALL, (blockIdx.x - 64) * NWAVES + F.wave, (F.G - 64) * NWAVES); __syncthreads(); }
            REFRESH(); if (layer == 0) mixer_layer0(F); else mixer_layer1(F); } }
        else if (st.kind == K_OUT) { if (INK(3)) {
            pg8::Gemm g{F_XN(F), (const bf16*)(args.ws + (layer == 0 ? WS_WOAB : WS_WOC)), MPAD, 1024, 1024}; pg8::StaticOrder S; S.init(st.nt, 1024, Gs, cs, st.tile0);
            pg8::EpiResid E{F_X0(F), F_X1(F), PM_META, DM, F_XG(F), (float*)nullptr, 0, F.in[20] + (size_t)layer * DM, F_SSQ(F, 2 * layer), (unsigned*)(args.ws + WS_PCNT) + (2 * layer) * 69 * 16,
                layer == 0 ? F.in[0] : (const float*)nullptr, F.in[1] - (size_t)ROW_S * DM, F.in[8] - (size_t)ROW_M * DM, layer == 0 ? NREAL : MPAD};
            pg8::gemm_phase<pg8::EpiResid, pg8::StaticOrder, false>(F.lds, g, S, E); } }
        else if (st.kind == K_UP) { if (INK(5)) {
            pg8::Gemm g{F_XG(F), (const bf16*)(args.ws + WS_WF1) + (size_t)layer * NFF * 1024, MPAD, NFF, 1024}; pg8::StaticOrder S; S.init(st.nt, NFF, Gs, cs, st.tile0);
            EpiFfn E{F_Z(F), F_HS1(F), F.in[22] + (size_t)layer * 3 * DFF, F.in[23] + (size_t)layer * DFF, F.in[7] + (size_t)layer * 128 * 2 * DFF, F.out + O_FS + (size_t)layer * 128 * 2 * DFF, F_SBL(F), F_SBF(F)};
            pg8::gemm_phase<EpiFfn, pg8::StaticOrder, true>(F.lds, g, S, E); } }
        else if (st.kind == K_DOWN) { if (INK(7)) {
            pg8::Gemm g{st.side ? F_HS1(F) : F_Z(F), (const bf16*)(args.ws + WS_WF2) + (size_t)layer * 1024 * DFF, MPAD, 1024, DFF}; pg8::StaticOrder S; S.init(st.nt, 1024, Gs, cs, st.tile0);
            if (!st.side) {
                REFRESH(); pg8::StaticOrder S2; S2.init(st.nt, 1024, Gs, cs, st.tile0); pg8::Unit fu; for (int i = 0; S2.next(i, fu); ++i) ffn_fixup_tile(F, layer, fu.pm, fu.pn == 0);
                asm volatile("s_waitcnt vmcnt(0)" ::: "memory"); __syncthreads(); }
            pg8::EpiResid E{F_X0(F), F_X1(F), PM_META, DM, F_XG(F), layer == 0 ? (float*)nullptr : F.out, ROW_M, layer == 0 ? F.in[9] + DM : F.in[25], F_SSQ(F, 2 * layer + 1), (unsigned*)(args.ws + WS_PCNT) + (2 * layer + 1) * 69 * 16,
                (const float*)nullptr, (const float*)nullptr, (const float*)nullptr, MPAD};
            pg8::gemm_phase<pg8::EpiResid, pg8::StaticOrder, false>(F.lds, g, S, E); } }
        STAMP(2 * pc + 1);
    }
#ifdef PROBE_BLOCK
    if (blockIdx.x == PROBE_BLOCK && threadIdx.x == 0) { const unsigned long long d = (STMP[PROBE_B] - STMP[PROBE_A]) * PROBE_MULT, t0 = __builtin_amdgcn_s_memrealtime(); while (__builtin_amdgcn_s_memrealtime() - t0 < d) __builtin_amdgcn_s_sleep(8); }
#endif
#undef INK
#undef REFRESH
}

extern "C" void kernel_launch(void* const* d_in, const int* in_sizes, int n_in, void* d_out, int out_size, void* d_ws, size_t ws_size, hipStream_t stream) {
    static int grid = 0;
    if (grid == 0) {
        if (n_in != 26 || (size_t)out_size != O_END || ws_size < WS_END) { fprintf(stderr, "kernel_launch: unexpected shapes: n_in %d out %d ws %zu\n", n_in, out_size, ws_size); grid = -1; return; }
        int dev = 0, cus = 0, per_cu = 0;
        if (hipGetDevice(&dev) != hipSuccess || hipDeviceGetAttribute(&cus, hipDeviceAttributeMultiprocessorCount, dev) != hipSuccess) { grid = -1; return; }
        if (hipFuncSetAttribute((const void*)fwd_kernel, hipFuncAttributeMaxDynamicSharedMemorySize, LDS_BYTES) != hipSuccess) { fprintf(stderr, "kernel_launch: hipFuncSetAttribute failed\n"); grid = -1; return; }
        if (hipOccupancyMaxActiveBlocksPerMultiprocessor(&per_cu, (const void*)fwd_kernel, NWAVES * 64, LDS_BYTES) != hipSuccess || per_cu < 1) { fprintf(stderr, "kernel_launch: occupancy query says %d\n", per_cu); per_cu = 1; }
        (void)hipGetLastError();
        grid = cus;
        if (grid != 256) { fprintf(stderr, "kernel_launch: the fused row-norm exchange needs one unit per workgroup in the N = 1024 GEMM steps: exactly 256 CUs (got %d)\n", grid); grid = -1; return; }
        if (grid < 128) { fprintf(stderr, "kernel_launch: this kernel's static work split needs >= 128 CUs (got %d)\n", grid); grid = -1; return; }
    }
    if (grid < 0) return;
    if (hipMemsetAsync((char*)d_ws + WS_CTL, 0, CTL_ZERO_BYTES, stream) != hipSuccess) { fprintf(stderr, "kernel_launch: hipMemsetAsync failed\n"); return; }
    Args a{};
    for (int i = 0; i < 26; ++i) a.in[i] = (const float*)d_in[i];
    a.out = (float*)d_out; a.ws = (unsigned char*)d_ws;
    a.ph_lo = 0; a.ph_hi = NSTEP;
    void* kargs[] = {&a};
    hipError_t e = hipLaunchCooperativeKernel((const void*)fwd_kernel, dim3(grid), dim3(NWAVES * 64), kargs, LDS_BYTES, stream);
    if (e != hipSuccess) fprintf(stderr, "kernel_launch: cooperative launch failed: %s (grid %d)\n", hipGetErrorString(e), grid);
}
```

```cpp
#include <hip/hip_runtime.h>
#include <hip/hip_cooperative_groups.h>
#include <cstdio>
#include <cstdint>
namespace cg = cooperative_groups;

namespace pg8 {
#define PG8_LAS __attribute__((address_space(3)))
typedef unsigned short bf16_t;
typedef short bf16x8 __attribute__((ext_vector_type(8)));
typedef float f32x4 __attribute__((ext_vector_type(4)));
typedef unsigned u32x4 __attribute__((ext_vector_type(4)));
typedef unsigned u32x2 __attribute__((ext_vector_type(2)));
constexpr int BM = 256, BK = 64, HALF = 128, HTB = HALF * BK * 2  , STAGE_BYTES = 8 * HTB, NXCD = 8, WGM = 8;

__host__ __device__ __forceinline__ int lds_byte(int r, int c) { const int st = (r >> 4) * 2 + (c >> 5), rr = r & 15, cc = c & 31, ob = rr * 64 + cc * 2; return st * 1024 + (ob ^ (((ob >> 9) & 1) << 5)); }
__host__ __device__ __forceinline__ void stage_rc(int b, int& R, int& C) { const int st = b / 1024, sb = b % 1024, swz = sb ^ (((sb >> 9) & 1) << 5); R = (st >> 1) * 16 + swz / 64; C = (st & 1) * 32 + (swz % 64) / 2; }
__host__ __device__ __forceinline__ int perm32(int rho) { const int n = rho >> 4, i = rho & 15; return 8 * (i >> 2) + 4 * n + (i & 3); }

struct Unit { int pm, pn; };
struct Gemm { const bf16_t* A; const bf16_t* Bt; int M, N, K, ld; };

struct StaticOrder {
    int nM, nN, nwg, G, c, pm0;
    __host__ __device__ __forceinline__ void init(int nMt, int N, int G_, int c_, int pm0_) { nM = nMt; nN = N / BM; nwg = nM * nN; G = G_; c = c_; pm0 = pm0_; }
    __host__ __device__ __forceinline__ bool next(int i, Unit& u) const {
        const long L = (long)i * G + c; if (L >= nwg) return false;
        int wgid = (int)L; { const int q = nwg / NXCD, r = nwg % NXCD, xcd = wgid % NXCD, off = wgid / NXCD; wgid = (xcd < r ? xcd * (q + 1) : r * (q + 1) + (xcd - r) * q) + off; }
        const int nig = WGM * nN, gid = wgid / nig, fm = gid * WGM, gsz = (nM - fm) < WGM ? (nM - fm) : WGM;
        u.pm = pm0 + fm + ((wgid % nig) % gsz); u.pn = (wgid % nig) / gsz; return true;
    }
    __device__ __forceinline__ void a_ready(const Unit&) const {}
    __device__ __forceinline__ void done(const Unit&) const {}
};

__device__ __forceinline__ unsigned cvt_pk_bf16(float lo, float hi) { unsigned r; asm volatile("v_cvt_pk_bf16_f32 %0, %1, %2" : "=v"(r) : "v"(lo), "v"(hi)); return r; }

struct EpiBf16 {
    static constexpr bool PERM = true, AFTER_DRAIN = false;
    bf16_t* O0; bf16_t* O1; int pm_split; int ldc;
    __device__ __forceinline__ void operator()(f32x4 (&acc)[2][2][4][2], const Unit& u, int wr, int wc, int fr, int fq) const {
        bf16_t* O = (u.pm < pm_split) ? O0 : O1;
        const int row0 = u.pm * BM + wr * 64 + fr; const int col0 = u.pn * BM + wc * 32 + 8 * fq;
#pragma unroll
        for (int ai = 0; ai < 2; ++ai)
#pragma unroll
            for (int m = 0; m < 4; ++m) { bf16_t* rowp = O + (size_t)(row0 + ai * HALF + m * 16) * ldc + col0;
#pragma unroll
                for (int bj = 0; bj < 2; ++bj) { const f32x4 v0 = acc[ai][bj][m][0], v1 = acc[ai][bj][m][1];
                    u32x4 w; w.x = cvt_pk_bf16(v0[0], v0[1]); w.y = cvt_pk_bf16(v0[2], v0[3]); w.z = cvt_pk_bf16(v1[0], v1[1]); w.w = cvt_pk_bf16(v1[2], v1[3]);
                    *(u32x4*)(rowp + bj * HALF) = w; } }
    }
};

template <bool SLAB> struct EpiResid {
    static constexpr bool PERM = true, AFTER_DRAIN = false;
    float* X0; float* X1; int pm_split; int ldc; bf16_t* XG; float* Y; int yrows; const float* gain; float* ssq; unsigned* cnt;
    float* slab0; float* slab1; unsigned* sflag; int pm0;
    const float* R0; const float* R1; const float* R2; int nreal;
    __device__ __forceinline__ void operator()(f32x4 (&acc)[2][2][4][2], const Unit& u, int wr, int wc, int fr, int fq) const {
        if constexpr (SLAB) {
            const int ui = (u.pm - pm0) * 4 + u.pn;
            float* sl = (ui < 15 ? slab0 + (size_t)ui * 65536 : slab1 + (size_t)(ui - 15) * 65536);
            const int vo_ = ((wr * 4 + wc) * 64 + fr + 16 * fq) * 16;
            unsigned* fl = sflag + ui * 16;
            const __amdgpu_buffer_rsrc_t rs_ = __builtin_amdgcn_make_buffer_rsrc((void*)sl, 0, 262144, 0x00020000);
            if (fr == 0 && fq == 0) { unsigned sp = 0u; while (__hip_atomic_load(fl, __ATOMIC_RELAXED, __HIP_MEMORY_SCOPE_AGENT) < 8u) { __builtin_amdgcn_s_sleep(1); if (++sp > (1u << 22)) break; } }
            asm volatile("" ::: "memory");
#pragma unroll
            for (int ai = 0; ai < 2; ++ai)
#pragma unroll
                for (int bj = 0; bj < 2; ++bj)
#pragma unroll
                    for (int m = 0; m < 4; ++m) {
                        const u32x4 t0_ = __builtin_amdgcn_raw_buffer_load_b128(rs_, vo_, (((ai * 2 + bj) * 4 + m) * 2 + 0) * 8192, 16), t1_ = __builtin_amdgcn_raw_buffer_load_b128(rs_, vo_, (((ai * 2 + bj) * 4 + m) * 2 + 1) * 8192, 16);
                        acc[ai][bj][m][0] = acc[ai][bj][m][0] + __builtin_bit_cast(f32x4, t0_); acc[ai][bj][m][1] = acc[ai][bj][m][1] + __builtin_bit_cast(f32x4, t1_);
                        asm volatile("" : "+v"(acc[ai][bj][m][0]), "+v"(acc[ai][bj][m][1])); }
        }
        float* C = (u.pm < pm_split) ? X0 : X1;
        const float* Rsrc = R0 ? (u.pm < 64 ? R0 : u.pm < pm_split ? R1 : R2) : (const float*)C;
        const int row0 = u.pm * BM + wr * 64 + fr, col0 = u.pn * BM + wc * 32 + 8 * fq;
#pragma unroll
        for (int ai = 0; ai < 2; ++ai)
#pragma unroll
            for (int mp = 0; mp < 2; ++mp) {
                f32x4 t[2][2][2];
#pragma unroll
                for (int mm = 0; mm < 2; ++mm) { const int rr_ = row0 + ai * HALF + (2 * mp + mm) * 16; const float* rowp = Rsrc + (size_t)rr_ * ldc + col0; const bool have = rr_ < nreal;
#pragma unroll
                    for (int bj = 0; bj < 2; ++bj)
#pragma unroll
                        for (int n = 0; n < 2; ++n) t[mm][bj][n] = have ? *(const f32x4*)(rowp + bj * HALF + 4 * n) : (f32x4){0.f, 0.f, 0.f, 0.f}; }
#pragma unroll
                for (int mm = 0; mm < 2; ++mm) { const int m = 2 * mp + mm; const int row = row0 + ai * HALF + m * 16; float sq = 0.f;
#pragma unroll
                    for (int bj = 0; bj < 2; ++bj)
#pragma unroll
                        for (int n = 0; n < 2; ++n) { const f32x4 v = t[mm][bj][n] + acc[ai][bj][m][n]; acc[ai][bj][m][n] = v;
                            sq += (v[0] * v[0] + v[1] * v[1]) + (v[2] * v[2] + v[3] * v[3]); }
                    sq += __shfl_xor(sq, 16); sq += __shfl_xor(sq, 32); if (fq == 0) atomicAdd(ssq + row, sq); }
                asm volatile("" ::: "memory"); }
        asm volatile("s_waitcnt vmcnt(0)" ::: "memory");
        unsigned* pc = cnt + u.pm * 16;
        if (fr == 0 && fq == 0) {
            __hip_atomic_fetch_add(pc, 1u, __ATOMIC_RELAXED, __HIP_MEMORY_SCOPE_AGENT);
        }
        if (!Y) {
#pragma unroll
            for (int ai = 0; ai < 2; ++ai)
#pragma unroll
                for (int m = 0; m < 4; ++m) { float* rowp = C + (size_t)(row0 + ai * HALF + m * 16) * ldc + col0;
#pragma unroll
                    for (int bj = 0; bj < 2; ++bj)
#pragma unroll
                        for (int n = 0; n < 2; ++n) *(f32x4*)(rowp + bj * HALF + 4 * n) = acc[ai][bj][m][n]; }
        }
        if (fr == 0 && fq == 0) {
            unsigned sp = 0u;
            while (__hip_atomic_load(pc, __ATOMIC_RELAXED, __HIP_MEMORY_SCOPE_AGENT) < 32u) { __builtin_amdgcn_s_sleep(1); if (++sp > (1u << 22)) break; }
        }
        asm volatile("" ::: "memory");
        f32x4 gv[2][2];
#pragma unroll
        for (int bj = 0; bj < 2; ++bj)
#pragma unroll
            for (int n = 0; n < 2; ++n) gv[bj][n] = *(const f32x4*)(gain + col0 + bj * HALF + 4 * n);
#pragma unroll
        for (int ai = 0; ai < 2; ++ai)
#pragma unroll
            for (int m = 0; m < 4; ++m) { const int row = row0 + ai * HALF + m * 16;
                const float rs = __builtin_amdgcn_rsqf(__hip_atomic_load(ssq + row, __ATOMIC_RELAXED, __HIP_MEMORY_SCOPE_AGENT) * (1.0f / 1024.0f) + 1e-6f);
#pragma unroll
                for (int bj = 0; bj < 2; ++bj) { const f32x4 y0 = acc[ai][bj][m][0] * rs * gv[bj][0], y1 = acc[ai][bj][m][1] * rs * gv[bj][1];
                    if (Y) { if (row < yrows) { *(f32x4*)(Y + (size_t)row * ldc + col0 + bj * HALF) = y0; *(f32x4*)(Y + (size_t)row * ldc + col0 + bj * HALF + 4) = y1; } }
                    else { u32x4 w; w.x = cvt_pk_bf16(y0[0], y0[1]); w.y = cvt_pk_bf16(y0[2], y0[3]); w.z = cvt_pk_bf16(y1[0], y1[1]); w.w = cvt_pk_bf16(y1[2], y1[3]);
                        *(u32x4*)(XG + (size_t)row * ldc + col0 + bj * HALF) = w; } } }
    }
};

struct EpiSlab {
    static constexpr bool PERM = true, AFTER_DRAIN = false;
    float* slab0; float* slab1; unsigned* sflag; int pm0;
    __device__ __forceinline__ void operator()(f32x4 (&acc)[2][2][4][2], const Unit& u, int wr, int wc, int fr, int fq) const {
        const int ui = (u.pm - pm0) * 4 + u.pn;
        float* sl = (ui < 15 ? slab0 + (size_t)ui * 65536 : slab1 + (size_t)(ui - 15) * 65536);
        const int vo_ = ((wr * 4 + wc) * 64 + fr + 16 * fq) * 16;
        const __amdgpu_buffer_rsrc_t rs_ = __builtin_amdgcn_make_buffer_rsrc((void*)sl, 0, 262144, 0x00020000);
#pragma unroll
        for (int ai = 0; ai < 2; ++ai)
#pragma unroll
            for (int bj = 0; bj < 2; ++bj)
#pragma unroll
                for (int m = 0; m < 4; ++m)
#pragma unroll
                    for (int n = 0; n < 2; ++n) __builtin_amdgcn_raw_buffer_store_b128(__builtin_bit_cast(u32x4, acc[ai][bj][m][n]), rs_, vo_, (((ai * 2 + bj) * 4 + m) * 2 + n) * 8192, 16);
        asm volatile("s_waitcnt vmcnt(0)" ::: "memory");
        if (fr == 0 && fq == 0) __hip_atomic_fetch_add(sflag + ui * 16, 1u, __ATOMIC_RELAXED, __HIP_MEMORY_SCOPE_AGENT);
    }
};

template <class Epi, class Sched, bool APERM>
__device__ __forceinline__ void gemm_phase(PG8_LAS unsigned char* lds, const Gemm g, const Sched& S, const Epi& E) {
    int tid_ = threadIdx.x; asm volatile("" : "+v"(tid_));
    const int tid = tid_, wid = __builtin_amdgcn_readfirstlane(tid >> 6), lane = tid & 63, wr = wid >> 2, wc = wid & 3, fr = lane & 15, fq = lane >> 4;
    const int K = g.ld, nt = g.K / BK;
    unsigned voffA[2], voffB[2];
#pragma unroll
    for (int i = 0; i < 2; ++i) { int R, C; stage_rc(tid * 16 + i * 8192, R, C); const int Rb = Epi::PERM ? ((R & ~31) + perm32(R & 31)) : R;
        const int Ra = APERM ? (128 * (R >> 6) + 8 * (R & 15) + ((R >> 4) & 3)) : R;
        voffA[i] = (unsigned)(Ra * K + C) * 2u; voffB[i] = (unsigned)(Rb * K + C) * 2u; }
    const size_t kstep = (size_t)(BK * 2);
    const size_t hstep = (size_t)HALF * K * 2;
    const size_t hstepA = APERM ? (size_t)4 * K * 2 : hstep;
    const size_t tstep = 2 * hstep;
    const unsigned ldsw = (unsigned)wid * 1024u;
    const int aoff = lds_byte(wr * 64 + fr, fq * 8), boff = lds_byte(wc * 32 + fr, fq * 8);
#define PG8_SA(b, h) (((b) * 2 + (h)) * HTB)
#define PG8_SB(b, h) ((4 + (b) * 2 + (h)) * HTB)
#define PG8_STAGE(bufoff, gbase, voff) do { _Pragma("unroll") for (int _i = 0; _i < 2; ++_i) \
        __builtin_amdgcn_global_load_lds((const unsigned*)((const char*)(gbase) + (voff)[_i]), (PG8_LAS unsigned*)(lds + (bufoff) + ldsw + _i * 8192), 16, 0, 0); } while (0)
#define PG8_LDA(dst, b, h) do { _Pragma("unroll") for (int m = 0; m < 4; ++m) _Pragma("unroll") for (int k = 0; k < 2; ++k) dst[m][k] = *(const PG8_LAS bf16x8*)(lds + PG8_SA(b, h) + aoff + m * 2048 + k * 1024); } while (0)
#define PG8_LDB(dst, b, h) do { _Pragma("unroll") for (int n = 0; n < 2; ++n) _Pragma("unroll") for (int k = 0; k < 2; ++k) dst[n][k] = *(const PG8_LAS bf16x8*)(lds + PG8_SB(b, h) + boff + n * 2048 + k * 1024); } while (0)
#define PG8_MMA(ai, bj, At, Bt) do { __builtin_amdgcn_s_setprio(1); _Pragma("unroll") for (int m = 0; m < 4; ++m) _Pragma("unroll") for (int n = 0; n < 2; ++n) _Pragma("unroll") for (int k = 0; k < 2; ++k) \
        acc[ai][bj][m][n] = __builtin_amdgcn_mfma_f32_16x16x32_bf16(Bt[n][k], At[m][k], acc[ai][bj][m][n], 0, 0, 0); __builtin_amdgcn_s_setprio(0); } while (0)
#define PG8_WAIT_V(n) asm volatile("s_waitcnt vmcnt(" #n ")" ::: "memory")
#define PG8_WAIT_L(n) asm volatile("s_waitcnt lgkmcnt(" #n ")" ::: "memory")
#define PG8_BAR __builtin_amdgcn_s_barrier()
#define PG8_SCHED __builtin_amdgcn_sched_barrier(0)
    Unit cur, nxt; int ui = 0;
    if (!S.next(0, cur)) return;
    f32x4 acc[2][2][4][2];
#pragma unroll
    for (int a = 0; a < 2; ++a)
#pragma unroll
        for (int b = 0; b < 2; ++b)
#pragma unroll
            for (int m = 0; m < 4; ++m)
#pragma unroll
                for (int n = 0; n < 2; ++n) acc[a][b][m][n] = (f32x4){0.f, 0.f, 0.f, 0.f};
    bf16x8 At[4][2], B0[2][2], B1[2][2];
    const char* cA = (const char*)g.A + (size_t)cur.pm * tstep; const char* cB = (const char*)g.Bt + (size_t)cur.pn * tstep;
    S.a_ready(cur);
    PG8_STAGE(PG8_SB(0, 0), cB, voffB); PG8_STAGE(PG8_SB(0, 1), cB + hstep, voffB); PG8_STAGE(PG8_SA(0, 0), cA, voffA); PG8_STAGE(PG8_SA(0, 1), cA + hstepA, voffA);
    if (wr == 1) PG8_BAR;
    PG8_WAIT_V(2); PG8_BAR;
    PG8_STAGE(PG8_SB(1, 0), cB + kstep, voffB); PG8_STAGE(PG8_SA(1, 0), cA + kstep, voffA); PG8_STAGE(PG8_SB(1, 1), cB + hstep + kstep, voffB);
    PG8_WAIT_V(6); PG8_BAR;
    for (;;) {
        const bool has_next = S.next(ui + 1, nxt);
        const char* nA = has_next ? (const char*)g.A + (size_t)nxt.pm * tstep : cA; const char* nB = has_next ? (const char*)g.Bt + (size_t)nxt.pn * tstep : cB;
        for (int t = 0; t < nt; t += 2) {
            const bool last = (t == nt - 2);
            const char* a1 = cA + (size_t)(t + 1) * kstep;
            const char* a2 = last ? nA : cA + (size_t)(t + 2) * kstep; const char* b2 = last ? nB : cB + (size_t)(t + 2) * kstep;
            const char* a3 = a2 + kstep; const char* b3 = b2 + kstep;
            if (last && has_next) S.a_ready(nxt);
            PG8_LDB(B0, 0, 0); PG8_LDB(B1, 0, 1); PG8_SCHED; PG8_LDA(At, 0, 0); PG8_STAGE(PG8_SA(1, 1), a1 + hstepA, voffA);
            PG8_WAIT_V(8); PG8_WAIT_L(0); PG8_BAR; PG8_MMA(0, 0, At, B0); PG8_MMA(0, 1, At, B1); PG8_BAR; PG8_SCHED;
            PG8_LDA(At, 0, 1); PG8_STAGE(PG8_SB(0, 0), b2, voffB); PG8_STAGE(PG8_SB(0, 1), b2 + hstep, voffB); PG8_STAGE(PG8_SA(0, 0), a2, voffA);
            PG8_WAIT_V(8); PG8_WAIT_L(0); PG8_BAR; PG8_MMA(1, 0, At, B0); PG8_MMA(1, 1, At, B1); PG8_BAR; PG8_SCHED;
            PG8_LDB(B0, 1, 0); PG8_LDB(B1, 1, 1); PG8_SCHED; PG8_LDA(At, 1, 0); PG8_STAGE(PG8_SA(0, 1), a2 + hstepA, voffA);
            PG8_WAIT_V(8); PG8_WAIT_L(0); PG8_BAR; PG8_MMA(0, 0, At, B0); PG8_MMA(0, 1, At, B1); PG8_BAR; PG8_SCHED;
            PG8_LDA(At, 1, 1); PG8_STAGE(PG8_SB(1, 0), b3, voffB); PG8_STAGE(PG8_SB(1, 1), b3 + hstep, voffB); PG8_STAGE(PG8_SA(1, 0), a3, voffA);
            PG8_WAIT_V(8); PG8_WAIT_L(0); PG8_BAR; PG8_MMA(1, 0, At, B0); PG8_MMA(1, 1, At, B1); PG8_BAR; PG8_SCHED;
        }
        if (wr == 0) PG8_BAR;
        E(acc, cur, wr, wc, fr, fq); S.done(cur);
        if (!has_next) break;
#pragma unroll
        for (int a = 0; a < 2; ++a)
#pragma unroll
            for (int b = 0; b < 2; ++b)
#pragma unroll
                for (int m = 0; m < 4; ++m)
#pragma unroll
                    for (int n = 0; n < 2; ++n) acc[a][b][m][n] = (f32x4){0.f, 0.f, 0.f, 0.f};
        cur = nxt; cA = nA; cB = nB; ++ui;
        if (wr == 1) PG8_BAR;
    }
    PG8_WAIT_V(0);
    PG8_BAR;
#undef PG8_SA
#undef PG8_SB
#undef PG8_STAGE
#undef PG8_LDA
#undef PG8_LDB
#undef PG8_MMA
#undef PG8_WAIT_V
#undef PG8_WAIT_L
#undef PG8_BAR
#undef PG8_SCHED
}
}
constexpr int DM = 1024;
constexpr int ROW_S = 16384;
constexpr int ROW_M = 17408;
constexpr int NREAL = 17424;
constexpr int MPAD = 17664;
constexpr int PM_META = 68;
constexpr int NAB = 4096, NCC = 4096, DFF = 2816, NFF = 5632, ABW = 4104;
constexpr int NGRP = 138, GRP_META = 136;
constexpr float EPS = 1e-6f;
constexpr float KSCALE = 0.08838834764831845f;

constexpr size_t O_YP = 0, O_YS = 16777216, O_CP = 17825792, O_CS = 18350080, O_NP = 26738688, O_NS = 26742784, O_MP = 26808320, O_MS = 26808352,
                 O_RP = 26808864, O_RS = 27333152, O_HP = 35721760, O_HS = 36770336, O_FP = 53547552, O_FS = 53637664, O_END = 55079456;

constexpr size_t MiB = 1u << 20;
constexpr size_t WS_CTL = 0, CTL_ZERO_BYTES = 128 * 1024;
constexpr size_t WS_PCNT = 64 * 1024;
constexpr size_t WS_SFLAG = 96 * 1024;
constexpr size_t WS_SLAB0 = 223 * MiB + 65536, WS_SLAB1 = 277 * MiB + 512 * 1024;
constexpr size_t WS_WAB = 1 * MiB, WS_WOAB = 9 * MiB, WS_WC = 11 * MiB, WS_WOC = 19 * MiB, WS_WF1 = 21 * MiB  , WS_WF2 = 43 * MiB  ;
constexpr size_t WS_XN = 54 * MiB;
constexpr size_t WS_Z = 89 * MiB;
constexpr size_t WS_GD = 217 * MiB;
constexpr size_t WS_GDS = 222 * MiB;
constexpr size_t WS_LB = 223 * MiB;
constexpr size_t WS_XM = 227 * MiB;
constexpr size_t WS_G = 228 * MiB;
constexpr size_t WS_SBL = 229 * MiB;
constexpr size_t WS_SBF = 233 * MiB;
constexpr size_t WS_ROT = 240 * MiB;
constexpr size_t WS_XG = 242 * MiB;
constexpr size_t WS_SSQ = 277 * MiB;
constexpr size_t WS_ZS = 279 * MiB;
constexpr size_t WS_ZS2 = 290 * MiB;
constexpr size_t WS_HS = 301 * MiB;
constexpr size_t WS_END = 309 * MiB;
static_assert(WS_SLAB0 + 15 * 262144 <= 227 * MiB && WS_SSQ + 4 * (size_t)MPAD * 4 <= WS_SLAB1 && WS_SLAB1 + 5 * 262144 <= 279 * MiB, "slab map");
static_assert(WS_XN + (size_t)MPAD * DM * 2 <= WS_Z && WS_Z + (size_t)MPAD * 4096 * 2 <= WS_XM && WS_SBL + (size_t)NGRP * 2 * DFF * 4 <= WS_SBF && WS_SBF + (size_t)NGRP * 4 * DFF * 4 <= WS_END, "ws map");

constexpr int P0_ITEMS_L0 = 16 * 128 + 16 * 32 + 16 * 128 + 16 * 176 + 44 * 32, P0_ITEMS_ALL = P0_ITEMS_L0 + 16 * 32 + 16 * 176 + 44 * 32;
constexpr int P0_ITEMS_AB = 16 * 128;
constexpr int LDS_BYTES = 147456;
constexpr int NWAVES = 8;

#define GAS __attribute__((address_space(1)))
#define LAS __attribute__((address_space(3)))
typedef unsigned short bf16;
typedef float f32x4 __attribute__((ext_vector_type(4)));
typedef unsigned u32x2 __attribute__((ext_vector_type(2)));
typedef unsigned u32x4 __attribute__((ext_vector_type(4)));
#define LDS_WAIT() asm volatile("s_waitcnt lgkmcnt(0)" ::: "memory")

__device__ __forceinline__ unsigned f2bf(float f) { unsigned u = __builtin_bit_cast(unsigned, f); return (u + 0x7fffu + ((u >> 16) & 1u)) >> 16; }
__device__ __forceinline__ unsigned pk2(float lo, float hi) { return f2bf(lo) | (f2bf(hi) << 16); }
__device__ __forceinline__ float bf2f(unsigned short b) { return __builtin_bit_cast(float, ((unsigned)b) << 16); }
__device__ __forceinline__ float bflo(unsigned w) { return __builtin_bit_cast(float, w << 16); }
__device__ __forceinline__ float bfhi(unsigned w) { return __builtin_bit_cast(float, w & 0xffff0000u); }
__device__ __forceinline__ f32x4 ld_bf4(const bf16* p) { const u32x2 w = *(const u32x2*)p; return (f32x4){bflo(w.x), bfhi(w.x), bflo(w.y), bfhi(w.y)}; }
__device__ __forceinline__ float wave_sum(float v) {
#pragma unroll
    for (int o = 1; o < 64; o <<= 1) v += __shfl_xor(v, o);
    return v;
}
__device__ __forceinline__ float half_sum(float v) {
#pragma unroll
    for (int o = 1; o < 32; o <<= 1) v += __shfl_xor(v, o);
    return v;
}
__device__ __forceinline__ float sigmoidf_(float x) { return 1.f / (1.f + __expf(-x)); }
__device__ __forceinline__ float siluf_(float x) { return x / (1.f + __expf(-x)); }
__device__ __forceinline__ float logsigmoidf_(float x) { return fminf(x, 0.f) - __logf(1.f + __expf(-fabsf(x))); }

struct Args { const float* in[26]; float* out; unsigned char* ws; int ph_lo, ph_hi; };

struct Frame {
    LAS unsigned char* lds;
    int tid, lane, wave, G, gw, NGW;
    const float* const* in; float* out; unsigned char* ws;
};
#define F_X0(F) ((F).out)
#define F_X1(F) ((float*)((F).ws + WS_XM) - (size_t)ROW_M * DM)
#define F_XN(F) ((bf16*)((F).ws + WS_XN))
#define F_XG(F) ((bf16*)((F).ws + WS_XG))
#define F_SSQ(F, i) ((float*)((F).ws + WS_SSQ) + (size_t)(i) * MPAD)
#define F_Z(F) ((bf16*)((F).ws + WS_Z))
#define F_ZS1(F, layer) ((bf16*)((F).ws + ((layer) == 0 ? WS_ZS : WS_ZS2)) - (size_t)ROW_S * 4096)
#define F_HS1(F) ((bf16*)((F).ws + WS_HS) - (size_t)ROW_S * DFF)
#define ZROW(F, row, layer) (((row) < ROW_S ? F_Z(F) : F_ZS1(F, layer)) + (size_t)(row) * 4096)
#define F_GT(F) ((float*)((F).ws + WS_G))
#define F_SBL(F) ((float*)((F).ws + WS_SBL))
#define F_SBF(F) ((float*)((F).ws + WS_SBF))
__device__ __forceinline__ float* xrow(const Frame& F, int r) { return (r < ROW_M ? F_X0(F) : F_X1(F)) + (size_t)r * DM; }

__device__ __forceinline__ void p0_transpose_item(const float* W, int K, int Nsrc, int n0src, bf16* WT, int dstrow0, LAS float* scr, int kb, int lane) {
    const int k0 = 64 * kb;
    f32x4 v[8];
#pragma unroll
    for (int i = 0; i < 8; ++i) v[i] = *(const f32x4*)(W + (size_t)(k0 + 8 * i + (lane >> 3)) * Nsrc + n0src + 4 * (lane & 7));
#pragma unroll
    for (int i = 0; i < 8; ++i) { LAS float* d = scr + (8 * i + (lane >> 3)) * 33 + 4 * (lane & 7); d[0] = v[i][0]; d[1] = v[i][1]; d[2] = v[i][2]; d[3] = v[i][3]; }
    LDS_WAIT(); asm volatile("" ::: "memory");
    const int c = lane & 7;
#pragma unroll
    for (int j = 0; j < 4; ++j) { const int n = (lane >> 3) + 8 * j; const LAS float* s = scr + (8 * c) * 33 + n;
        u32x4 o; o.x = pk2(s[0 * 33], s[1 * 33]); o.y = pk2(s[2 * 33], s[3 * 33]); o.z = pk2(s[4 * 33], s[5 * 33]); o.w = pk2(s[6 * 33], s[7 * 33]);
        *(u32x4*)(WT + (size_t)(dstrow0 + n) * K + k0 + 8 * c) = o; }
    LDS_WAIT(); asm volatile("" ::: "memory");
}

__device__ __forceinline__ void p0_weights(Frame& F, int it0, int it1, int gw, int ngw) {
    LAS float* scr = (LAS float*)(F.lds + F.wave * 16384);
    constexpr int I_AB = 16 * 128, I_O = 16 * 32, I_C = 16 * 128, I_F1 = 16 * 176, I_F2 = 44 * 32;
    for (int it = it0 + gw; it < it1; it += ngw) {
        int r = it;
        if (r < I_AB) { const int kb = r / 128, nb = r % 128; p0_transpose_item(F.in[10], 1024, ABW, nb < 64 ? 32 * nb : 32 * nb + 8, (bf16*)(F.ws + WS_WAB), 32 * nb, scr, kb, F.lane); continue; } r -= I_AB;
        if (r < I_O) { const int kb = r / 32, nb = r % 32; p0_transpose_item(F.in[15], 1024, 1024, 32 * nb, (bf16*)(F.ws + WS_WOAB), 32 * nb, scr, kb, F.lane); continue; } r -= I_O;
        if (r < I_C) { const int kb = r / 128, nb = r % 128; const int c = 32 * nb;
            const int dst = c < 1024 ? 256 * (c / 128) + (c % 128) : c < 2048 ? 256 * ((c - 1024) / 128) + 128 + (c % 128) : c;
            p0_transpose_item(F.in[17], 1024, 4096, c, (bf16*)(F.ws + WS_WC), dst, scr, kb, F.lane); continue; } r -= I_C;
        int l = 0;
        if (r >= I_F1 + I_F2) { r -= I_F1 + I_F2; l = 1;
            if (r < I_O) { const int kb = r / 32, nb = r % 32; p0_transpose_item(F.in[19], 1024, 1024, 32 * nb, (bf16*)(F.ws + WS_WOC), 32 * nb, scr, kb, F.lane); continue; } r -= I_O; }
        if (r < I_F1) { const int kb = r / 176, nb = r % 176; const int c = 32 * nb;
            const int ch = c < DFF ? c : c - DFF; const int dst = 256 * (ch / 128) + (c < DFF ? 0 : 128) + (ch % 128);
            p0_transpose_item(F.in[21] + (size_t)l * 1024 * NFF, 1024, NFF, c, (bf16*)(F.ws + WS_WF1) + (size_t)l * NFF * 1024, dst, scr, kb, F.lane); continue; } r -= I_F1;
        { const int kb = r / 32, nb = r % 32;
            p0_transpose_item(F.in[24] + (size_t)l * DFF * 1024, DFF, 1024, 32 * nb, (bf16*)(F.ws + WS_WF2) + (size_t)l * 1024 * DFF, 32 * nb, scr, kb, F.lane); }
    }
}

__device__ __forceinline__ void p0_rows(Frame& F) {
    LAS float* wg = (LAS float*)F.lds;
    for (int i = F.tid; i < 8192; i += NWAVES * 64) { const int k = i >> 3, c = i & 7; wg[c * 1024 + k] = F.in[10][(size_t)k * ABW + 2048 + c]; }
    __syncthreads();
    const float* gain = F.in[9];
    f32x4 gn[4];
#pragma unroll
    for (int j = 0; j < 4; ++j) gn[j] = *(const f32x4*)(gain + 4 * F.lane + 256 * j);
#define P0_ROWSRC(r) ((r) < ROW_S ? F.in[0] + (size_t)(r) * DM : (r) < ROW_M ? F.in[1] + (size_t)((r) - ROW_S) * DM : (r) < NREAL ? F.in[8] + (size_t)((r) - ROW_M) * DM : (const float*)nullptr)
    f32x4 v[4], vn[4];
    { const float* src = F.gw < MPAD ? P0_ROWSRC(F.gw) : nullptr;
#pragma unroll
      for (int j = 0; j < 4; ++j) vn[j] = src ? *(const f32x4*)(src + 4 * F.lane + 256 * j) : (f32x4){0.f, 0.f, 0.f, 0.f}; }
#pragma unroll 1
    for (int r = F.gw; r < MPAD; r += F.NGW) {
#pragma unroll
        for (int j = 0; j < 4; ++j) v[j] = vn[j];
        { const int rn = r + F.NGW; const float* src = rn < MPAD ? P0_ROWSRC(rn) : nullptr;
#pragma unroll
          for (int j = 0; j < 4; ++j) vn[j] = src ? *(const f32x4*)(src + 4 * F.lane + 256 * j) : (f32x4){0.f, 0.f, 0.f, 0.f}; }
        float ss = 0.f;
#pragma unroll
        for (int j = 0; j < 4; ++j) ss += (v[j].x * v[j].x + v[j].y * v[j].y) + (v[j].z * v[j].z + v[j].w * v[j].w);
        const float rs = rsqrtf(wave_sum(ss) * (1.f / DM) + EPS);
        bf16* xn = F_XG(F) + (size_t)r * DM;
        float ga[8];
#pragma unroll
        for (int c = 0; c < 8; ++c) ga[c] = 0.f;
#pragma unroll
        for (int j = 0; j < 4; ++j) {
            const f32x4 y = v[j] * rs * gn[j];
            u32x2 w; w.x = pk2(y.x, y.y); w.y = pk2(y.z, y.w);
            *(u32x2*)(xn + 4 * F.lane + 256 * j) = w;
#pragma unroll
            for (int c = 0; c < 8; ++c) { const f32x4 wv = *(const LAS f32x4*)(wg + c * 1024 + 4 * F.lane + 256 * j); ga[c] += (y.x * wv.x + y.y * wv.y) + (y.z * wv.z + y.w * wv.w); }
        }
        float g4[4], g2[2], g1;
        { const bool hi = (F.lane & 32) != 0;
#pragma unroll
          for (int c = 0; c < 4; ++c) { const float keep = hi ? ga[4 + c] : ga[c], send = hi ? ga[c] : ga[4 + c]; g4[c] = keep + __shfl_xor(send, 32); } }
        { const bool hi = (F.lane & 16) != 0;
#pragma unroll
          for (int c = 0; c < 2; ++c) { const float keep = hi ? g4[2 + c] : g4[c], send = hi ? g4[c] : g4[2 + c]; g2[c] = keep + __shfl_xor(send, 16); } }
        { const bool hi = (F.lane & 8) != 0; const float keep = hi ? g2[1] : g2[0], send = hi ? g2[0] : g2[1]; g1 = keep + __shfl_xor(send, 8); }
        g1 += __shfl_xor(g1, 4); g1 += __shfl_xor(g1, 2); g1 += __shfl_xor(g1, 1);
        if ((F.lane & 7) == 0) F_GT(F)[(size_t)r * 8 + ((F.lane >> 5) & 1) * 4 + ((F.lane >> 4) & 1) * 2 + ((F.lane >> 3) & 1)] = g1;
    }
#undef P0_ROWSRC
}

__device__ __forceinline__ void p0_zero_ssq(Frame& F) { const int gt = blockIdx.x * (NWAVES * 64) + F.tid, NT = F.G * NWAVES * 64; for (int i = gt; i < 4 * MPAD; i += NT) F_SSQ(F, 0)[i] = 0.f;
    if (gt < 1024) ((float*)(F.ws + WS_LB))[gt] = sigmoidf_(F.in[16][1024 + gt] - F.in[16][gt]); }
__device__ __forceinline__ float dpp_row_shr1(float x) { return __builtin_bit_cast(float, __builtin_amdgcn_update_dpp(__builtin_bit_cast(int, x), __builtin_bit_cast(int, x), 0x111, 0xf, 0xf, false)); }
struct EpiFfn {
    static constexpr bool PERM = true, AFTER_DRAIN = false;
    bf16* H0; bf16* H1; const float* cw; const float* cb; const float* cst; float* cso; float* sbl; float* sbf;
    __device__ __forceinline__ void operator()(f32x4 (&acc)[2][2][4][2], const pg8::Unit& u, int wr, int wc, int fr, int fq) const {
        bf16* H = (u.pm < 64) ? H0 : H1;
        const int ch0 = 128 * u.pn + 32 * wc + 8 * fq;
        const int tok0 = 256 * u.pm + 128 * wr + 8 * fr;
        const int grp = 2 * u.pm + wr;
        const bool samp = (u.pm >= 64 && u.pm < PM_META), meta = (u.pm == PM_META);
        const int sb = 32 * (u.pm - 64) + 16 * wr + fr;
        const bool defer = (!samp && !meta && fr == 0);
        const bool lastlane = meta ? (wr == 0 && fr == 1) : (!samp && fr == 15);
        f32x4 w0[2], w1[2], w2[2], bb[2], p6[2], p7[2];
#pragma unroll
        for (int n = 0; n < 2; ++n) {
            const int c4 = ch0 + 4 * n;
            w0[n] = *(const f32x4*)(cw + c4); w1[n] = *(const f32x4*)(cw + DFF + c4); w2[n] = *(const f32x4*)(cw + 2 * DFF + c4); bb[n] = *(const f32x4*)(cb + c4);
#pragma unroll
            for (int e = 0; e < 4; ++e) { p6[n][e] = dpp_row_shr1(acc[1][0][2][n][e]); p7[n][e] = dpp_row_shr1(acc[1][0][3][n][e]); }
            if (samp) { p6[n] = *(const f32x4*)(cst + (size_t)(sb * 2 + 0) * DFF + c4); p7[n] = *(const f32x4*)(cst + (size_t)(sb * 2 + 1) * DFF + c4); }
            if (meta && wr == 0 && fr == 0) { p6[n] = (f32x4){0.f, 0.f, 0.f, 0.f}; p7[n] = p6[n]; }
            if (lastlane) { *(f32x4*)(sbl + (size_t)(grp * 2 + 0) * DFF + c4) = acc[1][0][2][n]; *(f32x4*)(sbl + (size_t)(grp * 2 + 1) * DFF + c4) = acc[1][0][3][n]; }
            if (samp) { *(f32x4*)(cso + (size_t)(sb * 2 + 0) * DFF + c4) = acc[1][0][2][n]; *(f32x4*)(cso + (size_t)(sb * 2 + 1) * DFF + c4) = acc[1][0][3][n]; }
        }
#pragma unroll
        for (int k = 0; k < 8; ++k) {
            unsigned hw[4];
#pragma unroll
            for (int n = 0; n < 2; ++n) {
                const f32x4 uk = acc[k >> 2][0][k & 3][n], gk = acc[k >> 2][1][k & 3][n];
                const f32x4 um1 = (k >= 1) ? acc[(k - 1 < 0 ? 0 : k - 1) >> 2][0][(k - 1 < 0 ? 0 : k - 1) & 3][n] : p7[n];
                const f32x4 um2 = (k >= 2) ? acc[(k - 2 < 0 ? 0 : k - 2) >> 2][0][(k - 2 < 0 ? 0 : k - 2) & 3][n] : (k == 1 ? p7[n] : p6[n]);
                const f32x4 cv = bb[n] + w0[n] * um2 + w1[n] * um1 + w2[n] * uk;
                f32x4 hv;
#pragma unroll
                for (int e = 0; e < 4; ++e) hv[e] = siluf_(cv[e]) * gk[e];
                hw[2 * n] = pg8::cvt_pk_bf16(hv[0], hv[1]); hw[2 * n + 1] = pg8::cvt_pk_bf16(hv[2], hv[3]);
                if (defer && k < 2) {
                    *(f32x4*)(sbf + (size_t)((grp * 2 + k) * 2 + 0) * DFF + ch0 + 4 * n) = uk;
                    *(f32x4*)(sbf + (size_t)((grp * 2 + k) * 2 + 1) * DFF + ch0 + 4 * n) = gk;
                }
            }
            if (!(defer && k < 2)) *(u32x4*)(H + (size_t)(tok0 + k) * DFF + ch0) = (u32x4){hw[0], hw[1], hw[2], hw[3]};
        }
    }
};

__device__ __forceinline__ void ffn_fixup_tile(Frame& F, int layer, int pm, bool conv_out) {
    const float* cw = F.in[22] + (size_t)layer * 3 * DFF; const float* cb = F.in[23] + (size_t)layer * DFF;
    bf16* H = F_Z(F);
    for (int i = F.tid; i < 2 * DFF; i += NWAVES * 64) {
        const int wr = i / DFF, ch = i - wr * DFF, grp = 2 * pm + wr;
        const int r0 = 128 * grp;
        const int pg = (r0 % 2048 == 0) ? GRP_META : grp - 1;
        const float um2 = F_SBL(F)[(size_t)(pg * 2 + 0) * DFF + ch], um1 = F_SBL(F)[(size_t)(pg * 2 + 1) * DFF + ch];
        const float u0 = F_SBF(F)[(size_t)((grp * 2 + 0) * 2 + 0) * DFF + ch], g0 = F_SBF(F)[(size_t)((grp * 2 + 0) * 2 + 1) * DFF + ch];
        const float u1 = F_SBF(F)[(size_t)((grp * 2 + 1) * 2 + 0) * DFF + ch], g1 = F_SBF(F)[(size_t)((grp * 2 + 1) * 2 + 1) * DFF + ch];
        const float w0 = cw[ch], w1 = cw[DFF + ch], w2 = cw[2 * DFF + ch], bb = cb[ch];
        const float c0 = bb + w0 * um2 + w1 * um1 + w2 * u0, c1 = bb + w0 * um1 + w1 * u0 + w2 * u1;
        H[(size_t)r0 * DFF + ch] = (bf16)f2bf(siluf_(c0) * g0);
        H[(size_t)(r0 + 1) * DFF + ch] = (bf16)f2bf(siluf_(c1) * g1);
        if (conv_out && (pm & 7) == 7 && wr == 1) {
            float* fo = F.out + O_FP + ((size_t)layer * 8 + (pm >> 3)) * 2 * DFF;
            fo[ch] = F_SBL(F)[(size_t)(grp * 2 + 0) * DFF + ch]; fo[DFF + ch] = F_SBL(F)[(size_t)(grp * 2 + 1) * DFF + ch];
        }
    }
}
typedef short bf16x8 __attribute__((ext_vector_type(8)));
typedef short v4i16_t __attribute__((ext_vector_type(4)));
constexpr int MX_PITCH = 272;
constexpr int MX_Q = 0, MX_K = 17408, MX_KH = 34816, MX_V = 52224, MX_GD = 69632  , MX_SC = 71680  , MX_OB = 74752  , MX_RP = 108544  , MX_DI = 110592  , MX_GN = 110848  , MX_LB = 111360  , MX_END = 111872;
constexpr int MX_OP = 132;
constexpr float LNKS = -2.4260151319598084f;
static_assert(MX_END <= 139264, "mixer LDS map");

__device__ __forceinline__ bf16x8 mk8(unsigned a, unsigned b, unsigned c, unsigned d) { const u32x4 v = {a, b, c, d}; return __builtin_bit_cast(bf16x8, v); }
__device__ __forceinline__ u32x2 tr16(const LAS unsigned char* p) { return __builtin_bit_cast(u32x2, __builtin_amdgcn_ds_read_tr16_b64_v4i16((LAS v4i16_t*)p)); }
typedef float f32x2_t __attribute__((ext_vector_type(2))); typedef __bf16 bf16x2_t __attribute__((ext_vector_type(2)));
__device__ __forceinline__ unsigned pkbf(float lo, float hi) { const f32x2_t v = {lo, hi}; const bf16x2_t b = __builtin_convertvector(v, bf16x2_t); return __builtin_bit_cast(unsigned, b); }
#define MFMA16(a, b, c) __builtin_amdgcn_mfma_f32_16x16x32_bf16((a), (b), (c), 0, 0, 0)
typedef short s16x4 __attribute__((ext_vector_type(4)));
__device__ __forceinline__ f32x4 mfma16k16(u32x2 a, u32x2 b, f32x4 c) { const u32x4 a4 = {a.x, a.y, 0u, 0u}, b4 = {b.x, b.y, 0u, 0u}; return __builtin_amdgcn_mfma_f32_16x16x32_bf16(__builtin_bit_cast(bf16x8, a4), __builtin_bit_cast(bf16x8, b4), c, 0, 0, 0); }
__device__ __forceinline__ bf16x8 ld8(const LAS unsigned char* p) { return __builtin_bit_cast(bf16x8, *(const LAS u32x4*)p); }
#define MX_POS4(d) (((d) & ~31) + 8 * ((((d) & 15)) >> 2) + 4 * (((d) >> 4) & 1))
template <int CTRL> __device__ __forceinline__ float dppf(float ident, float x) { return __builtin_bit_cast(float, __builtin_amdgcn_update_dpp(__builtin_bit_cast(int, ident), __builtin_bit_cast(int, x), CTRL, 0xf, 0xf, false)); }
__device__ __forceinline__ float row_prefix_sum(float x) { x += dppf<0x111>(0.f, x); x += dppf<0x112>(0.f, x); x += dppf<0x114>(0.f, x); x += dppf<0x118>(0.f, x); return x; }
__device__ __forceinline__ float row_prefix_max(float x) { x = fmaxf(x, dppf<0x111>(-3e38f, x)); x = fmaxf(x, dppf<0x112>(-3e38f, x)); x = fmaxf(x, dppf<0x114>(-3e38f, x)); x = fmaxf(x, dppf<0x118>(-3e38f, x)); return x; }
__device__ __forceinline__ float row_prefix_prod(float x) { x *= dppf<0x111>(1.f, x); x *= dppf<0x112>(1.f, x); x *= dppf<0x114>(1.f, x); x *= dppf<0x118>(1.f, x); return x; }
__device__ __forceinline__ float row_suffix_prod(float x) { x *= dppf<0x101>(1.f, x); x *= dppf<0x102>(1.f, x); x *= dppf<0x104>(1.f, x); x *= dppf<0x108>(1.f, x); return x; }
__device__ __forceinline__ float rdlane(float x, int l) { return __builtin_bit_cast(float, __builtin_amdgcn_readlane(__builtin_bit_cast(int, x), l)); }

struct EpiHg {
    static constexpr bool PERM = true, AFTER_DRAIN = false;
    bf16* O0; bf16* O1; int pm_split; int ldc; const float* LB; float* GD; float* GDS;
    __device__ __forceinline__ void operator()(f32x4 (&acc)[2][2][4][2], const pg8::Unit& u, int wr, int wc, int fr, int fq) const {
        bf16* O = (u.pm < pm_split) ? O0 : O1;
        const int row0 = u.pm * 256 + wr * 64 + fr;
        if (u.pn >= 8) {
            const int col0 = u.pn * 256 + wc * 32 + 8 * fq;
#pragma unroll
            for (int ai = 0; ai < 2; ++ai)
#pragma unroll
                for (int m = 0; m < 4; ++m) { bf16* rowp = O + (size_t)(row0 + ai * 128 + m * 16) * ldc + col0;
#pragma unroll
                    for (int bj = 0; bj < 2; ++bj) { const f32x4 v0 = acc[ai][bj][m][0], v1 = acc[ai][bj][m][1];
                        u32x4 w; w.x = pg8::cvt_pk_bf16(v0[0], v0[1]); w.y = pg8::cvt_pk_bf16(v0[2], v0[3]); w.z = pg8::cvt_pk_bf16(v1[0], v1[1]); w.w = pg8::cvt_pk_bf16(v1[2], v1[3]);
                        *(u32x4*)(rowp + bj * 128) = w; } }
            return;
        }
        const int c0 = 128 * u.pn + 32 * wc + 8 * fq;
        const bool samp = (u.pm >= 64 && u.pm < PM_META);
        const f32x4 lb0 = *(const f32x4*)(LB + c0), lb1 = *(const f32x4*)(LB + c0 + 4);
#pragma unroll
        for (int ai = 0; ai < 2; ++ai)
#pragma unroll
            for (int m = 0; m < 4; ++m) {
                const int row = row0 + ai * 128 + m * 16;
                f32x4 qt[2], kt[2], Ae[2];
#pragma unroll
                for (int n = 0; n < 2; ++n)
#pragma unroll
                    for (int e = 0; e < 4; ++e) {
                        const float lb = n ? lb1[e] : lb0[e];
                        const float sg = sigmoidf_(acc[ai][1][m][n][e]);
                        const float a = lb + (1.f - lb) * sg, kk = (1.f - lb) * (1.f - sg);
                        float A = a;
                        if (samp) { float t;
                            t = dppf<0x111>(1.f, A); A *= ((fr & 7) >= 1) ? t : 1.f; t = dppf<0x112>(1.f, A); A *= ((fr & 7) >= 2) ? t : 1.f; t = dppf<0x114>(1.f, A); A *= ((fr & 7) >= 4) ? t : 1.f; }
                        else A = row_prefix_prod(a);
                        qt[n][e] = acc[ai][0][m][n][e] * A; kt[n][e] = kk * __builtin_amdgcn_rcpf(fmaxf(A, 1e-30f)); Ae[n][e] = A;
                    }
                bf16* rowp = O + (size_t)row * ldc + c0;
                u32x4 w; w.x = pg8::cvt_pk_bf16(qt[0][0], qt[0][1]); w.y = pg8::cvt_pk_bf16(qt[0][2], qt[0][3]); w.z = pg8::cvt_pk_bf16(qt[1][0], qt[1][1]); w.w = pg8::cvt_pk_bf16(qt[1][2], qt[1][3]);
                *(u32x4*)rowp = w;
                w.x = pg8::cvt_pk_bf16(kt[0][0], kt[0][1]); w.y = pg8::cvt_pk_bf16(kt[0][2], kt[0][3]); w.z = pg8::cvt_pk_bf16(kt[1][0], kt[1][1]); w.w = pg8::cvt_pk_bf16(kt[1][2], kt[1][3]);
                *(u32x4*)(rowp + 1024) = w;
                if (!samp && fr == 15) { float* gp = GD + (size_t)(row >> 4) * 1024 + c0; *(f32x4*)gp = Ae[0]; *(f32x4*)(gp + 4) = Ae[1]; }
                if (samp && (fr & 7) == 7) { float* gp = GDS + (size_t)((row - ROW_S) >> 3) * 1024 + c0; *(f32x4*)gp = Ae[0]; *(f32x4*)(gp + 4) = Ae[1]; }
            }
    }
};

constexpr int ROT_N = 2072;
__device__ __forceinline__ void p0_rotary(Frame& F, float* tab) {
    const int gt = blockIdx.x * (NWAVES * 64) + F.tid, NT = F.G * NWAVES * 64;
    for (int i = gt; i < ROT_N * 64; i += NT) {
        const int pi = i >> 6, fi = i & 63;
        const float pos = pi < 2064 ? (float)pi : (float)(16384 + pi - 2064);
        const float inv = exp2f((float)fi * (-13.287712379549449f / 63.0f));
        float sn, cs; sincosf(pos * inv, &sn, &cs);
        tab[2 * i] = cs; tab[2 * i + 1] = sn;
    }
}

#ifdef PROBE_BLOCK
#define MSTAMP_DECL unsigned long long t_last_ = __builtin_amdgcn_s_memrealtime();
#define MSTAMP(id) do { if (blockIdx.x == PROBE_BLOCK && tid == 0) { const unsigned long long t_now_ = __builtin_amdgcn_s_memrealtime(); volatile LAS unsigned long long* a_ = (volatile LAS unsigned long long*)(F.lds + 139264 + 128) + 48 + (id); *a_ = *a_ + (t_now_ - t_last_); t_last_ = t_now_; } } while (0)
#else
#define MSTAMP_DECL
#define MSTAMP(id) do { } while (0)
#endif
#define MX_SC_PARAMS(scv, row0, ntok, nmc, pos0) do { if (mode != 1) { if ((scv) == 0) { row0 = ROW_M; ntok = 16; nmc = 1; pos0 = 0; } else { row0 = b * 2048 + ((scv) - 1) * 64; ntok = 64; nmc = 4; pos0 = 16 + ((scv) - 1) * 64; } } \
        else { row0 = ROW_S + 8 * b; ntok = 8; nmc = 1; pos0 = 2064; } } while (0)

template <int TYPE, int NMC>
__device__ __forceinline__ void sg_chain(LAS unsigned char* L, LAS float* SC, f32x4 (&S)[8], f32x4& nacc, int w, int r16, int q) {
    LAS float* OB = (LAS float*)(L + MX_OB); LAS float* RP = (LAS float*)(L + MX_RP); LAS float* DI = (LAS float*)(L + MX_DI);
    f32x4 oo[4];
#pragma unroll
    for (int mc = 0; mc < NMC; ++mc) {
        oo[mc] = (f32x4){0.f, 0.f, 0.f, 0.f};
        {
            const LAS unsigned char* Qb = L + MX_Q + 16 * mc * MX_PITCH; const LAS unsigned char* Kb = L + MX_K + 16 * mc * MX_PITCH; const LAS unsigned char* Vb = L + MX_V + 16 * mc * MX_PITCH;
            f32x4 g0 = {0.f, 0.f, 0.f, 0.f}, g1 = {0.f, 0.f, 0.f, 0.f};
#pragma unroll
            for (int ks = 0; ks < 4; ++ks) {
                const bf16x8 kf = ld8(Kb + r16 * MX_PITCH + (32 * ks + 8 * q) * 2), qf = ld8(Qb + r16 * MX_PITCH + (32 * ks + 8 * q) * 2);
                if (ks & 1) g1 = MFMA16(kf, qf, g1); else g0 = MFMA16(kf, qf, g0);
            }
            const f32x4 g = g0 + g1;
            const float xi = SC[mc * 16 + r16]; const f32x4 y4 = *(const LAS f32x4*)(SC + 64 + mc * 16 + 4 * q);
            f32x4 P;
#pragma unroll
            for (int r = 0; r < 4; ++r) P[r] = (4 * q + r <= r16) ? g[r] * __expf(xi + y4[r]) : 0.f;
            if (TYPE == 0) { float ps = (P[0] + P[1]) + (P[2] + P[3]); ps += __shfl_xor(ps, 16); ps += __shfl_xor(ps, 32); if (w == 0 && q == 0) DI[16 * mc + r16] = ps; }
            const u32x2 vt = tr16(Vb + (4 * q + (r16 >> 2)) * MX_PITCH + (16 * w + 4 * (r16 & 3)) * 2);
            oo[mc] = mfma16k16((u32x2){pkbf(P[0], P[1]), pkbf(P[2], P[3])}, vt, oo[mc]);
        }
        if (mc == 1 || TYPE == 1) __builtin_amdgcn_sched_barrier(0);
    }
#pragma unroll
    for (int mc = 0; mc < NMC; ++mc) {
        {
            const LAS unsigned char* Qb = L + MX_Q + 16 * mc * MX_PITCH; const LAS unsigned char* Kb = L + MX_K + 16 * mc * MX_PITCH;
            const u32x2 vt = tr16(L + MX_V + 16 * mc * MX_PITCH + (4 * q + (r16 >> 2)) * MX_PITCH + (16 * w + 4 * (r16 & 3)) * 2);
            f32x4 o2a = {0.f, 0.f, 0.f, 0.f}, o2b = {0.f, 0.f, 0.f, 0.f};
#pragma unroll
            for (int ks = 0; ks < 4; ++ks) {
                const bf16x8 qf = ld8(Qb + r16 * MX_PITCH + (32 * ks + 8 * q) * 2);
                const bf16x8 SB = mk8(pkbf(S[2 * ks][0], S[2 * ks][1]), pkbf(S[2 * ks][2], S[2 * ks][3]), pkbf(S[2 * ks + 1][0], S[2 * ks + 1][1]), pkbf(S[2 * ks + 1][2], S[2 * ks + 1][3]));
                if (ks & 1) o2b = MFMA16(qf, SB, o2b); else o2a = MFMA16(qf, SB, o2a);
            }
            const f32x4 in4 = *(const LAS f32x4*)(SC + 128 + mc * 16 + 4 * q);
            oo[mc] = oo[mc] + in4 * (o2a + o2b);
            const f32x4 w4 = *(const LAS f32x4*)(SC + 192 + mc * 16 + 4 * q); const float carry = SC[320 + mc];
            if (TYPE == 0) {
                const u32x2 qn = *(const LAS u32x2*)(Qb + r16 * MX_PITCH + MX_POS4(16 * w + 4 * q) * 2);
                f32x4 rr = {0.f, 0.f, 0.f, 0.f}; rr = mfma16k16(qn, (u32x2){pkbf(nacc[0], nacc[1]), pkbf(nacc[2], nacc[3])}, rr);
                if (r16 == 0) {
#pragma unroll
                    for (int r = 0; r < 4; ++r) RP[w * 64 + 16 * mc + 4 * q + r] = rr[r]; }
            }
#pragma unroll
            for (int r = 0; r < 4; ++r) OB[(16 * mc + 4 * q + r) * MX_OP + 16 * w + r16] = oo[mc][r];
            const u32x2 VH = {pkbf(bflo(vt.x) * w4[0], bfhi(vt.x) * w4[1]), pkbf(bflo(vt.y) * w4[2], bfhi(vt.y) * w4[3])};
#pragma unroll
            for (int mt = 0; mt < 8; ++mt) {
                const u32x2 kt = tr16(Kb + (4 * q + (r16 >> 2)) * MX_PITCH + MX_POS4(16 * mt + 4 * (r16 & 3)) * 2);
                S[mt] = S[mt] * carry; S[mt] = mfma16k16(kt, VH, S[mt]);
            }
            if (TYPE == 0) {
                const u32x2 kt = tr16(Kb + (4 * q + (r16 >> 2)) * MX_PITCH + MX_POS4(16 * w + 4 * (r16 & 3)) * 2);
                nacc = nacc * carry; nacc = mfma16k16(kt, (u32x2){pkbf(w4[0], w4[1]), pkbf(w4[2], w4[3])}, nacc);
            }
        }
        if (mc + 1 < NMC) __builtin_amdgcn_sched_barrier(0);
    }
}

template <int TYPE>
__device__ __forceinline__ void mix_sg_unit(Frame& F, int b, int h, int mode  , const float* rot) {
    const bool prompt = (mode != 1);
    const int tid = F.tid, lane = F.lane, w = F.wave, r16 = lane & 15, q = lane >> 4;
    const int tk = tid >> 3, p = tid & 7;
    LAS unsigned char* L = F.lds;
    LAS float* OB = (LAS float*)(L + MX_OB); LAS float* RP = (LAS float*)(L + MX_RP); LAS float* DI = (LAS float*)(L + MX_DI);
    bf16* MIX = F_XN(F);
    const int qcol = (TYPE == 0 ? 0 : 2048) + 128 * h, kcol = (TYPE == 0 ? 512 : 2560) + 128 * h, vcol = (TYPE == 0 ? 1024 : 3072) + 128 * h, gcol = (TYPE == 0 ? 1536 : 3584) + 128 * h, mcol = (TYPE == 0 ? 0 : 512) + 128 * h;
    f32x4 S[8]; f32x4 nacc = {0.f, 0.f, 0.f, 0.f}; float m0 = 0.f;
#pragma unroll
    for (int mt = 0; mt < 8; ++mt) S[mt] = (f32x4){0.f, 0.f, 0.f, 0.f};
    if (!prompt) {
        const float* Sin = (TYPE == 0 ? F.in[2] : F.in[5]) + (size_t)(b * 4 + h) * 16384;
#pragma unroll
        for (int mt = 0; mt < 8; ++mt)
#pragma unroll
            for (int r = 0; r < 4; ++r) S[mt][r] = Sin[(16 * mt + 4 * q + r) * 128 + 16 * w + r16];
        if (TYPE == 0) {
#pragma unroll
            for (int r = 0; r < 4; ++r) nacc[r] = F.in[3][(size_t)(b * 4 + h) * 128 + 16 * w + 4 * q + r];
            m0 = F.in[4][b * 4 + h];
        }
    }
    const float lgam = (TYPE != 1) ? 0.f : h == 0 ? -0.031748698314580298f : h == 1 ? -0.015748356968139168f : h == 2 ? -0.0078431774610258928f : -0.0039138993211363287f;
    const float bias_i = (TYPE == 0) ? F.in[11][h] : 0.f, bias_f = (TYPE == 0) ? F.in[12][h] : 0.f;
    LAS float* GN = (LAS float*)(L + MX_GN);
    if (tid < 128) GN[tid] = (TYPE == 0 ? F.in[13] : F.in[14])[128 * h + tid];
    const int nsc = (mode == 0) ? 33 : 1;
    u32x4 pa[6]; f32x4 pr[4]; float pli = 0.f, plf = 0.f; u32x4 pg[2];
    const u32x4 z4 = {0u, 0u, 0u, 0u};
#define SG_LOAD(scv) do { int row0_, ntok_, nmc_, pos0_; MX_SC_PARAMS(scv, row0_, ntok_, nmc_, pos0_); (void)nmc_; \
        const bool valid_ = tk < ntok_; const bf16* zr_ = ZROW(F, row0_ + (valid_ ? tk : 0), 0); \
        _Pragma("unroll") for (int i_ = 0; i_ < 6; ++i_) pa[i_] = z4; \
        if (valid_) { pa[4] = *(const u32x4*)(zr_ + vcol + 16 * p); pa[5] = *(const u32x4*)(zr_ + vcol + 16 * p + 8); \
            if (TYPE == 0) { pa[0] = *(const u32x4*)(zr_ + qcol + 16 * p); pa[1] = *(const u32x4*)(zr_ + qcol + 16 * p + 8); pa[2] = *(const u32x4*)(zr_ + kcol + 16 * p); pa[3] = *(const u32x4*)(zr_ + kcol + 16 * p + 8); } \
            else { pa[0] = *(const u32x4*)(zr_ + qcol + 8 * p); pa[1] = *(const u32x4*)(zr_ + qcol + 64 + 8 * p); pa[2] = *(const u32x4*)(zr_ + kcol + 8 * p); pa[3] = *(const u32x4*)(zr_ + kcol + 64 + 8 * p); } } \
        if (TYPE == 1) { const float* tb_ = rot + ((size_t)(pos0_ + (valid_ ? tk : 0)) * 64 + 8 * p) * 2; _Pragma("unroll") for (int e_ = 0; e_ < 4; ++e_) pr[e_] = *(const f32x4*)(tb_ + 4 * e_); } \
        if (TYPE == 0 && w == 0) { const bool vt_ = lane < ntok_; const float* gp_ = F_GT(F) + (size_t)(row0_ + (vt_ ? lane : 0)) * 8; pli = gp_[h]; plf = gp_[4 + h]; } } while (0)
    SG_LOAD(0);
    MSTAMP_DECL
#pragma unroll 1
    for (int sc = 0; sc < nsc; ++sc) {
        int row0, ntok, nmc, pos0; MX_SC_PARAMS(sc, row0, ntok, nmc, pos0); (void)pos0;
        LAS float* SC = (LAS float*)(L + MX_SC) + (sc & 1) * 384;
        MSTAMP(0);
        {
            *(LAS u32x4*)(L + MX_V + tk * MX_PITCH + 32 * p) = pa[4]; *(LAS u32x4*)(L + MX_V + tk * MX_PITCH + 32 * p + 16) = pa[5];
            if (TYPE == 0) {
                const int c0 = (MX_POS4(16 * p)) * 2;
#pragma unroll
                for (int g = 0; g < 4; ++g) {
                    *(LAS u32x2*)(L + MX_Q + tk * MX_PITCH + c0 + 16 * g) = (u32x2){pa[g >> 1][2 * (g & 1)], pa[g >> 1][2 * (g & 1) + 1]};
                    *(LAS u32x2*)(L + MX_K + tk * MX_PITCH + c0 + 16 * g) = (u32x2){pa[2 + (g >> 1)][2 * (g & 1)], pa[2 + (g >> 1)][2 * (g & 1) + 1]};
                }
            } else {
                u32x4 q1, q2, k1, k2;
#pragma unroll
                for (int e2 = 0; e2 < 4; ++e2) {
                    const f32x4 cs = pr[e2];
                    { const float x1l = bflo(pa[0][e2]), x1h = bfhi(pa[0][e2]), x2l = bflo(pa[1][e2]), x2h = bfhi(pa[1][e2]);
                      q1[e2] = pkbf(x1l * cs[0] - x2l * cs[1], x1h * cs[2] - x2h * cs[3]); q2[e2] = pkbf(x2l * cs[0] + x1l * cs[1], x2h * cs[2] + x1h * cs[3]); }
                    { const float x1l = bflo(pa[2][e2]), x1h = bfhi(pa[2][e2]), x2l = bflo(pa[3][e2]), x2h = bfhi(pa[3][e2]);
                      k1[e2] = pkbf(x1l * cs[0] - x2l * cs[1], x1h * cs[2] - x2h * cs[3]); k2[e2] = pkbf(x2l * cs[0] + x1l * cs[1], x2h * cs[2] + x1h * cs[3]); }
                }
                const int c0 = (MX_POS4(8 * p)) * 2;
                *(LAS u32x2*)(L + MX_Q + tk * MX_PITCH + c0) = (u32x2){q1[0], q1[1]}; *(LAS u32x2*)(L + MX_Q + tk * MX_PITCH + c0 + 16) = (u32x2){q1[2], q1[3]};
                *(LAS u32x2*)(L + MX_Q + tk * MX_PITCH + c0 + 128) = (u32x2){q2[0], q2[1]}; *(LAS u32x2*)(L + MX_Q + tk * MX_PITCH + c0 + 144) = (u32x2){q2[2], q2[3]};
                *(LAS u32x2*)(L + MX_K + tk * MX_PITCH + c0) = (u32x2){k1[0], k1[1]}; *(LAS u32x2*)(L + MX_K + tk * MX_PITCH + c0 + 16) = (u32x2){k1[2], k1[3]};
                *(LAS u32x2*)(L + MX_K + tk * MX_PITCH + c0 + 128) = (u32x2){k2[0], k2[1]}; *(LAS u32x2*)(L + MX_K + tk * MX_PITCH + c0 + 144) = (u32x2){k2[2], k2[3]};
            }
        }
        if (w == 0) {
            const bool valid = lane < ntok;
            float li = -1e30f, lf = 0.f;
            if (TYPE == 0) { if (valid) { li = pli + bias_i; lf = logsigmoidf_(plf + bias_f); } } else { if (valid) { li = 0.f; lf = lgam; } }
            const float bb = row_prefix_sum(lf);
            const float y = li - bb;
            const float am = row_prefix_max(y);
            const float a = bb + am;
            const float B0 = rdlane(bb, 15), B1 = rdlane(bb, 31), B2 = rdlane(bb, 47), B3 = rdlane(bb, 63);
            float M1 = 0.f, M2 = 0.f, M3 = 0.f, M4 = 0.f;
            if (TYPE == 0) { const float A0 = rdlane(a, 15), A1 = rdlane(a, 31), A2 = rdlane(a, 47), A3 = rdlane(a, 63);
                M1 = fmaxf(B0 + m0, A0); M2 = fmaxf(B1 + M1, A1); M3 = fmaxf(B2 + M2, A2); M4 = fmaxf(B3 + M3, A3); }
            const float m0q = q == 0 ? m0 : q == 1 ? M1 : q == 2 ? M2 : M3;
            const float mnq = q == 0 ? M1 : q == 1 ? M2 : q == 2 ? M3 : M4;
            const float b15 = q == 0 ? B0 : q == 1 ? B1 : q == 2 ? B2 : B3;
            const float m = (TYPE == 0) ? fmaxf(bb + m0q, a) : 0.f;
            SC[lane] = bb - m; SC[64 + lane] = y + LNKS; SC[128 + lane] = __expf(bb + m0q - m);
            SC[192 + lane] = __expf(y + LNKS + b15 - mnq); SC[256 + lane] = __expf(-m);
            if (r16 == 0) SC[320 + q] = __expf(b15 + m0q - mnq);
            m0 = (nmc == 4) ? M4 : M1;
        }
        MSTAMP(1);
        __syncthreads();
        MSTAMP(2);
        if (sc + 1 < nsc) SG_LOAD(sc + 1);
        { const bool valid = tk < ntok; const bf16* zr = ZROW(F, row0 + (valid ? tk : 0), 0) + gcol + 16 * p; pg[0] = *(const u32x4*)zr; pg[1] = *(const u32x4*)(zr + 8); }
        MSTAMP(3);
        if (nmc == 4) sg_chain<TYPE, 4>(L, SC, S, nacc, w, r16, q); else sg_chain<TYPE, 1>(L, SC, S, nacc, w, r16, q);
        MSTAMP(4);
        __syncthreads();
        MSTAMP(6);
        {
            const bool valid = tk < ntok; const int row = row0 + (valid ? tk : 0);
            f32x4 o[4];
#pragma unroll
            for (int c = 0; c < 4; ++c) o[c] = *(const LAS f32x4*)(OB + tk * MX_OP + 16 * p + 4 * c);
            if (tk >= 16 * nmc) {
#pragma unroll
                for (int c = 0; c < 4; ++c) o[c] = (f32x4){0.f, 0.f, 0.f, 0.f}; }
            if (TYPE == 0) {
                float rs = 0.f;
#pragma unroll
                for (int ww = 0; ww < 8; ++ww) rs += RP[ww * 64 + tk];
                const float den = DI[tk] + SC[128 + tk] * rs;
                float dn = fmaxf(fabsf(den), SC[256 + tk]); if (tk >= 16 * nmc) dn = 1.f;
                const float rd = 1.f / dn;
#pragma unroll
                for (int c = 0; c < 4; ++c) o[c] = o[c] * rd;
            }
            float sm = 0.f;
#pragma unroll
            for (int c = 0; c < 4; ++c) sm += (o[c].x + o[c].y) + (o[c].z + o[c].w);
            sm += __shfl_xor(sm, 1); sm += __shfl_xor(sm, 2); sm += __shfl_xor(sm, 4);
            const float mu = sm * (1.f / 128.f); float vs = 0.f;
#pragma unroll
            for (int c = 0; c < 4; ++c) { o[c] = o[c] - mu; vs += (o[c].x * o[c].x + o[c].y * o[c].y) + (o[c].z * o[c].z + o[c].w * o[c].w); }
            vs += __shfl_xor(vs, 1); vs += __shfl_xor(vs, 2); vs += __shfl_xor(vs, 4);
            const float rstd = rsqrtf(vs * (1.f / 128.f) + EPS);
            if (valid && !(mode == 0 && sc == 0)) {
                unsigned ow[8];
#pragma unroll
                for (int c = 0; c < 4; ++c) {
                    const unsigned ga = c < 2 ? pg[0][2 * c] : pg[1][2 * c - 4], gb = c < 2 ? pg[0][2 * c + 1] : pg[1][2 * c - 3];
                    f32x4 gt = {bflo(ga), bfhi(ga), bflo(gb), bfhi(gb)};
#pragma unroll
                    for (int e = 0; e < 4; ++e) gt[e] = (TYPE == 0) ? sigmoidf_(gt[e]) : siluf_(gt[e]);
                    const f32x4 r = o[c] * rstd * *(const LAS f32x4*)(GN + 16 * p + 4 * c) * gt;
                    ow[2 * c] = pkbf(r.x, r.y); ow[2 * c + 1] = pkbf(r.z, r.w);
                }
                bf16* mp = MIX + (size_t)row * DM + mcol + 16 * p;
                *(u32x4*)mp = (u32x4){ow[0], ow[1], ow[2], ow[3]}; *(u32x4*)(mp + 8) = (u32x4){ow[4], ow[5], ow[6], ow[7]};
            }
        }
        MSTAMP(7);
    }
#undef SG_LOAD
    __syncthreads();
    if (mode != 2) {
        int l2 = F.lane; asm volatile("" : "+v"(l2)); const int r16 = l2 & 15, q = l2 >> 4;
        float* So = F.out + (TYPE == 0 ? (prompt ? O_CP : O_CS) : (prompt ? O_RP : O_RS)) + (size_t)(b * 4 + h) * 16384;
#pragma unroll
        for (int mt = 0; mt < 8; ++mt)
#pragma unroll
            for (int r = 0; r < 4; ++r) So[(16 * mt + 4 * q + r) * 128 + 16 * w + r16] = S[mt][r];
        if (TYPE == 0) {
            if (r16 == 0) { float* No = F.out + (prompt ? O_NP : O_NS) + (size_t)(b * 4 + h) * 128;
#pragma unroll
                for (int r = 0; r < 4; ++r) No[16 * w + 4 * q + r] = nacc[r]; }
            if (w == 0 && lane == 0) F.out[(prompt ? O_MP : O_MS) + b * 4 + h] = m0;
        }
    }
}

template <int NMC>
__device__ __forceinline__ void hg_chain(LAS unsigned char* L, f32x4 (&S)[8], int w, int r16, int q) {
    LAS float* GD = (LAS float*)(L + MX_GD); LAS float* OB = (LAS float*)(L + MX_OB);
    f32x4 oo[4];
#pragma unroll
    for (int mc = 0; mc < NMC; ++mc) {
        oo[mc] = (f32x4){0.f, 0.f, 0.f, 0.f};
        {
            const LAS unsigned char* Qb = L + MX_Q + 16 * mc * MX_PITCH; const LAS unsigned char* Kb = L + MX_K + 16 * mc * MX_PITCH; const LAS unsigned char* Vb = L + MX_V + 16 * mc * MX_PITCH;
            f32x4 g0 = {0.f, 0.f, 0.f, 0.f}, g1 = {0.f, 0.f, 0.f, 0.f};
#pragma unroll
            for (int ks = 0; ks < 4; ++ks) {
                const bf16x8 kf = ld8(Kb + r16 * MX_PITCH + (32 * ks + 8 * q) * 2), qf = ld8(Qb + r16 * MX_PITCH + (32 * ks + 8 * q) * 2);
                if (ks & 1) g1 = MFMA16(kf, qf, g1); else g0 = MFMA16(kf, qf, g0);
            }
            const f32x4 g = g0 + g1;
            f32x4 P;
#pragma unroll
            for (int r = 0; r < 4; ++r) P[r] = (4 * q + r <= r16) ? g[r] : 0.f;
            const u32x2 vt = tr16(Vb + (4 * q + (r16 >> 2)) * MX_PITCH + (16 * w + 4 * (r16 & 3)) * 2);
            oo[mc] = mfma16k16((u32x2){pkbf(P[0], P[1]), pkbf(P[2], P[3])}, vt, oo[mc]);
        }
        if (mc == 1) __builtin_amdgcn_sched_barrier(0);
    }
#pragma unroll
    for (int mc = 0; mc < NMC; ++mc) {
        {
            const LAS unsigned char* Qb = L + MX_Q + 16 * mc * MX_PITCH; const LAS unsigned char* Kb = L + MX_K + 16 * mc * MX_PITCH;
            const u32x2 vt = tr16(L + MX_V + 16 * mc * MX_PITCH + (4 * q + (r16 >> 2)) * MX_PITCH + (16 * w + 4 * (r16 & 3)) * 2);
            f32x4 o2b = {0.f, 0.f, 0.f, 0.f};
#pragma unroll
            for (int ks = 0; ks < 4; ++ks) {
                const bf16x8 qf = ld8(Qb + r16 * MX_PITCH + (32 * ks + 8 * q) * 2);
                const bf16x8 SB = mk8(pkbf(S[2 * ks][0], S[2 * ks][1]), pkbf(S[2 * ks][2], S[2 * ks][3]), pkbf(S[2 * ks + 1][0], S[2 * ks + 1][1]), pkbf(S[2 * ks + 1][2], S[2 * ks + 1][3]));
                if (ks & 1) o2b = MFMA16(qf, SB, o2b); else oo[mc] = MFMA16(qf, SB, oo[mc]);
            }
            oo[mc] = oo[mc] + o2b;
#pragma unroll
            for (int mt = 0; mt < 8; ++mt) {
                const f32x4 gd = *(const LAS f32x4*)(GD + mc * 128 + 16 * mt + 4 * q);
                const u32x2 kt = tr16(Kb + (4 * q + (r16 >> 2)) * MX_PITCH + MX_POS4(16 * mt + 4 * (r16 & 3)) * 2);
                S[mt] = mfma16k16(kt, vt, S[mt]); S[mt] = S[mt] * gd;
            }
        }
        if (mc + 1 < NMC) __builtin_amdgcn_sched_barrier(0);
    }
#pragma unroll
    for (int mc = 0; mc < NMC; ++mc) {
        {
#pragma unroll
            for (int r = 0; r < 4; ++r) OB[(16 * mc + 4 * q + r) * MX_OP + 16 * w + r16] = oo[mc][r];
        }
    }
}

__device__ __forceinline__ void mix_hg_unit(Frame& F, int b, int h, int mode) {
    const bool prompt = (mode != 1);
    const int tid = F.tid, lane = F.lane, w = F.wave, r16 = lane & 15, q = lane >> 4;
    const int tk = tid >> 3, p = tid & 7;
    LAS unsigned char* L = F.lds;
    LAS float* GD = (LAS float*)(L + MX_GD); LAS float* OB = (LAS float*)(L + MX_OB);
    bf16* MIX = F_XN(F);
    f32x4 S[8];
#pragma unroll
    for (int mt = 0; mt < 8; ++mt) S[mt] = (f32x4){0.f, 0.f, 0.f, 0.f};
    if (!prompt) {
        const float* Sin = F.in[6] + (size_t)(b * 8 + h) * 16384;
#pragma unroll
        for (int mt = 0; mt < 8; ++mt)
#pragma unroll
            for (int r = 0; r < 4; ++r) S[mt][r] = Sin[(16 * mt + 4 * q + r) * 128 + 16 * w + r16];
    }
    LAS float* GN = (LAS float*)(L + MX_GN);
    if (tid < 128) GN[tid] = F.in[18][128 * h + tid];
    const int nsc = (mode == 0) ? 33 : 1;
    u32x4 pa[6]; u32x4 pg[2]; float pgd = 1.f;
    const u32x4 z4 = {0u, 0u, 0u, 0u};
#define HG_LOAD(scv) do { int row0_, ntok_, nmc_, pos0_; MX_SC_PARAMS(scv, row0_, ntok_, nmc_, pos0_); (void)pos0_; \
        const bool valid_ = tk < ntok_; const bf16* zr_ = ZROW(F, row0_ + (valid_ ? tk : 0), 1) + 128 * h + 16 * p; \
        _Pragma("unroll") for (int i_ = 0; i_ < 6; ++i_) pa[i_] = z4; \
        if (valid_) { pa[0] = *(const u32x4*)zr_; pa[1] = *(const u32x4*)(zr_ + 8); pa[2] = *(const u32x4*)(zr_ + 1024); pa[3] = *(const u32x4*)(zr_ + 1032); pa[4] = *(const u32x4*)(zr_ + 2048); pa[5] = *(const u32x4*)(zr_ + 2056); } \
        pgd = 1.f; if ((tid >> 7) < nmc_) pgd = (mode == 1) ? ((const float*)(F.ws + WS_GDS))[(size_t)b * 1024 + 128 * h + (tid & 127)] : ((const float*)(F.ws + WS_GD))[(size_t)((row0_ >> 4) + (tid >> 7)) * 1024 + 128 * h + (tid & 127)]; } while (0)
    HG_LOAD(0);
    MSTAMP_DECL
#pragma unroll 1
    for (int sc = 0; sc < nsc; ++sc) {
        int row0, ntok, nmc, pos0; MX_SC_PARAMS(sc, row0, ntok, nmc, pos0); (void)pos0;
        MSTAMP(8);
        {
            const int c0 = (MX_POS4(16 * p)) * 2;
#pragma unroll
            for (int g = 0; g < 4; ++g) {
                *(LAS u32x2*)(L + MX_Q + tk * MX_PITCH + c0 + 16 * g) = (u32x2){pa[g >> 1][2 * (g & 1)], pa[g >> 1][2 * (g & 1) + 1]};
                *(LAS u32x2*)(L + MX_K + tk * MX_PITCH + c0 + 16 * g) = (u32x2){pa[2 + (g >> 1)][2 * (g & 1)], pa[2 + (g >> 1)][2 * (g & 1) + 1]};
            }
            *(LAS u32x4*)(L + MX_V + tk * MX_PITCH + 32 * p) = pa[4]; *(LAS u32x4*)(L + MX_V + tk * MX_PITCH + 32 * p + 16) = pa[5];
            GD[tid] = pgd;
        }
        MSTAMP(9);
        __syncthreads();
        MSTAMP(10);
        if (sc + 1 < nsc) HG_LOAD(sc + 1);
        { const bool valid = tk < ntok; const bf16* zr = ZROW(F, row0 + (valid ? tk : 0), 1) + 3072 + 128 * h + 16 * p; pg[0] = *(const u32x4*)zr; pg[1] = *(const u32x4*)(zr + 8); }
        MSTAMP(11);
        if (nmc == 4) hg_chain<4>(L, S, w, r16, q); else hg_chain<1>(L, S, w, r16, q);
        MSTAMP(12);
        __syncthreads();
        MSTAMP(13);
        {
            const bool valid = tk < ntok; const int row = row0 + (valid ? tk : 0);
            f32x4 o[4];
#pragma unroll
            for (int c = 0; c < 4; ++c) o[c] = *(const LAS f32x4*)(OB + tk * MX_OP + 16 * p + 4 * c);
            if (tk >= 16 * nmc) {
#pragma unroll
                for (int c = 0; c < 4; ++c) o[c] = (f32x4){0.f, 0.f, 0.f, 0.f}; }
            float vs = 0.f;
#pragma unroll
            for (int c = 0; c < 4; ++c) vs += (o[c].x * o[c].x + o[c].y * o[c].y) + (o[c].z * o[c].z + o[c].w * o[c].w);
            vs += __shfl_xor(vs, 1); vs += __shfl_xor(vs, 2); vs += __shfl_xor(vs, 4);
            const float rstd = rsqrtf(vs * (1.f / 128.f) + EPS);
            if (valid && !(mode == 0 && sc == 0)) {
                unsigned ow[8];
#pragma unroll
                for (int c = 0; c < 4; ++c) {
                    const unsigned ga = c < 2 ? pg[0][2 * c] : pg[1][2 * c - 4], gb = c < 2 ? pg[0][2 * c + 1] : pg[1][2 * c - 3];
                    f32x4 gt = {bflo(ga), bfhi(ga), bflo(gb), bfhi(gb)};
#pragma unroll
                    for (int e = 0; e < 4; ++e) gt[e] = siluf_(gt[e]);
                    const f32x4 r = o[c] * rstd * *(const LAS f32x4*)(GN + 16 * p + 4 * c) * gt;
                    ow[2 * c] = pkbf(r.x, r.y); ow[2 * c + 1] = pkbf(r.z, r.w);
                }
                bf16* mp = MIX + (size_t)row * DM + 128 * h + 16 * p;
                *(u32x4*)mp = (u32x4){ow[0], ow[1], ow[2], ow[3]}; *(u32x4*)(mp + 8) = (u32x4){ow[4], ow[5], ow[6], ow[7]};
            }
        }
        MSTAMP(14);
    }
#undef HG_LOAD
    __syncthreads();
    if (mode != 2) {
        int l2 = F.lane; asm volatile("" : "+v"(l2)); const int r16 = l2 & 15, q = l2 >> 4;
        float* So = F.out + (prompt ? O_HP : O_HS) + (size_t)(b * 8 + h) * 16384;
#pragma unroll
        for (int mt = 0; mt < 8; ++mt)
#pragma unroll
            for (int r = 0; r < 4; ++r) So[(16 * mt + 4 * q + r) * 128 + 16 * w + r16] = S[mt][r];
    }
}

__device__ __forceinline__ void mixer_layer0(Frame& F) {
    const float* rot = (const float*)(F.ws + WS_ROT);
    int bid = blockIdx.x; asm volatile("" : "+s"(bid));
    if (bid < 64) { const int u = bid, ty = u >> 5, bh = u & 31; if (ty == 0) mix_sg_unit<0>(F, bh >> 2, bh & 3, 0, rot); else mix_sg_unit<1>(F, bh >> 2, bh & 3, 0, rot); return; }
#pragma unroll 1
    for (int u = bid - 64; u < 1024 + 8; u += F.G - 64) {
        int ty, bh, mode;
        if (u < 1024) { ty = u >> 9; bh = u & 511; mode = 1; } else { ty = (u - 1024) >> 2; bh = (u - 1024) & 3; mode = 2; }
        if (ty == 0) mix_sg_unit<0>(F, bh >> 2, bh & 3, mode, rot); else mix_sg_unit<1>(F, bh >> 2, bh & 3, mode, rot);
    }
}
__device__ __forceinline__ void mixer_layer1(Frame& F) {
    int bid = blockIdx.x; asm volatile("" : "+s"(bid));
    if (bid < 64) { mix_hg_unit(F, bid >> 3, bid & 7, 0); return; }
#pragma unroll 1
    for (int u = bid - 64; u < 1024 + 8; u += F.G - 64) {
        if (u < 1024) mix_hg_unit(F, u >> 3, u & 7, 1); else mix_hg_unit(F, 0, u - 1024, 2);
    }
}
constexpr int NSTEP = 18;
#ifndef P0_DEFER
#define P0_DEFER 1
#endif
constexpr int LDSCTL_OFF = 139264;
#define RLX_AGENT __ATOMIC_RELAXED, __HIP_MEMORY_SCOPE_AGENT
#define XB_TMO      128
#define XB_XCNT(j)  (256  + 64 * (j))
#define XB_XSUB(j)  (1280 + 64 * (j))
#define XB_XGEN(j)  (2304 + 64 * (j))
#define XB_TOP      3328
#define XB_TOPGEN   3392
#define XCD_BAR_WORDS 3456
#define XB_SPIN_CAP (1u << 18)

__device__ __forceinline__ unsigned xb_ld(unsigned* p)              { return __hip_atomic_load(p, __ATOMIC_RELAXED, __HIP_MEMORY_SCOPE_AGENT); }
__device__ __forceinline__ unsigned xb_add(unsigned* p, unsigned v) { return __hip_atomic_fetch_add(p, v, __ATOMIC_RELAXED, __HIP_MEMORY_SCOPE_AGENT); }
__device__ __forceinline__ unsigned xb_xcc_id() { return (unsigned)__builtin_amdgcn_s_getreg((3 << 11) | 20) & 0xFu; }
#define XB_SPIN(cond, bar) do { unsigned _sp = 0; while (cond) { __builtin_amdgcn_s_sleep(1); \
    if ((++_sp & 255u) == 0u) { if (xb_ld(&(bar)[XB_TMO])) break; if (_sp > XB_SPIN_CAP) { atomicAdd(&(bar)[XB_TMO], 1u); break; } } } } while (0)

struct XcdBarrier {
    unsigned gsz;
    unsigned* bar; unsigned x;
    volatile LAS unsigned* st;
};

__device__ __forceinline__ XcdBarrier xcd_barrier_post(unsigned* bar, volatile LAS unsigned* st, unsigned gsz) {
    XcdBarrier b; b.gsz = gsz; b.bar = bar; b.x = xb_xcc_id(); b.st = st;
    if (threadIdx.x == 0) (void)xb_add(&bar[XB_XCNT(b.x)], 1u);
    return b;
}
__device__ __forceinline__ void xcd_barrier_complete(unsigned* bar, unsigned x, unsigned G, unsigned& nloc, unsigned& nx) {
    unsigned sum, cnt, mine, sp = 0u;
    for (;;) {
        sum = 0u; cnt = 0u; mine = 0u;
#pragma unroll
        for (unsigned j = 0; j < 16; ++j) { const unsigned c = xb_ld(&bar[XB_XCNT(j)]); sum += c; cnt += (c > 0u) ? 1u : 0u; mine = (j == x) ? c : mine; }
        if (sum == G) break;
        __builtin_amdgcn_s_sleep(1);
        if ((++sp & 255u) == 0u) { if (xb_ld(&bar[XB_TMO])) break; if (sp > XB_SPIN_CAP) { atomicAdd(&bar[XB_TMO], 1u); break; } }
    }
    nloc = mine > 0u ? mine : 1u; nx = cnt > 0u ? cnt : 1u;
}

__device__ __forceinline__ void xcd_barrier(const XcdBarrier& b) {
    asm volatile("s_waitcnt vmcnt(0)" ::: "memory");
    __syncthreads();
    if (threadIdx.x == 0) {
        unsigned* bar = b.bar;
        __builtin_amdgcn_s_waitcnt(0);
        unsigned nloc = b.st[0], nx = b.st[1];
        if (nloc == 0u) { xcd_barrier_complete(bar, b.x, b.gsz, nloc, nx); b.st[0] = nloc; b.st[1] = nx; }
        const unsigned old = xb_add(&bar[XB_XSUB(b.x)], 1u);
        const unsigned gen = old / nloc;
        if (old + 1u == (gen + 1u) * nloc) {
            __builtin_amdgcn_fence(__ATOMIC_RELEASE, "agent");
            asm volatile("s_waitcnt vmcnt(0)" ::: "memory");
            const unsigned og = xb_add(&bar[XB_TOP], 1u);
            const unsigned tg = og / nx;
            if (og + 1u == (tg + 1u) * nx) xb_add(&bar[XB_TOPGEN], 1u);
            else XB_SPIN(xb_ld(&bar[XB_TOPGEN]) == tg, bar);
            __builtin_amdgcn_fence(__ATOMIC_ACQUIRE, "agent");
            xb_add(&bar[XB_XGEN(b.x)], 1u);
            asm volatile("s_waitcnt vmcnt(0)" ::: "memory");
        } else {
            XB_SPIN(xb_ld(&bar[XB_XGEN(b.x)]) == gen, bar);
            __builtin_amdgcn_fence(__ATOMIC_ACQUIRE, "agent");
            asm volatile("s_waitcnt vmcnt(0)" ::: "memory");
        }
    }
    __syncthreads();
}


enum { K_P0 = 0, K_IN = 1, K_MIX = 2, K_OUT = 3, K_UP = 5, K_FIX = 6, K_DOWN = 7, K_FINAL = 8 };
struct Step { int kind, layer, side, tile0, nt, pre; };
__device__ __forceinline__ Step get_step(int pc) {
    switch (pc) {
        case 0:  return Step{K_P0, 0, 0, 0, 0, 0};
        case 1:  return Step{K_IN, 0, 0, 0, 69, 1};
        case 2:  return Step{K_MIX, 0, 0, 0, 0, 1};
        case 3:  return Step{K_OUT, 0, 1, 64, 5, 2};
        case 4:  return Step{K_UP, 0, 1, 64, 5, 2};
        case 5:  return Step{K_DOWN, 0, 1, 64, 5, 2};
        case 6:  return Step{K_IN, 1, 1, 64, 5, 2};
        case 7:  return Step{K_OUT, 0, 0, 0, 64, 1};
        case 8:  return Step{K_UP, 0, 0, 0, 64, 1};
        case 9:  return Step{K_DOWN, 0, 0, 0, 64, 1};
        case 10: return Step{K_IN, 1, 0, 0, 64, 1};
        case 11: return Step{K_MIX, 1, 0, 0, 0, 1};
        case 12: return Step{K_OUT, 1, 1, 64, 5, 2};
        case 13: return Step{K_UP, 1, 1, 64, 5, 2};
        case 14: return Step{K_DOWN, 1, 1, 64, 5, 2};
        case 15: return Step{K_OUT, 1, 0, 0, 64, 1};
        case 16: return Step{K_UP, 1, 0, 0, 64, 1};
        default: return Step{K_DOWN, 1, 0, 0, 64, 1};
    }
}

__global__ void __launch_bounds__(NWAVES * 64, 2) fwd_kernel(Args args) {
    extern __shared__ __attribute__((aligned(16))) unsigned char lds_raw[];
    cg::grid_group grid = cg::this_grid();
    Frame F;
    F.lds = (LAS unsigned char*)lds_raw;
#define REFRESH() do { int t_ = threadIdx.x; asm volatile("" : "+v"(t_)); F.tid = t_; F.lane = t_ & 63; F.wave = __builtin_amdgcn_readfirstlane(t_ >> 6); F.gw = blockIdx.x * NWAVES + F.wave; } while (0)
    F.G = gridDim.x; F.NGW = F.G * NWAVES; REFRESH();
    F.in = args.in; F.out = args.out; F.ws = args.ws;
    volatile LAS unsigned* MISC = (volatile LAS unsigned*)(F.lds + LDSCTL_OFF);
    if (threadIdx.x < 16) MISC[threadIdx.x] = 0u;
    __syncthreads();
    const bool side_wg = blockIdx.x >= 64;
    (void)xcd_barrier_post((unsigned*)(args.ws + WS_CTL), MISC + 8, F.G);
    if (side_wg) (void)xcd_barrier_post((unsigned*)(args.ws + WS_CTL) + 4096, MISC + 10, F.G - 64);
#ifndef KMASK
#define KMASK 0x1ff
#endif
#define INK(kind) ((((KMASK) >> (kind)) & 1) != 0)
#ifndef PROBE_MULT
#define PROBE_MULT 1
#endif
#ifdef PROBE_BLOCK
    volatile LAS unsigned long long* STMP = (volatile LAS unsigned long long*)(F.lds + LDSCTL_OFF + 128);
    if (threadIdx.x < 64) STMP[threadIdx.x] = 0ull;
    __syncthreads();
#define STAMP(id) do { if (blockIdx.x == PROBE_BLOCK && threadIdx.x == 0) STMP[(id)] = __builtin_amdgcn_s_memrealtime(); } while (0)
#else
#define STAMP(id) do { } while (0)
#endif
#pragma unroll 1
    for (int pc = 0; pc < NSTEP; ++pc) {
        const Step st = get_step(pc);
        if (st.pre == 1) { if (args.ph_hi < 0) grid.sync();
            { XcdBarrier bar_; bar_.gsz = F.G; bar_.bar = (unsigned*)(args.ws + WS_CTL); bar_.x = xb_xcc_id(); bar_.st = (volatile LAS unsigned*)(F.lds + LDSCTL_OFF) + 8; xcd_barrier(bar_); } }
        if (st.side && !side_wg) continue;
        if (st.pre == 2) { XcdBarrier bar_; bar_.gsz = F.G - 64; bar_.bar = (unsigned*)(args.ws + WS_CTL) + 4096; bar_.x = xb_xcc_id(); bar_.st = (volatile LAS unsigned*)(F.lds + LDSCTL_OFF) + 10; xcd_barrier(bar_); }
        const int layer = st.layer;
        STAMP(2 * pc);
        const int Gs = st.side ? F.G - 64 : F.G, cs = st.side ? (int)blockIdx.x - 64 : (int)blockIdx.x;
        if (st.kind == K_P0) { if (INK(0)) { REFRESH(); p0_weights(F, 0, P0_DEFER ? P0_ITEMS_AB : P0_ITEMS_L0, F.gw, F.NGW); STAMP(42); __syncthreads(); REFRESH(); p0_rows(F); STAMP(43); REFRESH(); p0_rotary(F, (float*)(args.ws + WS_ROT)); p0_zero_ssq(F); STAMP(44); } }
        else if (st.kind == K_IN) { if (INK(1)) {
            pg8::Gemm g{F_XG(F), (const bf16*)(args.ws + (layer == 0 ? WS_WAB : WS_WC)), MPAD, 4096, 1024, 1024}; pg8::StaticOrder S; S.init(st.nt, 4096, Gs, cs, st.tile0);
            if (layer == 0) { pg8::EpiBf16 E{F_Z(F), F_ZS1(F, layer), 64, 4096}; pg8::gemm_phase<pg8::EpiBf16, pg8::StaticOrder, false>(F.lds, g, S, E);
                if (P0_DEFER) { const int nfull = (st.nt * 16) % Gs; if (nfull != 0 && cs >= nfull) { REFRESH(); p0_weights(F, P0_ITEMS_AB, P0_ITEMS_L0, (cs - nfull) * NWAVES + F.wave, (Gs - nfull) * NWAVES); } } }
            else { EpiHg E{F_Z(F), F_ZS1(F, layer), 64, 4096, (const float*)(args.ws + WS_LB), (float*)(args.ws + WS_GD), (float*)(args.ws + WS_GDS)}; pg8::gemm_phase<EpiHg, pg8::StaticOrder, false>(F.lds, g, S, E); } } }
        else if (st.kind == K_MIX) { if (INK(2)) {
            if (layer == 1 && side_wg) { REFRESH(); p0_weights(F, P0_ITEMS_L0, P0_ITEMS_ALL, (blockIdx.x - 64) * NWAVES + F.wave, (F.G - 64) * NWAVES); __syncthreads(); }
            REFRESH(); if (layer == 0) mixer_layer0(F); else mixer_layer1(F); } }
        else if (st.kind == K_OUT) { if (INK(3)) {
            pg8::Gemm g{F_XN(F), (const bf16*)(args.ws + (layer == 0 ? WS_WOAB : WS_WOC)), MPAD, 1024, 1024, 1024}; pg8::StaticOrder S; S.init(st.nt, 1024, Gs, cs, st.tile0);
            pg8::EpiResid<false> E{F_X0(F), F_X1(F), PM_META, DM, F_XG(F), (float*)nullptr, 0, F.in[20] + (size_t)layer * DM, F_SSQ(F, 2 * layer), (unsigned*)(args.ws + WS_PCNT) + (2 * layer) * 69 * 16, (float*)nullptr, (float*)nullptr, (unsigned*)nullptr, 0,
                layer == 0 ? F.in[0] : (const float*)nullptr, F.in[1] - (size_t)ROW_S * DM, F.in[8] - (size_t)ROW_M * DM, layer == 0 ? NREAL : MPAD};
            pg8::gemm_phase<pg8::EpiResid<false>, pg8::StaticOrder, false>(F.lds, g, S, E); } }
        else if (st.kind == K_UP) { if (INK(5)) {
            pg8::Gemm g{F_XG(F), (const bf16*)(args.ws + WS_WF1) + (size_t)layer * NFF * 1024, MPAD, NFF, 1024, 1024}; pg8::StaticOrder S; S.init(st.nt, NFF, Gs, cs, st.tile0);
            EpiFfn E{F_Z(F), F_HS1(F), F.in[22] + (size_t)layer * 3 * DFF, F.in[23] + (size_t)layer * DFF, F.in[7] + (size_t)layer * 128 * 2 * DFF, F.out + O_FS + (size_t)layer * 128 * 2 * DFF, F_SBL(F), F_SBF(F)};
            pg8::gemm_phase<EpiFfn, pg8::StaticOrder, true>(F.lds, g, S, E); } }
        else if (st.kind == K_DOWN) { if (INK(7)) {
            const bf16* Wd = (const bf16*)(args.ws + WS_WF2) + (size_t)layer * 1024 * DFF;
            float* Yo = layer == 0 ? (float*)nullptr : F.out; const float* gn = layer == 0 ? F.in[9] + DM : F.in[25];
            unsigned* pcnt = (unsigned*)(args.ws + WS_PCNT) + (2 * layer + 1) * 69 * 16;
            if (!st.side) {
                pg8::Gemm g{F_Z(F), Wd, MPAD, 1024, DFF, DFF}; pg8::StaticOrder S; S.init(st.nt, 1024, Gs, cs, st.tile0);
                { REFRESH(); pg8::StaticOrder S2; S2.init(st.nt, 1024, Gs, cs, st.tile0); pg8::Unit fu; for (int i = 0; S2.next(i, fu); ++i) ffn_fixup_tile(F, layer, fu.pm, fu.pn == 0); }
                asm volatile("s_waitcnt vmcnt(0)" ::: "memory"); __syncthreads();
                pg8::EpiResid<false> E{F_X0(F), F_X1(F), PM_META, DM, F_XG(F), Yo, ROW_M, gn, F_SSQ(F, 2 * layer + 1), pcnt, (float*)nullptr, (float*)nullptr, (unsigned*)nullptr, 0,
                    (const float*)nullptr, (const float*)nullptr, (const float*)nullptr, MPAD};
                pg8::gemm_phase<pg8::EpiResid<false>, pg8::StaticOrder, false>(F.lds, g, S, E);
            } else {
                const int nu = st.nt * 4; float* sl0 = (float*)(args.ws + WS_SLAB0); float* sl1 = (float*)(args.ws + WS_SLAB1); unsigned* sfl = (unsigned*)(args.ws + WS_SFLAG) + layer * 20 * 16;
                if (cs < nu) {
                    pg8::Gemm g{F_HS1(F), Wd, MPAD, 1024, DFF / 2, DFF}; pg8::StaticOrder S; S.init(st.nt, 1024, nu, cs, st.tile0);
                    pg8::EpiResid<true> E{F_X0(F), F_X1(F), PM_META, DM, F_XG(F), Yo, ROW_M, gn, F_SSQ(F, 2 * layer + 1), pcnt, sl0, sl1, sfl, st.tile0,
                        (const float*)nullptr, (const float*)nullptr, (const float*)nullptr, MPAD};
                    pg8::gemm_phase<pg8::EpiResid<true>, pg8::StaticOrder, false>(F.lds, g, S, E);
                } else if (cs < 2 * nu) {
                    pg8::Gemm g{F_HS1(F) + DFF / 2, Wd + DFF / 2, MPAD, 1024, DFF / 2, DFF}; pg8::StaticOrder S; S.init(st.nt, 1024, nu, cs - nu, st.tile0);
                    pg8::EpiSlab E{sl0, sl1, sfl, st.tile0};
                    pg8::gemm_phase<pg8::EpiSlab, pg8::StaticOrder, false>(F.lds, g, S, E);
                }
            } } }
        STAMP(2 * pc + 1);
    }
#ifdef PROBE_BLOCK
    if (blockIdx.x == PROBE_BLOCK && threadIdx.x == 0) { const unsigned long long d = (STMP[PROBE_B] - STMP[PROBE_A]) * PROBE_MULT, t0 = __builtin_amdgcn_s_memrealtime(); while (__builtin_amdgcn_s_memrealtime() - t0 < d) __builtin_amdgcn_s_sleep(8); }
#endif
#undef INK
#undef REFRESH
}

extern "C" void kernel_launch(void* const* d_in, const int* in_sizes, int n_in, void* d_out, int out_size, void* d_ws, size_t ws_size, hipStream_t stream) {
    static int grid = 0;
    if (grid == 0) {
        if (n_in != 26 || (size_t)out_size != O_END || ws_size < WS_END) { fprintf(stderr, "kernel_launch: unexpected shapes: n_in %d out %d ws %zu\n", n_in, out_size, ws_size); grid = -1; return; }
        int dev = 0, cus = 0, per_cu = 0;
        if (hipGetDevice(&dev) != hipSuccess || hipDeviceGetAttribute(&cus, hipDeviceAttributeMultiprocessorCount, dev) != hipSuccess) { grid = -1; return; }
        if (hipFuncSetAttribute((const void*)fwd_kernel, hipFuncAttributeMaxDynamicSharedMemorySize, LDS_BYTES) != hipSuccess) { fprintf(stderr, "kernel_launch: hipFuncSetAttribute failed\n"); grid = -1; return; }
        if (hipOccupancyMaxActiveBlocksPerMultiprocessor(&per_cu, (const void*)fwd_kernel, NWAVES * 64, LDS_BYTES) != hipSuccess || per_cu < 1) { fprintf(stderr, "kernel_launch: occupancy query says %d\n", per_cu); per_cu = 1; }
        (void)hipGetLastError();
        grid = cus;
        if (grid != 256) { fprintf(stderr, "kernel_launch: the fused row-norm exchange needs one unit per workgroup in the N = 1024 GEMM steps: exactly 256 CUs (got %d)\n", grid); grid = -1; return; }
        if (grid < 128) { fprintf(stderr, "kernel_launch: this kernel's static work split needs >= 128 CUs (got %d)\n", grid); grid = -1; return; }
    }
    if (grid < 0) return;
    if (hipMemsetAsync((char*)d_ws + WS_CTL, 0, CTL_ZERO_BYTES, stream) != hipSuccess) { fprintf(stderr, "kernel_launch: hipMemsetAsync failed\n"); return; }
    Args a{};
    for (int i = 0; i < 26; ++i) a.in[i] = (const float*)d_in[i];
    a.out = (float*)d_out; a.ws = (unsigned char*)d_ws;
    a.ph_lo = 0; a.ph_hi = NSTEP;
    void* kargs[] = {&a};
    hipError_t e = hipLaunchCooperativeKernel((const void*)fwd_kernel, dim3(grid), dim3(NWAVES * 64), kargs, LDS_BYTES, stream);
    if (e != hipSuccess) fprintf(stderr, "kernel_launch: cooperative launch failed: %s (grid %d)\n", hipGetErrorString(e), grid);
}
```

```cpp
#include <hip/hip_runtime.h>
#include <hip/hip_cooperative_groups.h>
#include <cstdio>
#include <cstdint>
namespace cg = cooperative_groups;

namespace pg8 {
#define PG8_LAS __attribute__((address_space(3)))
typedef unsigned short bf16_t;
typedef short bf16x8 __attribute__((ext_vector_type(8)));
typedef float f32x4 __attribute__((ext_vector_type(4)));
typedef unsigned u32x4 __attribute__((ext_vector_type(4)));
typedef unsigned u32x2 __attribute__((ext_vector_type(2)));
constexpr int BM = 256, BK = 64, HALF = 128, HTB = HALF * BK * 2  , STAGE_BYTES = 8 * HTB, NXCD = 8, WGM = 8;

__host__ __device__ __forceinline__ int lds_byte(int r, int c) { const int st = (r >> 4) * 2 + (c >> 5), rr = r & 15, cc = c & 31, ob = rr * 64 + cc * 2; return st * 1024 + (ob ^ (((ob >> 9) & 1) << 5)); }
__host__ __device__ __forceinline__ void stage_rc(int b, int& R, int& C) { const int st = b / 1024, sb = b % 1024, swz = sb ^ (((sb >> 9) & 1) << 5); R = (st >> 1) * 16 + swz / 64; C = (st & 1) * 32 + (swz % 64) / 2; }
__host__ __device__ __forceinline__ int perm32(int rho) { const int n = rho >> 4, i = rho & 15; return 8 * (i >> 2) + 4 * n + (i & 3); }

struct Unit { int pm, pn; };
struct Gemm { const bf16_t* A; const bf16_t* Bt; int M, N, K, ld; };

struct StaticOrder {
    int nM, nN, nwg, G, c, pm0;
    __host__ __device__ __forceinline__ void init(int nMt, int N, int G_, int c_, int pm0_) { nM = nMt; nN = N / BM; nwg = nM * nN; G = G_; c = c_; pm0 = pm0_; }
    __host__ __device__ __forceinline__ bool next(int i, Unit& u) const {
        const long L = (long)i * G + c; if (L >= nwg) return false;
        int wgid = (int)L; { const int q = nwg / NXCD, r = nwg % NXCD, xcd = wgid % NXCD, off = wgid / NXCD; wgid = (xcd < r ? xcd * (q + 1) : r * (q + 1) + (xcd - r) * q) + off; }
        const int nig = WGM * nN, gid = wgid / nig, fm = gid * WGM, gsz = (nM - fm) < WGM ? (nM - fm) : WGM;
        u.pm = pm0 + fm + ((wgid % nig) % gsz); u.pn = (wgid % nig) / gsz; return true;
    }
    __device__ __forceinline__ void a_ready(const Unit&) const {}
    __device__ __forceinline__ void done(const Unit&) const {}
};

__device__ __forceinline__ unsigned cvt_pk_bf16(float lo, float hi) { unsigned r; asm volatile("v_cvt_pk_bf16_f32 %0, %1, %2" : "=v"(r) : "v"(lo), "v"(hi)); return r; }

struct EpiBf16 {
    static constexpr bool PERM = true, AFTER_DRAIN = false;
    bf16_t* O0; bf16_t* O1; int pm_split; int ldc;
    __device__ __forceinline__ void operator()(f32x4 (&acc)[2][2][4][2], const Unit& u, int wr, int wc, int fr, int fq) const {
        bf16_t* O = (u.pm < pm_split) ? O0 : O1;
        const int row0 = u.pm * BM + wr * 64 + fr; const int col0 = u.pn * BM + wc * 32 + 8 * fq;
#pragma unroll
        for (int ai = 0; ai < 2; ++ai)
#pragma unroll
            for (int m = 0; m < 4; ++m) { bf16_t* rowp = O + (size_t)(row0 + ai * HALF + m * 16) * ldc + col0;
#pragma unroll
                for (int bj = 0; bj < 2; ++bj) { const f32x4 v0 = acc[ai][bj][m][0], v1 = acc[ai][bj][m][1];
                    u32x4 w; w.x = cvt_pk_bf16(v0[0], v0[1]); w.y = cvt_pk_bf16(v0[2], v0[3]); w.z = cvt_pk_bf16(v1[0], v1[1]); w.w = cvt_pk_bf16(v1[2], v1[3]);
                    *(u32x4*)(rowp + bj * HALF) = w; } }
    }
};

template <bool SLAB> struct EpiResid {
    static constexpr bool PERM = true, AFTER_DRAIN = false;
    float* X0; float* X1; int pm_split; int ldc; bf16_t* XG; float* Y; int yrows; const float* gain; float* ssq; unsigned* cnt;
    float* slab0; float* slab1; unsigned* sflag; int pm0;
    const float* R0; const float* R1; const float* R2; int nreal;
    __device__ __forceinline__ void operator()(f32x4 (&acc)[2][2][4][2], const Unit& u, int wr, int wc, int fr, int fq) const {
        if constexpr (SLAB) {
            const int ui = (u.pm - pm0) * 4 + u.pn;
            float* sl = (ui < 15 ? slab0 + (size_t)ui * 65536 : slab1 + (size_t)(ui - 15) * 65536);
            const int vo_ = ((wr * 4 + wc) * 64 + fr + 16 * fq) * 16;
            unsigned* fl = sflag + ui * 16;
            const __amdgpu_buffer_rsrc_t rs_ = __builtin_amdgcn_make_buffer_rsrc((void*)sl, 0, 262144, 0x00020000);
            if (fr == 0 && fq == 0) { unsigned sp = 0u; while (__hip_atomic_load(fl, __ATOMIC_RELAXED, __HIP_MEMORY_SCOPE_AGENT) < 8u) { __builtin_amdgcn_s_sleep(1); if (++sp > (1u << 22)) break; } }
            asm volatile("" ::: "memory");
#pragma unroll
            for (int ai = 0; ai < 2; ++ai)
#pragma unroll
                for (int bj = 0; bj < 2; ++bj)
#pragma unroll
                    for (int m = 0; m < 4; ++m) {
                        const u32x4 t0_ = __builtin_amdgcn_raw_buffer_load_b128(rs_, vo_, (((ai * 2 + bj) * 4 + m) * 2 + 0) * 8192, 16), t1_ = __builtin_amdgcn_raw_buffer_load_b128(rs_, vo_, (((ai * 2 + bj) * 4 + m) * 2 + 1) * 8192, 16);
                        acc[ai][bj][m][0] = acc[ai][bj][m][0] + __builtin_bit_cast(f32x4, t0_); acc[ai][bj][m][1] = acc[ai][bj][m][1] + __builtin_bit_cast(f32x4, t1_);
                        asm volatile("" : "+v"(acc[ai][bj][m][0]), "+v"(acc[ai][bj][m][1])); }
        }
        float* C = (u.pm < pm_split) ? X0 : X1;
        const float* Rsrc = R0 ? (u.pm < 64 ? R0 : u.pm < pm_split ? R1 : R2) : (const float*)C;
        const int row0 = u.pm * BM + wr * 64 + fr, col0 = u.pn * BM + wc * 32 + 8 * fq;
#pragma unroll
        for (int ai = 0; ai < 2; ++ai)
#pragma unroll
            for (int mp = 0; mp < 2; ++mp) {
                f32x4 t[2][2][2];
#pragma unroll
                for (int mm = 0; mm < 2; ++mm) { const int rr_ = row0 + ai * HALF + (2 * mp + mm) * 16; const float* rowp = Rsrc + (size_t)rr_ * ldc + col0; const bool have = rr_ < nreal;
#pragma unroll
                    for (int bj = 0; bj < 2; ++bj)
#pragma unroll
                        for (int n = 0; n < 2; ++n) t[mm][bj][n] = have ? *(const f32x4*)(rowp + bj * HALF + 4 * n) : (f32x4){0.f, 0.f, 0.f, 0.f}; }
#pragma unroll
                for (int mm = 0; mm < 2; ++mm) { const int m = 2 * mp + mm; const int row = row0 + ai * HALF + m * 16; float sq = 0.f;
#pragma unroll
                    for (int bj = 0; bj < 2; ++bj)
#pragma unroll
                        for (int n = 0; n < 2; ++n) { const f32x4 v = t[mm][bj][n] + acc[ai][bj][m][n]; acc[ai][bj][m][n] = v;
                            sq += (v[0] * v[0] + v[1] * v[1]) + (v[2] * v[2] + v[3] * v[3]); }
                    sq += __shfl_xor(sq, 16); sq += __shfl_xor(sq, 32); if (fq == 0) atomicAdd(ssq + row, sq); }
                asm volatile("" ::: "memory"); }
        asm volatile("s_waitcnt vmcnt(0)" ::: "memory");
        unsigned* pc = cnt + u.pm * 16;
        if (fr == 0 && fq == 0) {
            __hip_atomic_fetch_add(pc, 1u, __ATOMIC_RELAXED, __HIP_MEMORY_SCOPE_AGENT);
        }
        if (!Y) {
#pragma unroll
            for (int ai = 0; ai < 2; ++ai)
#pragma unroll
                for (int m = 0; m < 4; ++m) { float* rowp = C + (size_t)(row0 + ai * HALF + m * 16) * ldc + col0;
#pragma unroll
                    for (int bj = 0; bj < 2; ++bj)
#pragma unroll
                        for (int n = 0; n < 2; ++n) *(f32x4*)(rowp + bj * HALF + 4 * n) = acc[ai][bj][m][n]; }
        }
        if (fr == 0 && fq == 0) {
            unsigned sp = 0u;
            while (__hip_atomic_load(pc, __ATOMIC_RELAXED, __HIP_MEMORY_SCOPE_AGENT) < 32u) { __builtin_amdgcn_s_sleep(1); if (++sp > (1u << 22)) break; }
        }
        asm volatile("" ::: "memory");
        f32x4 gv[2][2];
#pragma unroll
        for (int bj = 0; bj < 2; ++bj)
#pragma unroll
            for (int n = 0; n < 2; ++n) gv[bj][n] = *(const f32x4*)(gain + col0 + bj * HALF + 4 * n);
#pragma unroll
        for (int ai = 0; ai < 2; ++ai)
#pragma unroll
            for (int m = 0; m < 4; ++m) { const int row = row0 + ai * HALF + m * 16;
                const float rs = __builtin_amdgcn_rsqf(__hip_atomic_load(ssq + row, __ATOMIC_RELAXED, __HIP_MEMORY_SCOPE_AGENT) * (1.0f / 1024.0f) + 1e-6f);
#pragma unroll
                for (int bj = 0; bj < 2; ++bj) { const f32x4 y0 = acc[ai][bj][m][0] * rs * gv[bj][0], y1 = acc[ai][bj][m][1] * rs * gv[bj][1];
                    if (Y) { if (row < yrows) { *(f32x4*)(Y + (size_t)row * ldc + col0 + bj * HALF) = y0; *(f32x4*)(Y + (size_t)row * ldc + col0 + bj * HALF + 4) = y1; } }
                    else { u32x4 w; w.x = cvt_pk_bf16(y0[0], y0[1]); w.y = cvt_pk_bf16(y0[2], y0[3]); w.z = cvt_pk_bf16(y1[0], y1[1]); w.w = cvt_pk_bf16(y1[2], y1[3]);
                        *(u32x4*)(XG + (size_t)row * ldc + col0 + bj * HALF) = w; } } }
    }
};

struct EpiSlab {
    static constexpr bool PERM = true, AFTER_DRAIN = false;
    float* slab0; float* slab1; unsigned* sflag; int pm0;
    __device__ __forceinline__ void operator()(f32x4 (&acc)[2][2][4][2], const Unit& u, int wr, int wc, int fr, int fq) const {
        const int ui = (u.pm - pm0) * 4 + u.pn;
        float* sl = (ui < 15 ? slab0 + (size_t)ui * 65536 : slab1 + (size_t)(ui - 15) * 65536);
        const int vo_ = ((wr * 4 + wc) * 64 + fr + 16 * fq) * 16;
        const __amdgpu_buffer_rsrc_t rs_ = __builtin_amdgcn_make_buffer_rsrc((void*)sl, 0, 262144, 0x00020000);
#pragma unroll
        for (int ai = 0; ai < 2; ++ai)
#pragma unroll
            for (int bj = 0; bj < 2; ++bj)
#pragma unroll
                for (int m = 0; m < 4; ++m)
#pragma unroll
                    for (int n = 0; n < 2; ++n) __builtin_amdgcn_raw_buffer_store_b128(__builtin_bit_cast(u32x4, acc[ai][bj][m][n]), rs_, vo_, (((ai * 2 + bj) * 4 + m) * 2 + n) * 8192, 16);
        asm volatile("s_waitcnt vmcnt(0)" ::: "memory");
        if (fr == 0 && fq == 0) __hip_atomic_fetch_add(sflag + ui * 16, 1u, __ATOMIC_RELAXED, __HIP_MEMORY_SCOPE_AGENT);
    }
};

template <class Epi, class Sched, bool APERM>
__device__ __forceinline__ void gemm_phase(PG8_LAS unsigned char* lds, const Gemm g, const Sched& S, const Epi& E) {
    int tid_ = threadIdx.x; asm volatile("" : "+v"(tid_));
    const int tid = tid_, wid = __builtin_amdgcn_readfirstlane(tid >> 6), lane = tid & 63, wr = wid >> 2, wc = wid & 3, fr = lane & 15, fq = lane >> 4;
    const int K = g.ld, nt = g.K / BK;
    unsigned voffA[2], voffB[2];
#pragma unroll
    for (int i = 0; i < 2; ++i) { int R, C; stage_rc(tid * 16 + i * 8192, R, C); const int Rb = Epi::PERM ? ((R & ~31) + perm32(R & 31)) : R;
        const int Ra = APERM ? (128 * (R >> 6) + 8 * (R & 15) + ((R >> 4) & 3)) : R;
        voffA[i] = (unsigned)(Ra * K + C) * 2u; voffB[i] = (unsigned)(Rb * K + C) * 2u; }
    const size_t kstep = (size_t)(BK * 2);
    const size_t hstep = (size_t)HALF * K * 2;
    const size_t hstepA = APERM ? (size_t)4 * K * 2 : hstep;
    const size_t tstep = 2 * hstep;
    const unsigned ldsw = (unsigned)wid * 1024u;
    const int aoff = lds_byte(wr * 64 + fr, fq * 8), boff = lds_byte(wc * 32 + fr, fq * 8);
#define PG8_SA(b, h) (((b) * 2 + (h)) * HTB)
#define PG8_SB(b, h) ((4 + (b) * 2 + (h)) * HTB)
#define PG8_STAGE(bufoff, gbase, voff) do { _Pragma("unroll") for (int _i = 0; _i < 2; ++_i) \
        __builtin_amdgcn_global_load_lds((const unsigned*)((const char*)(gbase) + (voff)[_i]), (PG8_LAS unsigned*)(lds + (bufoff) + ldsw + _i * 8192), 16, 0, 0); } while (0)
#define PG8_LDA(dst, b, h) do { _Pragma("unroll") for (int m = 0; m < 4; ++m) _Pragma("unroll") for (int k = 0; k < 2; ++k) dst[m][k] = *(const PG8_LAS bf16x8*)(lds + PG8_SA(b, h) + aoff + m * 2048 + k * 1024); } while (0)
#define PG8_LDB(dst, b, h) do { _Pragma("unroll") for (int n = 0; n < 2; ++n) _Pragma("unroll") for (int k = 0; k < 2; ++k) dst[n][k] = *(const PG8_LAS bf16x8*)(lds + PG8_SB(b, h) + boff + n * 2048 + k * 1024); } while (0)
#define PG8_MMA(ai, bj, At, Bt) do { __builtin_amdgcn_s_setprio(1); _Pragma("unroll") for (int m = 0; m < 4; ++m) _Pragma("unroll") for (int n = 0; n < 2; ++n) _Pragma("unroll") for (int k = 0; k < 2; ++k) \
        acc[ai][bj][m][n] = __builtin_amdgcn_mfma_f32_16x16x32_bf16(Bt[n][k], At[m][k], acc[ai][bj][m][n], 0, 0, 0); __builtin_amdgcn_s_setprio(0); } while (0)
#define PG8_WAIT_V(n) asm volatile("s_waitcnt vmcnt(" #n ")" ::: "memory")
#define PG8_WAIT_L(n) asm volatile("s_waitcnt lgkmcnt(" #n ")" ::: "memory")
#define PG8_BAR __builtin_amdgcn_s_barrier()
#define PG8_SCHED __builtin_amdgcn_sched_barrier(0)
    Unit cur, nxt; int ui = 0;
    if (!S.next(0, cur)) return;
    f32x4 acc[2][2][4][2];
#pragma unroll
    for (int a = 0; a < 2; ++a)
#pragma unroll
        for (int b = 0; b < 2; ++b)
#pragma unroll
            for (int m = 0; m < 4; ++m)
#pragma unroll
                for (int n = 0; n < 2; ++n) acc[a][b][m][n] = (f32x4){0.f, 0.f, 0.f, 0.f};
    bf16x8 At[4][2], B0[2][2], B1[2][2];
    const char* cA = (const char*)g.A + (size_t)cur.pm * tstep; const char* cB = (const char*)g.Bt + (size_t)cur.pn * tstep;
    S.a_ready(cur);
    PG8_STAGE(PG8_SB(0, 0), cB, voffB); PG8_STAGE(PG8_SB(0, 1), cB + hstep, voffB); PG8_STAGE(PG8_SA(0, 0), cA, voffA); PG8_STAGE(PG8_SA(0, 1), cA + hstepA, voffA);
    if (wr == 1) PG8_BAR;
    PG8_WAIT_V(2); PG8_BAR;
    PG8_STAGE(PG8_SB(1, 0), cB + kstep, voffB); PG8_STAGE(PG8_SA(1, 0), cA + kstep, voffA); PG8_STAGE(PG8_SB(1, 1), cB + hstep + kstep, voffB);
    PG8_WAIT_V(6); PG8_BAR;
    for (;;) {
        const bool has_next = S.next(ui + 1, nxt);
        const char* nA = has_next ? (const char*)g.A + (size_t)nxt.pm * tstep : cA; const char* nB = has_next ? (const char*)g.Bt + (size_t)nxt.pn * tstep : cB;
        for (int t = 0; t < nt; t += 2) {
            const bool last = (t == nt - 2);
            const char* a1 = cA + (size_t)(t + 1) * kstep;
            const char* a2 = last ? nA : cA + (size_t)(t + 2) * kstep; const char* b2 = last ? nB : cB + (size_t)(t + 2) * kstep;
            const char* a3 = a2 + kstep; const char* b3 = b2 + kstep;
            if (last && has_next) S.a_ready(nxt);
            PG8_LDB(B0, 0, 0); PG8_LDB(B1, 0, 1); PG8_SCHED; PG8_LDA(At, 0, 0); PG8_STAGE(PG8_SA(1, 1), a1 + hstepA, voffA);
            PG8_WAIT_V(8); PG8_WAIT_L(0); PG8_BAR; PG8_MMA(0, 0, At, B0); PG8_MMA(0, 1, At, B1); PG8_BAR; PG8_SCHED;
            PG8_LDA(At, 0, 1); PG8_STAGE(PG8_SB(0, 0), b2, voffB); PG8_STAGE(PG8_SB(0, 1), b2 + hstep, voffB); PG8_STAGE(PG8_SA(0, 0), a2, voffA);
            PG8_WAIT_V(8); PG8_WAIT_L(0); PG8_BAR; PG8_MMA(1, 0, At, B0); PG8_MMA(1, 1, At, B1); PG8_BAR; PG8_SCHED;
            PG8_LDB(B0, 1, 0); PG8_LDB(B1, 1, 1); PG8_SCHED; PG8_LDA(At, 1, 0); PG8_STAGE(PG8_SA(0, 1), a2 + hstepA, voffA);
            PG8_WAIT_V(8); PG8_WAIT_L(0); PG8_BAR; PG8_MMA(0, 0, At, B0); PG8_MMA(0, 1, At, B1); PG8_BAR; PG8_SCHED;
            PG8_LDA(At, 1, 1); PG8_STAGE(PG8_SB(1, 0), b3, voffB); PG8_STAGE(PG8_SB(1, 1), b3 + hstep, voffB); PG8_STAGE(PG8_SA(1, 0), a3, voffA);
            PG8_WAIT_V(8); PG8_WAIT_L(0); PG8_BAR; PG8_MMA(1, 0, At, B0); PG8_MMA(1, 1, At, B1); PG8_BAR; PG8_SCHED;
        }
        if (wr == 0) PG8_BAR;
        E(acc, cur, wr, wc, fr, fq); S.done(cur);
        if (!has_next) break;
#pragma unroll
        for (int a = 0; a < 2; ++a)
#pragma unroll
            for (int b = 0; b < 2; ++b)
#pragma unroll
                for (int m = 0; m < 4; ++m)
#pragma unroll
                    for (int n = 0; n < 2; ++n) acc[a][b][m][n] = (f32x4){0.f, 0.f, 0.f, 0.f};
        cur = nxt; cA = nA; cB = nB; ++ui;
        if (wr == 1) PG8_BAR;
    }
    PG8_WAIT_V(0);
    PG8_BAR;
#undef PG8_SA
#undef PG8_SB
#undef PG8_STAGE
#undef PG8_LDA
#undef PG8_LDB
#undef PG8_MMA
#undef PG8_WAIT_V
#undef PG8_WAIT_L
#undef PG8_BAR
#undef PG8_SCHED
}
}
constexpr int DM = 1024;
constexpr int ROW_S = 16384;
constexpr int ROW_M = 17408;
constexpr int NREAL = 17424;
constexpr int MPAD = 17664;
constexpr int PM_META = 68;
constexpr int NAB = 4096, NCC = 4096, DFF = 2816, NFF = 5632, ABW = 4104;
constexpr int NGRP = 138, GRP_META = 136;
constexpr float EPS = 1e-6f;
constexpr float KSCALE = 0.08838834764831845f;

constexpr size_t O_YP = 0, O_YS = 16777216, O_CP = 17825792, O_CS = 18350080, O_NP = 26738688, O_NS = 26742784, O_MP = 26808320, O_MS = 26808352,
                 O_RP = 26808864, O_RS = 27333152, O_HP = 35721760, O_HS = 36770336, O_FP = 53547552, O_FS = 53637664, O_END = 55079456;

constexpr size_t MiB = 1u << 20;
constexpr size_t WS_CTL = 0, CTL_ZERO_BYTES = 128 * 1024;
constexpr size_t WS_PCNT = 64 * 1024;
constexpr size_t WS_SFLAG = 96 * 1024;
constexpr size_t WS_SLAB0 = 223 * MiB + 65536, WS_SLAB1 = 277 * MiB + 512 * 1024;
constexpr size_t WS_WAB = 1 * MiB, WS_WOAB = 9 * MiB, WS_WC = 11 * MiB, WS_WOC = 19 * MiB, WS_WF1 = 21 * MiB  , WS_WF2 = 43 * MiB  ;
constexpr size_t WS_XN = 54 * MiB;
constexpr size_t WS_Z = 89 * MiB;
constexpr size_t WS_GD = 217 * MiB;
constexpr size_t WS_GDS = 222 * MiB;
constexpr size_t WS_LB = 223 * MiB;
constexpr size_t WS_XM = 227 * MiB;
constexpr size_t WS_G = 228 * MiB;
constexpr size_t WS_SBL = 229 * MiB;
constexpr size_t WS_SBF = 233 * MiB;
constexpr size_t WS_ROT = 240 * MiB;
constexpr size_t WS_XG = 242 * MiB;
constexpr size_t WS_SSQ = 277 * MiB;
constexpr size_t WS_ZS = 279 * MiB;
constexpr size_t WS_ZS2 = 290 * MiB;
constexpr size_t WS_HS = 301 * MiB;
constexpr size_t WS_END = 309 * MiB;
static_assert(WS_SLAB0 + 15 * 262144 <= 227 * MiB && WS_SSQ + 4 * (size_t)MPAD * 4 <= WS_SLAB1 && WS_SLAB1 + 5 * 262144 <= 279 * MiB, "slab map");
static_assert(WS_XN + (size_t)MPAD * DM * 2 <= WS_Z && WS_Z + (size_t)MPAD * 4096 * 2 <= WS_XM && WS_SBL + (size_t)NGRP * 2 * DFF * 4 <= WS_SBF && WS_SBF + (size_t)NGRP * 4 * DFF * 4 <= WS_END, "ws map");

constexpr int P0_ITEMS_L0 = 16 * 128 + 16 * 32 + 16 * 128 + 16 * 176 + 44 * 32, P0_ITEMS_ALL = P0_ITEMS_L0 + 16 * 32 + 16 * 176 + 44 * 32;
constexpr int P0_ITEMS_AB = 16 * 128;
constexpr int LDS_BYTES = 147456;
constexpr int NWAVES = 8;

#define GAS __attribute__((address_space(1)))
#define LAS __attribute__((address_space(3)))
typedef unsigned short bf16;
typedef float f32x4 __attribute__((ext_vector_type(4)));
typedef unsigned u32x2 __attribute__((ext_vector_type(2)));
typedef unsigned u32x4 __attribute__((ext_vector_type(4)));
#define LDS_WAIT() asm volatile("s_waitcnt lgkmcnt(0)" ::: "memory")

__device__ __forceinline__ unsigned f2bf(float f) { unsigned u = __builtin_bit_cast(unsigned, f); return (u + 0x7fffu + ((u >> 16) & 1u)) >> 16; }
__device__ __forceinline__ unsigned pk2(float lo, float hi) { return f2bf(lo) | (f2bf(hi) << 16); }
__device__ __forceinline__ float bf2f(unsigned short b) { return __builtin_bit_cast(float, ((unsigned)b) << 16); }
__device__ __forceinline__ float bflo(unsigned w) { return __builtin_bit_cast(float, w << 16); }
__device__ __forceinline__ float bfhi(unsigned w) { return __builtin_bit_cast(float, w & 0xffff0000u); }
__device__ __forceinline__ f32x4 ld_bf4(const bf16* p) { const u32x2 w = *(const u32x2*)p; return (f32x4){bflo(w.x), bfhi(w.x), bflo(w.y), bfhi(w.y)}; }
__device__ __forceinline__ float wave_sum(float v) {
#pragma unroll
    for (int o = 1; o < 64; o <<= 1) v += __shfl_xor(v, o);
    return v;
}
__device__ __forceinline__ float half_sum(float v) {
#pragma unroll
    for (int o = 1; o < 32; o <<= 1) v += __shfl_xor(v, o);
    return v;
}
__device__ __forceinline__ float sigmoidf_(float x) { return 1.f / (1.f + __expf(-x)); }
__device__ __forceinline__ float siluf_(float x) { return x / (1.f + __expf(-x)); }
__device__ __forceinline__ float logsigmoidf_(float x) { return fminf(x, 0.f) - __logf(1.f + __expf(-fabsf(x))); }

struct Args { const float* in[26]; float* out; unsigned char* ws; int ph_lo, ph_hi; };

struct Frame {
    LAS unsigned char* lds;
    int tid, lane, wave, G, gw, NGW;
    const float* const* in; float* out; unsigned char* ws;
};
#define F_X0(F) ((F).out)
#define F_X1(F) ((float*)((F).ws + WS_XM) - (size_t)ROW_M * DM)
#define F_XN(F) ((bf16*)((F).ws + WS_XN))
#define F_XG(F) ((bf16*)((F).ws + WS_XG))
#define F_SSQ(F, i) ((float*)((F).ws + WS_SSQ) + (size_t)(i) * MPAD)
#define F_Z(F) ((bf16*)((F).ws + WS_Z))
#define F_ZS1(F, layer) ((bf16*)((F).ws + ((layer) == 0 ? WS_ZS : WS_ZS2)) - (size_t)ROW_S * 4096)
#define F_HS1(F) ((bf16*)((F).ws + WS_HS) - (size_t)ROW_S * DFF)
#define ZROW(F, row, layer) (((row) < ROW_S ? F_Z(F) : F_ZS1(F, layer)) + (size_t)(row) * 4096)
#define F_GT(F) ((float*)((F).ws + WS_G))
#define F_SBL(F) ((float*)((F).ws + WS_SBL))
#define F_SBF(F) ((float*)((F).ws + WS_SBF))
__device__ __forceinline__ float* xrow(const Frame& F, int r) { return (r < ROW_M ? F_X0(F) : F_X1(F)) + (size_t)r * DM; }

__device__ __forceinline__ void p0_transpose_item(const float* W, int K, int Nsrc, int n0src, bf16* WT, int dstrow0, LAS float* scr, int kb, int lane) {
    const int k0 = 64 * kb;
    f32x4 v[8];
#pragma unroll
    for (int i = 0; i < 8; ++i) v[i] = *(const f32x4*)(W + (size_t)(k0 + 8 * i + (lane >> 3)) * Nsrc + n0src + 4 * (lane & 7));
#pragma unroll
    for (int i = 0; i < 8; ++i) { LAS float* d = scr + (8 * i + (lane >> 3)) * 33 + 4 * (lane & 7); d[0] = v[i][0]; d[1] = v[i][1]; d[2] = v[i][2]; d[3] = v[i][3]; }
    LDS_WAIT(); asm volatile("" ::: "memory");
    const int c = lane & 7;
#pragma unroll
    for (int j = 0; j < 4; ++j) { const int n = (lane >> 3) + 8 * j; const LAS float* s = scr + (8 * c) * 33 + n;
        u32x4 o; o.x = pk2(s[0 * 33], s[1 * 33]); o.y = pk2(s[2 * 33], s[3 * 33]); o.z = pk2(s[4 * 33], s[5 * 33]); o.w = pk2(s[6 * 33], s[7 * 33]);
        *(u32x4*)(WT + (size_t)(dstrow0 + n) * K + k0 + 8 * c) = o; }
    LDS_WAIT(); asm volatile("" ::: "memory");
}

__device__ __forceinline__ void p0_weights(Frame& F, int it0, int it1, int gw, int ngw) {
    LAS float* scr = (LAS float*)(F.lds + F.wave * 16384);
    constexpr int I_AB = 16 * 128, I_O = 16 * 32, I_C = 16 * 128, I_F1 = 16 * 176, I_F2 = 44 * 32;
    for (int it = it0 + gw; it < it1; it += ngw) {
        int r = it;
        if (r < I_AB) { const int kb = r / 128, nb = r % 128; const int c = 32 * nb, cc = c & 255;
            const int dst = (c >= 2048 && c < 3072) ? (c & ~255) + ((cc >> 6) & 1) * 128 + (cc >> 7) * 64 + (cc & 63) : c;
            p0_transpose_item(F.in[10], 1024, ABW, nb < 64 ? c : c + 8, (bf16*)(F.ws + WS_WAB), dst, scr, kb, F.lane); continue; } r -= I_AB;
        if (r < I_O) { const int kb = r / 32, nb = r % 32; p0_transpose_item(F.in[15], 1024, 1024, 32 * nb, (bf16*)(F.ws + WS_WOAB), 32 * nb, scr, kb, F.lane); continue; } r -= I_O;
        if (r < I_C) { const int kb = r / 128, nb = r % 128; const int c = 32 * nb;
            const int dst = c < 1024 ? 256 * (c / 128) + (c % 128) : c < 2048 ? 256 * ((c - 1024) / 128) + 128 + (c % 128) : c;
            p0_transpose_item(F.in[17], 1024, 4096, c, (bf16*)(F.ws + WS_WC), dst, scr, kb, F.lane); continue; } r -= I_C;
        int l = 0;
        if (r >= I_F1 + I_F2) { r -= I_F1 + I_F2; l = 1;
            if (r < I_O) { const int kb = r / 32, nb = r % 32; p0_transpose_item(F.in[19], 1024, 1024, 32 * nb, (bf16*)(F.ws + WS_WOC), 32 * nb, scr, kb, F.lane); continue; } r -= I_O; }
        if (r < I_F1) { const int kb = r / 176, nb = r % 176; const int c = 32 * nb;
            const int ch = c < DFF ? c : c - DFF; const int dst = 256 * (ch / 128) + (c < DFF ? 0 : 128) + (ch % 128);
            p0_transpose_item(F.in[21] + (size_t)l * 1024 * NFF, 1024, NFF, c, (bf16*)(F.ws + WS_WF1) + (size_t)l * NFF * 1024, dst, scr, kb, F.lane); continue; } r -= I_F1;
        { const int kb = r / 32, nb = r % 32;
            p0_transpose_item(F.in[24] + (size_t)l * DFF * 1024, DFF, 1024, 32 * nb, (bf16*)(F.ws + WS_WF2) + (size_t)l * 1024 * DFF, 32 * nb, scr, kb, F.lane); }
    }
}

__device__ __forceinline__ void p0_rows(Frame& F) {
    LAS float* wg = (LAS float*)F.lds;
    for (int i = F.tid; i < 8192; i += NWAVES * 64) { const int k = i >> 3, c = i & 7; wg[c * 1024 + k] = F.in[10][(size_t)k * ABW + 2048 + c]; }
    __syncthreads();
    const float* gain = F.in[9];
    f32x4 gn[4];
#pragma unroll
    for (int j = 0; j < 4; ++j) gn[j] = *(const f32x4*)(gain + 4 * F.lane + 256 * j);
#define P0_ROWSRC(r) ((r) < ROW_S ? F.in[0] + (size_t)(r) * DM : (r) < ROW_M ? F.in[1] + (size_t)((r) - ROW_S) * DM : (r) < NREAL ? F.in[8] + (size_t)((r) - ROW_M) * DM : (const float*)nullptr)
    f32x4 v[4], vn[4];
    { const float* src = F.gw < MPAD ? P0_ROWSRC(F.gw) : nullptr;
#pragma unroll
      for (int j = 0; j < 4; ++j) vn[j] = src ? *(const f32x4*)(src + 4 * F.lane + 256 * j) : (f32x4){0.f, 0.f, 0.f, 0.f}; }
#pragma unroll 1
    for (int r = F.gw; r < MPAD; r += F.NGW) {
#pragma unroll
        for (int j = 0; j < 4; ++j) v[j] = vn[j];
        { const int rn = r + F.NGW; const float* src = rn < MPAD ? P0_ROWSRC(rn) : nullptr;
#pragma unroll
          for (int j = 0; j < 4; ++j) vn[j] = src ? *(const f32x4*)(src + 4 * F.lane + 256 * j) : (f32x4){0.f, 0.f, 0.f, 0.f}; }
        float ss = 0.f;
#pragma unroll
        for (int j = 0; j < 4; ++j) ss += (v[j].x * v[j].x + v[j].y * v[j].y) + (v[j].z * v[j].z + v[j].w * v[j].w);
        const float rs = rsqrtf(wave_sum(ss) * (1.f / DM) + EPS);
        bf16* xn = F_XG(F) + (size_t)r * DM;
        float ga[8];
#pragma unroll
        for (int c = 0; c < 8; ++c) ga[c] = 0.f;
#pragma unroll
        for (int j = 0; j < 4; ++j) {
            const f32x4 y = v[j] * rs * gn[j];
            u32x2 w; w.x = pk2(y.x, y.y); w.y = pk2(y.z, y.w);
            *(u32x2*)(xn + 4 * F.lane + 256 * j) = w;
#pragma unroll
            for (int c = 0; c < 8; ++c) { const f32x4 wv = *(const LAS f32x4*)(wg + c * 1024 + 4 * F.lane + 256 * j); ga[c] += (y.x * wv.x + y.y * wv.y) + (y.z * wv.z + y.w * wv.w); }
        }
        float g4[4], g2[2], g1;
        { const bool hi = (F.lane & 32) != 0;
#pragma unroll
          for (int c = 0; c < 4; ++c) { const float keep = hi ? ga[4 + c] : ga[c], send = hi ? ga[c] : ga[4 + c]; g4[c] = keep + __shfl_xor(send, 32); } }
        { const bool hi = (F.lane & 16) != 0;
#pragma unroll
          for (int c = 0; c < 2; ++c) { const float keep = hi ? g4[2 + c] : g4[c], send = hi ? g4[c] : g4[2 + c]; g2[c] = keep + __shfl_xor(send, 16); } }
        { const bool hi = (F.lane & 8) != 0; const float keep = hi ? g2[1] : g2[0], send = hi ? g2[0] : g2[1]; g1 = keep + __shfl_xor(send, 8); }
        g1 += __shfl_xor(g1, 4); g1 += __shfl_xor(g1, 2); g1 += __shfl_xor(g1, 1);
        if ((F.lane & 7) == 0) F_GT(F)[(size_t)r * 8 + ((F.lane >> 5) & 1) * 4 + ((F.lane >> 4) & 1) * 2 + ((F.lane >> 3) & 1)] = g1;
    }
#undef P0_ROWSRC
}

__device__ __forceinline__ void p0_zero_ssq(Frame& F) { const int gt = blockIdx.x * (NWAVES * 64) + F.tid, NT = F.G * NWAVES * 64; for (int i = gt; i < 4 * MPAD; i += NT) F_SSQ(F, 0)[i] = 0.f;
    if (gt < 1024) ((float*)(F.ws + WS_LB))[gt] = sigmoidf_(F.in[16][1024 + gt] - F.in[16][gt]); }
__device__ __forceinline__ float dpp_row_shr1(float x) { return __builtin_bit_cast(float, __builtin_amdgcn_update_dpp(__builtin_bit_cast(int, x), __builtin_bit_cast(int, x), 0x111, 0xf, 0xf, false)); }
struct EpiFfn {
    static constexpr bool PERM = true, AFTER_DRAIN = false;
    bf16* H0; bf16* H1; const float* cw; const float* cb; const float* cst; float* cso; float* sbl; float* sbf;
    __device__ __forceinline__ void operator()(f32x4 (&acc)[2][2][4][2], const pg8::Unit& u, int wr, int wc, int fr, int fq) const {
        bf16* H = (u.pm < 64) ? H0 : H1;
        const int ch0 = 128 * u.pn + 32 * wc + 8 * fq;
        const int tok0 = 256 * u.pm + 128 * wr + 8 * fr;
        const int grp = 2 * u.pm + wr;
        const bool samp = (u.pm >= 64 && u.pm < PM_META), meta = (u.pm == PM_META);
        const int sb = 32 * (u.pm - 64) + 16 * wr + fr;
        const bool defer = (!samp && !meta && fr == 0);
        const bool lastlane = meta ? (wr == 0 && fr == 1) : (!samp && fr == 15);
        f32x4 w0[2], w1[2], w2[2], bb[2], p6[2], p7[2];
#pragma unroll
        for (int n = 0; n < 2; ++n) {
            const int c4 = ch0 + 4 * n;
            w0[n] = *(const f32x4*)(cw + c4); w1[n] = *(const f32x4*)(cw + DFF + c4); w2[n] = *(const f32x4*)(cw + 2 * DFF + c4); bb[n] = *(const f32x4*)(cb + c4);
#pragma unroll
            for (int e = 0; e < 4; ++e) { p6[n][e] = dpp_row_shr1(acc[1][0][2][n][e]); p7[n][e] = dpp_row_shr1(acc[1][0][3][n][e]); }
            if (samp) { p6[n] = *(const f32x4*)(cst + (size_t)(sb * 2 + 0) * DFF + c4); p7[n] = *(const f32x4*)(cst + (size_t)(sb * 2 + 1) * DFF + c4); }
            if (meta && wr == 0 && fr == 0) { p6[n] = (f32x4){0.f, 0.f, 0.f, 0.f}; p7[n] = p6[n]; }
            if (lastlane) { *(f32x4*)(sbl + (size_t)(grp * 2 + 0) * DFF + c4) = acc[1][0][2][n]; *(f32x4*)(sbl + (size_t)(grp * 2 + 1) * DFF + c4) = acc[1][0][3][n]; }
            if (samp) { *(f32x4*)(cso + (size_t)(sb * 2 + 0) * DFF + c4) = acc[1][0][2][n]; *(f32x4*)(cso + (size_t)(sb * 2 + 1) * DFF + c4) = acc[1][0][3][n]; }
        }
#pragma unroll
        for (int k = 0; k < 8; ++k) {
            unsigned hw[4];
#pragma unroll
            for (int n = 0; n < 2; ++n) {
                const f32x4 uk = acc[k >> 2][0][k & 3][n], gk = acc[k >> 2][1][k & 3][n];
                const f32x4 um1 = (k >= 1) ? acc[(k - 1 < 0 ? 0 : k - 1) >> 2][0][(k - 1 < 0 ? 0 : k - 1) & 3][n] : p7[n];
                const f32x4 um2 = (k >= 2) ? acc[(k - 2 < 0 ? 0 : k - 2) >> 2][0][(k - 2 < 0 ? 0 : k - 2) & 3][n] : (k == 1 ? p7[n] : p6[n]);
                const f32x4 cv = bb[n] + w0[n] * um2 + w1[n] * um1 + w2[n] * uk;
                f32x4 hv;
#pragma unroll
                for (int e = 0; e < 4; ++e) hv[e] = siluf_(cv[e]) * gk[e];
                hw[2 * n] = pg8::cvt_pk_bf16(hv[0], hv[1]); hw[2 * n + 1] = pg8::cvt_pk_bf16(hv[2], hv[3]);
                if (defer && k < 2) {
                    *(f32x4*)(sbf + (size_t)((grp * 2 + k) * 2 + 0) * DFF + ch0 + 4 * n) = uk;
                    *(f32x4*)(sbf + (size_t)((grp * 2 + k) * 2 + 1) * DFF + ch0 + 4 * n) = gk;
                }
            }
            if (!(defer && k < 2)) *(u32x4*)(H + (size_t)(tok0 + k) * DFF + ch0) = (u32x4){hw[0], hw[1], hw[2], hw[3]};
        }
    }
};

__device__ __forceinline__ void ffn_fixup_tile(Frame& F, int layer, int pm, bool conv_out) {
    const float* cw = F.in[22] + (size_t)layer * 3 * DFF; const float* cb = F.in[23] + (size_t)layer * DFF;
    bf16* H = F_Z(F);
    for (int i = F.tid; i < 2 * DFF; i += NWAVES * 64) {
        const int wr = i / DFF, ch = i - wr * DFF, grp = 2 * pm + wr;
        const int r0 = 128 * grp;
        const int pg = (r0 % 2048 == 0) ? GRP_META : grp - 1;
        const float um2 = F_SBL(F)[(size_t)(pg * 2 + 0) * DFF + ch], um1 = F_SBL(F)[(size_t)(pg * 2 + 1) * DFF + ch];
        const float u0 = F_SBF(F)[(size_t)((grp * 2 + 0) * 2 + 0) * DFF + ch], g0 = F_SBF(F)[(size_t)((grp * 2 + 0) * 2 + 1) * DFF + ch];
        const float u1 = F_SBF(F)[(size_t)((grp * 2 + 1) * 2 + 0) * DFF + ch], g1 = F_SBF(F)[(size_t)((grp * 2 + 1) * 2 + 1) * DFF + ch];
        const float w0 = cw[ch], w1 = cw[DFF + ch], w2 = cw[2 * DFF + ch], bb = cb[ch];
        const float c0 = bb + w0 * um2 + w1 * um1 + w2 * u0, c1 = bb + w0 * um1 + w1 * u0 + w2 * u1;
        H[(size_t)r0 * DFF + ch] = (bf16)f2bf(siluf_(c0) * g0);
        H[(size_t)(r0 + 1) * DFF + ch] = (bf16)f2bf(siluf_(c1) * g1);
        if (conv_out && (pm & 7) == 7 && wr == 1) {
            float* fo = F.out + O_FP + ((size_t)layer * 8 + (pm >> 3)) * 2 * DFF;
            fo[ch] = F_SBL(F)[(size_t)(grp * 2 + 0) * DFF + ch]; fo[DFF + ch] = F_SBL(F)[(size_t)(grp * 2 + 1) * DFF + ch];
        }
    }
}
typedef short bf16x8 __attribute__((ext_vector_type(8)));
typedef short v4i16_t __attribute__((ext_vector_type(4)));
constexpr int MX_PITCH = 272;
constexpr int MX_Q = 0, MX_K = 17408, MX_KH = 34816, MX_V = 52224, MX_GD = 69632  , MX_SC = 71680  , MX_OB = 74752  , MX_RP = 108544  , MX_DI = 110592  , MX_GN = 110848  , MX_LB = 111360  , MX_END = 111872;
constexpr int MX_OP = 132;
constexpr float LNKS = -2.4260151319598084f;
static_assert(MX_END <= 139264, "mixer LDS map");

__device__ __forceinline__ bf16x8 mk8(unsigned a, unsigned b, unsigned c, unsigned d) { const u32x4 v = {a, b, c, d}; return __builtin_bit_cast(bf16x8, v); }
__device__ __forceinline__ u32x2 tr16(const LAS unsigned char* p) { return __builtin_bit_cast(u32x2, __builtin_amdgcn_ds_read_tr16_b64_v4i16((LAS v4i16_t*)p)); }
typedef float f32x2_t __attribute__((ext_vector_type(2))); typedef __bf16 bf16x2_t __attribute__((ext_vector_type(2)));
__device__ __forceinline__ unsigned pkbf(float lo, float hi) { const f32x2_t v = {lo, hi}; const bf16x2_t b = __builtin_convertvector(v, bf16x2_t); return __builtin_bit_cast(unsigned, b); }
#define MFMA16(a, b, c) __builtin_amdgcn_mfma_f32_16x16x32_bf16((a), (b), (c), 0, 0, 0)
typedef short s16x4 __attribute__((ext_vector_type(4)));
__device__ __forceinline__ f32x4 mfma16k16(u32x2 a, u32x2 b, f32x4 c) { const u32x4 a4 = {a.x, a.y, 0u, 0u}, b4 = {b.x, b.y, 0u, 0u}; return __builtin_amdgcn_mfma_f32_16x16x32_bf16(__builtin_bit_cast(bf16x8, a4), __builtin_bit_cast(bf16x8, b4), c, 0, 0, 0); }
__device__ __forceinline__ bf16x8 ld8(const LAS unsigned char* p) { return __builtin_bit_cast(bf16x8, *(const LAS u32x4*)p); }
#define MX_POS4(d) (((d) & ~31) + 8 * ((((d) & 15)) >> 2) + 4 * (((d) >> 4) & 1))
template <int CTRL> __device__ __forceinline__ float dppf(float ident, float x) { return __builtin_bit_cast(float, __builtin_amdgcn_update_dpp(__builtin_bit_cast(int, ident), __builtin_bit_cast(int, x), CTRL, 0xf, 0xf, false)); }
__device__ __forceinline__ float row_prefix_sum(float x) { x += dppf<0x111>(0.f, x); x += dppf<0x112>(0.f, x); x += dppf<0x114>(0.f, x); x += dppf<0x118>(0.f, x); return x; }
__device__ __forceinline__ float row_prefix_max(float x) { x = fmaxf(x, dppf<0x111>(-3e38f, x)); x = fmaxf(x, dppf<0x112>(-3e38f, x)); x = fmaxf(x, dppf<0x114>(-3e38f, x)); x = fmaxf(x, dppf<0x118>(-3e38f, x)); return x; }
__device__ __forceinline__ float row_prefix_prod(float x) { x *= dppf<0x111>(1.f, x); x *= dppf<0x112>(1.f, x); x *= dppf<0x114>(1.f, x); x *= dppf<0x118>(1.f, x); return x; }
__device__ __forceinline__ float row_suffix_prod(float x) { x *= dppf<0x101>(1.f, x); x *= dppf<0x102>(1.f, x); x *= dppf<0x104>(1.f, x); x *= dppf<0x108>(1.f, x); return x; }
__device__ __forceinline__ float rdlane(float x, int l) { return __builtin_bit_cast(float, __builtin_amdgcn_readlane(__builtin_bit_cast(int, x), l)); }

struct EpiRot {
    static constexpr bool PERM = true, AFTER_DRAIN = false;
    bf16* O0; bf16* O1; int pm_split; int ldc; const float* rot;
    __device__ __forceinline__ void operator()(f32x4 (&acc)[2][2][4][2], const pg8::Unit& u, int wr, int wc, int fr, int fq) const {
        bf16* O = (u.pm < pm_split) ? O0 : O1;
        const int row0 = u.pm * 256 + wr * 64 + fr;
        if (u.pn < 8 || u.pn >= 12) {
            const int col0 = u.pn * 256 + wc * 32 + 8 * fq;
#pragma unroll
            for (int ai = 0; ai < 2; ++ai)
#pragma unroll
                for (int m = 0; m < 4; ++m) { bf16* rowp = O + (size_t)(row0 + ai * 128 + m * 16) * ldc + col0;
#pragma unroll
                    for (int bj = 0; bj < 2; ++bj) { const f32x4 v0 = acc[ai][bj][m][0], v1 = acc[ai][bj][m][1];
                        u32x4 w; w.x = pg8::cvt_pk_bf16(v0[0], v0[1]); w.y = pg8::cvt_pk_bf16(v0[2], v0[3]); w.z = pg8::cvt_pk_bf16(v1[0], v1[1]); w.w = pg8::cvt_pk_bf16(v1[2], v1[3]);
                        *(u32x4*)(rowp + bj * 128) = w; } }
            return;
        }
        const int c0 = wc * 32 + 8 * fq, j0 = c0 & 63;
        const int colr = u.pn * 256 + (c0 >> 6) * 128 + j0;
#pragma unroll
        for (int ai = 0; ai < 2; ++ai)
#pragma unroll
            for (int m = 0; m < 4; ++m) { const int row = row0 + ai * 128 + m * 16;
                const int idx = row < ROW_S ? 16 + (row & 2047) : row < ROW_M ? 2064 + (row & 7) : ((row - ROW_M) & 15);
                const float* tb = rot + ((size_t)idx * 64 + j0) * 2;
                f32x4 cs[4];
#pragma unroll
                for (int e = 0; e < 4; ++e) cs[e] = *(const f32x4*)(tb + 4 * e);
                f32x4 y1[2], y2[2];
#pragma unroll
                for (int n = 0; n < 2; ++n)
#pragma unroll
                    for (int e = 0; e < 4; ++e) { const int k = 4 * n + e; const float c = cs[k >> 1][2 * (k & 1)], s = cs[k >> 1][2 * (k & 1) + 1];
                        const float x1 = acc[ai][0][m][n][e], x2 = acc[ai][1][m][n][e]; y1[n][e] = x1 * c - x2 * s; y2[n][e] = x2 * c + x1 * s; }
                bf16* rowp = O + (size_t)row * ldc + colr;
                u32x4 w; w.x = pg8::cvt_pk_bf16(y1[0][0], y1[0][1]); w.y = pg8::cvt_pk_bf16(y1[0][2], y1[0][3]); w.z = pg8::cvt_pk_bf16(y1[1][0], y1[1][1]); w.w = pg8::cvt_pk_bf16(y1[1][2], y1[1][3]);
                *(u32x4*)rowp = w;
                w.x = pg8::cvt_pk_bf16(y2[0][0], y2[0][1]); w.y = pg8::cvt_pk_bf16(y2[0][2], y2[0][3]); w.z = pg8::cvt_pk_bf16(y2[1][0], y2[1][1]); w.w = pg8::cvt_pk_bf16(y2[1][2], y2[1][3]);
                *(u32x4*)(rowp + 64) = w; }
    }
};

struct EpiHg {
    static constexpr bool PERM = true, AFTER_DRAIN = false;
    bf16* O0; bf16* O1; int pm_split; int ldc; const float* LB; float* GD; float* GDS;
    __device__ __forceinline__ void operator()(f32x4 (&acc)[2][2][4][2], const pg8::Unit& u, int wr, int wc, int fr, int fq) const {
        bf16* O = (u.pm < pm_split) ? O0 : O1;
        const int row0 = u.pm * 256 + wr * 64 + fr;
        if (u.pn >= 8) {
            const int col0 = u.pn * 256 + wc * 32 + 8 * fq;
#pragma unroll
            for (int ai = 0; ai < 2; ++ai)
#pragma unroll
                for (int m = 0; m < 4; ++m) { bf16* rowp = O + (size_t)(row0 + ai * 128 + m * 16) * ldc + col0;
#pragma unroll
                    for (int bj = 0; bj < 2; ++bj) { const f32x4 v0 = acc[ai][bj][m][0], v1 = acc[ai][bj][m][1];
                        u32x4 w; w.x = pg8::cvt_pk_bf16(v0[0], v0[1]); w.y = pg8::cvt_pk_bf16(v0[2], v0[3]); w.z = pg8::cvt_pk_bf16(v1[0], v1[1]); w.w = pg8::cvt_pk_bf16(v1[2], v1[3]);
                        *(u32x4*)(rowp + bj * 128) = w; } }
            return;
        }
        const int c0 = 128 * u.pn + 32 * wc + 8 * fq;
        const bool samp = (u.pm >= 64 && u.pm < PM_META);
        const f32x4 lb0 = *(const f32x4*)(LB + c0), lb1 = *(const f32x4*)(LB + c0 + 4);
#pragma unroll
        for (int ai = 0; ai < 2; ++ai)
#pragma unroll
            for (int m = 0; m < 4; ++m) {
                const int row = row0 + ai * 128 + m * 16;
                f32x4 qt[2], kt[2], Ae[2];
#pragma unroll
                for (int n = 0; n < 2; ++n)
#pragma unroll
                    for (int e = 0; e < 4; ++e) {
                        const float lb = n ? lb1[e] : lb0[e];
                        const float sg = sigmoidf_(acc[ai][1][m][n][e]);
                        const float a = lb + (1.f - lb) * sg, kk = (1.f - lb) * (1.f - sg);
                        float A = a;
                        if (samp) { float t;
                            t = dppf<0x111>(1.f, A); A *= ((fr & 7) >= 1) ? t : 1.f; t = dppf<0x112>(1.f, A); A *= ((fr & 7) >= 2) ? t : 1.f; t = dppf<0x114>(1.f, A); A *= ((fr & 7) >= 4) ? t : 1.f; }
                        else A = row_prefix_prod(a);
                        qt[n][e] = acc[ai][0][m][n][e] * A; kt[n][e] = kk * __builtin_amdgcn_rcpf(fmaxf(A, 1e-30f)); Ae[n][e] = A;
                    }
                bf16* rowp = O + (size_t)row * ldc + c0;
                u32x4 w; w.x = pg8::cvt_pk_bf16(qt[0][0], qt[0][1]); w.y = pg8::cvt_pk_bf16(qt[0][2], qt[0][3]); w.z = pg8::cvt_pk_bf16(qt[1][0], qt[1][1]); w.w = pg8::cvt_pk_bf16(qt[1][2], qt[1][3]);
                *(u32x4*)rowp = w;
                w.x = pg8::cvt_pk_bf16(kt[0][0], kt[0][1]); w.y = pg8::cvt_pk_bf16(kt[0][2], kt[0][3]); w.z = pg8::cvt_pk_bf16(kt[1][0], kt[1][1]); w.w = pg8::cvt_pk_bf16(kt[1][2], kt[1][3]);
                *(u32x4*)(rowp + 1024) = w;
                if (!samp && fr == 15) { float* gp = GD + (size_t)(row >> 4) * 1024 + c0; *(f32x4*)gp = Ae[0]; *(f32x4*)(gp + 4) = Ae[1]; }
                if (samp && (fr & 7) == 7) { float* gp = GDS + (size_t)((row - ROW_S) >> 3) * 1024 + c0; *(f32x4*)gp = Ae[0]; *(f32x4*)(gp + 4) = Ae[1]; }
            }
    }
};

constexpr int ROT_N = 2072;
__device__ __forceinline__ void p0_rotary(Frame& F, float* tab) {
    const int gt = blockIdx.x * (NWAVES * 64) + F.tid, NT = F.G * NWAVES * 64;
    for (int i = gt; i < ROT_N * 64; i += NT) {
        const int pi = i >> 6, fi = i & 63;
        const float pos = pi < 2064 ? (float)pi : (float)(16384 + pi - 2064);
        const float inv = exp2f((float)fi * (-13.287712379549449f / 63.0f));
        float sn, cs; sincosf(pos * inv, &sn, &cs);
        tab[2 * i] = cs; tab[2 * i + 1] = sn;
    }
}

#ifdef PROBE_BLOCK
#define MSTAMP_DECL unsigned long long t_last_ = __builtin_amdgcn_s_memrealtime();
#define MSTAMP(id) do { if (blockIdx.x == PROBE_BLOCK && tid == 0) { const unsigned long long t_now_ = __builtin_amdgcn_s_memrealtime(); volatile LAS unsigned long long* a_ = (volatile LAS unsigned long long*)(F.lds + 139264 + 128) + 48 + (id); *a_ = *a_ + (t_now_ - t_last_); t_last_ = t_now_; } } while (0)
#else
#define MSTAMP_DECL
#define MSTAMP(id) do { } while (0)
#endif
#define MX_SC_PARAMS(scv, row0, ntok, nmc, pos0) do { if (mode != 1) { if ((scv) == 0) { row0 = ROW_M; ntok = 16; nmc = 1; pos0 = 0; } else { row0 = b * 2048 + ((scv) - 1) * 64; ntok = 64; nmc = 4; pos0 = 16 + ((scv) - 1) * 64; } } \
        else { row0 = ROW_S + 8 * b; ntok = 8; nmc = 1; pos0 = 2064; } } while (0)

template <int TYPE, int NMC>
__device__ __forceinline__ void sg_chain(LAS unsigned char* L, LAS float* SC, f32x4 (&S)[8], f32x4& nacc, int w, int r16, int q) {
    LAS float* OB = (LAS float*)(L + MX_OB); LAS float* RP = (LAS float*)(L + MX_RP); LAS float* DI = (LAS float*)(L + MX_DI);
    f32x4 oo[4];
#pragma unroll
    for (int mc = 0; mc < NMC; ++mc) {
        oo[mc] = (f32x4){0.f, 0.f, 0.f, 0.f};
        {
            const LAS unsigned char* Qb = L + MX_Q + 16 * mc * MX_PITCH; const LAS unsigned char* Kb = L + MX_K + 16 * mc * MX_PITCH; const LAS unsigned char* Vb = L + MX_V + 16 * mc * MX_PITCH;
            f32x4 g0 = {0.f, 0.f, 0.f, 0.f}, g1 = {0.f, 0.f, 0.f, 0.f};
#pragma unroll
            for (int ks = 0; ks < 4; ++ks) {
                const bf16x8 kf = ld8(Kb + r16 * MX_PITCH + (32 * ks + 8 * q) * 2), qf = ld8(Qb + r16 * MX_PITCH + (32 * ks + 8 * q) * 2);
                if (ks & 1) g1 = MFMA16(kf, qf, g1); else g0 = MFMA16(kf, qf, g0);
            }
            const f32x4 g = g0 + g1;
            const float xi = SC[mc * 16 + r16]; const f32x4 y4 = *(const LAS f32x4*)(SC + 64 + mc * 16 + 4 * q);
            f32x4 P;
#pragma unroll
            for (int r = 0; r < 4; ++r) P[r] = (4 * q + r <= r16) ? g[r] * __expf(xi + y4[r]) : 0.f;
            if (TYPE == 0) { float ps = (P[0] + P[1]) + (P[2] + P[3]); ps += __shfl_xor(ps, 16); ps += __shfl_xor(ps, 32); if (w == 0 && q == 0) DI[16 * mc + r16] = ps; }
            const u32x2 vt = tr16(Vb + (4 * q + (r16 >> 2)) * MX_PITCH + (16 * w + 4 * (r16 & 3)) * 2);
            oo[mc] = mfma16k16((u32x2){pkbf(P[0], P[1]), pkbf(P[2], P[3])}, vt, oo[mc]);
        }
        if (mc == 1 || TYPE == 1) __builtin_amdgcn_sched_barrier(0);
    }
#pragma unroll
    for (int mc = 0; mc < NMC; ++mc) {
        {
            const LAS unsigned char* Qb = L + MX_Q + 16 * mc * MX_PITCH; const LAS unsigned char* Kb = L + MX_K + 16 * mc * MX_PITCH;
            const u32x2 vt = tr16(L + MX_V + 16 * mc * MX_PITCH + (4 * q + (r16 >> 2)) * MX_PITCH + (16 * w + 4 * (r16 & 3)) * 2);
            f32x4 o2a = {0.f, 0.f, 0.f, 0.f}, o2b = {0.f, 0.f, 0.f, 0.f};
#pragma unroll
            for (int ks = 0; ks < 4; ++ks) {
                const bf16x8 qf = ld8(Qb + r16 * MX_PITCH + (32 * ks + 8 * q) * 2);
                const bf16x8 SB = mk8(pkbf(S[2 * ks][0], S[2 * ks][1]), pkbf(S[2 * ks][2], S[2 * ks][3]), pkbf(S[2 * ks + 1][0], S[2 * ks + 1][1]), pkbf(S[2 * ks + 1][2], S[2 * ks + 1][3]));
                if (ks & 1) o2b = MFMA16(qf, SB, o2b); else o2a = MFMA16(qf, SB, o2a);
            }
            const f32x4 in4 = *(const LAS f32x4*)(SC + 128 + mc * 16 + 4 * q);
            oo[mc] = oo[mc] + in4 * (o2a + o2b);
            const f32x4 w4 = *(const LAS f32x4*)(SC + 192 + mc * 16 + 4 * q); const float carry = SC[320 + mc];
            if (TYPE == 0) {
                const u32x2 qn = *(const LAS u32x2*)(Qb + r16 * MX_PITCH + MX_POS4(16 * w + 4 * q) * 2);
                f32x4 rr = {0.f, 0.f, 0.f, 0.f}; rr = mfma16k16(qn, (u32x2){pkbf(nacc[0], nacc[1]), pkbf(nacc[2], nacc[3])}, rr);
                if (r16 == 0) {
#pragma unroll
                    for (int r = 0; r < 4; ++r) RP[w * 64 + 16 * mc + 4 * q + r] = rr[r]; }
            }
#pragma unroll
            for (int r = 0; r < 4; ++r) OB[(16 * mc + 4 * q + r) * MX_OP + 16 * w + r16] = oo[mc][r];
            const u32x2 VH = {pkbf(bflo(vt.x) * w4[0], bfhi(vt.x) * w4[1]), pkbf(bflo(vt.y) * w4[2], bfhi(vt.y) * w4[3])};
#pragma unroll
            for (int mt = 0; mt < 8; ++mt) {
                const u32x2 kt = tr16(Kb + (4 * q + (r16 >> 2)) * MX_PITCH + MX_POS4(16 * mt + 4 * (r16 & 3)) * 2);
                S[mt] = S[mt] * carry; S[mt] = mfma16k16(kt, VH, S[mt]);
            }
            if (TYPE == 0) {
                const u32x2 kt = tr16(Kb + (4 * q + (r16 >> 2)) * MX_PITCH + MX_POS4(16 * w + 4 * (r16 & 3)) * 2);
                nacc = nacc * carry; nacc = mfma16k16(kt, (u32x2){pkbf(w4[0], w4[1]), pkbf(w4[2], w4[3])}, nacc);
            }
        }
        if (mc + 1 < NMC) __builtin_amdgcn_sched_barrier(0);
    }
}

template <int TYPE>
__device__ __forceinline__ void mix_sg_unit(Frame& F, int b, int h, int mode  , const float* rot) {
    const bool prompt = (mode != 1);
    const int tid = F.tid, lane = F.lane, w = F.wave, r16 = lane & 15, q = lane >> 4;
    const int tk = tid >> 3, p = tid & 7;
    LAS unsigned char* L = F.lds;
    LAS float* OB = (LAS float*)(L + MX_OB); LAS float* RP = (LAS float*)(L + MX_RP); LAS float* DI = (LAS float*)(L + MX_DI);
    bf16* MIX = F_XN(F);
    const int qcol = (TYPE == 0 ? 0 : 2048) + 128 * h, kcol = (TYPE == 0 ? 512 : 2560) + 128 * h, vcol = (TYPE == 0 ? 1024 : 3072) + 128 * h, gcol = (TYPE == 0 ? 1536 : 3584) + 128 * h, mcol = (TYPE == 0 ? 0 : 512) + 128 * h;
    f32x4 S[8]; f32x4 nacc = {0.f, 0.f, 0.f, 0.f}; float m0 = 0.f;
#pragma unroll
    for (int mt = 0; mt < 8; ++mt) S[mt] = (f32x4){0.f, 0.f, 0.f, 0.f};
    if (!prompt) {
        const float* Sin = (TYPE == 0 ? F.in[2] : F.in[5]) + (size_t)(b * 4 + h) * 16384;
#pragma unroll
        for (int mt = 0; mt < 8; ++mt)
#pragma unroll
            for (int r = 0; r < 4; ++r) S[mt][r] = Sin[(16 * mt + 4 * q + r) * 128 + 16 * w + r16];
        if (TYPE == 0) {
#pragma unroll
            for (int r = 0; r < 4; ++r) nacc[r] = F.in[3][(size_t)(b * 4 + h) * 128 + 16 * w + 4 * q + r];
            m0 = F.in[4][b * 4 + h];
        }
    }
    const float lgam = (TYPE != 1) ? 0.f : h == 0 ? -0.031748698314580298f : h == 1 ? -0.015748356968139168f : h == 2 ? -0.0078431774610258928f : -0.0039138993211363287f;
    const float bias_i = (TYPE == 0) ? F.in[11][h] : 0.f, bias_f = (TYPE == 0) ? F.in[12][h] : 0.f;
    LAS float* GN = (LAS float*)(L + MX_GN);
    if (tid < 128) GN[tid] = (TYPE == 0 ? F.in[13] : F.in[14])[128 * h + tid];
    const int nsc = (mode == 0) ? 33 : 1;
    u32x4 pa[6]; float pli = 0.f, plf = 0.f; u32x4 pg[2];
    const u32x4 z4 = {0u, 0u, 0u, 0u};
#define SG_LOAD(scv) do { int row0_, ntok_, nmc_, pos0_; MX_SC_PARAMS(scv, row0_, ntok_, nmc_, pos0_); (void)nmc_; (void)pos0_; \
        const bool valid_ = tk < ntok_; const bf16* zr_ = ZROW(F, row0_ + (valid_ ? tk : 0), 0); \
        _Pragma("unroll") for (int i_ = 0; i_ < 6; ++i_) pa[i_] = z4; \
        if (valid_) { pa[4] = *(const u32x4*)(zr_ + vcol + 16 * p); pa[5] = *(const u32x4*)(zr_ + vcol + 16 * p + 8); \
            pa[0] = *(const u32x4*)(zr_ + qcol + 16 * p); pa[1] = *(const u32x4*)(zr_ + qcol + 16 * p + 8); pa[2] = *(const u32x4*)(zr_ + kcol + 16 * p); pa[3] = *(const u32x4*)(zr_ + kcol + 16 * p + 8); } \
        if (TYPE == 0 && w == 0) { const bool vt_ = lane < ntok_; const float* gp_ = F_GT(F) + (size_t)(row0_ + (vt_ ? lane : 0)) * 8; pli = gp_[h]; plf = gp_[4 + h]; } } while (0)
    SG_LOAD(0);
    MSTAMP_DECL
#pragma unroll 1
    for (int sc = 0; sc < nsc; ++sc) {
        int row0, ntok, nmc, pos0; MX_SC_PARAMS(sc, row0, ntok, nmc, pos0); (void)pos0;
        LAS float* SC = (LAS float*)(L + MX_SC) + (sc & 1) * 384;
        MSTAMP(0);
        {
            *(LAS u32x4*)(L + MX_V + tk * MX_PITCH + 32 * p) = pa[4]; *(LAS u32x4*)(L + MX_V + tk * MX_PITCH + 32 * p + 16) = pa[5];
            {
                const int c0 = (MX_POS4(16 * p)) * 2;
#pragma unroll
                for (int g = 0; g < 4; ++g) {
                    *(LAS u32x2*)(L + MX_Q + tk * MX_PITCH + c0 + 16 * g) = (u32x2){pa[g >> 1][2 * (g & 1)], pa[g >> 1][2 * (g & 1) + 1]};
                    *(LAS u32x2*)(L + MX_K + tk * MX_PITCH + c0 + 16 * g) = (u32x2){pa[2 + (g >> 1)][2 * (g & 1)], pa[2 + (g >> 1)][2 * (g & 1) + 1]};
                }
            }
        }
        if (w == 0) {
            const bool valid = lane < ntok;
            float li = -1e30f, lf = 0.f;
            if (TYPE == 0) { if (valid) { li = pli + bias_i; lf = logsigmoidf_(plf + bias_f); } } else { if (valid) { li = 0.f; lf = lgam; } }
            const float bb = row_prefix_sum(lf);
            const float y = li - bb;
            const float am = row_prefix_max(y);
            const float a = bb + am;
            const float B0 = rdlane(bb, 15), B1 = rdlane(bb, 31), B2 = rdlane(bb, 47), B3 = rdlane(bb, 63);
            float M1 = 0.f, M2 = 0.f, M3 = 0.f, M4 = 0.f;
            if (TYPE == 0) { const float A0 = rdlane(a, 15), A1 = rdlane(a, 31), A2 = rdlane(a, 47), A3 = rdlane(a, 63);
                M1 = fmaxf(B0 + m0, A0); M2 = fmaxf(B1 + M1, A1); M3 = fmaxf(B2 + M2, A2); M4 = fmaxf(B3 + M3, A3); }
            const float m0q = q == 0 ? m0 : q == 1 ? M1 : q == 2 ? M2 : M3;
            const float mnq = q == 0 ? M1 : q == 1 ? M2 : q == 2 ? M3 : M4;
            const float b15 = q == 0 ? B0 : q == 1 ? B1 : q == 2 ? B2 : B3;
            const float m = (TYPE == 0) ? fmaxf(bb + m0q, a) : 0.f;
            SC[lane] = bb - m; SC[64 + lane] = y + LNKS; SC[128 + lane] = __expf(bb + m0q - m);
            SC[192 + lane] = __expf(y + LNKS + b15 - mnq); SC[256 + lane] = __expf(-m);
            if (r16 == 0) SC[320 + q] = __expf(b15 + m0q - mnq);
            m0 = (nmc == 4) ? M4 : M1;
        }
        MSTAMP(1);
        __syncthreads();
        MSTAMP(2);
        if (sc + 1 < nsc) SG_LOAD(sc + 1);
        { const bool valid = tk < ntok; const bf16* zr = ZROW(F, row0 + (valid ? tk : 0), 0) + gcol + 16 * p; pg[0] = *(const u32x4*)zr; pg[1] = *(const u32x4*)(zr + 8); }
        MSTAMP(3);
        if (nmc == 4) sg_chain<TYPE, 4>(L, SC, S, nacc, w, r16, q); else sg_chain<TYPE, 1>(L, SC, S, nacc, w, r16, q);
        MSTAMP(4);
        __syncthreads();
        MSTAMP(6);
        {
            const bool valid = tk < ntok; const int row = row0 + (valid ? tk : 0);
            f32x4 o[4];
#pragma unroll
            for (int c = 0; c < 4; ++c) o[c] = *(const LAS f32x4*)(OB + tk * MX_OP + 16 * p + 4 * c);
            if (tk >= 16 * nmc) {
#pragma unroll
                for (int c = 0; c < 4; ++c) o[c] = (f32x4){0.f, 0.f, 0.f, 0.f}; }
            if (TYPE == 0) {
                float rs = 0.f;
#pragma unroll
                for (int ww = 0; ww < 8; ++ww) rs += RP[ww * 64 + tk];
                const float den = DI[tk] + SC[128 + tk] * rs;
                float dn = fmaxf(fabsf(den), SC[256 + tk]); if (tk >= 16 * nmc) dn = 1.f;
                const float rd = 1.f / dn;
#pragma unroll
                for (int c = 0; c < 4; ++c) o[c] = o[c] * rd;
            }
            float sm = 0.f;
#pragma unroll
            for (int c = 0; c < 4; ++c) sm += (o[c].x + o[c].y) + (o[c].z + o[c].w);
            sm += __shfl_xor(sm, 1); sm += __shfl_xor(sm, 2); sm += __shfl_xor(sm, 4);
            const float mu = sm * (1.f / 128.f); float vs = 0.f;
#pragma unroll
            for (int c = 0; c < 4; ++c) { o[c] = o[c] - mu; vs += (o[c].x * o[c].x + o[c].y * o[c].y) + (o[c].z * o[c].z + o[c].w * o[c].w); }
            vs += __shfl_xor(vs, 1); vs += __shfl_xor(vs, 2); vs += __shfl_xor(vs, 4);
            const float rstd = rsqrtf(vs * (1.f / 128.f) + EPS);
            if (valid && !(mode == 0 && sc == 0)) {
                unsigned ow[8];
#pragma unroll
                for (int c = 0; c < 4; ++c) {
                    const unsigned ga = c < 2 ? pg[0][2 * c] : pg[1][2 * c - 4], gb = c < 2 ? pg[0][2 * c + 1] : pg[1][2 * c - 3];
                    f32x4 gt = {bflo(ga), bfhi(ga), bflo(gb), bfhi(gb)};
#pragma unroll
                    for (int e = 0; e < 4; ++e) gt[e] = (TYPE == 0) ? sigmoidf_(gt[e]) : siluf_(gt[e]);
                    const f32x4 r = o[c] * rstd * *(const LAS f32x4*)(GN + 16 * p + 4 * c) * gt;
                    ow[2 * c] = pkbf(r.x, r.y); ow[2 * c + 1] = pkbf(r.z, r.w);
                }
                bf16* mp = MIX + (size_t)row * DM + mcol + 16 * p;
                *(u32x4*)mp = (u32x4){ow[0], ow[1], ow[2], ow[3]}; *(u32x4*)(mp + 8) = (u32x4){ow[4], ow[5], ow[6], ow[7]};
            }
        }
        MSTAMP(7);
    }
#undef SG_LOAD
    __syncthreads();
    if (mode != 2) {
        int l2 = F.lane; asm volatile("" : "+v"(l2)); const int r16 = l2 & 15, q = l2 >> 4;
        float* So = F.out + (TYPE == 0 ? (prompt ? O_CP : O_CS) : (prompt ? O_RP : O_RS)) + (size_t)(b * 4 + h) * 16384;
#pragma unroll
        for (int mt = 0; mt < 8; ++mt)
#pragma unroll
            for (int r = 0; r < 4; ++r) So[(16 * mt + 4 * q + r) * 128 + 16 * w + r16] = S[mt][r];
        if (TYPE == 0) {
            if (r16 == 0) { float* No = F.out + (prompt ? O_NP : O_NS) + (size_t)(b * 4 + h) * 128;
#pragma unroll
                for (int r = 0; r < 4; ++r) No[16 * w + 4 * q + r] = nacc[r]; }
            if (w == 0 && lane == 0) F.out[(prompt ? O_MP : O_MS) + b * 4 + h] = m0;
        }
    }
}

template <int NMC>
__device__ __forceinline__ void hg_chain(LAS unsigned char* L, f32x4 (&S)[8], int w, int r16, int q) {
    LAS float* GD = (LAS float*)(L + MX_GD); LAS float* OB = (LAS float*)(L + MX_OB);
    f32x4 oo[4];
#pragma unroll
    for (int mc = 0; mc < NMC; ++mc) {
        oo[mc] = (f32x4){0.f, 0.f, 0.f, 0.f};
        {
            const LAS unsigned char* Qb = L + MX_Q + 16 * mc * MX_PITCH; const LAS unsigned char* Kb = L + MX_K + 16 * mc * MX_PITCH; const LAS unsigned char* Vb = L + MX_V + 16 * mc * MX_PITCH;
            f32x4 g0 = {0.f, 0.f, 0.f, 0.f}, g1 = {0.f, 0.f, 0.f, 0.f};
#pragma unroll
            for (int ks = 0; ks < 4; ++ks) {
                const bf16x8 kf = ld8(Kb + r16 * MX_PITCH + (32 * ks + 8 * q) * 2), qf = ld8(Qb + r16 * MX_PITCH + (32 * ks + 8 * q) * 2);
                if (ks & 1) g1 = MFMA16(kf, qf, g1); else g0 = MFMA16(kf, qf, g0);
            }
            const f32x4 g = g0 + g1;
            f32x4 P;
#pragma unroll
            for (int r = 0; r < 4; ++r) P[r] = (4 * q + r <= r16) ? g[r] : 0.f;
            const u32x2 vt = tr16(Vb + (4 * q + (r16 >> 2)) * MX_PITCH + (16 * w + 4 * (r16 & 3)) * 2);
            oo[mc] = mfma16k16((u32x2){pkbf(P[0], P[1]), pkbf(P[2], P[3])}, vt, oo[mc]);
        }
        if (mc == 1) __builtin_amdgcn_sched_barrier(0);
    }
#pragma unroll
    for (int mc = 0; mc < NMC; ++mc) {
        {
            const LAS unsigned char* Qb = L + MX_Q + 16 * mc * MX_PITCH; const LAS unsigned char* Kb = L + MX_K + 16 * mc * MX_PITCH;
            const u32x2 vt = tr16(L + MX_V + 16 * mc * MX_PITCH + (4 * q + (r16 >> 2)) * MX_PITCH + (16 * w + 4 * (r16 & 3)) * 2);
            f32x4 o2b = {0.f, 0.f, 0.f, 0.f};
#pragma unroll
            for (int ks = 0; ks < 4; ++ks) {
                const bf16x8 qf = ld8(Qb + r16 * MX_PITCH + (32 * ks + 8 * q) * 2);
                const bf16x8 SB = mk8(pkbf(S[2 * ks][0], S[2 * ks][1]), pkbf(S[2 * ks][2], S[2 * ks][3]), pkbf(S[2 * ks + 1][0], S[2 * ks + 1][1]), pkbf(S[2 * ks + 1][2], S[2 * ks + 1][3]));
                if (ks & 1) o2b = MFMA16(qf, SB, o2b); else oo[mc] = MFMA16(qf, SB, oo[mc]);
            }
            oo[mc] = oo[mc] + o2b;
#pragma unroll
            for (int mt = 0; mt < 8; ++mt) {
                const f32x4 gd = *(const LAS f32x4*)(GD + mc * 128 + 16 * mt + 4 * q);
                const u32x2 kt = tr16(Kb + (4 * q + (r16 >> 2)) * MX_PITCH + MX_POS4(16 * mt + 4 * (r16 & 3)) * 2);
                S[mt] = mfma16k16(kt, vt, S[mt]); S[mt] = S[mt] * gd;
            }
        }
        if (mc + 1 < NMC) __builtin_amdgcn_sched_barrier(0);
    }
#pragma unroll
    for (int mc = 0; mc < NMC; ++mc) {
        {
#pragma unroll
            for (int r = 0; r < 4; ++r) OB[(16 * mc + 4 * q + r) * MX_OP + 16 * w + r16] = oo[mc][r];
        }
    }
}

__device__ __forceinline__ void mix_hg_unit(Frame& F, int b, int h, int mode) {
    const bool prompt = (mode != 1);
    const int tid = F.tid, lane = F.lane, w = F.wave, r16 = lane & 15, q = lane >> 4;
    const int tk = tid >> 3, p = tid & 7;
    LAS unsigned char* L = F.lds;
    LAS float* GD = (LAS float*)(L + MX_GD); LAS float* OB = (LAS float*)(L + MX_OB);
    bf16* MIX = F_XN(F);
    f32x4 S[8];
#pragma unroll
    for (int mt = 0; mt < 8; ++mt) S[mt] = (f32x4){0.f, 0.f, 0.f, 0.f};
    if (!prompt) {
        const float* Sin = F.in[6] + (size_t)(b * 8 + h) * 16384;
#pragma unroll
        for (int mt = 0; mt < 8; ++mt)
#pragma unroll
            for (int r = 0; r < 4; ++r) S[mt][r] = Sin[(16 * mt + 4 * q + r) * 128 + 16 * w + r16];
    }
    LAS float* GN = (LAS float*)(L + MX_GN);
    if (tid < 128) GN[tid] = F.in[18][128 * h + tid];
    const int nsc = (mode == 0) ? 33 : 1;
    u32x4 pa[6]; u32x4 pg[2]; float pgd = 1.f;
    const u32x4 z4 = {0u, 0u, 0u, 0u};
#define HG_LOAD(scv) do { int row0_, ntok_, nmc_, pos0_; MX_SC_PARAMS(scv, row0_, ntok_, nmc_, pos0_); (void)pos0_; \
        const bool valid_ = tk < ntok_; const bf16* zr_ = ZROW(F, row0_ + (valid_ ? tk : 0), 1) + 128 * h + 16 * p; \
        _Pragma("unroll") for (int i_ = 0; i_ < 6; ++i_) pa[i_] = z4; \
        if (valid_) { pa[0] = *(const u32x4*)zr_; pa[1] = *(const u32x4*)(zr_ + 8); pa[2] = *(const u32x4*)(zr_ + 1024); pa[3] = *(const u32x4*)(zr_ + 1032); pa[4] = *(const u32x4*)(zr_ + 2048); pa[5] = *(const u32x4*)(zr_ + 2056); } \
        pgd = 1.f; if ((tid >> 7) < nmc_) pgd = (mode == 1) ? ((const float*)(F.ws + WS_GDS))[(size_t)b * 1024 + 128 * h + (tid & 127)] : ((const float*)(F.ws + WS_GD))[(size_t)((row0_ >> 4) + (tid >> 7)) * 1024 + 128 * h + (tid & 127)]; } while (0)
    HG_LOAD(0);
    MSTAMP_DECL
#pragma unroll 1
    for (int sc = 0; sc < nsc; ++sc) {
        int row0, ntok, nmc, pos0; MX_SC_PARAMS(sc, row0, ntok, nmc, pos0); (void)pos0;
        MSTAMP(8);
        {
            const int c0 = (MX_POS4(16 * p)) * 2;
#pragma unroll
            for (int g = 0; g < 4; ++g) {
                *(LAS u32x2*)(L + MX_Q + tk * MX_PITCH + c0 + 16 * g) = (u32x2){pa[g >> 1][2 * (g & 1)], pa[g >> 1][2 * (g & 1) + 1]};
                *(LAS u32x2*)(L + MX_K + tk * MX_PITCH + c0 + 16 * g) = (u32x2){pa[2 + (g >> 1)][2 * (g & 1)], pa[2 + (g >> 1)][2 * (g & 1) + 1]};
            }
            *(LAS u32x4*)(L + MX_V + tk * MX_PITCH + 32 * p) = pa[4]; *(LAS u32x4*)(L + MX_V + tk * MX_PITCH + 32 * p + 16) = pa[5];
            GD[tid] = pgd;
        }
        MSTAMP(9);
        __syncthreads();
        MSTAMP(10);
        if (sc + 1 < nsc) HG_LOAD(sc + 1);
        { const bool valid = tk < ntok; const bf16* zr = ZROW(F, row0 + (valid ? tk : 0), 1) + 3072 + 128 * h + 16 * p; pg[0] = *(const u32x4*)zr; pg[1] = *(const u32x4*)(zr + 8); }
        MSTAMP(11);
        if (nmc == 4) hg_chain<4>(L, S, w, r16, q); else hg_chain<1>(L, S, w, r16, q);
        MSTAMP(12);
        __syncthreads();
        MSTAMP(13);
        {
            const bool valid = tk < ntok; const int row = row0 + (valid ? tk : 0);
            f32x4 o[4];
#pragma unroll
            for (int c = 0; c < 4; ++c) o[c] = *(const LAS f32x4*)(OB + tk * MX_OP + 16 * p + 4 * c);
            if (tk >= 16 * nmc) {
#pragma unroll
                for (int c = 0; c < 4; ++c) o[c] = (f32x4){0.f, 0.f, 0.f, 0.f}; }
            float vs = 0.f;
#pragma unroll
            for (int c = 0; c < 4; ++c) vs += (o[c].x * o[c].x + o[c].y * o[c].y) + (o[c].z * o[c].z + o[c].w * o[c].w);
            vs += __shfl_xor(vs, 1); vs += __shfl_xor(vs, 2); vs += __shfl_xor(vs, 4);
            const float rstd = rsqrtf(vs * (1.f / 128.f) + EPS);
            if (valid && !(mode == 0 && sc == 0)) {
                unsigned ow[8];
#pragma unroll
                for (int c = 0; c < 4; ++c) {
                    const unsigned ga = c < 2 ? pg[0][2 * c] : pg[1][2 * c - 4], gb = c < 2 ? pg[0][2 * c + 1] : pg[1][2 * c - 3];
                    f32x4 gt = {bflo(ga), bfhi(ga), bflo(gb), bfhi(gb)};
#pragma unroll
                    for (int e = 0; e < 4; ++e) gt[e] = siluf_(gt[e]);
                    const f32x4 r = o[c] * rstd * *(const LAS f32x4*)(GN + 16 * p + 4 * c) * gt;
                    ow[2 * c] = pkbf(r.x, r.y); ow[2 * c + 1] = pkbf(r.z, r.w);
                }
                bf16* mp = MIX + (size_t)row * DM + 128 * h + 16 * p;
                *(u32x4*)mp = (u32x4){ow[0], ow[1], ow[2], ow[3]}; *(u32x4*)(mp + 8) = (u32x4){ow[4], ow[5], ow[6], ow[7]};
            }
        }
        MSTAMP(14);
    }
#undef HG_LOAD
    __syncthreads();
    if (mode != 2) {
        int l2 = F.lane; asm volatile("" : "+v"(l2)); const int r16 = l2 & 15, q = l2 >> 4;
        float* So = F.out + (prompt ? O_HP : O_HS) + (size_t)(b * 8 + h) * 16384;
#pragma unroll
        for (int mt = 0; mt < 8; ++mt)
#pragma unroll
            for (int r = 0; r < 4; ++r) So[(16 * mt + 4 * q + r) * 128 + 16 * w + r16] = S[mt][r];
    }
}

__device__ __forceinline__ void mixer_layer0(Frame& F) {
    const float* rot = (const float*)(F.ws + WS_ROT);
    int bid = blockIdx.x; asm volatile("" : "+s"(bid));
    if (bid < 64) { const int u = bid, ty = u >> 5, bh = u & 31; if (ty == 0) mix_sg_unit<0>(F, bh >> 2, bh & 3, 0, rot); else mix_sg_unit<1>(F, bh >> 2, bh & 3, 0, rot); return; }
#pragma unroll 1
    for (int u = bid - 64; u < 1024 + 8; u += F.G - 64) {
        int ty, bh, mode;
        if (u < 1024) { ty = u >> 9; bh = u & 511; mode = 1; } else { ty = (u - 1024) >> 2; bh = (u - 1024) & 3; mode = 2; }
        if (ty == 0) mix_sg_unit<0>(F, bh >> 2, bh & 3, mode, rot); else mix_sg_unit<1>(F, bh >> 2, bh & 3, mode, rot);
    }
}
__device__ __forceinline__ void mixer_layer1(Frame& F) {
    int bid = blockIdx.x; asm volatile("" : "+s"(bid));
    if (bid < 64) { mix_hg_unit(F, bid >> 3, bid & 7, 0); return; }
#pragma unroll 1
    for (int u = bid - 64; u < 1024 + 8; u += F.G - 64) {
        if (u < 1024) mix_hg_unit(F, u >> 3, u & 7, 1); else mix_hg_unit(F, 0, u - 1024, 2);
    }
}
constexpr int NSTEP = 18;
#ifndef P0_DEFER
#define P0_DEFER 1
#endif
constexpr int LDSCTL_OFF = 139264;
#define RLX_AGENT __ATOMIC_RELAXED, __HIP_MEMORY_SCOPE_AGENT
#define XB_TMO      128
#define XB_XCNT(j)  (256  + 64 * (j))
#define XB_XSUB(j)  (1280 + 64 * (j))
#define XB_XGEN(j)  (2304 + 64 * (j))
#define XB_TOP      3328
#define XB_TOPGEN   3392
#define XCD_BAR_WORDS 3456
#define XB_SPIN_CAP (1u << 18)

__device__ __forceinline__ unsigned xb_ld(unsigned* p)              { return __hip_atomic_load(p, __ATOMIC_RELAXED, __HIP_MEMORY_SCOPE_AGENT); }
__device__ __forceinline__ unsigned xb_add(unsigned* p, unsigned v) { return __hip_atomic_fetch_add(p, v, __ATOMIC_RELAXED, __HIP_MEMORY_SCOPE_AGENT); }
__device__ __forceinline__ unsigned xb_xcc_id() { return (unsigned)__builtin_amdgcn_s_getreg((3 << 11) | 20) & 0xFu; }
#define XB_SPIN(cond, bar) do { unsigned _sp = 0; while (cond) { __builtin_amdgcn_s_sleep(1); \
    if ((++_sp & 255u) == 0u) { if (xb_ld(&(bar)[XB_TMO])) break; if (_sp > XB_SPIN_CAP) { atomicAdd(&(bar)[XB_TMO], 1u); break; } } } } while (0)

struct XcdBarrier {
    unsigned gsz;
    unsigned* bar; unsigned x;
    volatile LAS unsigned* st;
};

__device__ __forceinline__ XcdBarrier xcd_barrier_post(unsigned* bar, volatile LAS unsigned* st, unsigned gsz) {
    XcdBarrier b; b.gsz = gsz; b.bar = bar; b.x = xb_xcc_id(); b.st = st;
    if (threadIdx.x == 0) (void)xb_add(&bar[XB_XCNT(b.x)], 1u);
    return b;
}
__device__ __forceinline__ void xcd_barrier_complete(unsigned* bar, unsigned x, unsigned G, unsigned& nloc, unsigned& nx) {
    unsigned sum, cnt, mine, sp = 0u;
    for (;;) {
        sum = 0u; cnt = 0u; mine = 0u;
#pragma unroll
        for (unsigned j = 0; j < 16; ++j) { const unsigned c = xb_ld(&bar[XB_XCNT(j)]); sum += c; cnt += (c > 0u) ? 1u : 0u; mine = (j == x) ? c : mine; }
        if (sum == G) break;
        __builtin_amdgcn_s_sleep(1);
        if ((++sp & 255u) == 0u) { if (xb_ld(&bar[XB_TMO])) break; if (sp > XB_SPIN_CAP) { atomicAdd(&bar[XB_TMO], 1u); break; } }
    }
    nloc = mine > 0u ? mine : 1u; nx = cnt > 0u ? cnt : 1u;
}

__device__ __forceinline__ void xcd_barrier(const XcdBarrier& b) {
    asm volatile("s_waitcnt vmcnt(0)" ::: "memory");
    __syncthreads();
    if (threadIdx.x == 0) {
        unsigned* bar = b.bar;
        __builtin_amdgcn_s_waitcnt(0);
        unsigned nloc = b.st[0], nx = b.st[1];
        if (nloc == 0u) { xcd_barrier_complete(bar, b.x, b.gsz, nloc, nx); b.st[0] = nloc; b.st[1] = nx; }
        const unsigned old = xb_add(&bar[XB_XSUB(b.x)], 1u);
        const unsigned gen = old / nloc;
        if (old + 1u == (gen + 1u) * nloc) {
            __builtin_amdgcn_fence(__ATOMIC_RELEASE, "agent");
            asm volatile("s_waitcnt vmcnt(0)" ::: "memory");
            const unsigned og = xb_add(&bar[XB_TOP], 1u);
            const unsigned tg = og / nx;
            if (og + 1u == (tg + 1u) * nx) xb_add(&bar[XB_TOPGEN], 1u);
            else XB_SPIN(xb_ld(&bar[XB_TOPGEN]) == tg, bar);
            __builtin_amdgcn_fence(__ATOMIC_ACQUIRE, "agent");
            xb_add(&bar[XB_XGEN(b.x)], 1u);
            asm volatile("s_waitcnt vmcnt(0)" ::: "memory");
        } else {
            XB_SPIN(xb_ld(&bar[XB_XGEN(b.x)]) == gen, bar);
            __builtin_amdgcn_fence(__ATOMIC_ACQUIRE, "agent");
            asm volatile("s_waitcnt vmcnt(0)" ::: "memory");
        }
    }
    __syncthreads();
}


enum { K_P0 = 0, K_IN = 1, K_MIX = 2, K_OUT = 3, K_UP = 5, K_FIX = 6, K_DOWN = 7, K_FINAL = 8 };
struct Step { int kind, layer, side, tile0, nt, pre; };
__device__ __forceinline__ Step get_step(int pc) {
    switch (pc) {
        case 0:  return Step{K_P0, 0, 0, 0, 0, 0};
        case 1:  return Step{K_IN, 0, 0, 0, 69, 1};
        case 2:  return Step{K_MIX, 0, 0, 0, 0, 1};
        case 3:  return Step{K_OUT, 0, 1, 64, 5, 2};
        case 4:  return Step{K_UP, 0, 1, 64, 5, 2};
        case 5:  return Step{K_DOWN, 0, 1, 64, 5, 2};
        case 6:  return Step{K_IN, 1, 1, 64, 5, 2};
        case 7:  return Step{K_OUT, 0, 0, 0, 64, 1};
        case 8:  return Step{K_UP, 0, 0, 0, 64, 1};
        case 9:  return Step{K_DOWN, 0, 0, 0, 64, 1};
        case 10: return Step{K_IN, 1, 0, 0, 64, 1};
        case 11: return Step{K_MIX, 1, 0, 0, 0, 1};
        case 12: return Step{K_OUT, 1, 1, 64, 5, 2};
        case 13: return Step{K_UP, 1, 1, 64, 5, 2};
        case 14: return Step{K_DOWN, 1, 1, 64, 5, 2};
        case 15: return Step{K_OUT, 1, 0, 0, 64, 1};
        case 16: return Step{K_UP, 1, 0, 0, 64, 1};
        default: return Step{K_DOWN, 1, 0, 0, 64, 1};
    }
}

__global__ void __launch_bounds__(NWAVES * 64, 2) fwd_kernel(Args args) {
    extern __shared__ __attribute__((aligned(16))) unsigned char lds_raw[];
    cg::grid_group grid = cg::this_grid();
    Frame F;
    F.lds = (LAS unsigned char*)lds_raw;
#define REFRESH() do { int t_ = threadIdx.x; asm volatile("" : "+v"(t_)); F.tid = t_; F.lane = t_ & 63; F.wave = __builtin_amdgcn_readfirstlane(t_ >> 6); F.gw = blockIdx.x * NWAVES + F.wave; } while (0)
    F.G = gridDim.x; F.NGW = F.G * NWAVES; REFRESH();
    F.in = args.in; F.out = args.out; F.ws = args.ws;
    volatile LAS unsigned* MISC = (volatile LAS unsigned*)(F.lds + LDSCTL_OFF);
    if (threadIdx.x < 16) MISC[threadIdx.x] = 0u;
    __syncthreads();
    const bool side_wg = blockIdx.x >= 64;
    (void)xcd_barrier_post((unsigned*)(args.ws + WS_CTL), MISC + 8, F.G);
    if (side_wg) (void)xcd_barrier_post((unsigned*)(args.ws + WS_CTL) + 4096, MISC + 10, F.G - 64);
#ifndef KMASK
#define KMASK 0x1ff
#endif
#define INK(kind) ((((KMASK) >> (kind)) & 1) != 0)
#ifndef PROBE_MULT
#define PROBE_MULT 1
#endif
#ifdef PROBE_BLOCK
    volatile LAS unsigned long long* STMP = (volatile LAS unsigned long long*)(F.lds + LDSCTL_OFF + 128);
    if (threadIdx.x < 64) STMP[threadIdx.x] = 0ull;
    __syncthreads();
#define STAMP(id) do { if (blockIdx.x == PROBE_BLOCK && threadIdx.x == 0) STMP[(id)] = __builtin_amdgcn_s_memrealtime(); } while (0)
#else
#define STAMP(id) do { } while (0)
#endif
#pragma unroll 1
    for (int pc = 0; pc < NSTEP; ++pc) {
        const Step st = get_step(pc);
        if (st.pre == 1) { if (args.ph_hi < 0) grid.sync();
            { XcdBarrier bar_; bar_.gsz = F.G; bar_.bar = (unsigned*)(args.ws + WS_CTL); bar_.x = xb_xcc_id(); bar_.st = (volatile LAS unsigned*)(F.lds + LDSCTL_OFF) + 8; xcd_barrier(bar_); } }
        if (st.side && !side_wg) continue;
        if (st.pre == 2) { XcdBarrier bar_; bar_.gsz = F.G - 64; bar_.bar = (unsigned*)(args.ws + WS_CTL) + 4096; bar_.x = xb_xcc_id(); bar_.st = (volatile LAS unsigned*)(F.lds + LDSCTL_OFF) + 10; xcd_barrier(bar_); }
        const int layer = st.layer;
        STAMP(2 * pc);
        const int Gs = st.side ? F.G - 64 : F.G, cs = st.side ? (int)blockIdx.x - 64 : (int)blockIdx.x;
        if (st.kind == K_P0) { if (INK(0)) { REFRESH(); p0_weights(F, 0, P0_DEFER ? P0_ITEMS_AB : P0_ITEMS_L0, F.gw, F.NGW); STAMP(42); __syncthreads(); REFRESH(); p0_rows(F); STAMP(43); REFRESH(); p0_rotary(F, (float*)(args.ws + WS_ROT)); p0_zero_ssq(F); STAMP(44); } }
        else if (st.kind == K_IN) { if (INK(1)) {
            pg8::Gemm g{F_XG(F), (const bf16*)(args.ws + (layer == 0 ? WS_WAB : WS_WC)), MPAD, 4096, 1024, 1024}; pg8::StaticOrder S; S.init(st.nt, 4096, Gs, cs, st.tile0);
            if (layer == 0) { EpiRot E{F_Z(F), F_ZS1(F, layer), 64, 4096, (const float*)(args.ws + WS_ROT)}; pg8::gemm_phase<EpiRot, pg8::StaticOrder, false>(F.lds, g, S, E);
                if (P0_DEFER) { const int nfull = (st.nt * 16) % Gs; if (nfull != 0 && cs >= nfull) { REFRESH(); p0_weights(F, P0_ITEMS_AB, P0_ITEMS_L0, (cs - nfull) * NWAVES + F.wave, (Gs - nfull) * NWAVES); } } }
            else { EpiHg E{F_Z(F), F_ZS1(F, layer), 64, 4096, (const float*)(args.ws + WS_LB), (float*)(args.ws + WS_GD), (float*)(args.ws + WS_GDS)}; pg8::gemm_phase<EpiHg, pg8::StaticOrder, false>(F.lds, g, S, E); } } }
        else if (st.kind == K_MIX) { if (INK(2)) {
            if (layer == 1 && side_wg) { REFRESH(); p0_weights(F, P0_ITEMS_L0, P0_ITEMS_ALL, (blockIdx.x - 64) * NWAVES + F.wave, (F.G - 64) * NWAVES); __syncthreads(); }
            REFRESH(); if (layer == 0) mixer_layer0(F); else mixer_layer1(F); } }
        else if (st.kind == K_OUT) { if (INK(3)) {
            pg8::Gemm g{F_XN(F), (const bf16*)(args.ws + (layer == 0 ? WS_WOAB : WS_WOC)), MPAD, 1024, 1024, 1024}; pg8::StaticOrder S; S.init(st.nt, 1024, Gs, cs, st.tile0);
            pg8::EpiResid<false> E{F_X0(F), F_X1(F), PM_META, DM, F_XG(F), (float*)nullptr, 0, F.in[20] + (size_t)layer * DM, F_SSQ(F, 2 * layer), (unsigned*)(args.ws + WS_PCNT) + (2 * layer) * 69 * 16, (float*)nullptr, (float*)nullptr, (unsigned*)nullptr, 0,
                layer == 0 ? F.in[0] : (const float*)nullptr, F.in[1] - (size_t)ROW_S * DM, F.in[8] - (size_t)ROW_M * DM, layer == 0 ? NREAL : MPAD};
            pg8::gemm_phase<pg8::EpiResid<false>, pg8::StaticOrder, false>(F.lds, g, S, E); } }
        else if (st.kind == K_UP) { if (INK(5)) {
            pg8::Gemm g{F_XG(F), (const bf16*)(args.ws + WS_WF1) + (size_t)layer * NFF * 1024, MPAD, NFF, 1024, 1024}; pg8::StaticOrder S; S.init(st.nt, NFF, Gs, cs, st.tile0);
            EpiFfn E{F_Z(F), F_HS1(F), F.in[22] + (size_t)layer * 3 * DFF, F.in[23] + (size_t)layer * DFF, F.in[7] + (size_t)layer * 128 * 2 * DFF, F.out + O_FS + (size_t)layer * 128 * 2 * DFF, F_SBL(F), F_SBF(F)};
            pg8::gemm_phase<EpiFfn, pg8::StaticOrder, true>(F.lds, g, S, E); } }
        else if (st.kind == K_DOWN) { if (INK(7)) {
            const bf16* Wd = (const bf16*)(args.ws + WS_WF2) + (size_t)layer * 1024 * DFF;
            float* Yo = layer == 0 ? (float*)nullptr : F.out; const float* gn = layer == 0 ? F.in[9] + DM : F.in[25];
            unsigned* pcnt = (unsigned*)(args.ws + WS_PCNT) + (2 * layer + 1) * 69 * 16;
            if (!st.side) {
                pg8::Gemm g{F_Z(F), Wd, MPAD, 1024, DFF, DFF}; pg8::StaticOrder S; S.init(st.nt, 1024, Gs, cs, st.tile0);
                { REFRESH(); pg8::StaticOrder S2; S2.init(st.nt, 1024, Gs, cs, st.tile0); pg8::Unit fu; for (int i = 0; S2.next(i, fu); ++i) ffn_fixup_tile(F, layer, fu.pm, fu.pn == 0); }
                asm volatile("s_waitcnt vmcnt(0)" ::: "memory"); __syncthreads();
                pg8::EpiResid<false> E{F_X0(F), F_X1(F), PM_META, DM, F_XG(F), Yo, ROW_M, gn, F_SSQ(F, 2 * layer + 1), pcnt, (float*)nullptr, (float*)nullptr, (unsigned*)nullptr, 0,
                    (const float*)nullptr, (const float*)nullptr, (const float*)nullptr, MPAD};
                pg8::gemm_phase<pg8::EpiResid<false>, pg8::StaticOrder, false>(F.lds, g, S, E);
            } else {
                const int nu = st.nt * 4; float* sl0 = (float*)(args.ws + WS_SLAB0); float* sl1 = (float*)(args.ws + WS_SLAB1); unsigned* sfl = (unsigned*)(args.ws + WS_SFLAG) + layer * 20 * 16;
                if (cs < nu) {
                    pg8::Gemm g{F_HS1(F), Wd, MPAD, 1024, DFF / 2, DFF}; pg8::StaticOrder S; S.init(st.nt, 1024, nu, cs, st.tile0);
                    pg8::EpiResid<true> E{F_X0(F), F_X1(F), PM_META, DM, F_XG(F), Yo, ROW_M, gn, F_SSQ(F, 2 * layer + 1), pcnt, sl0, sl1, sfl, st.tile0,
                        (const float*)nullptr, (const float*)nullptr, (const float*)nullptr, MPAD};
                    pg8::gemm_phase<pg8::EpiResid<true>, pg8::StaticOrder, false>(F.lds, g, S, E);
                } else if (cs < 2 * nu) {
                    pg8::Gemm g{F_HS1(F) + DFF / 2, Wd + DFF / 2, MPAD, 1024, DFF / 2, DFF}; pg8::StaticOrder S; S.init(st.nt, 1024, nu, cs - nu, st.tile0);
                    pg8::EpiSlab E{sl0, sl1, sfl, st.tile0};
                    pg8::gemm_phase<pg8::EpiSlab, pg8::StaticOrder, false>(F.lds, g, S, E);
                }
            } } }
        STAMP(2 * pc + 1);
    }
#ifdef PROBE_BLOCK
    if (blockIdx.x == PROBE_BLOCK && threadIdx.x == 0) { const unsigned long long d = (STMP[PROBE_B] - STMP[PROBE_A]) * PROBE_MULT, t0 = __builtin_amdgcn_s_memrealtime(); while (__builtin_amdgcn_s_memrealtime() - t0 < d) __builtin_amdgcn_s_sleep(8); }
#endif
#undef INK
#undef REFRESH
}

extern "C" void kernel_launch(void* const* d_in, const int* in_sizes, int n_in, void* d_out, int out_size, void* d_ws, size_t ws_size, hipStream_t stream) {
    static int grid = 0;
    if (grid == 0) {
        if (n_in != 26 || (size_t)out_size != O_END || ws_size < WS_END) { fprintf(stderr, "kernel_launch: unexpected shapes: n_in %d out %d ws %zu\n", n_in, out_size, ws_size); grid = -1; return; }
        int dev = 0, cus = 0, per_cu = 0;
        if (hipGetDevice(&dev) != hipSuccess || hipDeviceGetAttribute(&cus, hipDeviceAttributeMultiprocessorCount, dev) != hipSuccess) { grid = -1; return; }
        if (hipFuncSetAttribute((const void*)fwd_kernel, hipFuncAttributeMaxDynamicSharedMemorySize, LDS_BYTES) != hipSuccess) { fprintf(stderr, "kernel_launch: hipFuncSetAttribute failed\n"); grid = -1; return; }
        if (hipOccupancyMaxActiveBlocksPerMultiprocessor(&per_cu, (const void*)fwd_kernel, NWAVES * 64, LDS_BYTES) != hipSuccess || per_cu < 1) { fprintf(stderr, "kernel_launch: occupancy query says %d\n", per_cu); per_cu = 1; }
        (void)hipGetLastError();
        grid = cus;
        if (grid != 256) { fprintf(stderr, "kernel_launch: the fused row-norm exchange needs one unit per workgroup in the N = 1024 GEMM steps: exactly 256 CUs (got %d)\n", grid); grid = -1; return; }
        if (grid < 128) { fprintf(stderr, "kernel_launch: this kernel's static work split needs >= 128 CUs (got %d)\n", grid); grid = -1; return; }
    }
    if (grid < 0) return;
    if (hipMemsetAsync((char*)d_ws + WS_CTL, 0, CTL_ZERO_BYTES, stream) != hipSuccess) { fprintf(stderr, "kernel_launch: hipMemsetAsync failed\n"); return; }
    Args a{};
    for (int i = 0; i < 26; ++i) a.in[i] = (const float*)d_in[i];
    a.out = (float*)d_out; a.ws = (unsigned char*)d_ws;
    a.ph_lo = 0; a.ph_hi = NSTEP;
    void* kargs[] = {&a};
    hipError_t e = hipLaunchCooperativeKernel((const void*)fwd_kernel, dim3(grid), dim3(NWAVES * 64), kargs, LDS_BYTES, stream);
    if (e != hipSuccess) fprintf(stderr, "kernel_launch: cooperative launch failed: %s (grid %d)\n", hipGetErrorString(e), grid);
}
```
